# Optimizing an MI355X kernel written in HIP

```python
import math
import jax
import jax.numpy as jnp
from jax import lax
import numpy as np

D_MODEL = 2048
BATCH = 16
SEQ = 2048
DEPTH = 4
DEC_BATCH = 32
DEC_SEQ = 32
PAST_LEN = 1024

CHUNK = 64
A_DK = 128
A_DV = 128
A_W = D_MODEL // 2
A_HEADS = A_W // A_DK
B_W = D_MODEL // 2
B_HEADDIM = 64
B_HEADS = B_W // B_HEADDIM
B_GROUPS = 2
B_DSTATE = 128
CONV_W = 4
B_CONV_DIM = B_W + 2 * B_GROUPS * B_DSTATE
C_W = D_MODEL // 2
C_GROUPS = 4
CMLP_CHUNK = 128
N_BRANCH = 3
D_FF = 4 * D_MODEL
IN_SIZES = (A_W, A_W, A_W, A_W, B_W, B_CONV_DIM, B_HEADS, C_W, C_W, N_BRANCH * D_MODEL)
IN_TOTAL = 4 * A_W + B_W + B_CONV_DIM + B_HEADS + 2 * C_W + N_BRANCH * D_MODEL
NORM_EPS = 1e-6
LB_FLOOR = 1e-30

kernel_name = 'hybrid_hgrn2_ssd_gmlp_stream_step'


def rms_norm(x, g):
    xf = x.astype(jnp.float32)
    y = xf * lax.rsqrt(jnp.mean(xf * xf, axis=-1, keepdims=True) + NORM_EPS)
    return (y * g.astype(jnp.float32)).astype(x.dtype)


def group_rms_norm(x, g, groups):
    shp = x.shape
    xg = x.astype(jnp.float32).reshape(shp[:-1] + (groups, shp[-1] // groups))
    y = xg * lax.rsqrt(jnp.mean(xg * xg, axis=-1, keepdims=True) + NORM_EPS)
    return y.reshape(shp) * g.astype(jnp.float32)


def layer_norm(x, g, b):
    xf = x.astype(jnp.float32)
    mu = jnp.mean(xf, axis=-1, keepdims=True)
    var = jnp.mean(jnp.square(xf - mu), axis=-1, keepdims=True)
    y = (xf - mu) * lax.rsqrt(var + NORM_EPS) * g.astype(jnp.float32) + b.astype(jnp.float32)
    return y.astype(x.dtype)


def masked_exp(diff, mask):
    return jnp.where(mask, jnp.exp(jnp.where(mask, diff, 0.0)), 0.0)


def segsum_exp(cs):
    t = cs.shape[-1]
    mask = jnp.tril(jnp.ones((t, t), dtype=bool))
    return masked_exp(cs[..., :, None] - cs[..., None, :], mask)


def gla_chunked(q, k, v, log_f, s0, qc):
    bsz, L, H, _ = q.shape
    n = L // qc
    causal = jnp.tril(jnp.ones((qc, qc), dtype=bool))[None, :, :, None, None]

    def to_blocks(t):
        return jnp.moveaxis(t.reshape((bsz, n, qc) + t.shape[2:]), 1, 0)

    def step(s, inp):
        qb, kb, vb, gb = inp
        b = jnp.cumsum(gb, axis=1)
        o_inter = jnp.einsum('bthk,bhkv->bthv', qb * jnp.exp(b), s)
        decay = masked_exp(b[:, :, None] - b[:, None, :], causal)
        att = jnp.einsum('bthk,bshk,btshk->bhts', qb, kb, decay)
        o_intra = jnp.einsum('bhts,bshv->bthv', att, vb)
        b_last = b[:, -1]
        s_new = jnp.exp(b_last)[..., None] * s + jnp.einsum(
            'bshk,bshv->bhkv', kb * jnp.exp(b_last[:, None] - b), vb)
        return s_new, o_inter + o_intra

    s_fin, o = lax.scan(step, s0, (to_blocks(q), to_blocks(k), to_blocks(v), to_blocks(log_f)))
    o = jnp.moveaxis(o, 0, 1).reshape(bsz, L, H, v.shape[-1])
    return o, s_fin


def ssd_chunked(xh, dt, a_neg, bh, ch, s0, qc):
    bsz, L, H, P = xh.shape
    nc = L // qc

    def blk(t):
        return t.reshape((bsz, nc, qc) + t.shape[2:])

    x_, dt_, b_, c_ = blk(xh), blk(dt), blk(bh), blk(ch)
    a = jnp.moveaxis(dt_ * a_neg, -1, 1)
    a_cum = jnp.cumsum(a, axis=-1)
    lmat = segsum_exp(a_cum)
    xdt = x_ * dt_[..., None]
    y_diag = jnp.einsum('bclhn,bcshn,bhcls,bcshp->bclhp', c_, b_, lmat, xdt)
    decay_states = jnp.exp(a_cum[..., -1:] - a_cum)
    states = jnp.einsum('bcshn,bhcs,bcshp->bchpn', b_, decay_states, xdt)
    states = jnp.concatenate([s0[:, None], states], axis=1)
    chunk_cs = jnp.cumsum(jnp.pad(a_cum[..., -1], ((0, 0), (0, 0), (1, 0))), axis=-1)
    decay_chunk = segsum_exp(chunk_cs)
    new_states = jnp.einsum('bhzc,bchpn->bzhpn', decay_chunk, states)
    states_in, s_fin = new_states[:, :-1], new_states[:, -1]
    y_off = jnp.einsum('bclhn,bchpn,bhcl->bclhp', c_, states_in, jnp.exp(a_cum))
    return (y_diag + y_off).reshape(bsz, L, H, P), s_fin


def chunk_token_mix(v, ws, bs):
    bsz, L, W = v.shape
    lc = min(L, CMLP_CHUNK)
    n = L // lc
    w = jnp.tril(ws)[:, :lc, :lc]
    vv = v.reshape(bsz, n, lc, C_GROUPS, W // C_GROUPS)
    out = jnp.einsum('gts,bnsgd->bntgd', w, vv) + bs[:, :lc].T[None, None, :, :, None]
    return out.reshape(bsz, L, W)


def sq_relu_mlp(h, w_up, w_down):
    return jnp.square(jax.nn.relu(h @ w_up)) @ w_down


def mixer_block(h, s_hgrn, s_ssm, conv_buf, lb, w_in, hgrn_onorm_g, ssm_conv_w, ssm_conv_b,
                ssm_dt_bias, ssm_a_log, ssm_d, ssm_onorm_g, cmlp_ln_g, cmlp_ln_b, cmlp_ws, cmlp_bs,
                w_branch, w_out):
    bsz, L, _ = h.shape
    dtp = h.dtype
    f32 = jnp.float32
    qc = min(L, CHUNK)
    split_at = [int(i) for i in np.cumsum(IN_SIZES)[:-1]]
    a_q, a_f, a_i, a_g, b_z, b_xbc, b_dt, c_u, c_v, gate_in = jnp.split(h @ w_in, split_at, axis=-1)

    lbf = lb.astype(f32).reshape(A_HEADS, A_DK)
    zf = a_f.astype(f32).reshape(bsz, L, A_HEADS, A_DK)
    log_lb = jnp.log(jnp.maximum(lbf, LB_FLOOR))
    log_f = jnp.logaddexp(log_lb, jnp.log1p(-lbf) + jax.nn.log_sigmoid(zf))
    k_in = (1.0 - lbf) * jax.nn.sigmoid(-zf)
    q = jax.nn.silu(a_q.astype(f32)).reshape(bsz, L, A_HEADS, A_DK)
    i_v = a_i.astype(f32).reshape(bsz, L, A_HEADS, A_DV)
    o_a, s_hgrn_new = gla_chunked(q, k_in, i_v, log_f, s_hgrn.astype(f32), qc)
    y_a = group_rms_norm(o_a.reshape(bsz, L, A_W), hgrn_onorm_g, A_HEADS) * jax.nn.silu(a_g.astype(f32))

    xpad = jnp.concatenate([conv_buf.astype(dtp), b_xbc], axis=1)
    conv = ssm_conv_b.astype(dtp)
    for j in range(CONV_W):
        conv = conv + xpad[:, j:j + L] * ssm_conv_w[j]
    xbc = jax.nn.silu(conv)
    conv_new = xpad[:, L:]
    x_s, b_s, c_s = jnp.split(xbc, [B_W, B_W + B_GROUPS * B_DSTATE], axis=-1)
    rep = B_HEADS // B_GROUPS
    xh = x_s.astype(f32).reshape(bsz, L, B_HEADS, B_HEADDIM)
    bh = jnp.repeat(b_s.astype(f32).reshape(bsz, L, B_GROUPS, B_DSTATE), rep, axis=2)
    ch = jnp.repeat(c_s.astype(f32).reshape(bsz, L, B_GROUPS, B_DSTATE), rep, axis=2)
    dt = jax.nn.softplus(b_dt.astype(f32) + ssm_dt_bias.astype(f32))
    a_neg = -jnp.exp(ssm_a_log.astype(f32))
    y_b, s_ssm_new = ssd_chunked(xh, dt, a_neg, bh, ch, s_ssm.astype(f32), qc)
    y_b = (y_b + ssm_d.astype(f32)[:, None] * xh).reshape(bsz, L, B_W)
    y_b = group_rms_norm(y_b * jax.nn.silu(b_z.astype(f32)), ssm_onorm_g, B_GROUPS)

    u = jax.nn.gelu(c_u, approximate=False)
    v = layer_norm(jax.nn.gelu(c_v, approximate=False), cmlp_ln_g, cmlp_ln_b)
    y_c = u * chunk_token_mix(v, cmlp_ws, cmlp_bs)

    gates = jax.nn.sigmoid(gate_in).reshape(bsz, L, N_BRANCH, D_MODEL)
    merged = (gates[:, :, 0] * (y_a.astype(dtp) @ w_branch[:A_W])
              + gates[:, :, 1] * (y_b.astype(dtp) @ w_branch[A_W:A_W + B_W])
              + gates[:, :, 2] * (y_c @ w_branch[A_W + B_W:]))
    return (merged @ w_out, s_hgrn_new, s_ssm_new, conv_new, v)


def run_trunk(x, c, st_hgrn, st_ssm, st_conv, lbs, keep_chunk_rows, norm1_g, norm2_g, w_mod, b_mod,
              w_in, hgrn_onorm_g, ssm_conv_w, ssm_conv_b, ssm_dt_bias, ssm_a_log, ssm_d, ssm_onorm_g,
              cmlp_ln_g, cmlp_ln_b, cmlp_ws, cmlp_bs, w_branch, w_out, w_up, w_down, final_g):
    cs = jax.nn.silu(c)
    hgrn_out, ssm_out, conv_out, v_out = [], [], [], []
    for l in range(DEPTH):
        mod = cs @ w_mod[l] + b_mod[l]
        sh1, sc1, g1, sh2, sc2, g2 = [m[:, None, :] for m in jnp.split(mod, 6, axis=-1)]
        h = rms_norm(x, norm1_g[l]) * (1 + sc1) + sh1
        y, s_h, s_s, cb, v = mixer_block(
            h, st_hgrn[l], st_ssm[l], st_conv[l], lbs[l], w_in[l], hgrn_onorm_g[l], ssm_conv_w[l],
            ssm_conv_b[l], ssm_dt_bias[l], ssm_a_log[l], ssm_d[l], ssm_onorm_g[l], cmlp_ln_g[l],
            cmlp_ln_b[l], cmlp_ws[l], cmlp_bs[l], w_branch[l], w_out[l])
        x = x + g1 * y
        h = rms_norm(x, norm2_g[l]) * (1 + sc2) + sh2
        x = x + g2 * sq_relu_mlp(h, w_up[l], w_down[l])
        hgrn_out.append(s_h.astype(x.dtype))
        ssm_out.append(s_s.astype(x.dtype))
        conv_out.append(cb.astype(x.dtype))
        if keep_chunk_rows:
            v_out.append(v)
    y = rms_norm(x, final_g)
    v_stack = jnp.stack(v_out) if keep_chunk_rows else None
    return (y, jnp.stack(hgrn_out), jnp.stack(ssm_out), jnp.stack(conv_out), v_stack)


def setup_inputs(seed: int = 0) -> dict:
    key = jax.random.key(seed)
    ks = jax.random.split(key, 32)
    f32 = jnp.float32

    def nrm(k, shape, s):
        return s * jax.random.normal(k, shape, f32)

    dt0 = jnp.exp(jax.random.uniform(ks[16], (DEPTH, B_HEADS), f32, math.log(1e-3), math.log(1e-1)))
    return {
        'x_prompt': nrm(ks[0], (BATCH, SEQ, D_MODEL), 1.0),
        'x_sample': nrm(ks[1], (DEC_BATCH, DEC_SEQ, D_MODEL), 1.0),
        'state_hgrn': nrm(ks[2], (DEPTH, DEC_BATCH, A_HEADS, A_DK, A_DV), 0.5),
        'state_ssm': nrm(ks[3], (DEPTH, DEC_BATCH, B_HEADS, B_HEADDIM, B_DSTATE), 0.1),
        'state_conv': nrm(ks[4], (DEPTH, DEC_BATCH, CONV_W - 1, B_CONV_DIM), 1.0),
        'c_prompt': nrm(ks[5], (BATCH, D_MODEL), 1.0),
        'c_sample': nrm(ks[6], (DEC_BATCH, D_MODEL), 1.0),
        'norm1_g': 1.0 + nrm(ks[7], (DEPTH, D_MODEL), 0.05),
        'norm2_g': 1.0 + nrm(ks[8], (DEPTH, D_MODEL), 0.05),
        'w_mod': nrm(ks[9], (DEPTH, D_MODEL, 6 * D_MODEL), 0.5 * D_MODEL ** -0.5),
        'b_mod': nrm(ks[10], (DEPTH, 6 * D_MODEL), 0.1),
        'w_in': nrm(ks[11], (DEPTH, D_MODEL, IN_TOTAL), D_MODEL ** -0.5),
        'hgrn_lb': nrm(ks[12], (DEPTH, A_W), 0.5),
        'hgrn_onorm_g': 1.0 + nrm(ks[13], (DEPTH, A_W), 0.05),
        'ssm_conv_w': nrm(ks[14], (DEPTH, CONV_W, B_CONV_DIM), CONV_W ** -0.5),
        'ssm_conv_b': nrm(ks[15], (DEPTH, B_CONV_DIM), 0.02),
        'ssm_dt_bias': dt0 + jnp.log(-jnp.expm1(-dt0)),
        'ssm_a_log': jnp.log(jax.random.uniform(ks[17], (DEPTH, B_HEADS), f32, 1.0, 16.0)),
        'ssm_d': 1.0 + nrm(ks[18], (DEPTH, B_HEADS), 0.1),
        'ssm_onorm_g': 1.0 + nrm(ks[19], (DEPTH, B_W), 0.05),
        'cmlp_ln_g': 1.0 + nrm(ks[20], (DEPTH, C_W), 0.05),
        'cmlp_ln_b': nrm(ks[21], (DEPTH, C_W), 0.02),
        'cmlp_ws': nrm(ks[22], (DEPTH, C_GROUPS, CMLP_CHUNK, CMLP_CHUNK), CMLP_CHUNK ** -0.5),
        'cmlp_bs': 1.0 + nrm(ks[23], (DEPTH, C_GROUPS, CMLP_CHUNK), 0.1),
        'w_branch': nrm(ks[24], (DEPTH, A_W + B_W + C_W, D_MODEL), A_W ** -0.5),
        'w_out': nrm(ks[25], (DEPTH, D_MODEL, D_MODEL), D_MODEL ** -0.5),
        'w_up': nrm(ks[26], (DEPTH, D_MODEL, D_FF), D_MODEL ** -0.5),
        'w_down': nrm(ks[27], (DEPTH, D_FF, D_MODEL), D_FF ** -0.5),
        'final_g': 1.0 + nrm(ks[28], (D_MODEL,), 0.05),
    }


def reference(x_prompt, x_sample, state_hgrn, state_ssm, state_conv, c_prompt, c_sample, norm1_g,
              norm2_g, w_mod, b_mod, w_in, hgrn_lb, hgrn_onorm_g, ssm_conv_w, ssm_conv_b, ssm_dt_bias,
              ssm_a_log, ssm_d, ssm_onorm_g, cmlp_ln_g, cmlp_ln_b, cmlp_ws, cmlp_bs, w_branch, w_out,
              w_up, w_down, final_g):
    p = jax.nn.softmax(hgrn_lb.astype(jnp.float32), axis=0)
    lbs = jnp.cumsum(p, axis=0) - p[0]
    weights = (norm1_g, norm2_g, w_mod, b_mod, w_in, hgrn_onorm_g, ssm_conv_w, ssm_conv_b, ssm_dt_bias,
               ssm_a_log, ssm_d, ssm_onorm_g, cmlp_ln_g, cmlp_ln_b, cmlp_ws, cmlp_bs, w_branch, w_out,
               w_up, w_down, final_g)
    zero_hgrn = jnp.zeros((DEPTH, BATCH, A_HEADS, A_DK, A_DV), jnp.float32)
    zero_ssm = jnp.zeros((DEPTH, BATCH, B_HEADS, B_HEADDIM, B_DSTATE), jnp.float32)
    zero_conv = jnp.zeros((DEPTH, BATCH, CONV_W - 1, B_CONV_DIM), x_prompt.dtype)
    y_prompt, hgrn_p, ssm_p, conv_p, _ = run_trunk(
        x_prompt, c_prompt, zero_hgrn, zero_ssm, zero_conv, lbs, False, *weights)
    y_sample, hgrn_s, ssm_s, conv_s, cmlp_v_s = run_trunk(
        x_sample, c_sample, state_hgrn, state_ssm, state_conv, lbs, True, *weights)
    return (y_prompt, y_sample, hgrn_p, ssm_p, conv_p, hgrn_s, ssm_s, conv_s, cmlp_v_s)
```

```cpp
#include <hip/hip_runtime.h>
#include <cstdio>
#include <cstdint>
namespace pg8 {
#define PG8_LAS __attribute__((address_space(3)))
typedef unsigned short bf16_t;
typedef short bf16x8 __attribute__((ext_vector_type(8)));
typedef float f32x4 __attribute__((ext_vector_type(4)));
typedef unsigned u32x4 __attribute__((ext_vector_type(4)));
constexpr int BM = 256, BK = 64, HALF = 128, HTB = HALF * BK * 2  , STAGE_BYTES = 8 * HTB, NXCD = 8, WGM = 4;

__host__ __device__ __forceinline__ int lds_byte(int r, int c) { const int st = (r >> 4) * 2 + (c >> 5), rr = r & 15, cc = c & 31, ob = rr * 64 + cc * 2; return st * 1024 + (ob ^ (((ob >> 9) & 1) << 5)); }
__host__ __device__ __forceinline__ void stage_rc(int b, int& R, int& C) { const int st = b / 1024, sb = b % 1024, swz = sb ^ (((sb >> 9) & 1) << 5); R = (st >> 1) * 16 + swz / 64; C = (st & 1) * 32 + (swz % 64) / 2; }
__host__ __device__ __forceinline__ int perm32(int rho) { const int n = rho >> 4, i = rho & 15; return 8 * (i >> 2) + 4 * n + (i & 3); }

struct Unit { int pm, pn, ko, aux; };
struct Gemm { const bf16_t* A; const bf16_t* Bt; int M, N, K, ld; };

struct StaticOrder {
    int nM, nN, nwg, G, c, nlim, rev, wgm, off;
    __host__ __device__ void init(int M, int N, int G_, int c_) { nM = M / BM; nN = N / BM; nwg = nM * nN; G = G_; c = c_; nlim = nwg; rev = 0; wgm = WGM; off = 0; }
    __host__ __device__ void tile_of(int wgid, Unit& u) const {
        { const int q = nwg / NXCD, r = nwg % NXCD, xcd = wgid % NXCD, off = wgid / NXCD; wgid = (xcd < r ? xcd * (q + 1) : r * (q + 1) + (xcd - r) * q) + off; }
        const int nig = wgm * nN, gid = wgid / nig, fm = gid * wgm, gsz = (nM - fm) < wgm ? (nM - fm) : wgm;
        u.pm = fm + ((wgid % nig) % gsz); u.pn = (wgid % nig) / gsz; u.ko = 0; u.aux = 0; if (rev) u.pm = nM - 1 - u.pm; }
    __host__ __device__ bool next(int i, Unit& u) const {
        const long L = (long)i * G + c + off; if (L >= nlim) return false;
        tile_of((int)L, u); return true;
    }
    __device__ __forceinline__ void a_ready(const Unit&) const {}
    __device__ __forceinline__ void done(const Unit&) const {}
};
typedef float pg8_f32x2 __attribute__((ext_vector_type(2))); typedef __bf16 pg8_bf16x2 __attribute__((ext_vector_type(2)));
__device__ __forceinline__ unsigned cvt_pk_bf16(float lo, float hi) { const pg8_f32x2 v = {lo, hi}; const pg8_bf16x2 b = __builtin_convertvector(v, pg8_bf16x2); return __builtin_bit_cast(unsigned, b); }
typedef unsigned u32x2 __attribute__((ext_vector_type(2)));
__device__ __forceinline__ float bf_lo(unsigned w) { return __uint_as_float(w << 16); }
__device__ __forceinline__ float bf_hi(unsigned w) { return __uint_as_float(w & 0xffff0000u); }
__device__ __forceinline__ float fast_sigmoid(float x) { return __builtin_amdgcn_rcpf(1.0f + __builtin_amdgcn_exp2f(-1.44269504089f * x)); }

#ifndef EPI_NT_STORE
#define EPI_NT_STORE 0
#endif
template <int ACT> struct EpiStore {
    static constexpr bool PERM = true, AFTER_DRAIN = false;
    bf16_t* O; int ldc;
    __device__ __forceinline__ void operator()(const f32x4 (&acc)[2][2][4][2], const Unit& u, int wr, int wc, int fr, int fq) const {
        const int row0 = u.pm * BM + wr * 64 + fr, col0 = u.pn * BM + wc * 32 + 8 * fq;
#pragma unroll
        for (int ai = 0; ai < 2; ++ai)
#pragma unroll
            for (int m = 0; m < 4; ++m) { bf16_t* rowp = O + (size_t)(row0 + ai * HALF + m * 16) * ldc + col0;
#pragma unroll
                for (int bj = 0; bj < 2; ++bj) { f32x4 v0 = acc[ai][bj][m][0], v1 = acc[ai][bj][m][1];
                    if (ACT == 1) {
#pragma unroll
                        for (int j = 0; j < 4; ++j) { const float a = fmaxf(v0[j], 0.f), b = fmaxf(v1[j], 0.f); v0[j] = a * a; v1[j] = b * b; } }
                    u32x4 w; w.x = cvt_pk_bf16(v0[0], v0[1]); w.y = cvt_pk_bf16(v0[2], v0[3]); w.z = cvt_pk_bf16(v1[0], v1[1]); w.w = cvt_pk_bf16(v1[2], v1[3]);
                    if (EPI_NT_STORE) __builtin_nontemporal_store(w, (u32x4*)(rowp + bj * HALF)); else *(u32x4*)(rowp + bj * HALF) = w; } }
    }
};

struct EpiBranch {
    static constexpr bool PERM = true, AFTER_DRAIN = false;
    const bf16_t* P; int ldp; int gate_off; bf16_t* MG; int ldm; int npm, npn;
    __device__ __forceinline__ void operator()(const f32x4 (&acc)[2][2][4][2], const Unit& u, int wr, int wc, int fr, int fq) const {
        const int k = u.pm / npm, pm = u.pm - k * npm, pn = u.pn - k * npn;
        const int row0 = pm * BM + wr * 64 + fr, col0 = pn * BM + wc * 32 + 8 * fq;
#pragma unroll
        for (int ai = 0; ai < 2; ++ai)
#pragma unroll
            for (int m = 0; m < 4; ++m) { const size_t r = (size_t)(row0 + ai * HALF + m * 16);
                const bf16_t* gp = P + r * ldp + gate_off + k * 2048 + col0; bf16_t* mp = MG + r * ldm + col0;
#pragma unroll
                for (int bj = 0; bj < 2; ++bj) { const u32x4 g = *(const u32x4*)(gp + bj * HALF);
                    f32x4 v0 = acc[ai][bj][m][0], v1 = acc[ai][bj][m][1];
                    v0[0] *= fast_sigmoid(bf_lo(g.x)); v0[1] *= fast_sigmoid(bf_hi(g.x)); v0[2] *= fast_sigmoid(bf_lo(g.y)); v0[3] *= fast_sigmoid(bf_hi(g.y));
                    v1[0] *= fast_sigmoid(bf_lo(g.z)); v1[1] *= fast_sigmoid(bf_hi(g.z)); v1[2] *= fast_sigmoid(bf_lo(g.w)); v1[3] *= fast_sigmoid(bf_hi(g.w));
                    if (k > 0) { const u32x4 p = *(const u32x4*)(mp + bj * HALF);
                        v0[0] += bf_lo(p.x); v0[1] += bf_hi(p.x); v0[2] += bf_lo(p.y); v0[3] += bf_hi(p.y);
                        v1[0] += bf_lo(p.z); v1[1] += bf_hi(p.z); v1[2] += bf_lo(p.w); v1[3] += bf_hi(p.w); }
                    u32x4 w; w.x = cvt_pk_bf16(v0[0], v0[1]); w.y = cvt_pk_bf16(v0[2], v0[3]); w.z = cvt_pk_bf16(v1[0], v1[1]); w.w = cvt_pk_bf16(v1[2], v1[3]);
                    *(u32x4*)(mp + bj * HALF) = w; }
                if (m == 3) asm volatile("" ::: "memory"); }
    }
};

struct EpiRes {
    static constexpr bool PERM = true, AFTER_DRAIN = false;
    bf16_t* X; const float* gmod; int gstride;
    __device__ __forceinline__ void operator()(const f32x4 (&acc)[2][2][4][2], const Unit& u, int wr, int wc, int fr, int fq) const {
        const int row0 = u.pm * BM + wr * 64 + fr, col0 = u.pn * BM + wc * 32 + 8 * fq;
#pragma unroll
        for (int ai = 0; ai < 2; ++ai)
#pragma unroll
            for (int m = 0; m < 4; ++m) { const int r = row0 + ai * HALF + m * 16;
                const int seq = r < 32768 ? (r >> 11) : 16 + ((r - 32768) >> 5);
                const float* gp = gmod + (size_t)seq * gstride + col0; bf16_t* xp = X + (size_t)r * 2048 + col0;
#pragma unroll
                for (int bj = 0; bj < 2; ++bj) { const f32x4 g0 = *(const f32x4*)(gp + bj * HALF), g1 = *(const f32x4*)(gp + bj * HALF + 4); const u32x4 b = *(const u32x4*)(xp + bj * HALF);
                    const f32x4 v0 = acc[ai][bj][m][0] * g0, v1 = acc[ai][bj][m][1] * g1;
                    u32x4 w; w.x = cvt_pk_bf16(bf_lo(b.x) + v0[0], bf_hi(b.x) + v0[1]); w.y = cvt_pk_bf16(bf_lo(b.y) + v0[2], bf_hi(b.y) + v0[3]);
                    w.z = cvt_pk_bf16(bf_lo(b.z) + v1[0], bf_hi(b.z) + v1[1]); w.w = cvt_pk_bf16(bf_lo(b.w) + v1[2], bf_hi(b.w) + v1[3]);
                    *(u32x4*)(xp + bj * HALF) = w; }
                if (m == 3) asm volatile("" ::: "memory"); }
    }
};

struct BranchOrder {
    int G, c, npm, npn, ntile;
    __device__ void init(int npm_, int npn_, int G_, int c_) { npm = npm_; npn = npn_; ntile = npm_ * npn_; G = G_; c = c_; }
    __device__ bool next(int i, Unit& u) const {
        const int ti = i / 3, k = i - 3 * ti; const long L = (long)ti * G + c; if (L >= ntile) return false;
        int wgid = (int)L; { const int q = ntile / NXCD, r = ntile % NXCD, xcd = wgid % NXCD, off = wgid / NXCD; wgid = (xcd < r ? xcd * (q + 1) : r * (q + 1) + (xcd - r) * q) + off; }
        const int nig = WGM * npn, gid = wgid / nig, fm = gid * WGM, gsz = (npm - fm) < WGM ? (npm - fm) : WGM;
        u.pm = k * npm + fm + ((wgid % nig) % gsz); u.pn = k * npn + (wgid % nig) / gsz; u.ko = 0; u.aux = 0; return true;
    }
    __device__ __forceinline__ void a_ready(const Unit&) const {}
    __device__ __forceinline__ void done(const Unit&) const {}
};


struct EpiResAtomic {
    static constexpr bool PERM = false, AFTER_DRAIN = false;
    float* out; const float* gmod;
    __device__ __forceinline__ void operator()(const f32x4 (&acc)[2][2][4][2], const Unit& u, int wr, int wc, int fr, int fq) const {
        const int row0 = u.pm * BM + wr * 64 + fr, col0 = u.pn * BM + wc * 32 + 4 * fq;
#pragma unroll
        for (int ai = 0; ai < 2; ++ai)
#pragma unroll
            for (int m = 0; m < 4; ++m) { const int r = row0 + ai * HALF + m * 16;
                const int seq = r < 32768 ? (r >> 11) : 16 + ((r - 32768) >> 5);
                const float* gp = gmod + (size_t)seq * 12288 + col0; float* op = out + (size_t)r * 2048 + col0;
#pragma unroll
                for (int bj = 0; bj < 2; ++bj)
#pragma unroll
                    for (int n = 0; n < 2; ++n) { const f32x4 g = *(const f32x4*)(gp + bj * HALF + n * 16); const f32x4 v = g * acc[ai][bj][m][n]; float* o = op + bj * HALF + n * 16;
                        typedef __attribute__((address_space(1))) float gfloat; gfloat* og = (gfloat*)o;
                        (void)__builtin_amdgcn_global_atomic_fadd_f32(og + 0, v.x); (void)__builtin_amdgcn_global_atomic_fadd_f32(og + 1, v.y); (void)__builtin_amdgcn_global_atomic_fadd_f32(og + 2, v.z); (void)__builtin_amdgcn_global_atomic_fadd_f32(og + 3, v.w); } }
    }
};
struct TailOrder {
    StaticOrder base; int nfull, SL, Ks;
    __device__ void init(const StaticOrder& b, int nfull_, int SL_, int Ks_) { base = b; nfull = nfull_; SL = SL_; Ks = Ks_; }
    __device__ bool next(int i, Unit& u) const { const long L = (long)i * base.G + base.c; if (L >= (long)(base.nwg - nfull) * SL) return false;
        const int t = (int)L / SL, sl = (int)L - t * SL; base.tile_of(nfull + t, u); u.ko = sl * Ks; u.aux = (int)L; return true; }
    __device__ __forceinline__ void a_ready(const Unit&) const {}
    __device__ __forceinline__ void done(const Unit&) const {}
};

struct EpiSlab {
    static constexpr bool PERM = false, AFTER_DRAIN = false;
    float* slab; const float* gmod;
    __device__ __forceinline__ void operator()(const f32x4 (&acc)[2][2][4][2], const Unit& u, int wr, int wc, int fr, int fq) const {
        const int rt0 = wr * 64 + fr, ct0 = wc * 32 + 4 * fq; float* sb = slab + (size_t)u.aux * 65536;
#pragma unroll
        for (int ai = 0; ai < 2; ++ai)
#pragma unroll
            for (int m = 0; m < 4; ++m) { const int rt = rt0 + ai * HALF + m * 16, r = u.pm * BM + rt;
                const int seq = r < 32768 ? (r >> 11) : 16 + ((r - 32768) >> 5);
                const float* gp = gmod + (size_t)seq * 12288 + u.pn * BM + ct0; float* op = sb + rt * 256 + ct0;
#pragma unroll
                for (int bj = 0; bj < 2; ++bj)
#pragma unroll
                    for (int n = 0; n < 2; ++n) { const f32x4 g = *(const f32x4*)(gp + bj * HALF + n * 16); *(f32x4*)(op + bj * HALF + n * 16) = g * acc[ai][bj][m][n]; } }
    }
};
template <class Epi, class Sched, bool ALIGN_EPI = false, bool SP2 = false, int A_AUX = 0, int B_AUX = 0>
__device__ __forceinline__ void gemm_phase(PG8_LAS unsigned char* lds, const Gemm g, const Sched& S, const Epi& E, int tid_in) {
    int tid_ = tid_in; asm volatile("" : "+v"(tid_));
    const int tid = tid_, wid = __builtin_amdgcn_readfirstlane(tid >> 6), lane = tid & 63, wr = wid >> 2, wc = wid & 3, fr = lane & 15, fq = lane >> 4;
    const int K = g.K, ld = g.ld, nt = K / BK;
    unsigned voffA[2], voffB[2];
#pragma unroll
    for (int i = 0; i < 2; ++i) { int R, C; stage_rc(tid * 16 + i * 8192, R, C); const int Rb = Epi::PERM ? ((R & ~31) + perm32(R & 31)) : R;
        voffA[i] = (unsigned)(R * ld + C) * 2u; voffB[i] = (unsigned)(Rb * ld + C) * 2u; }
    const size_t kstep = (size_t)(BK * 2);
    const size_t hstep = (size_t)HALF * ld * 2;
    const size_t tstep = 2 * hstep;
    const unsigned ldsw = (unsigned)wid * 1024u;
    const int aoff = lds_byte(wr * 64 + fr, fq * 8), boff = lds_byte(wc * 32 + fr, fq * 8);
#define PG8_SA(b, h) (((b) * 2 + (h)) * HTB)
#define PG8_SB(b, h) ((4 + (b) * 2 + (h)) * HTB)
#define PG8_STAGE(bufoff, gbase, voff) do { _Pragma("unroll") for (int _i = 0; _i < 2; ++_i) \
        __builtin_amdgcn_global_load_lds((const unsigned*)((const char*)(gbase) + (voff)[_i]), (PG8_LAS unsigned*)(lds + (bufoff) + ldsw + _i * 8192), 16, 0, B_AUX); } while (0)
#define PG8_STAGEA(bufoff, gbase, voff) do { _Pragma("unroll") for (int _i = 0; _i < 2; ++_i) \
        __builtin_amdgcn_global_load_lds((const unsigned*)((const char*)(gbase) + (voff)[_i]), (PG8_LAS unsigned*)(lds + (bufoff) + ldsw + _i * 8192), 16, 0, A_AUX); } while (0)
#define PG8_LDA(dst, b, h) do { _Pragma("unroll") for (int m = 0; m < 4; ++m) _Pragma("unroll") for (int k = 0; k < 2; ++k) dst[m][k] = *(const PG8_LAS bf16x8*)(lds + PG8_SA(b, h) + aoff + m * 2048 + k * 1024); } while (0)
#define PG8_LDB(dst, b, h) do { _Pragma("unroll") for (int n = 0; n < 2; ++n) _Pragma("unroll") for (int k = 0; k < 2; ++k) dst[n][k] = *(const PG8_LAS bf16x8*)(lds + PG8_SB(b, h) + boff + n * 2048 + k * 1024); } while (0)
#define PG8_MMA(ai, bj, At, Bt) do { __builtin_amdgcn_s_setprio(1); _Pragma("unroll") for (int m = 0; m < 4; ++m) _Pragma("unroll") for (int n = 0; n < 2; ++n) _Pragma("unroll") for (int k = 0; k < 2; ++k) \
        acc[ai][bj][m][n] = __builtin_amdgcn_mfma_f32_16x16x32_bf16(Bt[n][k], At[m][k], acc[ai][bj][m][n], 0, 0, 0); __builtin_amdgcn_s_setprio(0); } while (0)
#define PG8_WAIT_V(n) asm volatile("s_waitcnt vmcnt(" #n ")" ::: "memory")
#define PG8_WAIT_L(n) asm volatile("s_waitcnt lgkmcnt(" #n ")" ::: "memory")
#define PG8_BAR __builtin_amdgcn_s_barrier()
#define PG8_SCHED __builtin_amdgcn_sched_barrier(0)
    Unit cur, nxt; int ui = 0;
    if (!S.next(0, cur)) return;
    f32x4 acc[2][2][4][2];
#pragma unroll
    for (int a = 0; a < 2; ++a)
#pragma unroll
        for (int b = 0; b < 2; ++b)
#pragma unroll
            for (int m = 0; m < 4; ++m)
#pragma unroll
                for (int n = 0; n < 2; ++n) acc[a][b][m][n] = (f32x4){0.f, 0.f, 0.f, 0.f};
    bf16x8 At[4][2], B0[2][2], B1[2][2];
    const char* cA = (const char*)g.A + (size_t)cur.pm * tstep + (size_t)cur.ko * 2; const char* cB = (const char*)g.Bt + (size_t)cur.pn * tstep + (size_t)cur.ko * 2;
    S.a_ready(cur);
    if constexpr (SP2) {
        PG8_STAGE(PG8_SB(0, 0), cB, voffB); PG8_STAGE(PG8_SB(0, 1), cB + hstep, voffB); PG8_STAGEA(PG8_SA(0, 0), cA, voffA); PG8_STAGEA(PG8_SA(0, 1), cA + hstep, voffA);
        if (wr == 1) PG8_BAR;
        PG8_WAIT_V(2); PG8_BAR;
        PG8_STAGE(PG8_SB(1, 0), cB + kstep, voffB); PG8_STAGEA(PG8_SA(1, 0), cA + kstep, voffA); PG8_STAGE(PG8_SB(1, 1), cB + hstep + kstep, voffB);
        PG8_WAIT_V(6); PG8_BAR;
    } else {
        PG8_STAGE(PG8_SB(0, 0), cB, voffB); PG8_STAGEA(PG8_SA(0, 0), cA, voffA); PG8_STAGE(PG8_SB(0, 1), cB + hstep, voffB); PG8_STAGEA(PG8_SA(0, 1), cA + hstep, voffA);
        if (wr == 1) PG8_BAR;
        PG8_WAIT_V(4); PG8_BAR;
        PG8_STAGE(PG8_SB(1, 0), cB + kstep, voffB); PG8_STAGEA(PG8_SA(1, 0), cA + kstep, voffA); PG8_STAGE(PG8_SB(1, 1), cB + hstep + kstep, voffB);
        PG8_WAIT_V(6); PG8_BAR;
    }
    for (;;) {
        const bool has_next = S.next(ui + 1, nxt);
        const char* nA = has_next ? (const char*)g.A + (size_t)nxt.pm * tstep + (size_t)nxt.ko * 2 : cA; const char* nB = has_next ? (const char*)g.Bt + (size_t)nxt.pn * tstep + (size_t)nxt.ko * 2 : cB;
        for (int t = 0; t < nt; t += 2) {
            const bool last = (t == nt - 2);
            const char* a1 = cA + (size_t)(t + 1) * kstep;
            const char* a2 = last ? nA : cA + (size_t)(t + 2) * kstep; const char* b2 = last ? nB : cB + (size_t)(t + 2) * kstep;
            const char* a3 = a2 + kstep; const char* b3 = b2 + kstep;
            if (last && has_next) S.a_ready(nxt);
            if constexpr (SP2) {
            PG8_LDB(B0, 0, 0); PG8_LDB(B1, 0, 1); PG8_SCHED; PG8_LDA(At, 0, 0); PG8_STAGEA(PG8_SA(1, 1), a1 + hstep, voffA);
            PG8_WAIT_V(8); PG8_WAIT_L(0); PG8_BAR; PG8_MMA(0, 0, At, B0); PG8_MMA(0, 1, At, B1); PG8_BAR; PG8_SCHED;
            PG8_LDA(At, 0, 1); PG8_STAGE(PG8_SB(0, 0), b2, voffB); PG8_STAGE(PG8_SB(0, 1), b2 + hstep, voffB); PG8_STAGEA(PG8_SA(0, 0), a2, voffA);
            PG8_WAIT_V(8); PG8_WAIT_L(0); PG8_BAR; PG8_MMA(1, 0, At, B0); PG8_MMA(1, 1, At, B1); PG8_BAR; PG8_SCHED;
            PG8_LDB(B0, 1, 0); PG8_LDB(B1, 1, 1); PG8_SCHED; PG8_LDA(At, 1, 0); PG8_STAGEA(PG8_SA(0, 1), a2 + hstep, voffA);
            PG8_WAIT_V(8); PG8_WAIT_L(0); PG8_BAR; PG8_MMA(0, 0, At, B0); PG8_MMA(0, 1, At, B1); PG8_BAR; PG8_SCHED;
            PG8_LDA(At, 1, 1); PG8_STAGE(PG8_SB(1, 0), b3, voffB); PG8_STAGE(PG8_SB(1, 1), b3 + hstep, voffB); PG8_STAGEA(PG8_SA(1, 0), a3, voffA);
            PG8_WAIT_V(8); PG8_WAIT_L(0); PG8_BAR; PG8_MMA(1, 0, At, B0); PG8_MMA(1, 1, At, B1); PG8_BAR; PG8_SCHED;
            } else {
            PG8_LDB(B0, 0, 0); PG8_SCHED; PG8_LDA(At, 0, 0); PG8_STAGEA(PG8_SA(1, 1), a1 + hstep, voffA);
            PG8_WAIT_L(8); PG8_BAR; PG8_WAIT_L(0); PG8_MMA(0, 0, At, B0); PG8_BAR; PG8_SCHED;
            PG8_LDB(B1, 0, 1); PG8_STAGE(PG8_SB(0, 0), b2, voffB);
            PG8_BAR; PG8_WAIT_L(0); PG8_MMA(0, 1, At, B1); PG8_BAR;
            PG8_LDA(At, 0, 1); PG8_STAGEA(PG8_SA(0, 0), a2, voffA);
            PG8_BAR; PG8_WAIT_L(0); PG8_MMA(1, 0, At, B0); PG8_BAR; PG8_SCHED;
            PG8_STAGE(PG8_SB(0, 1), b2 + hstep, voffB);
            PG8_WAIT_V(6); PG8_BAR; PG8_MMA(1, 1, At, B1); PG8_BAR;
            PG8_LDB(B0, 1, 0); PG8_SCHED; PG8_LDA(At, 1, 0); PG8_STAGEA(PG8_SA(0, 1), a2 + hstep, voffA);
            PG8_WAIT_L(8); PG8_BAR; PG8_WAIT_L(0); PG8_MMA(0, 0, At, B0); PG8_BAR; PG8_SCHED;
            PG8_LDB(B1, 1, 1); PG8_STAGE(PG8_SB(1, 0), b3, voffB);
            PG8_BAR; PG8_WAIT_L(0); PG8_MMA(0, 1, At, B1); PG8_BAR;
            PG8_LDA(At, 1, 1); PG8_STAGEA(PG8_SA(1, 0), a3, voffA);
            PG8_BAR; PG8_WAIT_L(0); PG8_MMA(1, 0, At, B0); PG8_BAR; PG8_SCHED;
            PG8_STAGE(PG8_SB(1, 1), b3 + hstep, voffB);
            PG8_WAIT_V(6); PG8_BAR; PG8_MMA(1, 1, At, B1); PG8_BAR;
            }
        }
        if constexpr (ALIGN_EPI) { if (wr == 0) PG8_BAR; }
        if constexpr (!Epi::AFTER_DRAIN) { E(acc, cur, wr, wc, fr, fq); S.done(cur); }
        if (!has_next) break;
#pragma unroll
        for (int a = 0; a < 2; ++a)
#pragma unroll
            for (int b = 0; b < 2; ++b)
#pragma unroll
                for (int m = 0; m < 4; ++m)
#pragma unroll
                    for (int n = 0; n < 2; ++n) acc[a][b][m][n] = (f32x4){0.f, 0.f, 0.f, 0.f};
        cur = nxt; cA = nA; cB = nB; ++ui;
        if constexpr (ALIGN_EPI) { if (wr == 1) PG8_BAR; }
    }
    PG8_WAIT_V(0);
    if constexpr (!ALIGN_EPI) { if (wr == 0) PG8_BAR; }
    PG8_BAR;
    if constexpr (Epi::AFTER_DRAIN) { E.fused(acc, cur, wr, wc, fr, fq, lds, wid, lane); S.done(cur); }
#undef PG8_SA
#undef PG8_SB
#undef PG8_STAGE
#undef PG8_STAGEA
#undef PG8_LDA
#undef PG8_LDB
#undef PG8_MMA
#undef PG8_WAIT_V
#undef PG8_WAIT_L
#undef PG8_BAR
#undef PG8_SCHED
}
}

constexpr int NWAVES = 8;
constexpr int DM = 2048, NTOK_P = 32768, NTOK_S = 1024, MT = NTOK_P + NTOK_S  , NSEQ = 48, DEPTH = 4, DFF = 8192;
constexpr int IN_TOTAL = 14864, NPAD = 15104;
constexpr int OFF_AQ = 0, OFF_AF = 1024, OFF_AI = 2048, OFF_AG = 3072, OFF_BZ = 4096, OFF_XBC = 5120, OFF_CU = 6656, OFF_CV = 7680, OFF_GATE = 8704, OFF_DT = 14848;
constexpr float NORM_EPS = 1e-6f;
constexpr size_t OUT_X = 0, OUT_HGRN_P = 69206016, OUT_SSM_P = 77594624, OUT_CONV_P = 85983232, OUT_HGRN_S = 86278144, OUT_SSM_S = 103055360, OUT_CONV_S = 119832576, OUT_V_S = 120422400, OUT_TOTAL = 124616704;
constexpr size_t MiB = 1u << 20;
constexpr size_t WS_CTL = 0, CTL_ZERO_BYTES = 1 * MiB;
constexpr size_t WS_MOD = 1 * MiB;
constexpr size_t WS_WIN = 16 * MiB;
constexpr size_t WS_WBR = 76 * MiB;
constexpr size_t WS_WOUT = 88 * MiB;
constexpr size_t WS_WUP = 96 * MiB;
constexpr size_t WS_WDN = 128 * MiB;
constexpr size_t WS_H = 160 * MiB;
constexpr size_t WS_Y3 = 292 * MiB;
constexpr size_t WS_P = 490 * MiB;
constexpr size_t WS_XC = 1464 * MiB;
constexpr size_t WS_DT = 1564 * MiB;
constexpr size_t DT_ARR = (size_t)MT * 16 * 4;
constexpr size_t WS_WSET2 = 1576 * MiB;
constexpr size_t WSET_BYTES = WS_H - WS_WIN;
constexpr size_t WS_SLAB = WS_Y3;
constexpr size_t WS_X = WS_WSET2 + WSET_BYTES;
constexpr size_t WS_END = WS_X + (size_t)MT * DM * 2;
static_assert((size_t)32 * 8 * 65536 * 4 <= (size_t)3 * MT * 1024 * 2, "slabs fit the y_a|y_b|y_c region");
static_assert(WS_DT + 3 * DT_ARR <= WS_WSET2, "d_ws map 3");
__host__ __device__ constexpr size_t wofs(int l) { return (l & 1) ? (WS_WSET2 - WS_WIN) : 0; }
static_assert(WS_P + (size_t)MT * NPAD * 2 <= WS_XC && WS_XC + (size_t)MT * 1536 * 2 <= WS_DT, "d_ws map 2");
static_assert(WS_MOD + (size_t)DEPTH * NSEQ * 12288 * 4 <= WS_WIN && WS_WIN + (size_t)NPAD * DM * 2 <= WS_WBR && WS_H + (size_t)MT * DM * 2 <= WS_Y3 && WS_Y3 + (size_t)3 * MT * 1024 * 2 <= WS_P, "d_ws map");
constexpr int CW_BAR = 4096;
constexpr int CW_Q = 8192;
constexpr int CW_QC = 12288;
constexpr int RING_BYTES = 131072, ST_OFF = RING_BYTES  , MISC_OFF = RING_BYTES + 1024, LDS_BYTES = 147456;

#define GAS __attribute__((address_space(1)))
#define LAS __attribute__((address_space(3)))
typedef unsigned short bf16;
typedef unsigned v4u __attribute__((ext_vector_type(4)));
typedef unsigned v2u __attribute__((ext_vector_type(2)));
typedef float f32x4 __attribute__((ext_vector_type(4)));
typedef float f32x2 __attribute__((ext_vector_type(2)));
#define LDS_WAIT() asm volatile("s_waitcnt lgkmcnt(0)" ::: "memory")
#define VM_WAIT() asm volatile("s_waitcnt vmcnt(0)" ::: "memory")
typedef float cv_f32x2 __attribute__((ext_vector_type(2))); typedef __bf16 cv_bf16x2 __attribute__((ext_vector_type(2)));
__device__ __forceinline__ unsigned pk2(float lo, float hi) { const cv_f32x2 v = {lo, hi}; const cv_bf16x2 b = __builtin_convertvector(v, cv_bf16x2); return __builtin_bit_cast(unsigned, b); }
__device__ __forceinline__ unsigned f2bf(float f) { const __bf16 b = (__bf16)f; return (unsigned)__builtin_bit_cast(unsigned short, b); }
__device__ __forceinline__ float bflo(unsigned w) { return __uint_as_float(w << 16); }
__device__ __forceinline__ float bfhi(unsigned w) { return __uint_as_float(w & 0xffff0000u); }
__device__ __forceinline__ float bf1(bf16 v) { return __uint_as_float(((unsigned)v) << 16); }
__device__ __forceinline__ float sigmoidf_(float x) { return __builtin_amdgcn_rcpf(1.0f + __expf(-x)); }
__device__ __forceinline__ float siluf_(float x) { return x * __builtin_amdgcn_rcpf(1.0f + __expf(-x)); }
__device__ __forceinline__ float rsqrtf_(float x) { return __builtin_amdgcn_rsqf(x); }
__device__ __forceinline__ float geluf_(float v) {
    const float av = fabsf(v), t = __builtin_amdgcn_rcpf(1.0f + 0.2316418882f * av);
    float q = t * 0.5307027145f + (-0.7265760135f); q = q * t + 0.7107068705f; q = q * t + (-0.142248368f); q = q * t + 0.127414796f; q = q * t;
    const float e = __expf(-0.5f * v * v), m = v * (q * e);
    return v < 0.f ? m : v - m;
}
__device__ __forceinline__ float wave_sum(float v) {
#pragma unroll
    for (int o = 1; o < 64; o <<= 1) v += __shfl_xor(v, o);
    return v;
}
__device__ __forceinline__ float half_sum(float v) {
#pragma unroll
    for (int o = 1; o < 32; o <<= 1) v += __shfl_xor(v, o);
    return v;
}

#define XB_TMO      128
#define XB_XCNT(j)  (256  + 64 * (j))
#define XB_XSUB(j)  (1280 + 64 * (j))
#define XB_XGEN(j)  (2304 + 64 * (j))
#define XB_TOP      3328
#define XB_TOPGEN   3392
#define XCD_BAR_WORDS 3456
#define XB_SPIN_CAP (1u << 18)

__device__ __forceinline__ unsigned xb_ld(unsigned* p)              { return __hip_atomic_load(p, __ATOMIC_RELAXED, __HIP_MEMORY_SCOPE_AGENT); }
__device__ __forceinline__ unsigned xb_add(unsigned* p, unsigned v) { return __hip_atomic_fetch_add(p, v, __ATOMIC_RELAXED, __HIP_MEMORY_SCOPE_AGENT); }
__device__ __forceinline__ unsigned xb_xcc_id() { return (unsigned)__builtin_amdgcn_s_getreg((3 << 11) | 20) & 0xFu; }
#define XB_SPIN(cond, bar) do { unsigned _sp = 0; while (cond) { __builtin_amdgcn_s_sleep(1); \
    if ((++_sp & 255u) == 0u) { if (xb_ld(&(bar)[XB_TMO])) break; if (_sp > XB_SPIN_CAP) { atomicAdd(&(bar)[XB_TMO], 1u); break; } } } } while (0)

struct XcdBarrier {
    unsigned* bar; unsigned x;
    volatile LAS unsigned* st;
};

__device__ __forceinline__ XcdBarrier xcd_barrier_post(unsigned* bar, volatile LAS unsigned* st, int tid) {
    XcdBarrier b; b.bar = bar; b.x = xb_xcc_id(); b.st = st;
    if (tid == 0) (void)xb_add(&bar[XB_XCNT(b.x)], 1u);
    return b;
}
__device__ __forceinline__ void xcd_barrier_complete(unsigned* bar, unsigned x, unsigned& nloc, unsigned& nx) {
    const unsigned G = gridDim.x * gridDim.y * gridDim.z;
    unsigned sum, cnt, mine, sp = 0u;
    for (;;) {
        sum = 0u; cnt = 0u; mine = 0u;
#pragma unroll
        for (unsigned j = 0; j < 16; ++j) { const unsigned c = xb_ld(&bar[XB_XCNT(j)]); sum += c; cnt += (c > 0u) ? 1u : 0u; mine = (j == x) ? c : mine; }
        if (sum == G) break;
        __builtin_amdgcn_s_sleep(1);
        if ((++sp & 255u) == 0u) { if (xb_ld(&bar[XB_TMO])) break; if (sp > XB_SPIN_CAP) { atomicAdd(&bar[XB_TMO], 1u); break; } }
    }
    nloc = mine > 0u ? mine : 1u; nx = cnt > 0u ? cnt : 1u;
}

__device__ __forceinline__ void xcd_barrier(const XcdBarrier& b, int tid) {
    asm volatile("s_waitcnt vmcnt(0)" ::: "memory");
    __syncthreads();
    if (tid == 0) {
        unsigned* bar = b.bar;
        __builtin_amdgcn_s_waitcnt(0);
        unsigned nloc = b.st[0], nx = b.st[1];
        if (nloc == 0u) { xcd_barrier_complete(bar, b.x, nloc, nx); b.st[0] = nloc; b.st[1] = nx; }
        const unsigned old = xb_add(&bar[XB_XSUB(b.x)], 1u);
        const unsigned gen = old / nloc;
        if (old + 1u == (gen + 1u) * nloc) {
            __builtin_amdgcn_fence(__ATOMIC_RELEASE, "agent");
            asm volatile("s_waitcnt vmcnt(0)" ::: "memory");
            const unsigned og = xb_add(&bar[XB_TOP], 1u);
            const unsigned tg = og / nx;
            if (og + 1u == (tg + 1u) * nx) xb_add(&bar[XB_TOPGEN], 1u);
            else XB_SPIN(xb_ld(&bar[XB_TOPGEN]) == tg, bar);
            __builtin_amdgcn_fence(__ATOMIC_ACQUIRE, "agent");
            xb_add(&bar[XB_XGEN(b.x)], 1u);
            asm volatile("s_waitcnt vmcnt(0)" ::: "memory");
        } else {
            XB_SPIN(xb_ld(&bar[XB_XGEN(b.x)]) == gen, bar);
            __builtin_amdgcn_fence(__ATOMIC_ACQUIRE, "agent");
            asm volatile("s_waitcnt vmcnt(0)" ::: "memory");
        }
    }
    __syncthreads();
}


__device__ __forceinline__ void mod_item(LAS unsigned char* lds, int tid_in, int it, const float* c_prompt, const float* c_sample, const float* w_mod, const float* b_mod, float* MOD) {
    int tid = tid_in;
    const int l = it / 96, cb = it - l * 96, j0 = cb * 128;
    const int cp = tid & 63, kq = tid >> 6;
    LAS float* CS = (LAS float*)lds;
    float acc0[48], acc1[48];
#pragma unroll
    for (int s = 0; s < 48; ++s) { acc0[s] = 0.f; acc1[s] = 0.f; }
    const float* wbase = w_mod + (size_t)l * DM * 12288 + j0 + 2 * cp;
    for (int kt = 0; kt < 8; ++kt) {
        __syncthreads();
#pragma unroll 2
        for (int j = 0; j < 24; ++j) { const int e = tid + 512 * j, s = e >> 8, kidx = e & 255, kq2 = kidx >> 5, kk = kidx & 31, k = kq2 * 256 + kt * 32 + kk;
            const float cv = s < 16 ? c_prompt[s * DM + k] : c_sample[(s - 16) * DM + k];
            CS[(kq2 * 32 + kk) * 48 + s] = siluf_(cv); }
        __syncthreads();
#pragma unroll 1
        for (int kk = 0; kk < 32; ++kk) { const int k = kq * 256 + kt * 32 + kk;
            const f32x2 w2 = *(const f32x2*)(wbase + (size_t)k * 12288);
            const LAS f32x4* cr = (const LAS f32x4*)(CS + (kq * 32 + kk) * 48);
#pragma unroll
            for (int s4 = 0; s4 < 12; ++s4) { const f32x4 c4 = cr[s4];
#pragma unroll
                for (int i = 0; i < 4; ++i) { acc0[4 * s4 + i] = fmaf(w2.x, c4[i], acc0[4 * s4 + i]); acc1[4 * s4 + i] = fmaf(w2.y, c4[i], acc1[4 * s4 + i]); } } }
    }
    LAS float* RED = (LAS float*)lds;
    asm volatile("" : "+v"(tid));
    const int cp2 = tid & 63, kq2_ = tid >> 6;
#pragma unroll
    for (int sb = 0; sb < 4; ++sb) {
        __syncthreads();
#pragma unroll
        for (int i = 0; i < 12; ++i) { *(LAS f32x2*)(RED + (kq2_ * 12 + i) * 128 + 2 * cp2) = (f32x2){acc0[12 * sb + i], acc1[12 * sb + i]}; }
        __syncthreads();
#pragma unroll
        for (int j = 0; j < 3; ++j) { const int e = tid + 512 * j, s = e >> 7, col = e & 127; float v = 0.f;
#pragma unroll
            for (int q = 0; q < 8; ++q) v += RED[(q * 12 + s) * 128 + col];
            MOD[((size_t)l * NSEQ + 12 * sb + s) * 12288 + j0 + col] = v + b_mod[l * 12288 + j0 + col]; }
    }
    __syncthreads();
}

struct CvItem { const float* src; bf16* dst; int N, K, nv; };
constexpr int CV_A = 472 * 32, CV_B = 3 * 16 * 64, CV_C = 32 * 64, CV_D = 32 * 256, CV_E = 128 * 64, CV_ALL = CV_A + CV_B + CV_C + CV_D + CV_E;
__device__ __forceinline__ CvItem cvt_decode(int it, int l, const float* w_in, const float* w_branch, const float* w_out, const float* w_up, const float* w_down, unsigned char* ws) {
    CvItem c; int r = it;
    if (r < CV_A) { const int nb = r % 472, kb = r / 472; int n0s, nv;
        if (nb < 208) { n0s = 32 * nb; nv = 32; } else if (nb < 464) { n0s = 32 * nb + 16; nv = 32; } else if (nb == 464) { n0s = 6656; nv = 16; } else { n0s = 0; nv = 0; }
        c.N = IN_TOTAL; c.K = DM; c.nv = nv; c.src = w_in + (size_t)l * DM * IN_TOTAL + (size_t)(64 * kb) * IN_TOTAL + n0s; c.dst = (bf16*)(ws + WS_WIN) + (size_t)(32 * nb) * DM + 64 * kb; return c; }
    r -= CV_A;
    if (r < CV_B) { const int br = r / 1024, r2 = r % 1024, kb = r2 / 64, nb = r2 % 64;
        c.N = DM; c.K = 1024; c.nv = 32; c.src = w_branch + ((size_t)l * 3072 + br * 1024 + 64 * kb) * DM + 32 * nb; c.dst = (bf16*)(ws + WS_WBR) + (size_t)br * 2048 * 1024 + (size_t)(32 * nb) * 1024 + 64 * kb; return c; }
    r -= CV_B;
    if (r < CV_C) { const int kb = r / 64, nb = r % 64;
        c.N = DM; c.K = DM; c.nv = 32; c.src = w_out + (size_t)l * DM * DM + (size_t)(64 * kb) * DM + 32 * nb; c.dst = (bf16*)(ws + WS_WOUT) + (size_t)(32 * nb) * DM + 64 * kb; return c; }
    r -= CV_C;
    if (r < CV_D) { const int kb = r / 256, nb = r % 256;
        c.N = DFF; c.K = DM; c.nv = 32; c.src = w_up + (size_t)l * DM * DFF + (size_t)(64 * kb) * DFF + 32 * nb; c.dst = (bf16*)(ws + WS_WUP) + (size_t)(32 * nb) * DM + 64 * kb; return c; }
    r -= CV_D;
    { const int kb = r / 64, nb = r % 64;
        c.N = DM; c.K = DFF; c.nv = 32; c.src = w_down + (size_t)l * DFF * DM + (size_t)(64 * kb) * DM + 32 * nb; c.dst = (bf16*)(ws + WS_WDN) + (size_t)(32 * nb) * DFF + 64 * kb; return c; }
}
__device__ __forceinline__ void cvt_load(const CvItem& c, int lane, f32x4 (&v)[8]) {
    const int kk = lane >> 3, n4 = (lane & 7) * 4;
#pragma unroll
    for (int i = 0; i < 8; ++i) v[i] = (n4 < c.nv) ? *(const f32x4*)(c.src + (size_t)(8 * i + kk) * c.N + n4) : (f32x4){0.f, 0.f, 0.f, 0.f};
}
__device__ __forceinline__ void cvt_store(const CvItem& c, int lane, const f32x4 (&v)[8], LAS float* scr) {
    { const int kk = lane >> 3, n4 = (lane & 7) * 4;
#pragma unroll
        for (int i = 0; i < 8; ++i) { LAS float* d = scr + (8 * i + kk) * 33 + n4; d[0] = v[i].x; d[1] = v[i].y; d[2] = v[i].z; d[3] = v[i].w; } }
    LDS_WAIT(); asm volatile("" ::: "memory");
    const int cc = lane & 7;
#pragma unroll
    for (int j = 0; j < 4; ++j) { const int n = (lane >> 3) + 8 * j; const LAS float* s = scr + (8 * cc) * 33 + n;
        v4u o; o.x = pk2(s[0 * 33], s[1 * 33]); o.y = pk2(s[2 * 33], s[3 * 33]); o.z = pk2(s[4 * 33], s[5 * 33]); o.w = pk2(s[6 * 33], s[7 * 33]);
        *(v4u*)(c.dst + (size_t)n * c.K + 8 * cc) = o; }
    LDS_WAIT(); asm volatile("" ::: "memory");
}
template <bool QUEUE>
__device__ __forceinline__ void cvt_phase(LAS unsigned char* lds, int wave, int lane, int gw, int NGW, int l, const float* w_in, const float* w_branch, const float* w_out, const float* w_up, const float* w_down, unsigned char* ws, unsigned* qhead) {
    LAS float* scr = (LAS float*)(lds + wave * 16384);
    int it = gw, left = 0;
#define CV_NEXT() do { if (QUEUE) { if (left == 0) { unsigned t0 = 0; if (lane == 0) t0 = __hip_atomic_fetch_add(qhead, 4u, __ATOMIC_RELAXED, __HIP_MEMORY_SCOPE_AGENT); it = __builtin_amdgcn_readfirstlane((int)t0); left = 4; } else ++it; --left; } else it += NGW; } while (0)
    if (QUEUE) { it = 0; CV_NEXT(); }
    if (it >= CV_ALL) return;
    CvItem ca = cvt_decode(it, l, w_in, w_branch, w_out, w_up, w_down, ws), cb = ca; f32x4 va[8], vb[8];
    cvt_load(ca, lane, va);
    for (;;) {
        CV_NEXT(); const bool hb = it < CV_ALL;
        if (hb) { cb = cvt_decode(it, l, w_in, w_branch, w_out, w_up, w_down, ws); cvt_load(cb, lane, vb); }
        cvt_store(ca, lane, va, scr);
        if (!hb) break;
        CV_NEXT(); const bool ha = it < CV_ALL;
        if (ha) { ca = cvt_decode(it, l, w_in, w_branch, w_out, w_up, w_down, ws); cvt_load(ca, lane, va); }
        cvt_store(cb, lane, vb, scr);
        if (!ha) break;
    }
#undef CV_NEXT
}

#ifndef WGM_N8
#define WGM_N8 4
#endif
__device__ __forceinline__ int tail_nfull(int nwg, int G) { const int nf = (nwg / G) * G; return (nwg - nf) <= 32 ? nf : nwg; }
__device__ __forceinline__ void build_tail_map(LAS int* tmap, int tid, int G, int rev) {
    pg8::StaticOrder S; S.init(MT, DM, G, 0); S.rev = rev; S.wgm = WGM_N8; const int nfull = tail_nfull(S.nwg, G);
    for (int i = tid; i < S.nwg; i += NWAVES * 64) tmap[i] = -1;
    __syncthreads();
    for (int i = tid; i < S.nwg - nfull; i += NWAVES * 64) { pg8::Unit u; S.tile_of(nfull + i, u); tmap[u.pm * 8 + u.pn] = i; }
    __syncthreads();
}
template <bool SRC_F32>
__device__ __forceinline__ void norm_mod_phase(int lane, int gw, int NGW, const float* xP, const float* xS, bf16* X, const float* ng, const float* modl  , int part_sh, int part_sc, bf16* H,
                                               bool comb, const LAS int* tmap, const float* slab, bool desc) {
    const int g2 = desc ? NGW - 1 - gw : gw;
    const int ra = (int)(((unsigned)g2 * (unsigned)MT) / (unsigned)NGW), rb = (int)(((unsigned)(g2 + 1) * (unsigned)MT) / (unsigned)NGW);
    const int nr = rb - ra, rfirst = desc ? rb - 1 : ra, step = desc ? -1 : 1;
    if (nr <= 0) return;
    f32x4 ca[8], cb[8]; int cur_seq = -1;
    v2u xn[8];
    v2u xm[8];
    if (!SRC_F32) { const v2u* xb0 = (const v2u*)(X + (size_t)rfirst * DM) + lane;
#pragma unroll
        for (int j = 0; j < 8; ++j) xn[j] = xb0[64 * j];
        if (nr > 1) { const v2u* xb1 = (const v2u*)(X + (size_t)(rfirst + step) * DM) + lane;
#pragma unroll
            for (int j = 0; j < 8; ++j) xm[j] = xb1[64 * j]; } }
    for (int i = 0; i < nr; ++i) { const int r = rfirst + step * i;
        const int seq = r < NTOK_P ? (r >> 11) : 16 + ((r - NTOK_P) >> 5);
        if (seq != cur_seq) { cur_seq = seq; const float* mp = modl + (size_t)seq * 12288;
#pragma unroll
            for (int j = 0; j < 8; ++j) { const int c = 4 * lane + 256 * j; const f32x4 g = *(const f32x4*)(ng + c), sc = *(const f32x4*)(mp + part_sc * DM + c); ca[j] = g * (sc + 1.0f); cb[j] = *(const f32x4*)(mp + part_sh * DM + c); } }
        f32x4 v[8]; float ss = 0.f; v2u* xb = (v2u*)(X + (size_t)r * DM) + lane;
        if (SRC_F32) { const float* xr = (r < NTOK_P ? xP + (size_t)r * DM : xS + (size_t)(r - NTOK_P) * DM) + 4 * lane;
#pragma unroll
            for (int j = 0; j < 8; ++j) { v[j] = *(const f32x4*)(xr + 256 * j); v2u o; o.x = pk2(v[j].x, v[j].y); o.y = pk2(v[j].z, v[j].w); xb[64 * j] = o; } }
        else {
#pragma unroll
            for (int j = 0; j < 8; ++j) { const v2u o = xn[j]; v[j] = (f32x4){bflo(o.x), bfhi(o.x), bflo(o.y), bfhi(o.y)}; xn[j] = xm[j]; }
            if (i + 2 < nr) { const v2u* xb2 = (const v2u*)(X + (size_t)(r + 2 * step) * DM) + lane;
#pragma unroll
                for (int j = 0; j < 8; ++j) xm[j] = xb2[64 * j]; } }
        if (comb) {
#pragma unroll
            for (int j = 0; j < 8; ++j) { const int ti = tmap[(r >> 8) * 8 + j]; if (ti >= 0) { const float* sp = slab + (size_t)ti * 8 * 65536 + (r & 255) * 256 + 4 * lane;
#pragma unroll
                    for (int q = 0; q < 8; ++q) v[j] = v[j] + *(const f32x4*)(sp + (size_t)q * 65536);
                    v2u o; o.x = pk2(v[j].x, v[j].y); o.y = pk2(v[j].z, v[j].w); xb[64 * j] = o; } } }
#pragma unroll
        for (int j = 0; j < 8; ++j) ss += (v[j].x * v[j].x + v[j].y * v[j].y) + (v[j].z * v[j].z + v[j].w * v[j].w);
        const float rstd = 1.0f / sqrtf(wave_sum(ss) * (1.0f / DM) + NORM_EPS);
        unsigned long long* o8 = (unsigned long long*)(H + (size_t)r * DM) + lane;
#pragma unroll
        for (int j = 0; j < 8; ++j) { const f32x4 y = v[j] * rstd * ca[j] + cb[j]; o8[64 * j] = (unsigned long long)pk2(y.x, y.y) | ((unsigned long long)pk2(y.z, y.w) << 32); }
    }
}
__device__ __forceinline__ void final_norm_phase(int lane, int gw, int NGW, const bf16* X, float* Y, const float* fg, bool comb, const LAS int* tmap, const float* slab) {
    f32x4 g[8];
#pragma unroll
    for (int j = 0; j < 8; ++j) g[j] = *(const f32x4*)(fg + 4 * lane + 256 * j);
    v2u xn[8];
    if (gw < MT) { const v2u* xb0 = (const v2u*)(X + (size_t)gw * DM) + lane;
#pragma unroll
        for (int j = 0; j < 8; ++j) xn[j] = xb0[64 * j]; }
    for (int r = gw; r < MT; r += NGW) {
        float* yr = Y + (size_t)r * DM + 4 * lane; f32x4 v[8]; float ss = 0.f;
#pragma unroll
        for (int j = 0; j < 8; ++j) { const v2u o = xn[j]; v[j] = (f32x4){bflo(o.x), bfhi(o.x), bflo(o.y), bfhi(o.y)}; }
        if (r + NGW < MT) { const v2u* xb1 = (const v2u*)(X + (size_t)(r + NGW) * DM) + lane;
#pragma unroll
            for (int j = 0; j < 8; ++j) xn[j] = xb1[64 * j]; }
        if (comb) {
#pragma unroll
            for (int j = 0; j < 8; ++j) { const int ti = tmap[(r >> 8) * 8 + j]; if (ti >= 0) { const float* sp = slab + (size_t)ti * 8 * 65536 + (r & 255) * 256 + 4 * lane;
#pragma unroll
                    for (int q = 0; q < 8; ++q) v[j] = v[j] + *(const f32x4*)(sp + (size_t)q * 65536); } } }
#pragma unroll
        for (int j = 0; j < 8; ++j) ss += (v[j].x * v[j].x + v[j].y * v[j].y) + (v[j].z * v[j].z + v[j].w * v[j].w);
        const float rstd = 1.0f / sqrtf(wave_sum(ss) * (1.0f / DM) + NORM_EPS);
#pragma unroll
        for (int j = 0; j < 8; ++j) *(f32x4*)(yr + 256 * j) = v[j] * rstd * g[j];
    }
}
__device__ __forceinline__ void ssd_norm_phase(int lane, int gw, int NGW, bf16* YB, const float* g) {
    float gv[16];
#pragma unroll
    for (int j = 0; j < 4; ++j) { const f32x4 t = *(const f32x4*)(g + 16 * lane + 4 * j); gv[4 * j] = t.x; gv[4 * j + 1] = t.y; gv[4 * j + 2] = t.z; gv[4 * j + 3] = t.w; }
    v4u na = (v4u){0u, 0u, 0u, 0u}, nb = na;
    if (gw < MT) { const v4u* p0 = (const v4u*)(YB + (size_t)gw * 1024 + 16 * lane); na = p0[0]; nb = p0[1]; }
    for (int r = gw; r < MT; r += NGW) {
        v4u* p = (v4u*)(YB + (size_t)r * 1024 + 16 * lane); const v4u a = na, b = nb;
        if (r + NGW < MT) { const v4u* p1 = (const v4u*)(YB + (size_t)(r + NGW) * 1024 + 16 * lane); na = p1[0]; nb = p1[1]; }
        float v[16]; v[0] = bflo(a.x); v[1] = bfhi(a.x); v[2] = bflo(a.y); v[3] = bfhi(a.y); v[4] = bflo(a.z); v[5] = bfhi(a.z); v[6] = bflo(a.w); v[7] = bfhi(a.w);
        v[8] = bflo(b.x); v[9] = bfhi(b.x); v[10] = bflo(b.y); v[11] = bfhi(b.y); v[12] = bflo(b.z); v[13] = bfhi(b.z); v[14] = bflo(b.w); v[15] = bfhi(b.w);
        float ss = 0.f;
#pragma unroll
        for (int j = 0; j < 16; ++j) ss += v[j] * v[j];
        const float rstd = 1.0f / sqrtf(half_sum(ss) * (1.0f / 512.0f) + NORM_EPS);
#pragma unroll
        for (int j = 0; j < 16; ++j) v[j] = v[j] * rstd * gv[j];
        v4u oa, ob; oa.x = pk2(v[0], v[1]); oa.y = pk2(v[2], v[3]); oa.z = pk2(v[4], v[5]); oa.w = pk2(v[6], v[7]); ob.x = pk2(v[8], v[9]); ob.y = pk2(v[10], v[11]); ob.z = pk2(v[12], v[13]); ob.w = pk2(v[14], v[15]);
        p[0] = oa; p[1] = ob;
    }
}

__device__ __forceinline__ void hgrn_item(LAS unsigned char* lds, int tid, int lane, int wave, const bf16* P, bf16* YA, int row0, int T, int h, int l,
                                          const float* s0, float* sout, const float* lb_raw, const float* onorm_g) {
    LAS float* LBV = (LAS float*)lds;
    LAS float* GV = LBV + 128;
    LAS float* Q = GV + 128;
    LAS float* F = Q + 2048; LAS float* KN = F + 2048; LAS float* IV = KN + 2048;
    LAS float* PO = IV + 2048;
    __syncthreads();
    if (tid < 128) { const int ch = h * 128 + tid; const float a0 = lb_raw[ch], a1 = lb_raw[1024 + ch], a2 = lb_raw[2048 + ch], a3 = lb_raw[3072 + ch];
        const float mx = fmaxf(fmaxf(a0, a1), fmaxf(a2, a3)); const float e0 = __expf(a0 - mx), e1 = __expf(a1 - mx), e2 = __expf(a2 - mx), e3 = __expf(a3 - mx); const float inv = 1.0f / (e0 + e1 + e2 + e3);
        float lb = 0.f; if (l >= 1) lb += e1; if (l >= 2) lb += e2; if (l >= 3) lb += e3; LBV[tid] = lb * inv; GV[tid] = onorm_g[ch]; }
    v2u nq2, nf2, ni2;
    { const bf16* pr = P + (size_t)(row0 + (tid >> 5)) * NPAD + h * 128 + (tid & 31) * 4; nq2 = *(const v2u*)(pr + OFF_AQ); nf2 = *(const v2u*)(pr + OFF_AF); ni2 = *(const v2u*)(pr + OFF_AI); }
    float S0[16], S1[16];
#pragma unroll
    for (int kk = 0; kk < 16; ++kk) { if (s0) { const f32x2 v = *(const f32x2*)(s0 + (16 * wave + kk) * 128 + 2 * lane); S0[kk] = v.x; S1[kk] = v.y; } else { S0[kk] = 0.f; S1[kk] = 0.f; } }
    __syncthreads();
    const int nch = T / 16;
    for (int c = 0; c < nch; ++c) {
        unsigned agv[2];
#pragma unroll
        for (int tt = 0; tt < 2; ++tt) agv[tt] = *(const unsigned*)(P + (size_t)(row0 + c * 16 + 2 * wave + tt) * NPAD + OFF_AG + h * 128 + 2 * lane);
        { const int t = tid >> 5, k4 = (tid & 31) * 4;
            const v2u q2 = nq2, f2 = nf2, i2 = ni2;
            if (c + 1 < nch) { const bf16* pr = P + (size_t)(row0 + (c + 1) * 16 + t) * NPAD + h * 128 + k4; nq2 = *(const v2u*)(pr + OFF_AQ); nf2 = *(const v2u*)(pr + OFF_AF); ni2 = *(const v2u*)(pr + OFF_AI); }
            const f32x4 lb = *(const LAS f32x4*)(LBV + k4);
            const float aq[4] = {bflo(q2.x), bfhi(q2.x), bflo(q2.y), bfhi(q2.y)}, az[4] = {bflo(f2.x), bfhi(f2.x), bflo(f2.y), bfhi(f2.y)};
            f32x4 qv, fv, kv;
#pragma unroll
            for (int j = 0; j < 4; ++j) { qv[j] = siluf_(aq[j]); const float sg = sigmoidf_(az[j]); fv[j] = lb[j] + (1.0f - lb[j]) * sg; kv[j] = (1.0f - lb[j]) * (1.0f - sg); }
            *(LAS f32x4*)(Q + t * 128 + k4) = qv; *(LAS f32x4*)(F + t * 128 + k4) = fv; *(LAS f32x4*)(KN + t * 128 + k4) = kv;
            *(LAS f32x4*)(IV + t * 128 + k4) = (f32x4){bflo(i2.x), bfhi(i2.x), bflo(i2.y), bfhi(i2.y)}; }
        __syncthreads();
#pragma unroll 2
        for (int t = 0; t < 16; ++t) {
            const f32x2 iv = *(const LAS f32x2*)(IV + t * 128 + 2 * lane); float po0 = 0.f, po1 = 0.f;
#pragma unroll
            for (int k4 = 0; k4 < 4; ++k4) { const f32x4 f4 = *(const LAS f32x4*)(F + t * 128 + 16 * wave + 4 * k4), n4 = *(const LAS f32x4*)(KN + t * 128 + 16 * wave + 4 * k4), q4 = *(const LAS f32x4*)(Q + t * 128 + 16 * wave + 4 * k4);
#pragma unroll
                for (int j = 0; j < 4; ++j) { const int kk = 4 * k4 + j; S0[kk] = fmaf(f4[j], S0[kk], n4[j] * iv.x); S1[kk] = fmaf(f4[j], S1[kk], n4[j] * iv.y); po0 = fmaf(q4[j], S0[kk], po0); po1 = fmaf(q4[j], S1[kk], po1); } }
            *(LAS f32x2*)(PO + (t * 8 + wave) * 128 + 2 * lane) = (f32x2){po0, po1};
        }
        __syncthreads();
#pragma unroll
        for (int tt = 0; tt < 2; ++tt) { const int t = 2 * wave + tt; float o0 = 0.f, o1 = 0.f;
#pragma unroll
            for (int w = 0; w < 8; ++w) { const f32x2 p = *(const LAS f32x2*)(PO + (t * 8 + w) * 128 + 2 * lane); o0 += p.x; o1 += p.y; }
            const float rstd = 1.0f / sqrtf(wave_sum(o0 * o0 + o1 * o1) * (1.0f / 128.0f) + NORM_EPS);
            const size_t row = (size_t)(row0 + c * 16 + t);
            const unsigned ag = agv[tt];
            const f32x2 gg = *(const LAS f32x2*)(GV + 2 * lane);
            *(unsigned*)(YA + row * 1024 + h * 128 + 2 * lane) = pk2(o0 * rstd * gg.x * siluf_(bflo(ag)), o1 * rstd * gg.y * siluf_(bfhi(ag))); }
    }
#pragma unroll
    for (int kk = 0; kk < 16; ++kk) *(f32x2*)(sout + (16 * wave + kk) * 128 + 2 * lane) = (f32x2){S0[kk], S1[kk]};
    __syncthreads();
}

typedef short bf16x8_t __attribute__((ext_vector_type(8)));
#define BAR_LDS() do { asm volatile("s_waitcnt lgkmcnt(0)" ::: "memory"); __builtin_amdgcn_s_barrier(); asm volatile("" ::: "memory"); } while (0)
#define MFMA16(x, y, acc) __builtin_amdgcn_mfma_f32_16x16x32_bf16((x), (y), (acc), 0, 0, 0)
#define LDFRAG(base, row, pitch, koff) (*(const LAS bf16x8_t*)((base) + (row) * (pitch) + (koff)))
__device__ __forceinline__ void hgrn_mfma_item(LAS unsigned char* lds, int tid, int lane, int wave, const bf16* P, bf16* YA, int row0, int h, int l, float* sout, const float* lb_raw, const float* onorm_g) {
    constexpr int PQ = 136, PT = 40;
    LAS float* LBV = (LAS float*)lds;
    LAS float* GV = LBV + 128;
    LAS float* DEC = GV + 128;
    LAS float* SS = DEC + 128;
    LAS float* LF = SS + 256;
    LAS bf16* QB = (LAS bf16*)(LF + 4096);
    LAS bf16* KB = QB + 32 * PQ;
    LAS bf16* Qt = KB + 32 * PQ;
    LAS bf16* Qm = Qt + 32 * PQ;
    LAS bf16* Km = Qm + 32 * PQ;
    LAS bf16* Qr = Km + 32 * PQ;
    LAS bf16* Kr = Qr + 16 * PQ;
    LAS bf16* KtT = Kr + 16 * PQ;
    LAS bf16* VT = KtT + 128 * PT;
    LAS bf16* IVr = VT + 128 * PT;
    LAS float* RSW = (LAS float*)(IVr + 32 * 128);
    const int fr = lane & 15, fq = lane >> 4;
    __syncthreads();
    if (tid < 128) { const int ch = h * 128 + tid; const float a0 = lb_raw[ch], a1 = lb_raw[1024 + ch], a2 = lb_raw[2048 + ch], a3 = lb_raw[3072 + ch];
        const float mx = fmaxf(fmaxf(a0, a1), fmaxf(a2, a3)); const float e0 = __expf(a0 - mx), e1 = __expf(a1 - mx), e2 = __expf(a2 - mx), e3 = __expf(a3 - mx); const float inv = 1.0f / (e0 + e1 + e2 + e3);
        float lb = 0.f; if (l >= 1) lb += e1; if (l >= 2) lb += e2; if (l >= 3) lb += e3; LBV[tid] = lb * inv; GV[tid] = onorm_g[ch]; }
    for (int i = tid; i < (128 * PT * 2) / 2; i += 512) ((LAS unsigned*)KtT)[i] = 0u;
    f32x4 sacc[8];
#pragma unroll
    for (int j = 0; j < 8; ++j) sacc[j] = (f32x4){0.f, 0.f, 0.f, 0.f};
    const int st = tid >> 4, sk8 = (tid & 15) * 8;
    const unsigned pst = (unsigned)((unsigned)(row0 + st) * (unsigned)NPAD + h * 128 + sk8) * 2u;
#define HG_LD16(off_) (*(const v4u*)((const char*)P + (unsigned)(off_)))
    v4u nq = HG_LD16(pst + 2u * OFF_AQ), nf = HG_LD16(pst + 2u * OFF_AF), ni = HG_LD16(pst + 2u * OFF_AI);
    f32x4 po0 = (f32x4){0.f, 0.f, 0.f, 0.f}, po1 = po0; bf16 pag[2][4];
#pragma unroll
    for (int hh = 0; hh < 2; ++hh)
#pragma unroll
        for (int r = 0; r < 4; ++r) pag[hh][r] = 0;
    const float gvv = onorm_g[h * 128 + 16 * wave + fr];
    __syncthreads();
#define HG_OUT(rb_) do { { const int t_ = lane & 31; const f32x4 p0 = *(const LAS f32x4*)(SS + t_ * 8), p1 = *(const LAS f32x4*)(SS + t_ * 8 + 4); \
            RSW[wave * 32 + t_] = rsqrtf_(((p0.x + p0.y) + (p0.z + p0.w) + (p1.x + p1.y) + (p1.z + p1.w)) * (1.0f / 128.0f) + NORM_EPS); } \
        LDS_WAIT(); asm volatile("" ::: "memory"); \
        _Pragma("unroll") for (int hh = 0; hh < 2; ++hh) { const f32x4 rs4 = *(const LAS f32x4*)(RSW + wave * 32 + 16 * hh + 4 * fq); \
            _Pragma("unroll") for (int r = 0; r < 4; ++r) { const int t = 16 * hh + 4 * fq + r; const float ov = hh ? po1[r] : po0[r]; \
            *(bf16*)((char*)YA + (unsigned)(((unsigned)(rb_) + t) * 1024u + h * 128 + 16 * wave + fr) * 2u) = (bf16)f2bf(ov * rs4[r] * gvv * siluf_(bf1(pag[hh][r]))); } } } while (0)
    for (int c = 0; c < 64; ++c) {
        const unsigned rbase = (unsigned)row0 + 32u * c;
        bf16 ag[2][4];
        { const f32x4 lb0 = *(const LAS f32x4*)(LBV + sk8), lb1 = *(const LAS f32x4*)(LBV + sk8 + 4); const float lb[8] = {lb0.x, lb0.y, lb0.z, lb0.w, lb1.x, lb1.y, lb1.z, lb1.w};
            const float aq[8] = {bflo(nq.x), bfhi(nq.x), bflo(nq.y), bfhi(nq.y), bflo(nq.z), bfhi(nq.z), bflo(nq.w), bfhi(nq.w)}, az[8] = {bflo(nf.x), bfhi(nf.x), bflo(nf.y), bfhi(nf.y), bflo(nf.z), bfhi(nf.z), bflo(nf.w), bfhi(nf.w)};
            float qv[8], kv[8], lf[8];
#pragma unroll
            for (int j = 0; j < 8; ++j) { qv[j] = siluf_(aq[j]); const float sg = sigmoidf_(az[j]); const float f = fmaxf(lb[j] + (1.0f - lb[j]) * sg, 1e-30f); kv[j] = (1.0f - lb[j]) * (1.0f - sg); lf[j] = __log2f(f); }
            *(LAS f32x4*)(LF + st * 128 + sk8) = (f32x4){lf[0], lf[1], lf[2], lf[3]}; *(LAS f32x4*)(LF + st * 128 + sk8 + 4) = (f32x4){lf[4], lf[5], lf[6], lf[7]};
            v4u qo, ko; qo.x = pk2(qv[0], qv[1]); qo.y = pk2(qv[2], qv[3]); qo.z = pk2(qv[4], qv[5]); qo.w = pk2(qv[6], qv[7]); ko.x = pk2(kv[0], kv[1]); ko.y = pk2(kv[2], kv[3]); ko.z = pk2(kv[4], kv[5]); ko.w = pk2(kv[6], kv[7]);
            *(LAS v4u*)(QB + st * PQ + sk8) = qo; *(LAS v4u*)(KB + st * PQ + sk8) = ko; *(LAS v4u*)(IVr + st * 128 + sk8) = ni;
#pragma unroll
            for (int hh = 0; hh < 2; ++hh)
#pragma unroll
                for (int r = 0; r < 4; ++r) ag[hh][r] = *(const bf16*)((const char*)P + (unsigned)((rbase + 16 * hh + 4 * fq + r) * (unsigned)NPAD + OFF_AG + h * 128 + 16 * wave + fr) * 2u);
            if (c + 1 < 64) { const unsigned pn = pst + (unsigned)(c + 1) * 32u * (unsigned)NPAD * 2u; nq = HG_LD16(pn + 2u * OFF_AQ); nf = HG_LD16(pn + 2u * OFF_AF); ni = HG_LD16(pn + 2u * OFF_AI); } }
        BAR_LDS();
        { const int k = tid & 127, tq = tid >> 7; float b[32]; float run = 0.f;
#pragma unroll
            for (int t = 0; t < 32; ++t) { run += LF[t * 128 + k]; b[t] = run; }
#pragma unroll
            for (int tq2 = 0; tq2 < 4; ++tq2) if (tq2 == tq) { const float mh = (tq2 < 2) ? b[7] : b[23]; float kt[8]; bf16 iv[8];
#pragma unroll
                for (int i = 0; i < 8; ++i) { const int t = 8 * tq2 + i; const float qv = bf1(QB[t * PQ + k]), kv = bf1(KB[t * PQ + k]); iv[i] = IVr[t * 128 + k];
                    Qt[t * PQ + k] = (bf16)f2bf(qv * __builtin_amdgcn_exp2f(b[t])); kt[i] = kv * __builtin_amdgcn_exp2f(b[31] - b[t]);
                    Qm[t * PQ + k] = (bf16)f2bf(qv * __builtin_amdgcn_exp2f(fminf(b[t] - mh, 115.f))); Km[t * PQ + k] = (bf16)f2bf(kv * __builtin_amdgcn_exp2f(fminf(mh - b[t], 115.f)));
                    if (tq2 < 2) Kr[t * PQ + k] = (bf16)f2bf(kv * __builtin_amdgcn_exp2f(b[15] - b[t])); else Qr[(t - 16) * PQ + k] = (bf16)f2bf(qv * __builtin_amdgcn_exp2f(b[t] - b[15])); }
                v4u ko; ko.x = pk2(kt[0], kt[1]); ko.y = pk2(kt[2], kt[3]); ko.z = pk2(kt[4], kt[5]); ko.w = pk2(kt[6], kt[7]); *(LAS v4u*)(KtT + k * PT + 8 * tq2) = ko;
                v4u vo; vo.x = (unsigned)iv[0] | ((unsigned)iv[1] << 16); vo.y = (unsigned)iv[2] | ((unsigned)iv[3] << 16); vo.z = (unsigned)iv[4] | ((unsigned)iv[5] << 16); vo.w = (unsigned)iv[6] | ((unsigned)iv[7] << 16); *(LAS v4u*)(VT + k * PT + 8 * tq2) = vo; }
            if (tq == 0) DEC[k] = __builtin_amdgcn_exp2f(b[31]); }
        if (c > 0) HG_OUT(rbase - 32);
        BAR_LDS();
        f32x4 at0 = (f32x4){0.f, 0.f, 0.f, 0.f}, at1 = at0, at2 = at0, o0 = at0, o1 = at0;
#pragma unroll
        for (int ks = 0; ks < 4; ++ks) { const int ko = 32 * ks + 8 * fq;
            at0 = MFMA16(LDFRAG(Km, fr, PQ, ko), LDFRAG(Qm, fr, PQ, ko), at0);
            at1 = MFMA16(LDFRAG(Km, 16 + fr, PQ, ko), LDFRAG(Qm, 16 + fr, PQ, ko), at1);
            at2 = MFMA16(LDFRAG(Kr, fr, PQ, ko), LDFRAG(Qr, fr, PQ, ko), at2);
            v4u sy; sy.x = pk2(sacc[2 * ks][0], sacc[2 * ks][1]); sy.y = pk2(sacc[2 * ks][2], sacc[2 * ks][3]); sy.z = pk2(sacc[2 * ks + 1][0], sacc[2 * ks + 1][1]); sy.w = pk2(sacc[2 * ks + 1][2], sacc[2 * ks + 1][3]);
            const v2u xa0 = *(const LAS v2u*)(Qt + fr * PQ + 32 * ks + 4 * fq), xb0 = *(const LAS v2u*)(Qt + fr * PQ + 32 * ks + 16 + 4 * fq);
            const v2u xa1 = *(const LAS v2u*)(Qt + (16 + fr) * PQ + 32 * ks + 4 * fq), xb1 = *(const LAS v2u*)(Qt + (16 + fr) * PQ + 32 * ks + 16 + 4 * fq);
            v4u x0; x0.x = xa0.x; x0.y = xa0.y; x0.z = xb0.x; x0.w = xb0.y; v4u x1; x1.x = xa1.x; x1.y = xa1.y; x1.z = xb1.x; x1.w = xb1.y;
            o0 = MFMA16(__builtin_bit_cast(bf16x8_t, x0), __builtin_bit_cast(bf16x8_t, sy), o0); o1 = MFMA16(__builtin_bit_cast(bf16x8_t, x1), __builtin_bit_cast(bf16x8_t, sy), o1); }
        {
            v4u a0, a1, a2; a0.z = 0u; a0.w = 0u; a1.z = 0u; a1.w = 0u; a2.z = 0u; a2.w = 0u;
            a0.x = pk2(4 * fq + 0 <= fr ? at0[0] : 0.f, 4 * fq + 1 <= fr ? at0[1] : 0.f); a0.y = pk2(4 * fq + 2 <= fr ? at0[2] : 0.f, 4 * fq + 3 <= fr ? at0[3] : 0.f);
            a1.x = pk2(4 * fq + 0 <= fr ? at1[0] : 0.f, 4 * fq + 1 <= fr ? at1[1] : 0.f); a1.y = pk2(4 * fq + 2 <= fr ? at1[2] : 0.f, 4 * fq + 3 <= fr ? at1[3] : 0.f);
            a2.x = pk2(at2[0], at2[1]); a2.y = pk2(at2[2], at2[3]);
            const v2u y0 = *(const LAS v2u*)(VT + (16 * wave + fr) * PT + 4 * fq), y1 = *(const LAS v2u*)(VT + (16 * wave + fr) * PT + 16 + 4 * fq);
            v4u v0; v0.x = y0.x; v0.y = y0.y; v0.z = 0u; v0.w = 0u; v4u v1; v1.x = y1.x; v1.y = y1.y; v1.z = 0u; v1.w = 0u;
            o0 = MFMA16(__builtin_bit_cast(bf16x8_t, a0), __builtin_bit_cast(bf16x8_t, v0), o0);
            o1 = MFMA16(__builtin_bit_cast(bf16x8_t, a1), __builtin_bit_cast(bf16x8_t, v1), o1);
            o1 = MFMA16(__builtin_bit_cast(bf16x8_t, a2), __builtin_bit_cast(bf16x8_t, v0), o1); }
#pragma unroll
        for (int r = 0; r < 4; ++r) { float q0 = o0[r] * o0[r], q1 = o1[r] * o1[r];
            q0 += __shfl_xor(q0, 1); q1 += __shfl_xor(q1, 1); q0 += __shfl_xor(q0, 2); q1 += __shfl_xor(q1, 2); q0 += __shfl_xor(q0, 4); q1 += __shfl_xor(q1, 4); q0 += __shfl_xor(q0, 8); q1 += __shfl_xor(q1, 8);
            if (fr == 0) { SS[(4 * fq + r) * 8 + wave] = q0; SS[(16 + 4 * fq + r) * 8 + wave] = q1; } }
        {
            const bf16x8_t vy = LDFRAG(VT, 16 * wave + fr, PT, 8 * fq);
#pragma unroll
            for (int kt = 0; kt < 8; ++kt) { const f32x4 d4 = *(const LAS f32x4*)(DEC + 16 * kt + 4 * fq); sacc[kt] = sacc[kt] * d4; sacc[kt] = MFMA16(LDFRAG(KtT, 16 * kt + fr, PT, 8 * fq), vy, sacc[kt]); } }
        po0 = o0; po1 = o1;
#pragma unroll
        for (int hh = 0; hh < 2; ++hh)
#pragma unroll
            for (int r = 0; r < 4; ++r) pag[hh][r] = ag[hh][r];
    }
    BAR_LDS();
    HG_OUT((unsigned)row0 + 2048u - 32u);
#undef HG_OUT
#undef HG_LD16
#pragma unroll
    for (int kt = 0; kt < 8; ++kt)
#pragma unroll
        for (int r = 0; r < 4; ++r) sout[(16 * kt + 4 * fq + r) * 128 + 16 * wave + fr] = sacc[kt][r];
    __syncthreads();
}

__device__ __forceinline__ void ssd_pre_phase(int lane, int gw, int NGW, const bf16* P, bf16* XC, float* DTb, float* ADT, float* ACUM,
                                              const float* conv_w, const float* conv_b, const float* dt_bias, const float* a_log, const float* state_conv, float* conv_out_p, float* conv_out_s) {
    unsigned ua = (unsigned)(((unsigned long long)(unsigned)gw * (3u * MT)) / (unsigned)NGW); const unsigned ub = (unsigned)(((unsigned long long)((unsigned)gw + 1u) * (3u * MT)) / (unsigned)NGW);
#define PRE_UNPK(dst, u) do { dst[0] = bflo(u.x); dst[1] = bfhi(u.x); dst[2] = bflo(u.y); dst[3] = bfhi(u.y); dst[4] = bflo(u.z); dst[5] = bfhi(u.z); dst[6] = bflo(u.w); dst[7] = bfhi(u.w); } while (0)
    while (ua < ub) {
        const int cg = (int)(ua / (unsigned)MT); const unsigned ue = ub < (unsigned)(cg + 1) * MT ? ub : (unsigned)(cg + 1) * MT;
        const int t0 = (int)(ua - (unsigned)cg * MT), t1 = (int)(ue - (unsigned)cg * MT), cc = cg * 512 + 8 * lane; ua = ue;
        float w[4][8], cb[8], a0[8], a1[8], a2[8];
#pragma unroll
        for (int j = 0; j < 4; ++j) { const f32x4 u0 = *(const f32x4*)(conv_w + j * 1536 + cc), u1 = *(const f32x4*)(conv_w + j * 1536 + cc + 4);
            w[j][0] = u0.x; w[j][1] = u0.y; w[j][2] = u0.z; w[j][3] = u0.w; w[j][4] = u1.x; w[j][5] = u1.y; w[j][6] = u1.z; w[j][7] = u1.w; }
        { const f32x4 u0 = *(const f32x4*)(conv_b + cc), u1 = *(const f32x4*)(conv_b + cc + 4); cb[0] = u0.x; cb[1] = u0.y; cb[2] = u0.z; cb[3] = u0.w; cb[4] = u1.x; cb[5] = u1.y; cb[6] = u1.z; cb[7] = u1.w; }
#pragma unroll
        for (int e = 0; e < 8; ++e) { a0[e] = 0.f; a1[e] = 0.f; a2[e] = 0.f; }
        const int ts = t0 >= 3 ? t0 - 3 : 0;
        const bf16* pc = P + OFF_XBC + cc; bf16* xo = XC + cc;
        v4u un[4];
#pragma unroll
        for (int k = 0; k < 4; ++k) { const int tt = ts + k < t1 ? ts + k : t1 - 1; un[k] = *(const v4u*)(pc + (size_t)tt * NPAD); }
        for (int tb = ts; tb < t1; tb += 4) { v4u uc[4];
#pragma unroll
            for (int k = 0; k < 4; ++k) uc[k] = un[k];
            if (tb + 4 < t1) {
#pragma unroll
                for (int k = 0; k < 4; ++k) { const int tt = tb + 4 + k < t1 ? tb + 4 + k : t1 - 1; un[k] = *(const v4u*)(pc + (size_t)tt * NPAD); } }
#pragma unroll
            for (int k = 0; k < 4; ++k) { const int t = tb + k; if (t < t1) {
                const bool smp = t >= NTOK_P; const bool st = smp ? (((t - NTOK_P) & 31) == 0) : ((t & 2047) == 0);
                if (st) {
                    if (smp) { const float* cbuf = state_conv + (size_t)((t - NTOK_P) >> 5) * 4608 + cc;
#pragma unroll
                        for (int e = 0; e < 8; ++e) { a0[e] = cbuf[e]; a1[e] = cbuf[1536 + e]; a2[e] = cbuf[3072 + e]; } }
                    else {
#pragma unroll
                        for (int e = 0; e < 8; ++e) { a0[e] = 0.f; a1[e] = 0.f; a2[e] = 0.f; } } }
                float cur[8]; PRE_UNPK(cur, uc[k]);
                if (t >= t0) { float o[8];
#pragma unroll
                    for (int e = 0; e < 8; ++e) o[e] = siluf_(cb[e] + w[0][e] * a0[e] + w[1][e] * a1[e] + w[2][e] * a2[e] + w[3][e] * cur[e]);
                    v4u ov; ov.x = pk2(o[0], o[1]); ov.y = pk2(o[2], o[3]); ov.z = pk2(o[4], o[5]); ov.w = pk2(o[6], o[7]);
                    *(v4u*)(xo + (size_t)t * 1536) = ov; }
#pragma unroll
                for (int e = 0; e < 8; ++e) { a0[e] = a1[e]; a1[e] = a2[e]; a2[e] = cur[e]; } } }
        }
    }
#undef PRE_UNPK
    for (int it = gw; it < 528 * 16; it += NGW) {
        const int rb = it >> 4, h = it & 15; const size_t row = (size_t)rb * 64 + lane;
        const float xv = bf1(P[row * NPAD + OFF_DT + h]) + dt_bias[h]; const float dt = xv > 20.f ? xv : log1pf(__expf(xv)); const float a = -dt * __expf(a_log[h]);
        float cs = a;
#pragma unroll
        for (int o = 1; o < 64; o <<= 1) { const float t = __shfl_up(cs, o); if (lane >= o) cs += t; }
        DTb[row * 16 + h] = dt; ADT[row * 16 + h] = a; ACUM[row * 16 + h] = cs;
    }
    for (int e = gw * 64 + lane; e < 48 * 4608; e += NGW * 64) {
        const int sq = e / 4608, r = e - sq * 4608, j = r / 1536, cc = r - j * 1536;
        const size_t row = sq < 16 ? (size_t)sq * 2048 + 2045 + j : (size_t)NTOK_P + (sq - 16) * 32 + 29 + j;
        const float v = bf1(P[row * NPAD + OFF_XBC + cc]);
        if (sq < 16) conv_out_p[sq * 4608 + r] = v; else conv_out_s[(sq - 16) * 4608 + r] = v;
    }
}

__device__ __forceinline__ void ssd_item(LAS unsigned char* lds, int tid, int lane, int wave, const bf16* P, const bf16* XC, const float* DTb, const float* ADT, bf16* YB, int row0, int T, int h,
                                         const float* s0, float* sout, float Dh) {
    LAS float* X = (LAS float*)lds;
    LAS float* Bs = X + 2048;
    LAS float* Cs = Bs + 4096;
    LAS float* DT = Cs + 4096;
    LAS float* DA = DT + 32;
    LAS float* PY = DA + 32;
    const int g = h >> 3, ci = tid;
    int cc = 0; LAS float* dst = X; int dstride = 64;
    if (ci < 64) { cc = h * 64 + ci; dst = X + ci; dstride = 64; } else if (ci < 192) { cc = 1024 + g * 128 + (ci - 64); dst = Bs + (ci - 64); dstride = 128; } else if (ci < 320) { cc = 1280 + g * 128 + (ci - 192); dst = Cs + (ci - 192); dstride = 128; }
    float hst[16];
#pragma unroll
    for (int j = 0; j < 4; ++j) { f32x4 v = (f32x4){0.f, 0.f, 0.f, 0.f}; if (s0) v = *(const f32x4*)(s0 + lane * 128 + 16 * wave + 4 * j); hst[4 * j] = v.x; hst[4 * j + 1] = v.y; hst[4 * j + 2] = v.z; hst[4 * j + 3] = v.w; }
    __syncthreads();
    const int nch = T / 32;
    for (int c = 0; c < nch; ++c) {
        const size_t rbase = (size_t)(row0 + c * 32);
        if (ci < 320) { const bf16* pc = XC + rbase * 1536 + cc;
            bf16 sv[32];
#pragma unroll
            for (int t = 0; t < 32; ++t) sv[t] = pc[(size_t)t * 1536];
#pragma unroll
            for (int t = 0; t < 32; ++t) dst[t * dstride] = bf1(sv[t]); }
        else if (ci < 352) { const int t = ci - 320; DT[t] = DTb[(rbase + t) * 16 + h]; DA[t] = __expf(ADT[(rbase + t) * 16 + h]); }
        unsigned zg[2];
#pragma unroll
        for (int j = 0; j < 2; ++j) { const int e = tid + 512 * j; zg[j] = *(const unsigned*)(P + (rbase + (e >> 5)) * NPAD + OFF_BZ + h * 64 + (e & 31) * 2); }
        __syncthreads();
#pragma unroll 2
        for (int t = 0; t < 32; ++t) {
            const float dA = DA[t], xdt = X[t * 64 + lane] * DT[t]; float py = 0.f;
#pragma unroll
            for (int n4 = 0; n4 < 4; ++n4) { const f32x4 b4 = *(const LAS f32x4*)(Bs + t * 128 + 16 * wave + 4 * n4), c4 = *(const LAS f32x4*)(Cs + t * 128 + 16 * wave + 4 * n4);
#pragma unroll
                for (int j = 0; j < 4; ++j) { const int nn = 4 * n4 + j; hst[nn] = fmaf(xdt, b4[j], dA * hst[nn]); py = fmaf(hst[nn], c4[j], py); } }
            PY[(t * 8 + wave) * 64 + lane] = py;
        }
        __syncthreads();
#pragma unroll
        for (int j = 0; j < 2; ++j) { const int e = tid + 512 * j, t = e >> 5, p2 = (e & 31) * 2; float y0 = 0.f, y1 = 0.f;
#pragma unroll
            for (int w = 0; w < 8; ++w) { const f32x2 p = *(const LAS f32x2*)(PY + (t * 8 + w) * 64 + p2); y0 += p.x; y1 += p.y; }
            const f32x2 xv = *(const LAS f32x2*)(X + t * 64 + p2); y0 += Dh * xv.x; y1 += Dh * xv.y;
            const size_t row = rbase + t; const unsigned z = zg[j];
            *(unsigned*)(YB + row * 1024 + h * 64 + p2) = pk2(y0 * siluf_(bflo(z)), y1 * siluf_(bfhi(z))); }
        __syncthreads();
    }
#pragma unroll
    for (int j = 0; j < 4; ++j) *(f32x4*)(sout + lane * 128 + 16 * wave + 4 * j) = (f32x4){hst[4 * j], hst[4 * j + 1], hst[4 * j + 2], hst[4 * j + 3]};
    __syncthreads();
}

__device__ __forceinline__ bf16 v4u_el(const v4u& d, int e) { const unsigned w = d[e >> 1]; return (bf16)((e & 1) ? (w >> 16) : (w & 0xffffu)); }
__device__ __forceinline__ void ssd_mfma_pair(LAS unsigned char* lds, int tid, int lane, int wave, const bf16* P, const bf16* XC, const float* DTb, const float* ACUM, bf16* YB, int row0, int h0, float Dh0, float Dh1, float* sout0) {
    constexpr int PC = 136, PS = 72;
    LAS bf16* Cm0 = (LAS bf16*)lds;
    LAS bf16* Bm = Cm0 + 2 * 64 * PC;
    LAS bf16* BmT = Bm + 64 * PC;
    LAS bf16* XT0 = BmT + 128 * PS;
    LAS bf16* Mm0 = XT0 + 4 * 64 * PS;
    LAS float* AC0 = (LAS float*)(Mm0 + 2 * 64 * PS);
    static_assert((2 * 64 * PC + 64 * PC + 128 * PS + 4 * 64 * PS + 2 * 64 * PS) * 2 + 4 * 192 * 4 <= RING_BYTES, "ssd pair LDS");
    const int fr = lane & 15, fq = lane >> 4, g = h0 >> 3;
    const int hw = wave >> 2, pt = wave & 3;
    __syncthreads();
    f32x4 hacc[8];
#pragma unroll
    for (int j = 0; j < 8; ++j) hacc[j] = (f32x4){0.f, 0.f, 0.f, 0.f};
    int pf_s[6], pf_c[6]; v4u pf[6];
#pragma unroll
    for (int j = 0; j < 6; ++j) { const int q = tid + 512 * j; pf_s[j] = q / 48; const int c16 = q - 48 * pf_s[j];
        const int col = c16 < 16 ? (h0 + (c16 >> 3)) * 64 + 8 * (c16 & 7) : (c16 < 32 ? 1024 + g * 128 + 8 * (c16 - 16) : 1280 + g * 128 + 8 * (c16 - 32));
        pf_c[j] = (c16 << 16) | col; pf[j] = *(const v4u*)((const char*)XC + (unsigned)(((unsigned)row0 + pf_s[j]) * 1536u + col) * 2u); }
    float pf_ac = 0.f, pf_dt = 0.f, pf_acl = 0.f; const int sh = tid >> 6, ssx = tid & 63;
    if (tid < 128) { pf_ac = *(const float*)((const char*)ACUM + (unsigned)(((unsigned)row0 + ssx) * 16u + h0 + sh) * 4u); pf_dt = *(const float*)((const char*)DTb + (unsigned)(((unsigned)row0 + ssx) * 16u + h0 + sh) * 4u); pf_acl = *(const float*)((const char*)ACUM + (unsigned)(((unsigned)row0 + 63u) * 16u + h0 + sh) * 4u); }
    for (int c = 0; c < 32; ++c) {
        const unsigned rbase = (unsigned)row0 + 64u * c;
        const int cb = c & 1;
        LAS bf16* Cm = Cm0 + cb * 64 * PC; LAS bf16* XTb = XT0 + cb * 2 * 64 * PS; LAS float* ACb = AC0 + cb * 2 * 192;
        if (tid < 128) { LAS float* A = ACb + sh * 192; A[ssx] = pf_ac; A[128 + ssx] = pf_dt; A[64 + ssx] = __expf(pf_acl - pf_ac) * pf_dt; }
#pragma unroll
        for (int j = 0; j < 6; ++j) { const int s = pf_s[j], c16 = pf_c[j] >> 16; const v4u d = pf[j];
            if (c16 < 16) { LAS bf16* XT = XTb + (c16 >> 3) * 64 * PS; const int cc = c16 & 7;
#pragma unroll
                for (int e = 0; e < 8; ++e) XT[(8 * cc + e) * PS + (s ^ (cc << 3))] = v4u_el(d, e); }
            else if (c16 < 32) { const int n0 = 8 * (c16 - 16); *(LAS v4u*)(Bm + s * PC + n0) = d;
#pragma unroll
                for (int e = 0; e < 8; ++e) BmT[(n0 + e) * PS + (s ^ (((c16 - 16) & 7) << 3))] = v4u_el(d, e); }
            else { *(LAS v4u*)(Cm + s * PC + 8 * (c16 - 32)) = d; } }
        if (c + 1 < 32) {
#pragma unroll
            for (int j = 0; j < 6; ++j) pf[j] = *(const v4u*)((const char*)XC + (unsigned)((rbase + 64u + pf_s[j]) * 1536u + (pf_c[j] & 0xffff)) * 2u);
            if (tid < 128) { pf_ac = *(const float*)((const char*)ACUM + (unsigned)((rbase + 64u + ssx) * 16u + h0 + sh) * 4u); pf_dt = *(const float*)((const char*)DTb + (unsigned)((rbase + 64u + ssx) * 16u + h0 + sh) * 4u); pf_acl = *(const float*)((const char*)ACUM + (unsigned)((rbase + 127u) * 16u + h0 + sh) * 4u); } }
        BAR_LDS();
        const LAS float* AC = ACb + hw * 192; const LAS bf16* XT = XTb + hw * 64 * PS;
        f32x4 yo[4];
        { bf16x8_t hb[4];
#pragma unroll
          for (int m = 0; m < 4; ++m) { v4u o; o.x = pk2(hacc[2 * m][0], hacc[2 * m][1]); o.y = pk2(hacc[2 * m][2], hacc[2 * m][3]); o.z = pk2(hacc[2 * m + 1][0], hacc[2 * m + 1][1]); o.w = pk2(hacc[2 * m + 1][2], hacc[2 * m + 1][3]);
              hb[m] = __builtin_bit_cast(bf16x8_t, o); }
#pragma unroll
          for (int li = 0; li < 4; ++li) { yo[li] = (f32x4){0.f, 0.f, 0.f, 0.f};
#pragma unroll
              for (int m = 0; m < 4; ++m) { const LAS bf16* cp = Cm + (16 * li + fr) * PC + 32 * m + 4 * fq; const v2u c0 = *(const LAS v2u*)cp, c1 = *(const LAS v2u*)(cp + 16);
                  v4u xo; xo.x = c0.x; xo.y = c0.y; xo.z = c1.x; xo.w = c1.y; yo[li] = MFMA16(__builtin_bit_cast(bf16x8_t, xo), hb[m], yo[li]); } } }
        { const LAS float* WU = AC + 64; const float dec = __expf(AC[63]);
          bf16x8_t xs[2];
#pragma unroll
          for (int ss = 0; ss < 2; ++ss) { const v4u d = *(const LAS v4u*)(XT + (16 * pt + fr) * PS + ((32 * ss + 8 * fq) ^ (((2 * pt + (fr >> 3)) & 7) << 3)));
              const f32x4 wa = *(const LAS f32x4*)(WU + 32 * ss + 8 * fq), wb = *(const LAS f32x4*)(WU + 32 * ss + 8 * fq + 4);
              v4u o; o.x = pk2(bflo(d.x) * wa.x, bfhi(d.x) * wa.y); o.y = pk2(bflo(d.y) * wa.z, bfhi(d.y) * wa.w); o.z = pk2(bflo(d.z) * wb.x, bfhi(d.z) * wb.y); o.w = pk2(bflo(d.w) * wb.z, bfhi(d.w) * wb.w);
              xs[ss] = __builtin_bit_cast(bf16x8_t, o); }
#pragma unroll
          for (int j = 0; j < 8; ++j) { hacc[j] = hacc[j] * dec;
#pragma unroll
              for (int ss = 0; ss < 2; ++ss) hacc[j] = MFMA16(LDFRAG(BmT, 16 * j + fr, PS, (32 * ss + 8 * fq) ^ (((2 * j + (fr >> 3)) & 7) << 3)), xs[ss], hacc[j]); } }
        {
            const int li = wave >> 1, si0 = 2 * (wave & 1);
#pragma unroll
            for (int tt = 0; tt < 2; ++tt) { const int si = si0 + tt; f32x4 acc = (f32x4){0.f, 0.f, 0.f, 0.f};
                if (si <= li) {
#pragma unroll
                    for (int ks = 0; ks < 4; ++ks) acc = MFMA16(LDFRAG(Cm, 16 * li + fr, PC, 32 * ks + 8 * fq), LDFRAG(Bm, 16 * si + fr, PC, 32 * ks + 8 * fq), acc); }
                const int s = 16 * si + fr;
#pragma unroll
                for (int hh = 0; hh < 2; ++hh) { const LAS float* A2 = ACb + hh * 192; LAS bf16* Mm = Mm0 + hh * 64 * PS; const float acs = A2[s], dts = A2[128 + s];
#pragma unroll
                    for (int r = 0; r < 4; ++r) { const int l = 16 * li + 4 * fq + r; const float m = (s <= l) ? acc[r] * __expf(A2[l] - acs) * dts : 0.f; Mm[l * PS + s] = (bf16)f2bf(m); } } }
        }
        bf16 zr[4][4];
#pragma unroll
        for (int li = 0; li < 4; ++li)
#pragma unroll
            for (int r = 0; r < 4; ++r) zr[li][r] = *(const bf16*)((const char*)P + (unsigned)((rbase + 16 * li + 4 * fq + r) * (unsigned)NPAD + OFF_BZ + (h0 + hw) * 64 + 16 * pt + fr) * 2u);
        BAR_LDS();
        {
            const LAS bf16* Mm = Mm0 + hw * 64 * PS; const int h = h0 + hw; const float Dh = hw ? Dh1 : Dh0; const int p = 16 * pt + fr;
            bf16x8_t xf[2];
#pragma unroll
            for (int ss = 0; ss < 2; ++ss) xf[ss] = LDFRAG(XT, 16 * pt + fr, PS, (32 * ss + 8 * fq) ^ (((2 * pt + (fr >> 3)) & 7) << 3));
#pragma unroll
            for (int li = 0; li < 4; ++li) { f32x4 yd = (f32x4){0.f, 0.f, 0.f, 0.f};
#pragma unroll
                for (int ss = 0; ss < 2; ++ss) { if (ss == 1 && li < 2) continue;
                    yd = MFMA16(LDFRAG(Mm, 16 * li + fr, PS, 32 * ss + 8 * fq), xf[ss], yd); }
#pragma unroll
                for (int r = 0; r < 4; ++r) { const int l = 16 * li + 4 * fq + r; const float y = yd[r] + __expf(AC[l]) * yo[li][r] + Dh * bf1(XT[p * PS + (l ^ (((p >> 3) & 7) << 3))]);
                    const float z = bf1(zr[li][r]);
                    *(bf16*)((char*)YB + (unsigned)((rbase + l) * 1024u + h * 64 + p) * 2u) = (bf16)f2bf(y * siluf_(z)); } }
        }
    }
#pragma unroll
    for (int j = 0; j < 8; ++j) *(f32x4*)(sout0 + (size_t)hw * 8192 + (16 * pt + fr) * 128 + 16 * j + 4 * fq) = hacc[j];
    __syncthreads();
}

__device__ __forceinline__ unsigned cm_off_b(unsigned row, unsigned ch) { return 256u * row + 16u * (ch ^ (((row & 3u) << 2) | ((row >> 2) & 3u))); }
__device__ __forceinline__ unsigned cm_tr_addr(unsigned lane, unsigned c, unsigned ks, unsigned t) { const unsigned g = lane >> 4, q = (lane & 15) >> 2, p = lane & 3; return cm_off_b(32 * ks + 8 * g + 4 * t + q, 2 * c + (p >> 1)) + 8 * (p & 1); }
__device__ __forceinline__ void cmlp_mfma_item(LAS unsigned char* lds, int tid, int lane, int wave, bf16* P, bf16* YC, int row0, const float* ln_g, const float* ln_b, const float* wsl, const float* bsl) {
    constexpr int PW = 136;
    LAS bf16* Wb = (LAS bf16*)lds;
    LAS unsigned char* Vimg = lds + 34816;
    LAS bf16* OUTb = (LAS bf16*)(lds + 67584);
    LAS float* ST = (LAS float*)(lds + ST_OFF);
    const int fr = lane & 15, fq = lane >> 4;
    __syncthreads();
    for (int i = 0; i < 16; ++i) { const int s = wave * 16 + i;
        v4u* p = (v4u*)(P + (size_t)(row0 + s) * NPAD + OFF_CV + 16 * lane); const v4u a = p[0], b = p[1];
        float v[16]; v[0] = bflo(a.x); v[1] = bfhi(a.x); v[2] = bflo(a.y); v[3] = bfhi(a.y); v[4] = bflo(a.z); v[5] = bfhi(a.z); v[6] = bflo(a.w); v[7] = bfhi(a.w);
        v[8] = bflo(b.x); v[9] = bfhi(b.x); v[10] = bflo(b.y); v[11] = bfhi(b.y); v[12] = bflo(b.z); v[13] = bfhi(b.z); v[14] = bflo(b.w); v[15] = bfhi(b.w);
        float sm = 0.f;
#pragma unroll
        for (int j = 0; j < 16; ++j) { v[j] = geluf_(v[j]); sm += v[j]; }
        v4u oa, ob; oa.x = pk2(v[0], v[1]); oa.y = pk2(v[2], v[3]); oa.z = pk2(v[4], v[5]); oa.w = pk2(v[6], v[7]); ob.x = pk2(v[8], v[9]); ob.y = pk2(v[10], v[11]); ob.z = pk2(v[12], v[13]); ob.w = pk2(v[14], v[15]);
        p[0] = oa; p[1] = ob;
        const float mean = wave_sum(sm) * (1.0f / 1024.0f); float sq = 0.f;
#pragma unroll
        for (int j = 0; j < 16; ++j) { const float d = v[j] - mean; sq += d * d; }
        const float rstd = rsqrtf_(wave_sum(sq) * (1.0f / 1024.0f) + NORM_EPS);
        if (lane == 0) { ST[2 * s] = mean; ST[2 * s + 1] = rstd; } }
    __syncthreads();
    f32x4 wreg[8]; v2u vreg[8];
#pragma unroll
    for (int e = 0; e < 8; ++e) { const int q = tid + 512 * e; wreg[e] = *(const f32x4*)(wsl + (size_t)(q >> 5) * 128 + 4 * (q & 31)); vreg[e] = *(const v2u*)(P + (size_t)(row0 + (q >> 5)) * NPAD + OFF_CV + 4 * (q & 31)); }
    for (int gh = 0; gh < 8; ++gh) { const int g = gh >> 1, c0 = gh * 128;
        if ((gh & 1) == 0) {
#pragma unroll
            for (int e = 0; e < 8; ++e) { const int q = tid + 512 * e, t = q >> 5, s4 = 4 * (q & 31); const f32x4 w = wreg[e];
                v2u o; o.x = pk2(s4 + 0 <= t ? w.x : 0.f, s4 + 1 <= t ? w.y : 0.f); o.y = pk2(s4 + 2 <= t ? w.z : 0.f, s4 + 3 <= t ? w.w : 0.f); *(LAS v2u*)(Wb + t * PW + s4) = o; } }
#pragma unroll
        for (int e = 0; e < 8; ++e) { const int q = tid + 512 * e, sr = q >> 5, c4 = 4 * (q & 31); const v2u cv = vreg[e]; const float mean = ST[2 * sr], rstd = ST[2 * sr + 1];
            const f32x4 lg = *(const f32x4*)(ln_g + c0 + c4), lb = *(const f32x4*)(ln_b + c0 + c4);
            v2u o; o.x = pk2((bflo(cv.x) - mean) * rstd * lg.x + lb.x, (bfhi(cv.x) - mean) * rstd * lg.y + lb.y); o.y = pk2((bflo(cv.y) - mean) * rstd * lg.z + lb.z, (bfhi(cv.y) - mean) * rstd * lg.w + lb.w);
            *(LAS v2u*)(Vimg + cm_off_b((unsigned)sr, (unsigned)(c4 >> 3)) + 2 * (c4 & 7)) = o; }
        v4u ureg[4];
#pragma unroll
        for (int e = 0; e < 4; ++e) { const int q = tid + 512 * e; ureg[e] = *(const v4u*)(P + (size_t)(row0 + (q >> 4)) * NPAD + OFF_CU + c0 + 8 * (q & 15)); }
        if (gh + 1 < 8) {
#pragma unroll
            for (int e = 0; e < 8; ++e) { const int q = tid + 512 * e; vreg[e] = *(const v2u*)(P + (size_t)(row0 + (q >> 5)) * NPAD + OFF_CV + c0 + 128 + 4 * (q & 31)); }
            if (gh & 1) {
#pragma unroll
                for (int e = 0; e < 8; ++e) { const int q = tid + 512 * e; wreg[e] = *(const f32x4*)(wsl + ((size_t)(g + 1) * 128 + (q >> 5)) * 128 + 4 * (q & 31)); } } }
        BAR_LDS();
        { f32x4 acc[8];
#pragma unroll
            for (int ti = 0; ti < 8; ++ti) acc[ti] = (f32x4){0.f, 0.f, 0.f, 0.f};
            const unsigned vb = (unsigned)(size_t)Vimg;
#pragma unroll
            for (int ks = 0; ks < 4; ++ks) { v2u y0, y1;
                asm volatile("ds_read_b64_tr_b16 %0, %2\n\tds_read_b64_tr_b16 %1, %3\n\ts_waitcnt lgkmcnt(0)" : "=&v"(y0), "=&v"(y1) : "v"(vb + cm_tr_addr((unsigned)lane, (unsigned)wave, (unsigned)ks, 0u)), "v"(vb + cm_tr_addr((unsigned)lane, (unsigned)wave, (unsigned)ks, 1u)) : "memory");
                v4u yy; yy.x = y0.x; yy.y = y0.y; yy.z = y1.x; yy.w = y1.y; const bf16x8_t yf = __builtin_bit_cast(bf16x8_t, yy);
#pragma unroll
                for (int ti = 2 * ks; ti < 8; ++ti) acc[ti] = MFMA16(LDFRAG(Wb, 16 * ti + fr, PW, 32 * ks + 8 * fq), yf, acc[ti]); }
#pragma unroll
            for (int ti = 0; ti < 8; ++ti)
#pragma unroll
                for (int r = 0; r < 4; ++r) OUTb[(16 * ti + 4 * fq + r) * PW + 16 * wave + fr] = (bf16)f2bf(acc[ti][r]); }
        BAR_LDS();
#pragma unroll
        for (int e = 0; e < 4; ++e) { const int q = tid + 512 * e, t = q >> 4, c8 = 8 * (q & 15); const v4u o = *(const LAS v4u*)(OUTb + t * PW + c8); const v4u u = ureg[e]; const float bsv = bsl[g * 128 + t];
            v4u y; y.x = pk2(geluf_(bflo(u.x)) * (bflo(o.x) + bsv), geluf_(bfhi(u.x)) * (bfhi(o.x) + bsv)); y.y = pk2(geluf_(bflo(u.y)) * (bflo(o.y) + bsv), geluf_(bfhi(u.y)) * (bfhi(o.y) + bsv));
            y.z = pk2(geluf_(bflo(u.z)) * (bflo(o.z) + bsv), geluf_(bfhi(u.z)) * (bfhi(o.z) + bsv)); y.w = pk2(geluf_(bflo(u.w)) * (bflo(o.w) + bsv), geluf_(bfhi(u.w)) * (bfhi(o.w) + bsv));
            *(v4u*)(YC + (size_t)(row0 + t) * 1024 + c0 + c8) = y; }
    }
    __syncthreads();
}

__device__ __forceinline__ void cmlp_item(LAS unsigned char* lds, int tid, int lane, int wave, const bf16* P, bf16* YC, int row0, int Lc,
                                          const float* ln_g, const float* ln_b, const float* wsl, const float* bsl, float* vout) {
    LAS float* WT = (LAS float*)lds;
    LAS float* V = WT + 16384;
    LAS float* ST = (LAS float*)(lds + ST_OFF);
    __syncthreads();
    for (int i = 0; i < 16; ++i) { const int s = wave * 16 + i; if (s < Lc) {
            const v4u* p = (const v4u*)(P + (size_t)(row0 + s) * NPAD + OFF_CV + 16 * lane); const v4u a = p[0], b = p[1];
            float v[16]; v[0] = bflo(a.x); v[1] = bfhi(a.x); v[2] = bflo(a.y); v[3] = bfhi(a.y); v[4] = bflo(a.z); v[5] = bfhi(a.z); v[6] = bflo(a.w); v[7] = bfhi(a.w);
            v[8] = bflo(b.x); v[9] = bfhi(b.x); v[10] = bflo(b.y); v[11] = bfhi(b.y); v[12] = bflo(b.z); v[13] = bfhi(b.z); v[14] = bflo(b.w); v[15] = bfhi(b.w);
            float sm = 0.f;
#pragma unroll
            for (int j = 0; j < 16; ++j) { v[j] = geluf_(v[j]); sm += v[j]; }
            const float mean = wave_sum(sm) * (1.0f / 1024.0f); float sq = 0.f;
#pragma unroll
            for (int j = 0; j < 16; ++j) { const float d = v[j] - mean; sq += d * d; }
            const float rstd = 1.0f / sqrtf(wave_sum(sq) * (1.0f / 1024.0f) + NORM_EPS);
            if (lane == 0) { ST[2 * s] = mean; ST[2 * s + 1] = rstd; } } }
    const int tg = tid >> 4, cg = tid & 15;
    for (int g = 0; g < 4; ++g) {
        __syncthreads();
#pragma unroll 1
        for (int j = 0; j < 8; ++j) { const int e = tid + 512 * j, s4 = (e >> 7) * 4, t = e & 127;
            f32x4 w = (f32x4){0.f, 0.f, 0.f, 0.f}; if (t < Lc && s4 < Lc) w = *(const f32x4*)(wsl + ((size_t)g * 128 + t) * 128 + s4);
#pragma unroll
            for (int jj = 0; jj < 4; ++jj) WT[(s4 + jj) * 128 + t] = (s4 + jj <= t) ? w[jj] : 0.f; }
        for (int half = 0; half < 2; ++half) { const int c0 = g * 256 + half * 128;
            if (half) __syncthreads();
#pragma unroll 2
            for (int j = 0; j < 8; ++j) { const int e = tid + 512 * j, s = e >> 5, c4 = (e & 31) * 4;
                if (s < Lc) { const v2u cv = *(const v2u*)(P + (size_t)(row0 + s) * NPAD + OFF_CV + c0 + c4); const float mean = ST[2 * s], rstd = ST[2 * s + 1];
                    const f32x4 lg = *(const f32x4*)(ln_g + c0 + c4), lb = *(const f32x4*)(ln_b + c0 + c4);
                    f32x4 v; v.x = (geluf_(bflo(cv.x)) - mean) * rstd * lg.x + lb.x; v.y = (geluf_(bfhi(cv.x)) - mean) * rstd * lg.y + lb.y; v.z = (geluf_(bflo(cv.y)) - mean) * rstd * lg.z + lb.z; v.w = (geluf_(bfhi(cv.y)) - mean) * rstd * lg.w + lb.w;
                    *(LAS f32x4*)(V + s * 128 + c4) = v; if (vout) *(f32x4*)(vout + (size_t)s * 1024 + c0 + c4) = v; } }
            __syncthreads();
            float acc[4][8];
#pragma unroll
            for (int i = 0; i < 4; ++i)
#pragma unroll
                for (int j = 0; j < 8; ++j) acc[i][j] = 0.f;
            for (int s = 0; s < Lc; ++s) { const f32x4 w4 = *(const LAS f32x4*)(WT + s * 128 + 4 * tg), va = *(const LAS f32x4*)(V + s * 128 + 4 * cg), vb = *(const LAS f32x4*)(V + s * 128 + 64 + 4 * cg);
#pragma unroll
                for (int i = 0; i < 4; ++i) {
#pragma unroll
                    for (int j = 0; j < 4; ++j) { acc[i][j] = fmaf(w4[i], va[j], acc[i][j]); acc[i][4 + j] = fmaf(w4[i], vb[j], acc[i][4 + j]); } } }
#pragma unroll
            for (int i = 0; i < 4; ++i) { const int t = 4 * tg + i; if (t < Lc) { const size_t row = (size_t)(row0 + t); const float bsv = bsl[g * 128 + t];
                    const v2u ua = *(const v2u*)(P + row * NPAD + OFF_CU + c0 + 4 * cg), ub = *(const v2u*)(P + row * NPAD + OFF_CU + c0 + 64 + 4 * cg);
                    v2u oa, ob; oa.x = pk2(geluf_(bflo(ua.x)) * (acc[i][0] + bsv), geluf_(bfhi(ua.x)) * (acc[i][1] + bsv)); oa.y = pk2(geluf_(bflo(ua.y)) * (acc[i][2] + bsv), geluf_(bfhi(ua.y)) * (acc[i][3] + bsv));
                    ob.x = pk2(geluf_(bflo(ub.x)) * (acc[i][4] + bsv), geluf_(bfhi(ub.x)) * (acc[i][5] + bsv)); ob.y = pk2(geluf_(bflo(ub.y)) * (acc[i][6] + bsv), geluf_(bfhi(ub.y)) * (acc[i][7] + bsv));
                    *(v2u*)(YC + row * 1024 + c0 + 4 * cg) = oa; *(v2u*)(YC + row * 1024 + c0 + 64 + 4 * cg) = ob; } }
        }
    }
    __syncthreads();
}

#ifndef DOWN_REV
#define DOWN_REV 1
#endif
#ifndef EPI_ALIGN_HEAVY
#define EPI_ALIGN_HEAVY true
#endif
#ifndef TAIL_SPLIT
#define TAIL_SPLIT 1
#endif
#ifndef MK_N_LAUNCHES
#define MK_N_LAUNCHES 1
#endif
constexpr int PH_PER_LAYER = 10, N_PHASES = 2 + DEPTH * PH_PER_LAYER;
constexpr int Q_NITEMS = 128 + 128 + 256 + 256 + 512 + 32;
struct Args { const float* in[29]; float* out; unsigned char* ws; int ph_lo, ph_hi; };
static_assert(sizeof(Args) == 29 * 8 + 8 + 8 + 8, "no padding in Args");

typedef const __attribute__((address_space(4))) unsigned long long* karg_t;
__device__ __forceinline__ unsigned long long ldarg(int i) { karg_t p = (karg_t)__builtin_amdgcn_kernarg_segment_ptr(); asm volatile("" : "+s"(p)); return p[i]; }
#define INP(i) ((const float*)ldarg(i))
#define OUTP() ((float*)ldarg(29))
#define WSP() ((unsigned char*)ldarg(30))

__device__ __forceinline__ int tid_now(int wave_s) { return (int)__builtin_amdgcn_mbcnt_hi(~0u, __builtin_amdgcn_mbcnt_lo(~0u, 0u)) + 64 * wave_s; }
__global__ void __launch_bounds__(NWAVES * 64, 2) fwd(Args args) {
    extern __shared__ __attribute__((aligned(16))) unsigned char lds_raw[];
    LAS unsigned char* lds = (LAS unsigned char*)lds_raw;
    volatile LAS unsigned* MISC = (volatile LAS unsigned*)(lds + MISC_OFF);
    const int wave_s = __builtin_amdgcn_readfirstlane((int)threadIdx.x >> 6);
    for (int u = threadIdx.x; u < 64; u += NWAVES * 64) MISC[u] = 0u;
    __syncthreads();
    XcdBarrier bar = xcd_barrier_post((unsigned*)WSP() + CW_BAR, MISC + 8, (int)threadIdx.x);
    const int lo = args.ph_lo, hi = args.ph_hi;
#define IN(k) (lo <= (k) && (k) < hi)
#define SEAM(k) do { if (IN((k) + 1)) { XcdBarrier b2_ = bar; b2_.bar = (unsigned*)WSP() + CW_BAR; asm volatile("" : "+s"(b2_.x)); xcd_barrier(b2_, tid_now(wave_s)); } } while (0)
#define GEOM() int tid = tid_now(wave_s); asm volatile("" : "+v"(tid)); int G = gridDim.x, bx = blockIdx.x; asm volatile("" : "+s"(G), "+s"(bx)); \
    const int lane = tid & 63, wave = __builtin_amdgcn_readfirstlane(tid >> 6); \
    const int vcu = (G % 8 == 0) ? (bx % 8) * (G / 8) + bx / 8 : bx; const int gw = vcu * NWAVES + wave, NGW = G * NWAVES; (void)lane; (void)gw; (void)NGW; (void)wave; (void)tid

    if (IN(0)) { GEOM();
        for (int it = bx; it < DEPTH * 96; it += G) mod_item(lds, tid, it, INP(5), INP(6), INP(9), INP(10), (float*)(WSP() + WS_MOD));
        { unsigned char* ws = WSP(); cvt_phase<true>(lds, wave, lane, 0, 0, 0, INP(11), INP(24), INP(25), INP(26), INP(27), ws + wofs(0), (unsigned*)ws + CW_QC); }
        SEAM(0);
    }
    for (int lc = 0; lc < DEPTH; ++lc) {
        const int pb = 1 + PH_PER_LAYER * lc;
        if (IN(pb + 0)) { GEOM(); int l = lc; asm volatile("" : "+s"(l)); unsigned char* ws = WSP(); bf16* X = (bf16*)(ws + WS_X);
            const bool comb = TAIL_SPLIT && l > 0; if (comb) build_tail_map((LAS int*)lds, tid, G, DOWN_REV);
            const float* modl = (const float*)(ws + WS_MOD) + (size_t)l * NSEQ * 12288;
            if (l == 0) norm_mod_phase<true>(lane, gw, NGW, INP(0), INP(1), X, INP(7), modl, 0, 1, (bf16*)(ws + WS_H), false, (const LAS int*)lds, (const float*)(ws + WS_SLAB), false);
            else norm_mod_phase<false>(lane, gw, NGW, nullptr, nullptr, X, INP(7) + l * DM, modl, 0, 1, (bf16*)(ws + WS_H), comb, (const LAS int*)lds, (const float*)(ws + WS_SLAB), false);
            SEAM(pb + 0);
        }
        if (IN(pb + 1)) { unsigned char* ws = WSP(); const int G = gridDim.x, bx = blockIdx.x;
            pg8::Gemm g{(const bf16*)(ws + WS_H), (const bf16*)(ws + wofs(lc) + WS_WIN), MT, NPAD, DM, DM}; pg8::StaticOrder S; S.init(MT, NPAD, G, bx);
            pg8::EpiStore<0> E{(bf16*)(ws + WS_P), NPAD};
#ifndef REP_P1
#define REP_P1 1
#endif
#pragma unroll 1
            for (int rp = 0; rp < REP_P1; ++rp)
#ifndef WIN_B_AUX
#define WIN_B_AUX 0
#endif
#ifdef SPLIT_WIN
            { S.nlim = (S.nwg / (2 * G)) * G; pg8::gemm_phase<pg8::EpiStore<0>, pg8::StaticOrder, true, true, 0, WIN_B_AUX>(lds, g, S, E, tid_now(wave_s));
              { XcdBarrier b2_ = bar; b2_.bar = (unsigned*)WSP() + CW_BAR; asm volatile("" : "+s"(b2_.x)); xcd_barrier(b2_, tid_now(wave_s)); }
              S.off = S.nlim; S.nlim = S.nwg; }
#endif
            pg8::gemm_phase<pg8::EpiStore<0>, pg8::StaticOrder, true, true, 0, WIN_B_AUX>(lds, g, S, E, tid_now(wave_s));
            SEAM(pb + 1);
        }
        if (IN(pb + 2)) { GEOM(); int l = lc; asm volatile("" : "+s"(l)); unsigned char* ws = WSP(); float* out = OUTP();
#ifndef REP_P2
#define REP_P2 1
#endif
#pragma unroll 1
            for (int rp = 0; rp < REP_P2; ++rp)
            ssd_pre_phase(lane, gw, NGW, (const bf16*)(ws + WS_P), (bf16*)(ws + WS_XC), (float*)(ws + WS_DT), (float*)(ws + WS_DT + DT_ARR), (float*)(ws + WS_DT + 2 * DT_ARR),
                          INP(14) + (size_t)l * 4 * 1536, INP(15) + l * 1536, INP(16) + l * 16, INP(17) + l * 16, INP(4) + (size_t)l * 32 * 4608, out + OUT_CONV_P + (size_t)l * 16 * 4608, out + OUT_CONV_S + (size_t)l * 32 * 4608);
            SEAM(pb + 2);
        }
        if (IN(pb + 3)) { GEOM(); int l = lc; asm volatile("" : "+s"(l));
#ifndef MIX_REPS
#define MIX_REPS 1
#endif
#pragma unroll 1
            for (int rep = 0; rep < MIX_REPS; ++rep)
            for (;;) {
                unsigned char* ws = WSP(); float* out = OUTP(); bf16* Pb = (bf16*)(ws + WS_P); bf16* Y3 = (bf16*)(ws + WS_Y3);
                __syncthreads();
                if (tid_now(wave_s) == 0) MISC[0] = __hip_atomic_fetch_add((unsigned*)ws + CW_Q + 64 * (l + 4 * rep), 1u, __ATOMIC_RELAXED, __HIP_MEMORY_SCOPE_AGENT);
                __syncthreads();
                int it = (int)MISC[0];
#ifdef EXTRA_BASE
                if (it >= Q_NITEMS && it < Q_NITEMS + EXTRA_N) it = EXTRA_BASE + (it - Q_NITEMS);
#endif
                if (it >= Q_NITEMS) break;
#define ITEM_GEOM() int tid_i = tid_now(wave_s); asm volatile("" : "+v"(tid_i)); const int lane_i = tid_i & 63, wave_i = __builtin_amdgcn_readfirstlane(tid_i >> 6)
                if (it < 128) {
                    const int b = 15 - (it >> 3), h = it & 7;
                    ITEM_GEOM(); hgrn_mfma_item(lds, tid_i, lane_i, wave_i, Pb, Y3, b * 2048, h, l, out + OUT_HGRN_P + (((size_t)l * 16 + b) * 8 + h) * 16384, INP(12), INP(13) + l * 1024);
                } else if (it < 256) {
                    const int j = it - 128, b = 15 - (j >> 3), h0 = 2 * (j & 7);
                    ITEM_GEOM(); ssd_mfma_pair(lds, tid_i, lane_i, wave_i, Pb, (const bf16*)(ws + WS_XC), (const float*)(ws + WS_DT), (const float*)(ws + WS_DT + 2 * DT_ARR), Y3 + (size_t)MT * 1024, b * 2048, h0, INP(18)[l * 16 + h0], INP(18)[l * 16 + h0 + 1],
                                  out + OUT_SSM_P + (((size_t)l * 16 + b) * 16 + h0) * 8192);
                } else if (it < 512) {
                    ITEM_GEOM(); cmlp_mfma_item(lds, tid_i, lane_i, wave_i, Pb, Y3 + (size_t)2 * MT * 1024, (255 - (it - 256)) * 128, INP(20) + l * 1024, INP(21) + l * 1024, INP(22) + (size_t)l * 4 * 16384, INP(23) + l * 512);
                } else if (it < 768) {
                    const int j = it - 512, b = j >> 3, h = j & 7;
                    ITEM_GEOM(); hgrn_item(lds, tid_i, lane_i, wave_i, Pb, Y3, NTOK_P + b * 32, 32, h, l, INP(2) + (((size_t)l * 32 + b) * 8 + h) * 16384, out + OUT_HGRN_S + (((size_t)l * 32 + b) * 8 + h) * 16384, INP(12), INP(13) + l * 1024);
                } else if (it < 1280) {
                    const int j = it - 768, b = j >> 4, h = j & 15;
                    ITEM_GEOM(); ssd_item(lds, tid_i, lane_i, wave_i, Pb, (const bf16*)(ws + WS_XC), (const float*)(ws + WS_DT), (const float*)(ws + WS_DT + DT_ARR), Y3 + (size_t)MT * 1024, NTOK_P + b * 32, 32, h,
                             INP(3) + (((size_t)l * 32 + b) * 16 + h) * 8192, out + OUT_SSM_S + (((size_t)l * 32 + b) * 16 + h) * 8192, INP(18)[l * 16 + h]);
                } else {
                    const int j = it - 1280;
                    ITEM_GEOM(); cmlp_item(lds, tid_i, lane_i, wave_i, Pb, Y3 + (size_t)2 * MT * 1024, NTOK_P + j * 32, 32, INP(20) + l * 1024, INP(21) + l * 1024, INP(22) + (size_t)l * 4 * 16384, INP(23) + l * 512, out + OUT_V_S + ((size_t)l * 32 + j) * 32 * 1024);
                }
            }
            SEAM(pb + 3);
        }
        if (IN(pb + 4)) { GEOM(); int l = lc; asm volatile("" : "+s"(l)); ssd_norm_phase(lane, gw, NGW, (bf16*)(WSP() + WS_Y3) + (size_t)MT * 1024, INP(19) + l * 1024); SEAM(pb + 4); }
        if (IN(pb + 5)) { unsigned char* ws = WSP(); const int G = gridDim.x, bx = blockIdx.x;
            pg8::Gemm g{(const bf16*)(ws + WS_Y3), (const bf16*)(ws + wofs(lc) + WS_WBR), 3 * MT, 3 * DM, 1024, 1024}; pg8::BranchOrder S; S.init(MT / 256, DM / 256, G, bx);
            pg8::EpiBranch E{(const bf16*)(ws + WS_P), NPAD, OFF_GATE, (bf16*)(ws + WS_H), DM, MT / 256, DM / 256};
#ifndef STAGGER_BR
#define STAGGER_BR 0
#endif
            if (STAGGER_BR && ((bx >> 3) & 1)) { for (int i = 0; i < STAGGER_BR; ++i) __builtin_amdgcn_s_sleep(127); }
#ifndef REP_P5
#define REP_P5 1
#endif
#pragma unroll 1
            for (int rp = 0; rp < REP_P5; ++rp)
            pg8::gemm_phase<pg8::EpiBranch, pg8::BranchOrder, EPI_ALIGN_HEAVY, true>(lds, g, S, E, tid_now(wave_s));
            if (lc + 1 < DEPTH) {
                GEOM(); int l1 = lc + 1; asm volatile("" : "+s"(l1)); unsigned char* ws2 = WSP();
                cvt_phase<true>(lds, wave, lane, 0, 0, l1, INP(11), INP(24), INP(25), INP(26), INP(27), ws2 + wofs(l1), (unsigned*)ws2 + CW_QC + 64 * l1);
#ifdef REP_CVT
                cvt_phase<true>(lds, wave, lane, 0, 0, l1, INP(11), INP(24), INP(25), INP(26), INP(27), ws2 + wofs(l1), (unsigned*)ws2 + CW_QC + 64 * (l1 + 4));
#endif
            }
            SEAM(pb + 5);
        }
        if (IN(pb + 6)) { int l = lc; asm volatile("" : "+s"(l)); unsigned char* ws = WSP(); bf16* X = (bf16*)(ws + WS_X); const int G = gridDim.x, bx = blockIdx.x;
            pg8::StaticOrder S; S.init(MT, DM, G, bx); S.wgm = WGM_N8; const int nfull = TAIL_SPLIT ? tail_nfull(S.nwg, G) : S.nwg; S.nlim = nfull;
            const float* gm = (const float*)(ws + WS_MOD) + (size_t)l * NSEQ * 12288 + 2 * DM;
            { pg8::Gemm g{(const bf16*)(ws + WS_H), (const bf16*)(ws + wofs(lc) + WS_WOUT), MT, DM, DM, DM};
#ifdef REP_P6
              { pg8::EpiRes E0{X, (const float*)(ws + 524288), 0}; pg8::gemm_phase<pg8::EpiRes, pg8::StaticOrder, EPI_ALIGN_HEAVY, true>(lds, g, S, E0, tid_now(wave_s)); }
#endif
              pg8::EpiRes E{X, gm, 12288};
              pg8::gemm_phase<pg8::EpiRes, pg8::StaticOrder, EPI_ALIGN_HEAVY, true>(lds, g, S, E, tid_now(wave_s)); }
            if (TAIL_SPLIT) { pg8::Gemm g{(const bf16*)(ws + WS_H), (const bf16*)(ws + wofs(lc) + WS_WOUT), MT, DM, DM / 8, DM}; pg8::TailOrder T; T.init(S, nfull, 8, DM / 8);
              pg8::EpiSlab E{(float*)(ws + WS_SLAB), gm};
              pg8::gemm_phase<pg8::EpiSlab, pg8::TailOrder, true, true>(lds, g, T, E, tid_now(wave_s)); }
            SEAM(pb + 6);
        }
        if (IN(pb + 7)) { GEOM(); int l = lc; asm volatile("" : "+s"(l)); unsigned char* ws = WSP(); bf16* X = (bf16*)(ws + WS_X);
            if (TAIL_SPLIT) build_tail_map((LAS int*)lds, tid, G, 0);
#ifdef REP_N7
            norm_mod_phase<false>(lane, gw, NGW, nullptr, nullptr, X, INP(8) + l * DM, (const float*)(ws + WS_MOD) + (size_t)l * NSEQ * 12288, 3, 4, (bf16*)(ws + WS_H), false, (const LAS int*)lds, (const float*)(ws + WS_SLAB), true);
#endif
            norm_mod_phase<false>(lane, gw, NGW, nullptr, nullptr, X, INP(8) + l * DM, (const float*)(ws + WS_MOD) + (size_t)l * NSEQ * 12288, 3, 4, (bf16*)(ws + WS_H), TAIL_SPLIT != 0, (const LAS int*)lds, (const float*)(ws + WS_SLAB), true); SEAM(pb + 7); }
        if (IN(pb + 8)) { unsigned char* ws = WSP(); const int G = gridDim.x, bx = blockIdx.x;
            pg8::Gemm g{(const bf16*)(ws + WS_H), (const bf16*)(ws + wofs(lc) + WS_WUP), MT, DFF, DM, DM}; pg8::StaticOrder S; S.init(MT, DFF, G, bx);
            pg8::EpiStore<1> E{(bf16*)(ws + WS_P), DFF};
#ifndef REP_P8
#define REP_P8 1
#endif
#pragma unroll 1
            for (int rp = 0; rp < REP_P8; ++rp)
            pg8::gemm_phase<pg8::EpiStore<1>, pg8::StaticOrder, true, true, 0, WIN_B_AUX>(lds, g, S, E, tid_now(wave_s));
            SEAM(pb + 8);
        }
        if (IN(pb + 9)) { int l = lc; asm volatile("" : "+s"(l)); unsigned char* ws = WSP(); bf16* X = (bf16*)(ws + WS_X); const int G = gridDim.x, bx = blockIdx.x;
            pg8::StaticOrder S; S.init(MT, DM, G, bx); S.wgm = WGM_N8; S.rev = DOWN_REV; const int nfull = TAIL_SPLIT ? tail_nfull(S.nwg, G) : S.nwg; S.nlim = nfull;
            const float* gm = (const float*)(ws + WS_MOD) + (size_t)l * NSEQ * 12288 + 5 * DM;
            { pg8::Gemm g{(const bf16*)(ws + WS_P), (const bf16*)(ws + wofs(lc) + WS_WDN), MT, DM, DFF, DFF};
#ifdef REP_P9
              { pg8::EpiRes E0{X, (const float*)(ws + 524288), 0}; pg8::gemm_phase<pg8::EpiRes, pg8::StaticOrder, EPI_ALIGN_HEAVY, true>(lds, g, S, E0, tid_now(wave_s)); }
#endif
              pg8::EpiRes E{X, gm, 12288};
#ifndef DOWN_A_AUX
#define DOWN_A_AUX 0
#endif
              pg8::gemm_phase<pg8::EpiRes, pg8::StaticOrder, EPI_ALIGN_HEAVY, true, DOWN_A_AUX>(lds, g, S, E, tid_now(wave_s)); }
            if (TAIL_SPLIT) { pg8::Gemm g{(const bf16*)(ws + WS_P), (const bf16*)(ws + wofs(lc) + WS_WDN), MT, DM, DFF / 8, DFF}; pg8::TailOrder T; T.init(S, nfull, 8, DFF / 8);
              pg8::EpiSlab E{(float*)(ws + WS_SLAB), gm};
              pg8::gemm_phase<pg8::EpiSlab, pg8::TailOrder, true, true>(lds, g, T, E, tid_now(wave_s)); }
            SEAM(pb + 9);
        }
    }
    if (IN(N_PHASES - 1)) { GEOM(); unsigned char* ws = WSP(); if (TAIL_SPLIT) build_tail_map((LAS int*)lds, tid, G, DOWN_REV);
        final_norm_phase(lane, gw, NGW, (const bf16*)(ws + WS_X), OUTP(), INP(28), TAIL_SPLIT != 0, (const LAS int*)lds, (const float*)(ws + WS_SLAB)); }
#undef IN
#undef SEAM
#undef GEOM
}

extern "C" void kernel_launch(void* const* d_in, const int* in_sizes, int n_in, void* d_out, int out_size, void* d_ws, size_t ws_size, hipStream_t stream) {
    static int grid = 0;
    if (grid == 0) {
        if (n_in != 29 || (size_t)out_size != OUT_TOTAL || ws_size < WS_END) { fprintf(stderr, "kernel_launch: unexpected shapes: n_in %d out %d ws %zu (need %zu)\n", n_in, out_size, ws_size, (size_t)WS_END); grid = -1; return; }
        int dev = 0, cus = 0, per_cu = 0;
        if (hipGetDevice(&dev) != hipSuccess || hipDeviceGetAttribute(&cus, hipDeviceAttributeMultiprocessorCount, dev) != hipSuccess) { grid = -1; return; }
        if (hipFuncSetAttribute((const void*)fwd, hipFuncAttributeMaxDynamicSharedMemorySize, LDS_BYTES) != hipSuccess) { fprintf(stderr, "kernel_launch: hipFuncSetAttribute failed\n"); grid = -1; return; }
        if (hipOccupancyMaxActiveBlocksPerMultiprocessor(&per_cu, (const void*)fwd, NWAVES * 64, LDS_BYTES) != hipSuccess || per_cu < 1) fprintf(stderr, "kernel_launch: occupancy query says %d\n", per_cu);
        (void)hipGetLastError();
        grid = cus;
    }
    if (grid < 0) return;
    if (hipMemsetAsync((char*)d_ws + WS_CTL, 0, CTL_ZERO_BYTES, stream) != hipSuccess) return;
    Args a{};
    for (int i = 0; i < 29; ++i) a.in[i] = (const float*)d_in[i];
    a.out = (float*)d_out; a.ws = (unsigned char*)d_ws;
#if MK_N_LAUNCHES == 1
    a.ph_lo = 0; a.ph_hi = N_PHASES;
    hipLaunchKernelGGL(fwd, dim3(grid), dim3(NWAVES * 64), LDS_BYTES, stream, a);
#else
    for (int p = 0; p < N_PHASES; ++p) { a.ph_lo = p; a.ph_hi = p + 1; hipLaunchKernelGGL(fwd, dim3(grid), dim3(NWAVES * 64), LDS_BYTES, stream, a); }
#endif
}
```

```cpp
#include <hip/hip_runtime.h>
#include <cstdio>
#include <cstdint>
namespace pg8 {
#define PG8_LAS __attribute__((address_space(3)))
typedef unsigned short bf16_t;
typedef short bf16x8 __attribute__((ext_vector_type(8)));
typedef float f32x4 __attribute__((ext_vector_type(4)));
typedef unsigned u32x4 __attribute__((ext_vector_type(4)));
constexpr int BM = 256, BK = 64, HALF = 128, HTB = HALF * BK * 2  , STAGE_BYTES = 8 * HTB, NXCD = 8, WGM = 4;

__host__ __device__ __forceinline__ int lds_byte(int r, int c) { const int st = (r >> 4) * 2 + (c >> 5), rr = r & 15, cc = c & 31, ob = rr * 64 + cc * 2; return st * 1024 + (ob ^ (((ob >> 9) & 1) << 5)); }
__host__ __device__ __forceinline__ void stage_rc(int b, int& R, int& C) { const int st = b / 1024, sb = b % 1024, swz = sb ^ (((sb >> 9) & 1) << 5); R = (st >> 1) * 16 + swz / 64; C = (st & 1) * 32 + (swz % 64) / 2; }
__host__ __device__ __forceinline__ int perm32(int rho) { const int n = rho >> 4, i = rho & 15; return 8 * (i >> 2) + 4 * n + (i & 3); }

struct Unit { int pm, pn, ko, aux; };
struct Gemm { const bf16_t* A; const bf16_t* Bt; int M, N, K, ld; };

struct StaticOrder {
    int nM, nN, nwg, G, c, nlim, rev, wgm, off;
    __host__ __device__ void init(int M, int N, int G_, int c_) { nM = M / BM; nN = N / BM; nwg = nM * nN; G = G_; c = c_; nlim = nwg; rev = 0; wgm = WGM; off = 0; }
    __host__ __device__ void tile_of(int wgid, Unit& u) const {
        { const int q = nwg / NXCD, r = nwg % NXCD, xcd = wgid % NXCD, off = wgid / NXCD; wgid = (xcd < r ? xcd * (q + 1) : r * (q + 1) + (xcd - r) * q) + off; }
        const int nig = wgm * nN, gid = wgid / nig, fm = gid * wgm, gsz = (nM - fm) < wgm ? (nM - fm) : wgm;
        u.pm = fm + ((wgid % nig) % gsz); u.pn = (wgid % nig) / gsz; u.ko = 0; u.aux = 0; if (rev) u.pm = nM - 1 - u.pm; }
    __host__ __device__ bool next(int i, Unit& u) const {
        const long L = (long)i * G + c + off; if (L >= nlim) return false;
        tile_of((int)L, u); return true;
    }
    __device__ __forceinline__ void a_ready(const Unit&) const {}
    __device__ __forceinline__ void done(const Unit&) const {}
};
typedef float pg8_f32x2 __attribute__((ext_vector_type(2))); typedef __bf16 pg8_bf16x2 __attribute__((ext_vector_type(2)));
__device__ __forceinline__ unsigned cvt_pk_bf16(float lo, float hi) { const pg8_f32x2 v = {lo, hi}; const pg8_bf16x2 b = __builtin_convertvector(v, pg8_bf16x2); return __builtin_bit_cast(unsigned, b); }
typedef unsigned u32x2 __attribute__((ext_vector_type(2)));
__device__ __forceinline__ float bf_lo(unsigned w) { return __uint_as_float(w << 16); }
__device__ __forceinline__ float bf_hi(unsigned w) { return __uint_as_float(w & 0xffff0000u); }
__device__ __forceinline__ float fast_sigmoid(float x) { return __builtin_amdgcn_rcpf(1.0f + __builtin_amdgcn_exp2f(-1.44269504089f * x)); }

#ifndef EPI_NT_STORE
#define EPI_NT_STORE 0
#endif
template <int ACT> struct EpiStore {
    static constexpr bool PERM = true, AFTER_DRAIN = false;
    bf16_t* O; int ldc;
    __device__ __forceinline__ void operator()(const f32x4 (&acc)[2][2][4][2], const Unit& u, int wr, int wc, int fr, int fq) const {
        const int row0 = u.pm * BM + wr * 64 + fr, col0 = u.pn * BM + wc * 32 + 8 * fq;
#pragma unroll
        for (int ai = 0; ai < 2; ++ai)
#pragma unroll
            for (int m = 0; m < 4; ++m) { bf16_t* rowp = O + (size_t)(row0 + ai * HALF + m * 16) * ldc + col0;
#pragma unroll
                for (int bj = 0; bj < 2; ++bj) { f32x4 v0 = acc[ai][bj][m][0], v1 = acc[ai][bj][m][1];
                    if (ACT == 1) {
#pragma unroll
                        for (int j = 0; j < 4; ++j) { const float a = fmaxf(v0[j], 0.f), b = fmaxf(v1[j], 0.f); v0[j] = a * a; v1[j] = b * b; } }
                    u32x4 w; w.x = cvt_pk_bf16(v0[0], v0[1]); w.y = cvt_pk_bf16(v0[2], v0[3]); w.z = cvt_pk_bf16(v1[0], v1[1]); w.w = cvt_pk_bf16(v1[2], v1[3]);
                    if (EPI_NT_STORE) __builtin_nontemporal_store(w, (u32x4*)(rowp + bj * HALF)); else *(u32x4*)(rowp + bj * HALF) = w; } }
    }
};

struct EpiBranch {
    static constexpr bool PERM = true, AFTER_DRAIN = false;
    const bf16_t* P; int ldp; int gate_off; bf16_t* MG; int ldm; int npm, npn;
    __device__ __forceinline__ void operator()(const f32x4 (&acc)[2][2][4][2], const Unit& u, int wr, int wc, int fr, int fq) const {
        const int k = u.pm / npm, pm = u.pm - k * npm, pn = u.pn - k * npn;
        const int row0 = pm * BM + wr * 64 + fr, col0 = pn * BM + wc * 32 + 8 * fq;
#pragma unroll
        for (int ai = 0; ai < 2; ++ai)
#pragma unroll
            for (int m = 0; m < 4; ++m) { const size_t r = (size_t)(row0 + ai * HALF + m * 16);
                const bf16_t* gp = P + r * ldp + gate_off + k * 2048 + col0; bf16_t* mp = MG + r * ldm + col0;
#pragma unroll
                for (int bj = 0; bj < 2; ++bj) { const u32x4 g = *(const u32x4*)(gp + bj * HALF);
                    f32x4 v0 = acc[ai][bj][m][0], v1 = acc[ai][bj][m][1];
                    v0[0] *= fast_sigmoid(bf_lo(g.x)); v0[1] *= fast_sigmoid(bf_hi(g.x)); v0[2] *= fast_sigmoid(bf_lo(g.y)); v0[3] *= fast_sigmoid(bf_hi(g.y));
                    v1[0] *= fast_sigmoid(bf_lo(g.z)); v1[1] *= fast_sigmoid(bf_hi(g.z)); v1[2] *= fast_sigmoid(bf_lo(g.w)); v1[3] *= fast_sigmoid(bf_hi(g.w));
                    if (k > 0) { const u32x4 p = *(const u32x4*)(mp + bj * HALF);
                        v0[0] += bf_lo(p.x); v0[1] += bf_hi(p.x); v0[2] += bf_lo(p.y); v0[3] += bf_hi(p.y);
                        v1[0] += bf_lo(p.z); v1[1] += bf_hi(p.z); v1[2] += bf_lo(p.w); v1[3] += bf_hi(p.w); }
                    u32x4 w; w.x = cvt_pk_bf16(v0[0], v0[1]); w.y = cvt_pk_bf16(v0[2], v0[3]); w.z = cvt_pk_bf16(v1[0], v1[1]); w.w = cvt_pk_bf16(v1[2], v1[3]);
                    *(u32x4*)(mp + bj * HALF) = w; }
                if (m == 3) asm volatile("" ::: "memory"); }
    }
};

struct EpiRes {
    static constexpr bool PERM = true, AFTER_DRAIN = false;
    bf16_t* X; const float* gmod; int gstride;
    __device__ __forceinline__ void operator()(const f32x4 (&acc)[2][2][4][2], const Unit& u, int wr, int wc, int fr, int fq) const {
        const int row0 = u.pm * BM + wr * 64 + fr, col0 = u.pn * BM + wc * 32 + 8 * fq;
#pragma unroll
        for (int ai = 0; ai < 2; ++ai)
#pragma unroll
            for (int m = 0; m < 4; ++m) { const int r = row0 + ai * HALF + m * 16;
                const int seq = r < 32768 ? (r >> 11) : 16 + ((r - 32768) >> 5);
                const float* gp = gmod + (size_t)seq * gstride + col0; bf16_t* xp = X + (size_t)r * 2048 + col0;
#pragma unroll
                for (int bj = 0; bj < 2; ++bj) { const f32x4 g0 = *(const f32x4*)(gp + bj * HALF), g1 = *(const f32x4*)(gp + bj * HALF + 4); const u32x4 b = *(const u32x4*)(xp + bj * HALF);
                    const f32x4 v0 = acc[ai][bj][m][0] * g0, v1 = acc[ai][bj][m][1] * g1;
                    u32x4 w; w.x = cvt_pk_bf16(bf_lo(b.x) + v0[0], bf_hi(b.x) + v0[1]); w.y = cvt_pk_bf16(bf_lo(b.y) + v0[2], bf_hi(b.y) + v0[3]);
                    w.z = cvt_pk_bf16(bf_lo(b.z) + v1[0], bf_hi(b.z) + v1[1]); w.w = cvt_pk_bf16(bf_lo(b.w) + v1[2], bf_hi(b.w) + v1[3]);
                    *(u32x4*)(xp + bj * HALF) = w; }
                if (m == 3) asm volatile("" ::: "memory"); }
    }
};

struct BranchOrder {
    int G, c, npm, npn, ntile;
    __device__ void init(int npm_, int npn_, int G_, int c_) { npm = npm_; npn = npn_; ntile = npm_ * npn_; G = G_; c = c_; }
    __device__ bool next(int i, Unit& u) const {
        const int ti = i / 3, k = i - 3 * ti; const long L = (long)ti * G + c; if (L >= ntile) return false;
        int wgid = (int)L; { const int q = ntile / NXCD, r = ntile % NXCD, xcd = wgid % NXCD, off = wgid / NXCD; wgid = (xcd < r ? xcd * (q + 1) : r * (q + 1) + (xcd - r) * q) + off; }
        const int nig = WGM * npn, gid = wgid / nig, fm = gid * WGM, gsz = (npm - fm) < WGM ? (npm - fm) : WGM;
        u.pm = k * npm + fm + ((wgid % nig) % gsz); u.pn = k * npn + (wgid % nig) / gsz; u.ko = 0; u.aux = 0; return true;
    }
    __device__ __forceinline__ void a_ready(const Unit&) const {}
    __device__ __forceinline__ void done(const Unit&) const {}
};


struct EpiResAtomic {
    static constexpr bool PERM = false, AFTER_DRAIN = false;
    float* out; const float* gmod;
    __device__ __forceinline__ void operator()(const f32x4 (&acc)[2][2][4][2], const Unit& u, int wr, int wc, int fr, int fq) const {
        const int row0 = u.pm * BM + wr * 64 + fr, col0 = u.pn * BM + wc * 32 + 4 * fq;
#pragma unroll
        for (int ai = 0; ai < 2; ++ai)
#pragma unroll
            for (int m = 0; m < 4; ++m) { const int r = row0 + ai * HALF + m * 16;
                const int seq = r < 32768 ? (r >> 11) : 16 + ((r - 32768) >> 5);
                const float* gp = gmod + (size_t)seq * 12288 + col0; float* op = out + (size_t)r * 2048 + col0;
#pragma unroll
                for (int bj = 0; bj < 2; ++bj)
#pragma unroll
                    for (int n = 0; n < 2; ++n) { const f32x4 g = *(const f32x4*)(gp + bj * HALF + n * 16); const f32x4 v = g * acc[ai][bj][m][n]; float* o = op + bj * HALF + n * 16;
                        typedef __attribute__((address_space(1))) float gfloat; gfloat* og = (gfloat*)o;
                        (void)__builtin_amdgcn_global_atomic_fadd_f32(og + 0, v.x); (void)__builtin_amdgcn_global_atomic_fadd_f32(og + 1, v.y); (void)__builtin_amdgcn_global_atomic_fadd_f32(og + 2, v.z); (void)__builtin_amdgcn_global_atomic_fadd_f32(og + 3, v.w); } }
    }
};
struct TailOrder {
    StaticOrder base; int nfull, SL, Ks;
    __device__ void init(const StaticOrder& b, int nfull_, int SL_, int Ks_) { base = b; nfull = nfull_; SL = SL_; Ks = Ks_; }
    __device__ bool next(int i, Unit& u) const { const long L = (long)i * base.G + base.c; if (L >= (long)(base.nwg - nfull) * SL) return false;
        const int t = (int)L / SL, sl = (int)L - t * SL; base.tile_of(nfull + t, u); u.ko = sl * Ks; u.aux = (int)L; return true; }
    __device__ __forceinline__ void a_ready(const Unit&) const {}
    __device__ __forceinline__ void done(const Unit&) const {}
};

struct EpiSlab {
    static constexpr bool PERM = false, AFTER_DRAIN = false;
    float* slab; const float* gmod;
    __device__ __forceinline__ void operator()(const f32x4 (&acc)[2][2][4][2], const Unit& u, int wr, int wc, int fr, int fq) const {
        const int rt0 = wr * 64 + fr, ct0 = wc * 32 + 4 * fq; float* sb = slab + (size_t)u.aux * 65536;
#pragma unroll
        for (int ai = 0; ai < 2; ++ai)
#pragma unroll
            for (int m = 0; m < 4; ++m) { const int rt = rt0 + ai * HALF + m * 16, r = u.pm * BM + rt;
                const int seq = r < 32768 ? (r >> 11) : 16 + ((r - 32768) >> 5);
                const float* gp = gmod + (size_t)seq * 12288 + u.pn * BM + ct0; float* op = sb + rt * 256 + ct0;
#pragma unroll
                for (int bj = 0; bj < 2; ++bj)
#pragma unroll
                    for (int n = 0; n < 2; ++n) { const f32x4 g = *(const f32x4*)(gp + bj * HALF + n * 16); *(f32x4*)(op + bj * HALF + n * 16) = g * acc[ai][bj][m][n]; } }
    }
};
template <class Epi, class Sched, bool ALIGN_EPI = false, bool SP2 = false, int A_AUX = 0, int B_AUX = 0>
__device__ __forceinline__ void gemm_phase(PG8_LAS unsigned char* lds, const Gemm g, const Sched& S, const Epi& E, int tid_in) {
    int tid_ = tid_in; asm volatile("" : "+v"(tid_));
    const int tid = tid_, wid = __builtin_amdgcn_readfirstlane(tid >> 6), lane = tid & 63, wr = wid >> 2, wc = wid & 3, fr = lane & 15, fq = lane >> 4;
    const int K = g.K, ld = g.ld, nt = K / BK;
    unsigned voffA[2], voffB[2];
#pragma unroll
    for (int i = 0; i < 2; ++i) { int R, C; stage_rc(tid * 16 + i * 8192, R, C); const int Rb = Epi::PERM ? ((R & ~31) + perm32(R & 31)) : R;
        voffA[i] = (unsigned)(R * ld + C) * 2u; voffB[i] = (unsigned)(Rb * ld + C) * 2u; }
    const size_t kstep = (size_t)(BK * 2);
    const size_t hstep = (size_t)HALF * ld * 2;
    const size_t tstep = 2 * hstep;
    const unsigned ldsw = (unsigned)wid * 1024u;
    const int aoff = lds_byte(wr * 64 + fr, fq * 8), boff = lds_byte(wc * 32 + fr, fq * 8);
#define PG8_SA(b, h) (((b) * 2 + (h)) * HTB)
#define PG8_SB(b, h) ((4 + (b) * 2 + (h)) * HTB)
#define PG8_STAGE(bufoff, gbase, voff) do { _Pragma("unroll") for (int _i = 0; _i < 2; ++_i) \
        __builtin_amdgcn_global_load_lds((const unsigned*)((const char*)(gbase) + (voff)[_i]), (PG8_LAS unsigned*)(lds + (bufoff) + ldsw + _i * 8192), 16, 0, B_AUX); } while (0)
#define PG8_STAGEA(bufoff, gbase, voff) do { _Pragma("unroll") for (int _i = 0; _i < 2; ++_i) \
        __builtin_amdgcn_global_load_lds((const unsigned*)((const char*)(gbase) + (voff)[_i]), (PG8_LAS unsigned*)(lds + (bufoff) + ldsw + _i * 8192), 16, 0, A_AUX); } while (0)
#define PG8_LDA(dst, b, h) do { _Pragma("unroll") for (int m = 0; m < 4; ++m) _Pragma("unroll") for (int k = 0; k < 2; ++k) dst[m][k] = *(const PG8_LAS bf16x8*)(lds + PG8_SA(b, h) + aoff + m * 2048 + k * 1024); } while (0)
#define PG8_LDB(dst, b, h) do { _Pragma("unroll") for (int n = 0; n < 2; ++n) _Pragma("unroll") for (int k = 0; k < 2; ++k) dst[n][k] = *(const PG8_LAS bf16x8*)(lds + PG8_SB(b, h) + boff + n * 2048 + k * 1024); } while (0)
#define PG8_MMA(ai, bj, At, Bt) do { __builtin_amdgcn_s_setprio(1); _Pragma("unroll") for (int m = 0; m < 4; ++m) _Pragma("unroll") for (int n = 0; n < 2; ++n) _Pragma("unroll") for (int k = 0; k < 2; ++k) \
        acc[ai][bj][m][n] = __builtin_amdgcn_mfma_f32_16x16x32_bf16(Bt[n][k], At[m][k], acc[ai][bj][m][n], 0, 0, 0); __builtin_amdgcn_s_setprio(0); } while (0)
#define PG8_WAIT_V(n) asm volatile("s_waitcnt vmcnt(" #n ")" ::: "memory")
#define PG8_WAIT_L(n) asm volatile("s_waitcnt lgkmcnt(" #n ")" ::: "memory")
#define PG8_BAR __builtin_amdgcn_s_barrier()
#define PG8_SCHED __builtin_amdgcn_sched_barrier(0)
    Unit cur, nxt; int ui = 0;
    if (!S.next(0, cur)) return;
    f32x4 acc[2][2][4][2];
#pragma unroll
    for (int a = 0; a < 2; ++a)
#pragma unroll
        for (int b = 0; b < 2; ++b)
#pragma unroll
            for (int m = 0; m < 4; ++m)
#pragma unroll
                for (int n = 0; n < 2; ++n) acc[a][b][m][n] = (f32x4){0.f, 0.f, 0.f, 0.f};
    bf16x8 At[4][2], B0[2][2], B1[2][2];
    const char* cA = (const char*)g.A + (size_t)cur.pm * tstep + (size_t)cur.ko * 2; const char* cB = (const char*)g.Bt + (size_t)cur.pn * tstep + (size_t)cur.ko * 2;
    S.a_ready(cur);
    if constexpr (SP2) {
        PG8_STAGE(PG8_SB(0, 0), cB, voffB); PG8_STAGE(PG8_SB(0, 1), cB + hstep, voffB); PG8_STAGEA(PG8_SA(0, 0), cA, voffA); PG8_STAGEA(PG8_SA(0, 1), cA + hstep, voffA);
        if (wr == 1) PG8_BAR;
        PG8_WAIT_V(2); PG8_BAR;
        PG8_STAGE(PG8_SB(1, 0), cB + kstep, voffB); PG8_STAGEA(PG8_SA(1, 0), cA + kstep, voffA); PG8_STAGE(PG8_SB(1, 1), cB + hstep + kstep, voffB);
        PG8_WAIT_V(6); PG8_BAR;
    } else {
        PG8_STAGE(PG8_SB(0, 0), cB, voffB); PG8_STAGEA(PG8_SA(0, 0), cA, voffA); PG8_STAGE(PG8_SB(0, 1), cB + hstep, voffB); PG8_STAGEA(PG8_SA(0, 1), cA + hstep, voffA);
        if (wr == 1) PG8_BAR;
        PG8_WAIT_V(4); PG8_BAR;
        PG8_STAGE(PG8_SB(1, 0), cB + kstep, voffB); PG8_STAGEA(PG8_SA(1, 0), cA + kstep, voffA); PG8_STAGE(PG8_SB(1, 1), cB + hstep + kstep, voffB);
        PG8_WAIT_V(6); PG8_BAR;
    }
    for (;;) {
        const bool has_next = S.next(ui + 1, nxt);
        const char* nA = has_next ? (const char*)g.A + (size_t)nxt.pm * tstep + (size_t)nxt.ko * 2 : cA; const char* nB = has_next ? (const char*)g.Bt + (size_t)nxt.pn * tstep + (size_t)nxt.ko * 2 : cB;
        for (int t = 0; t < nt; t += 2) {
            const bool last = (t == nt - 2);
            const char* a1 = cA + (size_t)(t + 1) * kstep;
            const char* a2 = last ? nA : cA + (size_t)(t + 2) * kstep; const char* b2 = last ? nB : cB + (size_t)(t + 2) * kstep;
            const char* a3 = a2 + kstep; const char* b3 = b2 + kstep;
            if (last && has_next) S.a_ready(nxt);
            if constexpr (SP2) {
            PG8_LDB(B0, 0, 0); PG8_LDB(B1, 0, 1); PG8_SCHED; PG8_LDA(At, 0, 0); PG8_STAGEA(PG8_SA(1, 1), a1 + hstep, voffA);
            PG8_WAIT_V(8); PG8_WAIT_L(0); PG8_BAR; PG8_MMA(0, 0, At, B0); PG8_MMA(0, 1, At, B1); PG8_BAR; PG8_SCHED;
            PG8_LDA(At, 0, 1); PG8_STAGE(PG8_SB(0, 0), b2, voffB); PG8_STAGE(PG8_SB(0, 1), b2 + hstep, voffB); PG8_STAGEA(PG8_SA(0, 0), a2, voffA);
            PG8_WAIT_V(8); PG8_WAIT_L(0); PG8_BAR; PG8_MMA(1, 0, At, B0); PG8_MMA(1, 1, At, B1); PG8_BAR; PG8_SCHED;
            PG8_LDB(B0, 1, 0); PG8_LDB(B1, 1, 1); PG8_SCHED; PG8_LDA(At, 1, 0); PG8_STAGEA(PG8_SA(0, 1), a2 + hstep, voffA);
            PG8_WAIT_V(8); PG8_WAIT_L(0); PG8_BAR; PG8_MMA(0, 0, At, B0); PG8_MMA(0, 1, At, B1); PG8_BAR; PG8_SCHED;
            PG8_LDA(At, 1, 1); PG8_STAGE(PG8_SB(1, 0), b3, voffB); PG8_STAGE(PG8_SB(1, 1), b3 + hstep, voffB); PG8_STAGEA(PG8_SA(1, 0), a3, voffA);
            PG8_WAIT_V(8); PG8_WAIT_L(0); PG8_BAR; PG8_MMA(1, 0, At, B0); PG8_MMA(1, 1, At, B1); PG8_BAR; PG8_SCHED;
            } else {
            PG8_LDB(B0, 0, 0); PG8_SCHED; PG8_LDA(At, 0, 0); PG8_STAGEA(PG8_SA(1, 1), a1 + hstep, voffA);
            PG8_WAIT_L(8); PG8_BAR; PG8_WAIT_L(0); PG8_MMA(0, 0, At, B0); PG8_BAR; PG8_SCHED;
            PG8_LDB(B1, 0, 1); PG8_STAGE(PG8_SB(0, 0), b2, voffB);
            PG8_BAR; PG8_WAIT_L(0); PG8_MMA(0, 1, At, B1); PG8_BAR;
            PG8_LDA(At, 0, 1); PG8_STAGEA(PG8_SA(0, 0), a2, voffA);
            PG8_BAR; PG8_WAIT_L(0); PG8_MMA(1, 0, At, B0); PG8_BAR; PG8_SCHED;
            PG8_STAGE(PG8_SB(0, 1), b2 + hstep, voffB);
            PG8_WAIT_V(6); PG8_BAR; PG8_MMA(1, 1, At, B1); PG8_BAR;
            PG8_LDB(B0, 1, 0); PG8_SCHED; PG8_LDA(At, 1, 0); PG8_STAGEA(PG8_SA(0, 1), a2 + hstep, voffA);
            PG8_WAIT_L(8); PG8_BAR; PG8_WAIT_L(0); PG8_MMA(0, 0, At, B0); PG8_BAR; PG8_SCHED;
            PG8_LDB(B1, 1, 1); PG8_STAGE(PG8_SB(1, 0), b3, voffB);
            PG8_BAR; PG8_WAIT_L(0); PG8_MMA(0, 1, At, B1); PG8_BAR;
            PG8_LDA(At, 1, 1); PG8_STAGEA(PG8_SA(1, 0), a3, voffA);
            PG8_BAR; PG8_WAIT_L(0); PG8_MMA(1, 0, At, B0); PG8_BAR; PG8_SCHED;
            PG8_STAGE(PG8_SB(1, 1), b3 + hstep, voffB);
            PG8_WAIT_V(6); PG8_BAR; PG8_MMA(1, 1, At, B1); PG8_BAR;
            }
        }
        if constexpr (ALIGN_EPI) { if (wr == 0) PG8_BAR; }
        if constexpr (!Epi::AFTER_DRAIN) { E(acc, cur, wr, wc, fr, fq); S.done(cur); }
        if (!has_next) break;
#pragma unroll
        for (int a = 0; a < 2; ++a)
#pragma unroll
            for (int b = 0; b < 2; ++b)
#pragma unroll
                for (int m = 0; m < 4; ++m)
#pragma unroll
                    for (int n = 0; n < 2; ++n) acc[a][b][m][n] = (f32x4){0.f, 0.f, 0.f, 0.f};
        cur = nxt; cA = nA; cB = nB; ++ui;
        if constexpr (ALIGN_EPI) { if (wr == 1) PG8_BAR; }
    }
    PG8_WAIT_V(0);
    if constexpr (!ALIGN_EPI) { if (wr == 0) PG8_BAR; }
    PG8_BAR;
    if constexpr (Epi::AFTER_DRAIN) { E.fused(acc, cur, wr, wc, fr, fq, lds, wid, lane); S.done(cur); }
#undef PG8_SA
#undef PG8_SB
#undef PG8_STAGE
#undef PG8_STAGEA
#undef PG8_LDA
#undef PG8_LDB
#undef PG8_MMA
#undef PG8_WAIT_V
#undef PG8_WAIT_L
#undef PG8_BAR
#undef PG8_SCHED
}
}

constexpr int NWAVES = 8;
constexpr int DM = 2048, NTOK_P = 32768, NTOK_S = 1024, MT = NTOK_P + NTOK_S  , NSEQ = 48, DEPTH = 4, DFF = 8192;
constexpr int IN_TOTAL = 14864, NPAD = 15104;
constexpr int OFF_AQ = 0, OFF_AF = 1024, OFF_AI = 2048, OFF_AG = 3072, OFF_BZ = 4096, OFF_XBC = 5120, OFF_CU = 6656, OFF_CV = 7680, OFF_GATE = 8704, OFF_DT = 14848;
constexpr float NORM_EPS = 1e-6f;
constexpr size_t OUT_X = 0, OUT_HGRN_P = 69206016, OUT_SSM_P = 77594624, OUT_CONV_P = 85983232, OUT_HGRN_S = 86278144, OUT_SSM_S = 103055360, OUT_CONV_S = 119832576, OUT_V_S = 120422400, OUT_TOTAL = 124616704;
constexpr size_t MiB = 1u << 20;
constexpr size_t WS_CTL = 0, CTL_ZERO_BYTES = 1 * MiB;
constexpr size_t WS_MOD = 1 * MiB;
constexpr size_t WS_WIN = 16 * MiB;
constexpr size_t WS_WBR = 76 * MiB;
constexpr size_t WS_WOUT = 88 * MiB;
constexpr size_t WS_WUP = 96 * MiB;
constexpr size_t WS_WDN = 128 * MiB;
constexpr size_t WS_H = 160 * MiB;
constexpr size_t WS_Y3 = 292 * MiB;
constexpr size_t WS_P = 490 * MiB;
constexpr size_t WS_XC = 1464 * MiB;
constexpr size_t WS_DT = 1564 * MiB;
constexpr size_t DT_ARR = (size_t)MT * 16 * 4;
constexpr size_t WS_WSET2 = 1576 * MiB;
constexpr size_t WSET_BYTES = WS_H - WS_WIN;
constexpr size_t WS_SLAB = WS_Y3;
constexpr size_t WS_X = WS_WSET2 + WSET_BYTES;
constexpr size_t WS_END = WS_X + (size_t)MT * DM * 2;
static_assert((size_t)32 * 8 * 65536 * 4 <= (size_t)3 * MT * 1024 * 2, "slabs fit the y_a|y_b|y_c region");
static_assert(WS_DT + 3 * DT_ARR <= WS_WSET2, "d_ws map 3");
__host__ __device__ constexpr size_t wofs(int l) { return (l & 1) ? (WS_WSET2 - WS_WIN) : 0; }
static_assert(WS_P + (size_t)MT * NPAD * 2 <= WS_XC && WS_XC + (size_t)MT * 1536 * 2 <= WS_DT, "d_ws map 2");
static_assert(WS_MOD + (size_t)DEPTH * NSEQ * 12288 * 4 <= WS_WIN && WS_WIN + (size_t)NPAD * DM * 2 <= WS_WBR && WS_H + (size_t)MT * DM * 2 <= WS_Y3 && WS_Y3 + (size_t)3 * MT * 1024 * 2 <= WS_P, "d_ws map");
constexpr int CW_BAR = 4096;
constexpr int CW_Q = 8192;
constexpr int CW_QC = 12288;
constexpr int RING_BYTES = 131072, ST_OFF = RING_BYTES  , MISC_OFF = RING_BYTES + 1024, LDS_BYTES = 147456;

#define GAS __attribute__((address_space(1)))
#define LAS __attribute__((address_space(3)))
typedef unsigned short bf16;
typedef unsigned v4u __attribute__((ext_vector_type(4)));
typedef unsigned v2u __attribute__((ext_vector_type(2)));
typedef float f32x4 __attribute__((ext_vector_type(4)));
typedef float f32x2 __attribute__((ext_vector_type(2)));
#define LDS_WAIT() asm volatile("s_waitcnt lgkmcnt(0)" ::: "memory")
#define VM_WAIT() asm volatile("s_waitcnt vmcnt(0)" ::: "memory")
typedef float cv_f32x2 __attribute__((ext_vector_type(2))); typedef __bf16 cv_bf16x2 __attribute__((ext_vector_type(2)));
__device__ __forceinline__ unsigned pk2(float lo, float hi) { const cv_f32x2 v = {lo, hi}; const cv_bf16x2 b = __builtin_convertvector(v, cv_bf16x2); return __builtin_bit_cast(unsigned, b); }
__device__ __forceinline__ unsigned f2bf(float f) { const __bf16 b = (__bf16)f; return (unsigned)__builtin_bit_cast(unsigned short, b); }
__device__ __forceinline__ float bflo(unsigned w) { return __uint_as_float(w << 16); }
__device__ __forceinline__ float bfhi(unsigned w) { return __uint_as_float(w & 0xffff0000u); }
__device__ __forceinline__ float bf1(bf16 v) { return __uint_as_float(((unsigned)v) << 16); }
__device__ __forceinline__ float sigmoidf_(float x) { return __builtin_amdgcn_rcpf(1.0f + __expf(-x)); }
__device__ __forceinline__ float siluf_(float x) { return x * __builtin_amdgcn_rcpf(1.0f + __expf(-x)); }
__device__ __forceinline__ float rsqrtf_(float x) { return __builtin_amdgcn_rsqf(x); }
__device__ __forceinline__ float geluf_(float v) {
    const float av = fabsf(v), t = __builtin_amdgcn_rcpf(1.0f + 0.2316418882f * av);
    float q = t * 0.5307027145f + (-0.7265760135f); q = q * t + 0.7107068705f; q = q * t + (-0.142248368f); q = q * t + 0.127414796f; q = q * t;
    const float e = __expf(-0.5f * v * v), m = v * (q * e);
    return v < 0.f ? m : v - m;
}
__device__ __forceinline__ float wave_sum(float v) {
#pragma unroll
    for (int o = 1; o < 64; o <<= 1) v += __shfl_xor(v, o);
    return v;
}
__device__ __forceinline__ float half_sum(float v) {
#pragma unroll
    for (int o = 1; o < 32; o <<= 1) v += __shfl_xor(v, o);
    return v;
}

#define XB_TMO      128
#define XB_XCNT(j)  (256  + 64 * (j))
#define XB_XSUB(j)  (1280 + 64 * (j))
#define XB_XGEN(j)  (2304 + 64 * (j))
#define XB_TOP      3328
#define XB_TOPGEN   3392
#define XCD_BAR_WORDS 3456
#define XB_SPIN_CAP (1u << 18)

__device__ __forceinline__ unsigned xb_ld(unsigned* p)              { return __hip_atomic_load(p, __ATOMIC_RELAXED, __HIP_MEMORY_SCOPE_AGENT); }
__device__ __forceinline__ unsigned xb_add(unsigned* p, unsigned v) { return __hip_atomic_fetch_add(p, v, __ATOMIC_RELAXED, __HIP_MEMORY_SCOPE_AGENT); }
__device__ __forceinline__ unsigned xb_xcc_id() { return (unsigned)__builtin_amdgcn_s_getreg((3 << 11) | 20) & 0xFu; }
#define XB_SPIN(cond, bar) do { unsigned _sp = 0; while (cond) { __builtin_amdgcn_s_sleep(1); \
    if ((++_sp & 255u) == 0u) { if (xb_ld(&(bar)[XB_TMO])) break; if (_sp > XB_SPIN_CAP) { atomicAdd(&(bar)[XB_TMO], 1u); break; } } } } while (0)

struct XcdBarrier {
    unsigned* bar; unsigned x;
    volatile LAS unsigned* st;
};

__device__ __forceinline__ XcdBarrier xcd_barrier_post(unsigned* bar, volatile LAS unsigned* st, int tid) {
    XcdBarrier b; b.bar = bar; b.x = xb_xcc_id(); b.st = st;
    if (tid == 0) (void)xb_add(&bar[XB_XCNT(b.x)], 1u);
    return b;
}
__device__ __forceinline__ void xcd_barrier_complete(unsigned* bar, unsigned x, unsigned& nloc, unsigned& nx) {
    const unsigned G = gridDim.x * gridDim.y * gridDim.z;
    unsigned sum, cnt, mine, sp = 0u;
    for (;;) {
        sum = 0u; cnt = 0u; mine = 0u;
#pragma unroll
        for (unsigned j = 0; j < 16; ++j) { const unsigned c = xb_ld(&bar[XB_XCNT(j)]); sum += c; cnt += (c > 0u) ? 1u : 0u; mine = (j == x) ? c : mine; }
        if (sum == G) break;
        __builtin_amdgcn_s_sleep(1);
        if ((++sp & 255u) == 0u) { if (xb_ld(&bar[XB_TMO])) break; if (sp > XB_SPIN_CAP) { atomicAdd(&bar[XB_TMO], 1u); break; } }
    }
    nloc = mine > 0u ? mine : 1u; nx = cnt > 0u ? cnt : 1u;
}

__device__ __forceinline__ void xcd_barrier(const XcdBarrier& b, int tid) {
    asm volatile("s_waitcnt vmcnt(0)" ::: "memory");
    __syncthreads();
    if (tid == 0) {
        unsigned* bar = b.bar;
        __builtin_amdgcn_s_waitcnt(0);
        unsigned nloc = b.st[0], nx = b.st[1];
        if (nloc == 0u) { xcd_barrier_complete(bar, b.x, nloc, nx); b.st[0] = nloc; b.st[1] = nx; }
        const unsigned old = xb_add(&bar[XB_XSUB(b.x)], 1u);
        const unsigned gen = old / nloc;
        if (old + 1u == (gen + 1u) * nloc) {
            __builtin_amdgcn_fence(__ATOMIC_RELEASE, "agent");
            asm volatile("s_waitcnt vmcnt(0)" ::: "memory");
            const unsigned og = xb_add(&bar[XB_TOP], 1u);
            const unsigned tg = og / nx;
            if (og + 1u == (tg + 1u) * nx) xb_add(&bar[XB_TOPGEN], 1u);
            else XB_SPIN(xb_ld(&bar[XB_TOPGEN]) == tg, bar);
            __builtin_amdgcn_fence(__ATOMIC_ACQUIRE, "agent");
            xb_add(&bar[XB_XGEN(b.x)], 1u);
            asm volatile("s_waitcnt vmcnt(0)" ::: "memory");
        } else {
            XB_SPIN(xb_ld(&bar[XB_XGEN(b.x)]) == gen, bar);
            __builtin_amdgcn_fence(__ATOMIC_ACQUIRE, "agent");
            asm volatile("s_waitcnt vmcnt(0)" ::: "memory");
        }
    }
    __syncthreads();
}


__device__ __forceinline__ void mod_item(LAS unsigned char* lds, int tid_in, int it, const float* c_prompt, const float* c_sample, const float* w_mod, const float* b_mod, float* MOD) {
    int tid = tid_in;
    const int l = it / 96, cb = it - l * 96, j0 = cb * 128;
    const int cp = tid & 63, kq = tid >> 6;
    LAS float* CS = (LAS float*)lds;
    float acc0[48], acc1[48];
#pragma unroll
    for (int s = 0; s < 48; ++s) { acc0[s] = 0.f; acc1[s] = 0.f; }
    const float* wbase = w_mod + (size_t)l * DM * 12288 + j0 + 2 * cp;
    for (int kt = 0; kt < 8; ++kt) {
        __syncthreads();
#pragma unroll 8
        for (int j = 0; j < 24; ++j) { const int e = tid + 512 * j, s = e >> 8, kidx = e & 255, kq2 = kidx >> 5, kk = kidx & 31, k = kq2 * 256 + kt * 32 + kk;
            const float cv = s < 16 ? c_prompt[s * DM + k] : c_sample[(s - 16) * DM + k];
            CS[(kq2 * 32 + kk) * 48 + s] = siluf_(cv); }
        __syncthreads();
        { const float* wr = wbase + (size_t)(kq * 256 + kt * 32) * 12288;
          f32x2 wn[4];
#pragma unroll
          for (int i = 0; i < 4; ++i) wn[i] = *(const f32x2*)(wr + (size_t)i * 12288);
#pragma unroll 1
          for (int kk = 0; kk < 32; kk += 4) { f32x2 wc[4];
#pragma unroll
              for (int i = 0; i < 4; ++i) wc[i] = wn[i];
              if (kk + 4 < 32) {
#pragma unroll
                  for (int i = 0; i < 4; ++i) wn[i] = *(const f32x2*)(wr + (size_t)(kk + 4 + i) * 12288); }
#pragma unroll
              for (int i = 0; i < 4; ++i) { const f32x2 w2 = wc[i]; const LAS f32x4* cr = (const LAS f32x4*)(CS + (kq * 32 + kk + i) * 48);
#pragma unroll
                  for (int s4 = 0; s4 < 12; ++s4) { const f32x4 c4 = cr[s4];
#pragma unroll
                      for (int q = 0; q < 4; ++q) { acc0[4 * s4 + q] = fmaf(w2.x, c4[q], acc0[4 * s4 + q]); acc1[4 * s4 + q] = fmaf(w2.y, c4[q], acc1[4 * s4 + q]); } } } } }
    }
    LAS float* RED = (LAS float*)lds;
    asm volatile("" : "+v"(tid));
    const int cp2 = tid & 63, kq2_ = tid >> 6;
#pragma unroll
    for (int sb = 0; sb < 4; ++sb) {
        __syncthreads();
#pragma unroll
        for (int i = 0; i < 12; ++i) { *(LAS f32x2*)(RED + (kq2_ * 12 + i) * 128 + 2 * cp2) = (f32x2){acc0[12 * sb + i], acc1[12 * sb + i]}; }
        __syncthreads();
#pragma unroll
        for (int j = 0; j < 3; ++j) { const int e = tid + 512 * j, s = e >> 7, col = e & 127; float v = 0.f;
#pragma unroll
            for (int q = 0; q < 8; ++q) v += RED[(q * 12 + s) * 128 + col];
            MOD[((size_t)l * NSEQ + 12 * sb + s) * 12288 + j0 + col] = v + b_mod[l * 12288 + j0 + col]; }
    }
    __syncthreads();
}

struct CvItem { const float* src; bf16* dst; int N, K, nv; };
constexpr int CV_A = 472 * 32, CV_B = 3 * 16 * 64, CV_C = 32 * 64, CV_D = 32 * 256, CV_E = 128 * 64, CV_ALL = CV_A + CV_B + CV_C + CV_D + CV_E;
__device__ __forceinline__ CvItem cvt_decode(int it, int l, const float* w_in, const float* w_branch, const float* w_out, const float* w_up, const float* w_down, unsigned char* ws) {
    CvItem c; int r = it;
    if (r < CV_A) { const int nb = r % 472, kb = r / 472; int n0s, nv;
        if (nb < 208) { n0s = 32 * nb; nv = 32; } else if (nb < 464) { n0s = 32 * nb + 16; nv = 32; } else if (nb == 464) { n0s = 6656; nv = 16; } else { n0s = 0; nv = 0; }
        c.N = IN_TOTAL; c.K = DM; c.nv = nv; c.src = w_in + (size_t)l * DM * IN_TOTAL + (size_t)(64 * kb) * IN_TOTAL + n0s; c.dst = (bf16*)(ws + WS_WIN) + (size_t)(32 * nb) * DM + 64 * kb; return c; }
    r -= CV_A;
    if (r < CV_B) { const int br = r / 1024, r2 = r % 1024, kb = r2 / 64, nb = r2 % 64;
        c.N = DM; c.K = 1024; c.nv = 32; c.src = w_branch + ((size_t)l * 3072 + br * 1024 + 64 * kb) * DM + 32 * nb; c.dst = (bf16*)(ws + WS_WBR) + (size_t)br * 2048 * 1024 + (size_t)(32 * nb) * 1024 + 64 * kb; return c; }
    r -= CV_B;
    if (r < CV_C) { const int kb = r / 64, nb = r % 64;
        c.N = DM; c.K = DM; c.nv = 32; c.src = w_out + (size_t)l * DM * DM + (size_t)(64 * kb) * DM + 32 * nb; c.dst = (bf16*)(ws + WS_WOUT) + (size_t)(32 * nb) * DM + 64 * kb; return c; }
    r -= CV_C;
    if (r < CV_D) { const int kb = r / 256, nb = r % 256;
        c.N = DFF; c.K = DM; c.nv = 32; c.src = w_up + (size_t)l * DM * DFF + (size_t)(64 * kb) * DFF + 32 * nb; c.dst = (bf16*)(ws + WS_WUP) + (size_t)(32 * nb) * DM + 64 * kb; return c; }
    r -= CV_D;
    { const int kb = r / 64, nb = r % 64;
        c.N = DM; c.K = DFF; c.nv = 32; c.src = w_down + (size_t)l * DFF * DM + (size_t)(64 * kb) * DM + 32 * nb; c.dst = (bf16*)(ws + WS_WDN) + (size_t)(32 * nb) * DFF + 64 * kb; return c; }
}
__device__ __forceinline__ void cvt_load(const CvItem& c, int lane, f32x4 (&v)[8]) {
    const int kk = lane >> 3, n4 = (lane & 7) * 4;
#pragma unroll
    for (int i = 0; i < 8; ++i) v[i] = (n4 < c.nv) ? *(const f32x4*)(c.src + (size_t)(8 * i + kk) * c.N + n4) : (f32x4){0.f, 0.f, 0.f, 0.f};
}
__device__ __forceinline__ void cvt_store(const CvItem& c, int lane, const f32x4 (&v)[8], LAS float* scr) {
    { const int kk = lane >> 3, n4 = (lane & 7) * 4;
#pragma unroll
        for (int i = 0; i < 8; ++i) { LAS float* d = scr + (8 * i + kk) * 33 + n4; d[0] = v[i].x; d[1] = v[i].y; d[2] = v[i].z; d[3] = v[i].w; } }
    LDS_WAIT(); asm volatile("" ::: "memory");
    const int cc = lane & 7;
#pragma unroll
    for (int j = 0; j < 4; ++j) { const int n = (lane >> 3) + 8 * j; const LAS float* s = scr + (8 * cc) * 33 + n;
        v4u o; o.x = pk2(s[0 * 33], s[1 * 33]); o.y = pk2(s[2 * 33], s[3 * 33]); o.z = pk2(s[4 * 33], s[5 * 33]); o.w = pk2(s[6 * 33], s[7 * 33]);
        *(v4u*)(c.dst + (size_t)n * c.K + 8 * cc) = o; }
    LDS_WAIT(); asm volatile("" ::: "memory");
}
template <bool QUEUE>
__device__ __forceinline__ void cvt_phase(LAS unsigned char* lds, int wave, int lane, int gw, int NGW, int l, const float* w_in, const float* w_branch, const float* w_out, const float* w_up, const float* w_down, unsigned char* ws, unsigned* qhead) {
    LAS float* scr = (LAS float*)(lds + wave * 16384);
    int it = gw, left = 0;
#define CV_NEXT() do { if (QUEUE) { if (left == 0) { unsigned t0 = 0; if (lane == 0) t0 = __hip_atomic_fetch_add(qhead, 4u, __ATOMIC_RELAXED, __HIP_MEMORY_SCOPE_AGENT); it = __builtin_amdgcn_readfirstlane((int)t0); left = 4; } else ++it; --left; } else it += NGW; } while (0)
    if (QUEUE) { it = 0; CV_NEXT(); }
    if (it >= CV_ALL) return;
    CvItem ca = cvt_decode(it, l, w_in, w_branch, w_out, w_up, w_down, ws), cb = ca; f32x4 va[8], vb[8];
    cvt_load(ca, lane, va);
    for (;;) {
        CV_NEXT(); const bool hb = it < CV_ALL;
        if (hb) { cb = cvt_decode(it, l, w_in, w_branch, w_out, w_up, w_down, ws); cvt_load(cb, lane, vb); }
        cvt_store(ca, lane, va, scr);
        if (!hb) break;
        CV_NEXT(); const bool ha = it < CV_ALL;
        if (ha) { ca = cvt_decode(it, l, w_in, w_branch, w_out, w_up, w_down, ws); cvt_load(ca, lane, va); }
        cvt_store(cb, lane, vb, scr);
        if (!ha) break;
    }
#undef CV_NEXT
}

#ifndef WGM_N8
#define WGM_N8 4
#endif
__device__ __forceinline__ int tail_nfull(int nwg, int G) { const int nf = (nwg / G) * G; return (nwg - nf) <= 32 ? nf : nwg; }
__device__ __forceinline__ void build_tail_map(LAS int* tmap, int tid, int G, int rev) {
    pg8::StaticOrder S; S.init(MT, DM, G, 0); S.rev = rev; S.wgm = WGM_N8; const int nfull = tail_nfull(S.nwg, G);
    for (int i = tid; i < S.nwg; i += NWAVES * 64) tmap[i] = -1;
    __syncthreads();
    for (int i = tid; i < S.nwg - nfull; i += NWAVES * 64) { pg8::Unit u; S.tile_of(nfull + i, u); tmap[u.pm * 8 + u.pn] = i; }
    __syncthreads();
}
template <bool SRC_F32>
__device__ __forceinline__ void norm_mod_phase(int lane, int gw, int NGW, const float* xP, const float* xS, bf16* X, const float* ng, const float* modl  , int part_sh, int part_sc, bf16* H,
                                               bool comb, const LAS int* tmap, const float* slab, bool desc) {
    const int g2 = desc ? NGW - 1 - gw : gw;
    const int ra = (int)(((unsigned)g2 * (unsigned)MT) / (unsigned)NGW), rb = (int)(((unsigned)(g2 + 1) * (unsigned)MT) / (unsigned)NGW);
    const int nr = rb - ra, rfirst = desc ? rb - 1 : ra, step = desc ? -1 : 1;
    if (nr <= 0) return;
    f32x4 ca[8], cb[8]; int cur_seq = -1;
    v2u xn[8];
    v2u xm[8];
    if (!SRC_F32) { const v2u* xb0 = (const v2u*)(X + (size_t)rfirst * DM) + lane;
#pragma unroll
        for (int j = 0; j < 8; ++j) xn[j] = xb0[64 * j];
        if (nr > 1) { const v2u* xb1 = (const v2u*)(X + (size_t)(rfirst + step) * DM) + lane;
#pragma unroll
            for (int j = 0; j < 8; ++j) xm[j] = xb1[64 * j]; } }
    for (int i = 0; i < nr; ++i) { const int r = rfirst + step * i;
        const int seq = r < NTOK_P ? (r >> 11) : 16 + ((r - NTOK_P) >> 5);
        if (seq != cur_seq) { cur_seq = seq; const float* mp = modl + (size_t)seq * 12288;
#pragma unroll
            for (int j = 0; j < 8; ++j) { const int c = 4 * lane + 256 * j; const f32x4 g = *(const f32x4*)(ng + c), sc = *(const f32x4*)(mp + part_sc * DM + c); ca[j] = g * (sc + 1.0f); cb[j] = *(const f32x4*)(mp + part_sh * DM + c); } }
        f32x4 v[8]; float ss = 0.f; v2u* xb = (v2u*)(X + (size_t)r * DM) + lane;
        if (SRC_F32) { const float* xr = (r < NTOK_P ? xP + (size_t)r * DM : xS + (size_t)(r - NTOK_P) * DM) + 4 * lane;
#pragma unroll
            for (int j = 0; j < 8; ++j) { v[j] = *(const f32x4*)(xr + 256 * j); v2u o; o.x = pk2(v[j].x, v[j].y); o.y = pk2(v[j].z, v[j].w); xb[64 * j] = o; } }
        else {
#pragma unroll
            for (int j = 0; j < 8; ++j) { const v2u o = xn[j]; v[j] = (f32x4){bflo(o.x), bfhi(o.x), bflo(o.y), bfhi(o.y)}; xn[j] = xm[j]; }
            if (i + 2 < nr) { const v2u* xb2 = (const v2u*)(X + (size_t)(r + 2 * step) * DM) + lane;
#pragma unroll
                for (int j = 0; j < 8; ++j) xm[j] = xb2[64 * j]; } }
        if (comb) {
#pragma unroll
            for (int j = 0; j < 8; ++j) { const int ti = tmap[(r >> 8) * 8 + j]; if (ti >= 0) { const float* sp = slab + (size_t)ti * 8 * 65536 + (r & 255) * 256 + 4 * lane;
#pragma unroll
                    for (int q = 0; q < 8; ++q) v[j] = v[j] + *(const f32x4*)(sp + (size_t)q * 65536);
                    v2u o; o.x = pk2(v[j].x, v[j].y); o.y = pk2(v[j].z, v[j].w); xb[64 * j] = o; } } }
#pragma unroll
        for (int j = 0; j < 8; ++j) ss += (v[j].x * v[j].x + v[j].y * v[j].y) + (v[j].z * v[j].z + v[j].w * v[j].w);
        const float rstd = 1.0f / sqrtf(wave_sum(ss) * (1.0f / DM) + NORM_EPS);
        unsigned long long* o8 = (unsigned long long*)(H + (size_t)r * DM) + lane;
#pragma unroll
        for (int j = 0; j < 8; ++j) { const f32x4 y = v[j] * rstd * ca[j] + cb[j]; o8[64 * j] = (unsigned long long)pk2(y.x, y.y) | ((unsigned long long)pk2(y.z, y.w) << 32); }
    }
}
__device__ __forceinline__ void final_norm_phase(int lane, int gw, int NGW, const bf16* X, float* Y, const float* fg, bool comb, const LAS int* tmap, const float* slab) {
    f32x4 g[8];
#pragma unroll
    for (int j = 0; j < 8; ++j) g[j] = *(const f32x4*)(fg + 4 * lane + 256 * j);
    v2u xn[8];
    if (gw < MT) { const v2u* xb0 = (const v2u*)(X + (size_t)gw * DM) + lane;
#pragma unroll
        for (int j = 0; j < 8; ++j) xn[j] = xb0[64 * j]; }
    for (int r = gw; r < MT; r += NGW) {
        float* yr = Y + (size_t)r * DM + 4 * lane; f32x4 v[8]; float ss = 0.f;
#pragma unroll
        for (int j = 0; j < 8; ++j) { const v2u o = xn[j]; v[j] = (f32x4){bflo(o.x), bfhi(o.x), bflo(o.y), bfhi(o.y)}; }
        if (r + NGW < MT) { const v2u* xb1 = (const v2u*)(X + (size_t)(r + NGW) * DM) + lane;
#pragma unroll
            for (int j = 0; j < 8; ++j) xn[j] = xb1[64 * j]; }
        if (comb) {
#pragma unroll
            for (int j = 0; j < 8; ++j) { const int ti = tmap[(r >> 8) * 8 + j]; if (ti >= 0) { const float* sp = slab + (size_t)ti * 8 * 65536 + (r & 255) * 256 + 4 * lane;
#pragma unroll
                    for (int q = 0; q < 8; ++q) v[j] = v[j] + *(const f32x4*)(sp + (size_t)q * 65536); } } }
#pragma unroll
        for (int j = 0; j < 8; ++j) ss += (v[j].x * v[j].x + v[j].y * v[j].y) + (v[j].z * v[j].z + v[j].w * v[j].w);
        const float rstd = 1.0f / sqrtf(wave_sum(ss) * (1.0f / DM) + NORM_EPS);
#pragma unroll
        for (int j = 0; j < 8; ++j) *(f32x4*)(yr + 256 * j) = v[j] * rstd * g[j];
    }
}
__device__ __forceinline__ void ssd_norm_phase(int lane, int gw, int NGW, bf16* YB, const float* g) {
    float gv[16];
#pragma unroll
    for (int j = 0; j < 4; ++j) { const f32x4 t = *(const f32x4*)(g + 16 * lane + 4 * j); gv[4 * j] = t.x; gv[4 * j + 1] = t.y; gv[4 * j + 2] = t.z; gv[4 * j + 3] = t.w; }
    v4u na = (v4u){0u, 0u, 0u, 0u}, nb = na;
    if (gw < MT) { const v4u* p0 = (const v4u*)(YB + (size_t)gw * 1024 + 16 * lane); na = p0[0]; nb = p0[1]; }
    for (int r = gw; r < MT; r += NGW) {
        v4u* p = (v4u*)(YB + (size_t)r * 1024 + 16 * lane); const v4u a = na, b = nb;
        if (r + NGW < MT) { const v4u* p1 = (const v4u*)(YB + (size_t)(r + NGW) * 1024 + 16 * lane); na = p1[0]; nb = p1[1]; }
        float v[16]; v[0] = bflo(a.x); v[1] = bfhi(a.x); v[2] = bflo(a.y); v[3] = bfhi(a.y); v[4] = bflo(a.z); v[5] = bfhi(a.z); v[6] = bflo(a.w); v[7] = bfhi(a.w);
        v[8] = bflo(b.x); v[9] = bfhi(b.x); v[10] = bflo(b.y); v[11] = bfhi(b.y); v[12] = bflo(b.z); v[13] = bfhi(b.z); v[14] = bflo(b.w); v[15] = bfhi(b.w);
        float ss = 0.f;
#pragma unroll
        for (int j = 0; j < 16; ++j) ss += v[j] * v[j];
        const float rstd = 1.0f / sqrtf(half_sum(ss) * (1.0f / 512.0f) + NORM_EPS);
#pragma unroll
        for (int j = 0; j < 16; ++j) v[j] = v[j] * rstd * gv[j];
        v4u oa, ob; oa.x = pk2(v[0], v[1]); oa.y = pk2(v[2], v[3]); oa.z = pk2(v[4], v[5]); oa.w = pk2(v[6], v[7]); ob.x = pk2(v[8], v[9]); ob.y = pk2(v[10], v[11]); ob.z = pk2(v[12], v[13]); ob.w = pk2(v[14], v[15]);
        p[0] = oa; p[1] = ob;
    }
}

__device__ __forceinline__ void hgrn_item(LAS unsigned char* lds, int tid, int lane, int wave, const bf16* P, bf16* YA, int row0, int T, int h, int l,
                                          const float* s0, float* sout, const float* lb_raw, const float* onorm_g) {
    LAS float* LBV = (LAS float*)lds;
    LAS float* GV = LBV + 128;
    LAS float* Q = GV + 128;
    LAS float* F = Q + 2048; LAS float* KN = F + 2048; LAS float* IV = KN + 2048;
    LAS float* PO = IV + 2048;
    __syncthreads();
    if (tid < 128) { const int ch = h * 128 + tid; const float a0 = lb_raw[ch], a1 = lb_raw[1024 + ch], a2 = lb_raw[2048 + ch], a3 = lb_raw[3072 + ch];
        const float mx = fmaxf(fmaxf(a0, a1), fmaxf(a2, a3)); const float e0 = __expf(a0 - mx), e1 = __expf(a1 - mx), e2 = __expf(a2 - mx), e3 = __expf(a3 - mx); const float inv = 1.0f / (e0 + e1 + e2 + e3);
        float lb = 0.f; if (l >= 1) lb += e1; if (l >= 2) lb += e2; if (l >= 3) lb += e3; LBV[tid] = lb * inv; GV[tid] = onorm_g[ch]; }
    v2u nq2, nf2, ni2;
    { const bf16* pr = P + (size_t)(row0 + (tid >> 5)) * NPAD + h * 128 + (tid & 31) * 4; nq2 = *(const v2u*)(pr + OFF_AQ); nf2 = *(const v2u*)(pr + OFF_AF); ni2 = *(const v2u*)(pr + OFF_AI); }
    float S0[16], S1[16];
#pragma unroll
    for (int kk = 0; kk < 16; ++kk) { if (s0) { const f32x2 v = *(const f32x2*)(s0 + (16 * wave + kk) * 128 + 2 * lane); S0[kk] = v.x; S1[kk] = v.y; } else { S0[kk] = 0.f; S1[kk] = 0.f; } }
    __syncthreads();
    const int nch = T / 16;
    for (int c = 0; c < nch; ++c) {
        unsigned agv[2];
#pragma unroll
        for (int tt = 0; tt < 2; ++tt) agv[tt] = *(const unsigned*)(P + (size_t)(row0 + c * 16 + 2 * wave + tt) * NPAD + OFF_AG + h * 128 + 2 * lane);
        { const int t = tid >> 5, k4 = (tid & 31) * 4;
            const v2u q2 = nq2, f2 = nf2, i2 = ni2;
            if (c + 1 < nch) { const bf16* pr = P + (size_t)(row0 + (c + 1) * 16 + t) * NPAD + h * 128 + k4; nq2 = *(const v2u*)(pr + OFF_AQ); nf2 = *(const v2u*)(pr + OFF_AF); ni2 = *(const v2u*)(pr + OFF_AI); }
            const f32x4 lb = *(const LAS f32x4*)(LBV + k4);
            const float aq[4] = {bflo(q2.x), bfhi(q2.x), bflo(q2.y), bfhi(q2.y)}, az[4] = {bflo(f2.x), bfhi(f2.x), bflo(f2.y), bfhi(f2.y)};
            f32x4 qv, fv, kv;
#pragma unroll
            for (int j = 0; j < 4; ++j) { qv[j] = siluf_(aq[j]); const float sg = sigmoidf_(az[j]); fv[j] = lb[j] + (1.0f - lb[j]) * sg; kv[j] = (1.0f - lb[j]) * (1.0f - sg); }
            *(LAS f32x4*)(Q + t * 128 + k4) = qv; *(LAS f32x4*)(F + t * 128 + k4) = fv; *(LAS f32x4*)(KN + t * 128 + k4) = kv;
            *(LAS f32x4*)(IV + t * 128 + k4) = (f32x4){bflo(i2.x), bfhi(i2.x), bflo(i2.y), bfhi(i2.y)}; }
        __syncthreads();
#pragma unroll 2
        for (int t = 0; t < 16; ++t) {
            const f32x2 iv = *(const LAS f32x2*)(IV + t * 128 + 2 * lane); float po0 = 0.f, po1 = 0.f;
#pragma unroll
            for (int k4 = 0; k4 < 4; ++k4) { const f32x4 f4 = *(const LAS f32x4*)(F + t * 128 + 16 * wave + 4 * k4), n4 = *(const LAS f32x4*)(KN + t * 128 + 16 * wave + 4 * k4), q4 = *(const LAS f32x4*)(Q + t * 128 + 16 * wave + 4 * k4);
#pragma unroll
                for (int j = 0; j < 4; ++j) { const int kk = 4 * k4 + j; S0[kk] = fmaf(f4[j], S0[kk], n4[j] * iv.x); S1[kk] = fmaf(f4[j], S1[kk], n4[j] * iv.y); po0 = fmaf(q4[j], S0[kk], po0); po1 = fmaf(q4[j], S1[kk], po1); } }
            *(LAS f32x2*)(PO + (t * 8 + wave) * 128 + 2 * lane) = (f32x2){po0, po1};
        }
        __syncthreads();
#pragma unroll
        for (int tt = 0; tt < 2; ++tt) { const int t = 2 * wave + tt; float o0 = 0.f, o1 = 0.f;
#pragma unroll
            for (int w = 0; w < 8; ++w) { const f32x2 p = *(const LAS f32x2*)(PO + (t * 8 + w) * 128 + 2 * lane); o0 += p.x; o1 += p.y; }
            const float rstd = 1.0f / sqrtf(wave_sum(o0 * o0 + o1 * o1) * (1.0f / 128.0f) + NORM_EPS);
            const size_t row = (size_t)(row0 + c * 16 + t);
            const unsigned ag = agv[tt];
            const f32x2 gg = *(const LAS f32x2*)(GV + 2 * lane);
            *(unsigned*)(YA + row * 1024 + h * 128 + 2 * lane) = pk2(o0 * rstd * gg.x * siluf_(bflo(ag)), o1 * rstd * gg.y * siluf_(bfhi(ag))); }
    }
#pragma unroll
    for (int kk = 0; kk < 16; ++kk) *(f32x2*)(sout + (16 * wave + kk) * 128 + 2 * lane) = (f32x2){S0[kk], S1[kk]};
    __syncthreads();
}

typedef short bf16x8_t __attribute__((ext_vector_type(8)));
#define BAR_LDS() do { asm volatile("s_waitcnt lgkmcnt(0)" ::: "memory"); __builtin_amdgcn_s_barrier(); asm volatile("" ::: "memory"); } while (0)
#define MFMA16(x, y, acc) __builtin_amdgcn_mfma_f32_16x16x32_bf16((x), (y), (acc), 0, 0, 0)
#define LDFRAG(base, row, pitch, koff) (*(const LAS bf16x8_t*)((base) + (row) * (pitch) + (koff)))
__device__ __forceinline__ void hgrn_mfma_item(LAS unsigned char* lds, int tid, int lane, int wave, const bf16* P, bf16* YA, int row0, int h, int l, float* sout, const float* lb_raw, const float* onorm_g) {
    constexpr int PQ = 136, PT = 40;
    LAS float* LBV = (LAS float*)lds;
    LAS float* GV = LBV + 128;
    LAS float* DEC = GV + 128;
    LAS float* SS = DEC + 128;
    LAS float* LF = SS + 256;
    LAS bf16* QB = (LAS bf16*)(LF + 4096);
    LAS bf16* KB = QB + 32 * PQ;
    LAS bf16* Qt = KB + 32 * PQ;
    LAS bf16* Qm = Qt + 32 * PQ;
    LAS bf16* Km = Qm + 32 * PQ;
    LAS bf16* Qr = Km + 32 * PQ;
    LAS bf16* Kr = Qr + 16 * PQ;
    LAS bf16* KtT = Kr + 16 * PQ;
    LAS bf16* VT = KtT + 128 * PT;
    LAS bf16* IVr = VT + 128 * PT;
    LAS float* RSW = (LAS float*)(IVr + 32 * 128);
    const int fr = lane & 15, fq = lane >> 4;
    __syncthreads();
    if (tid < 128) { const int ch = h * 128 + tid; const float a0 = lb_raw[ch], a1 = lb_raw[1024 + ch], a2 = lb_raw[2048 + ch], a3 = lb_raw[3072 + ch];
        const float mx = fmaxf(fmaxf(a0, a1), fmaxf(a2, a3)); const float e0 = __expf(a0 - mx), e1 = __expf(a1 - mx), e2 = __expf(a2 - mx), e3 = __expf(a3 - mx); const float inv = 1.0f / (e0 + e1 + e2 + e3);
        float lb = 0.f; if (l >= 1) lb += e1; if (l >= 2) lb += e2; if (l >= 3) lb += e3; LBV[tid] = lb * inv; GV[tid] = onorm_g[ch]; }
    for (int i = tid; i < (128 * PT * 2) / 2; i += 512) ((LAS unsigned*)KtT)[i] = 0u;
    f32x4 sacc[8];
#pragma unroll
    for (int j = 0; j < 8; ++j) sacc[j] = (f32x4){0.f, 0.f, 0.f, 0.f};
    const int st = tid >> 4, sk8 = (tid & 15) * 8;
    const unsigned pst = (unsigned)((unsigned)(row0 + st) * (unsigned)NPAD + h * 128 + sk8) * 2u;
#define HG_LD16(off_) (*(const v4u*)((const char*)P + (unsigned)(off_)))
    v4u nq = HG_LD16(pst + 2u * OFF_AQ), nf = HG_LD16(pst + 2u * OFF_AF), ni = HG_LD16(pst + 2u * OFF_AI);
    f32x4 po0 = (f32x4){0.f, 0.f, 0.f, 0.f}, po1 = po0; bf16 pag[2][4];
#pragma unroll
    for (int hh = 0; hh < 2; ++hh)
#pragma unroll
        for (int r = 0; r < 4; ++r) pag[hh][r] = 0;
    const float gvv = onorm_g[h * 128 + 16 * wave + fr];
    __syncthreads();
#define HG_OUT(rb_) do { { const int t_ = lane & 31; const f32x4 p0 = *(const LAS f32x4*)(SS + t_ * 8), p1 = *(const LAS f32x4*)(SS + t_ * 8 + 4); \
            RSW[wave * 32 + t_] = rsqrtf_(((p0.x + p0.y) + (p0.z + p0.w) + (p1.x + p1.y) + (p1.z + p1.w)) * (1.0f / 128.0f) + NORM_EPS); } \
        LDS_WAIT(); asm volatile("" ::: "memory"); \
        _Pragma("unroll") for (int hh = 0; hh < 2; ++hh) { const f32x4 rs4 = *(const LAS f32x4*)(RSW + wave * 32 + 16 * hh + 4 * fq); \
            _Pragma("unroll") for (int r = 0; r < 4; ++r) { const int t = 16 * hh + 4 * fq + r; const float ov = hh ? po1[r] : po0[r]; \
            *(bf16*)((char*)YA + (unsigned)(((unsigned)(rb_) + t) * 1024u + h * 128 + 16 * wave + fr) * 2u) = (bf16)f2bf(ov * rs4[r] * gvv * siluf_(bf1(pag[hh][r]))); } } } while (0)
    for (int c = 0; c < 64; ++c) {
        const unsigned rbase = (unsigned)row0 + 32u * c;
        bf16 ag[2][4];
        { const f32x4 lb0 = *(const LAS f32x4*)(LBV + sk8), lb1 = *(const LAS f32x4*)(LBV + sk8 + 4); const float lb[8] = {lb0.x, lb0.y, lb0.z, lb0.w, lb1.x, lb1.y, lb1.z, lb1.w};
            const float aq[8] = {bflo(nq.x), bfhi(nq.x), bflo(nq.y), bfhi(nq.y), bflo(nq.z), bfhi(nq.z), bflo(nq.w), bfhi(nq.w)}, az[8] = {bflo(nf.x), bfhi(nf.x), bflo(nf.y), bfhi(nf.y), bflo(nf.z), bfhi(nf.z), bflo(nf.w), bfhi(nf.w)};
            float qv[8], kv[8], lf[8];
#pragma unroll
            for (int j = 0; j < 8; ++j) { qv[j] = siluf_(aq[j]); const float sg = sigmoidf_(az[j]); const float f = fmaxf(lb[j] + (1.0f - lb[j]) * sg, 1e-30f); kv[j] = (1.0f - lb[j]) * (1.0f - sg); lf[j] = __log2f(f); }
            *(LAS f32x4*)(LF + st * 128 + sk8) = (f32x4){lf[0], lf[1], lf[2], lf[3]}; *(LAS f32x4*)(LF + st * 128 + sk8 + 4) = (f32x4){lf[4], lf[5], lf[6], lf[7]};
            v4u qo, ko; qo.x = pk2(qv[0], qv[1]); qo.y = pk2(qv[2], qv[3]); qo.z = pk2(qv[4], qv[5]); qo.w = pk2(qv[6], qv[7]); ko.x = pk2(kv[0], kv[1]); ko.y = pk2(kv[2], kv[3]); ko.z = pk2(kv[4], kv[5]); ko.w = pk2(kv[6], kv[7]);
            *(LAS v4u*)(QB + st * PQ + sk8) = qo; *(LAS v4u*)(KB + st * PQ + sk8) = ko; *(LAS v4u*)(IVr + st * 128 + sk8) = ni;
#pragma unroll
            for (int hh = 0; hh < 2; ++hh)
#pragma unroll
                for (int r = 0; r < 4; ++r) ag[hh][r] = *(const bf16*)((const char*)P + (unsigned)((rbase + 16 * hh + 4 * fq + r) * (unsigned)NPAD + OFF_AG + h * 128 + 16 * wave + fr) * 2u);
            if (c + 1 < 64) { const unsigned pn = pst + (unsigned)(c + 1) * 32u * (unsigned)NPAD * 2u; nq = HG_LD16(pn + 2u * OFF_AQ); nf = HG_LD16(pn + 2u * OFF_AF); ni = HG_LD16(pn + 2u * OFF_AI); } }
        BAR_LDS();
        { const int k = tid & 127, tq = tid >> 7; float b[32]; float run = 0.f;
#pragma unroll
            for (int t = 0; t < 32; ++t) { run += LF[t * 128 + k]; b[t] = run; }
#pragma unroll
            for (int tq2 = 0; tq2 < 4; ++tq2) if (tq2 == tq) { const float mh = (tq2 < 2) ? b[7] : b[23]; float kt[8]; bf16 iv[8];
#pragma unroll
                for (int i = 0; i < 8; ++i) { const int t = 8 * tq2 + i; const float qv = bf1(QB[t * PQ + k]), kv = bf1(KB[t * PQ + k]); iv[i] = IVr[t * 128 + k];
                    Qt[t * PQ + k] = (bf16)f2bf(qv * __builtin_amdgcn_exp2f(b[t])); kt[i] = kv * __builtin_amdgcn_exp2f(b[31] - b[t]);
                    Qm[t * PQ + k] = (bf16)f2bf(qv * __builtin_amdgcn_exp2f(fminf(b[t] - mh, 115.f))); Km[t * PQ + k] = (bf16)f2bf(kv * __builtin_amdgcn_exp2f(fminf(mh - b[t], 115.f)));
                    if (tq2 < 2) Kr[t * PQ + k] = (bf16)f2bf(kv * __builtin_amdgcn_exp2f(b[15] - b[t])); else Qr[(t - 16) * PQ + k] = (bf16)f2bf(qv * __builtin_amdgcn_exp2f(b[t] - b[15])); }
                v4u ko; ko.x = pk2(kt[0], kt[1]); ko.y = pk2(kt[2], kt[3]); ko.z = pk2(kt[4], kt[5]); ko.w = pk2(kt[6], kt[7]); *(LAS v4u*)(KtT + k * PT + 8 * tq2) = ko;
                v4u vo; vo.x = (unsigned)iv[0] | ((unsigned)iv[1] << 16); vo.y = (unsigned)iv[2] | ((unsigned)iv[3] << 16); vo.z = (unsigned)iv[4] | ((unsigned)iv[5] << 16); vo.w = (unsigned)iv[6] | ((unsigned)iv[7] << 16); *(LAS v4u*)(VT + k * PT + 8 * tq2) = vo; }
            if (tq == 0) DEC[k] = __builtin_amdgcn_exp2f(b[31]); }
        if (c > 0) HG_OUT(rbase - 32);
        BAR_LDS();
        f32x4 at0 = (f32x4){0.f, 0.f, 0.f, 0.f}, at1 = at0, at2 = at0, o0 = at0, o1 = at0;
#pragma unroll
        for (int ks = 0; ks < 4; ++ks) { const int ko = 32 * ks + 8 * fq;
            at0 = MFMA16(LDFRAG(Km, fr, PQ, ko), LDFRAG(Qm, fr, PQ, ko), at0);
            at1 = MFMA16(LDFRAG(Km, 16 + fr, PQ, ko), LDFRAG(Qm, 16 + fr, PQ, ko), at1);
            at2 = MFMA16(LDFRAG(Kr, fr, PQ, ko), LDFRAG(Qr, fr, PQ, ko), at2);
            v4u sy; sy.x = pk2(sacc[2 * ks][0], sacc[2 * ks][1]); sy.y = pk2(sacc[2 * ks][2], sacc[2 * ks][3]); sy.z = pk2(sacc[2 * ks + 1][0], sacc[2 * ks + 1][1]); sy.w = pk2(sacc[2 * ks + 1][2], sacc[2 * ks + 1][3]);
            const v2u xa0 = *(const LAS v2u*)(Qt + fr * PQ + 32 * ks + 4 * fq), xb0 = *(const LAS v2u*)(Qt + fr * PQ + 32 * ks + 16 + 4 * fq);
            const v2u xa1 = *(const LAS v2u*)(Qt + (16 + fr) * PQ + 32 * ks + 4 * fq), xb1 = *(const LAS v2u*)(Qt + (16 + fr) * PQ + 32 * ks + 16 + 4 * fq);
            v4u x0; x0.x = xa0.x; x0.y = xa0.y; x0.z = xb0.x; x0.w = xb0.y; v4u x1; x1.x = xa1.x; x1.y = xa1.y; x1.z = xb1.x; x1.w = xb1.y;
            o0 = MFMA16(__builtin_bit_cast(bf16x8_t, x0), __builtin_bit_cast(bf16x8_t, sy), o0); o1 = MFMA16(__builtin_bit_cast(bf16x8_t, x1), __builtin_bit_cast(bf16x8_t, sy), o1); }
        {
            v4u a0, a1, a2; a0.z = 0u; a0.w = 0u; a1.z = 0u; a1.w = 0u; a2.z = 0u; a2.w = 0u;
            a0.x = pk2(4 * fq + 0 <= fr ? at0[0] : 0.f, 4 * fq + 1 <= fr ? at0[1] : 0.f); a0.y = pk2(4 * fq + 2 <= fr ? at0[2] : 0.f, 4 * fq + 3 <= fr ? at0[3] : 0.f);
            a1.x = pk2(4 * fq + 0 <= fr ? at1[0] : 0.f, 4 * fq + 1 <= fr ? at1[1] : 0.f); a1.y = pk2(4 * fq + 2 <= fr ? at1[2] : 0.f, 4 * fq + 3 <= fr ? at1[3] : 0.f);
            a2.x = pk2(at2[0], at2[1]); a2.y = pk2(at2[2], at2[3]);
            const v2u y0 = *(const LAS v2u*)(VT + (16 * wave + fr) * PT + 4 * fq), y1 = *(const LAS v2u*)(VT + (16 * wave + fr) * PT + 16 + 4 * fq);
            v4u v0; v0.x = y0.x; v0.y = y0.y; v0.z = 0u; v0.w = 0u; v4u v1; v1.x = y1.x; v1.y = y1.y; v1.z = 0u; v1.w = 0u;
            o0 = MFMA16(__builtin_bit_cast(bf16x8_t, a0), __builtin_bit_cast(bf16x8_t, v0), o0);
            o1 = MFMA16(__builtin_bit_cast(bf16x8_t, a1), __builtin_bit_cast(bf16x8_t, v1), o1);
            o1 = MFMA16(__builtin_bit_cast(bf16x8_t, a2), __builtin_bit_cast(bf16x8_t, v0), o1); }
#pragma unroll
        for (int r = 0; r < 4; ++r) { float q0 = o0[r] * o0[r], q1 = o1[r] * o1[r];
            q0 += __shfl_xor(q0, 1); q1 += __shfl_xor(q1, 1); q0 += __shfl_xor(q0, 2); q1 += __shfl_xor(q1, 2); q0 += __shfl_xor(q0, 4); q1 += __shfl_xor(q1, 4); q0 += __shfl_xor(q0, 8); q1 += __shfl_xor(q1, 8);
            if (fr == 0) { SS[(4 * fq + r) * 8 + wave] = q0; SS[(16 + 4 * fq + r) * 8 + wave] = q1; } }
        {
            const bf16x8_t vy = LDFRAG(VT, 16 * wave + fr, PT, 8 * fq);
#pragma unroll
            for (int kt = 0; kt < 8; ++kt) { const f32x4 d4 = *(const LAS f32x4*)(DEC + 16 * kt + 4 * fq); sacc[kt] = sacc[kt] * d4; sacc[kt] = MFMA16(LDFRAG(KtT, 16 * kt + fr, PT, 8 * fq), vy, sacc[kt]); } }
        po0 = o0; po1 = o1;
#pragma unroll
        for (int hh = 0; hh < 2; ++hh)
#pragma unroll
            for (int r = 0; r < 4; ++r) pag[hh][r] = ag[hh][r];
    }
    BAR_LDS();
    HG_OUT((unsigned)row0 + 2048u - 32u);
#undef HG_OUT
#undef HG_LD16
#pragma unroll
    for (int kt = 0; kt < 8; ++kt)
#pragma unroll
        for (int r = 0; r < 4; ++r) sout[(16 * kt + 4 * fq + r) * 128 + 16 * wave + fr] = sacc[kt][r];
    __syncthreads();
}

__device__ __forceinline__ void ssd_pre_phase(int lane, int gw, int NGW, const bf16* P, bf16* XC, float* DTb, float* ADT, float* ACUM,
                                              const float* conv_w, const float* conv_b, const float* dt_bias, const float* a_log, const float* state_conv, float* conv_out_p, float* conv_out_s) {
    unsigned ua = (unsigned)(((unsigned long long)(unsigned)gw * (3u * MT)) / (unsigned)NGW); const unsigned ub = (unsigned)(((unsigned long long)((unsigned)gw + 1u) * (3u * MT)) / (unsigned)NGW);
#define PRE_UNPK(dst, u) do { dst[0] = bflo(u.x); dst[1] = bfhi(u.x); dst[2] = bflo(u.y); dst[3] = bfhi(u.y); dst[4] = bflo(u.z); dst[5] = bfhi(u.z); dst[6] = bflo(u.w); dst[7] = bfhi(u.w); } while (0)
    while (ua < ub) {
        const int cg = (int)(ua / (unsigned)MT); const unsigned ue = ub < (unsigned)(cg + 1) * MT ? ub : (unsigned)(cg + 1) * MT;
        const int t0 = (int)(ua - (unsigned)cg * MT), t1 = (int)(ue - (unsigned)cg * MT), cc = cg * 512 + 8 * lane; ua = ue;
        float w[4][8], cb[8], a0[8], a1[8], a2[8];
#pragma unroll
        for (int j = 0; j < 4; ++j) { const f32x4 u0 = *(const f32x4*)(conv_w + j * 1536 + cc), u1 = *(const f32x4*)(conv_w + j * 1536 + cc + 4);
            w[j][0] = u0.x; w[j][1] = u0.y; w[j][2] = u0.z; w[j][3] = u0.w; w[j][4] = u1.x; w[j][5] = u1.y; w[j][6] = u1.z; w[j][7] = u1.w; }
        { const f32x4 u0 = *(const f32x4*)(conv_b + cc), u1 = *(const f32x4*)(conv_b + cc + 4); cb[0] = u0.x; cb[1] = u0.y; cb[2] = u0.z; cb[3] = u0.w; cb[4] = u1.x; cb[5] = u1.y; cb[6] = u1.z; cb[7] = u1.w; }
#pragma unroll
        for (int e = 0; e < 8; ++e) { a0[e] = 0.f; a1[e] = 0.f; a2[e] = 0.f; }
        const int ts = t0 >= 3 ? t0 - 3 : 0;
        const bf16* pc = P + OFF_XBC + cc; bf16* xo = XC + cc;
        v4u un[4];
#pragma unroll
        for (int k = 0; k < 4; ++k) { const int tt = ts + k < t1 ? ts + k : t1 - 1; un[k] = *(const v4u*)(pc + (size_t)tt * NPAD); }
        for (int tb = ts; tb < t1; tb += 4) { v4u uc[4];
#pragma unroll
            for (int k = 0; k < 4; ++k) uc[k] = un[k];
            if (tb + 4 < t1) {
#pragma unroll
                for (int k = 0; k < 4; ++k) { const int tt = tb + 4 + k < t1 ? tb + 4 + k : t1 - 1; un[k] = *(const v4u*)(pc + (size_t)tt * NPAD); } }
#pragma unroll
            for (int k = 0; k < 4; ++k) { const int t = tb + k; if (t < t1) {
                const bool smp = t >= NTOK_P; const bool st = smp ? (((t - NTOK_P) & 31) == 0) : ((t & 2047) == 0);
                if (st) {
                    if (smp) { const float* cbuf = state_conv + (size_t)((t - NTOK_P) >> 5) * 4608 + cc;
#pragma unroll
                        for (int e = 0; e < 8; ++e) { a0[e] = cbuf[e]; a1[e] = cbuf[1536 + e]; a2[e] = cbuf[3072 + e]; } }
                    else {
#pragma unroll
                        for (int e = 0; e < 8; ++e) { a0[e] = 0.f; a1[e] = 0.f; a2[e] = 0.f; } } }
                float cur[8]; PRE_UNPK(cur, uc[k]);
                if (t >= t0) { float o[8];
#pragma unroll
                    for (int e = 0; e < 8; ++e) o[e] = siluf_(cb[e] + w[0][e] * a0[e] + w[1][e] * a1[e] + w[2][e] * a2[e] + w[3][e] * cur[e]);
                    v4u ov; ov.x = pk2(o[0], o[1]); ov.y = pk2(o[2], o[3]); ov.z = pk2(o[4], o[5]); ov.w = pk2(o[6], o[7]);
                    *(v4u*)(xo + (size_t)t * 1536) = ov; }
#pragma unroll
                for (int e = 0; e < 8; ++e) { a0[e] = a1[e]; a1[e] = a2[e]; a2[e] = cur[e]; } } }
        }
    }
#undef PRE_UNPK
    for (int it = gw; it < 528 * 16; it += NGW) {
        const int rb = it >> 4, h = it & 15; const size_t row = (size_t)rb * 64 + lane;
        const float xv = bf1(P[row * NPAD + OFF_DT + h]) + dt_bias[h]; const float dt = xv > 20.f ? xv : log1pf(__expf(xv)); const float a = -dt * __expf(a_log[h]);
        float cs = a;
#pragma unroll
        for (int o = 1; o < 64; o <<= 1) { const float t = __shfl_up(cs, o); if (lane >= o) cs += t; }
        DTb[row * 16 + h] = dt; ADT[row * 16 + h] = a; ACUM[row * 16 + h] = cs;
    }
    for (int e = gw * 64 + lane; e < 48 * 4608; e += NGW * 64) {
        const int sq = e / 4608, r = e - sq * 4608, j = r / 1536, cc = r - j * 1536;
        const size_t row = sq < 16 ? (size_t)sq * 2048 + 2045 + j : (size_t)NTOK_P + (sq - 16) * 32 + 29 + j;
        const float v = bf1(P[row * NPAD + OFF_XBC + cc]);
        if (sq < 16) conv_out_p[sq * 4608 + r] = v; else conv_out_s[(sq - 16) * 4608 + r] = v;
    }
}

__device__ __forceinline__ void ssd_item(LAS unsigned char* lds, int tid, int lane, int wave, const bf16* P, const bf16* XC, const float* DTb, const float* ADT, bf16* YB, int row0, int T, int h,
                                         const float* s0, float* sout, float Dh) {
    LAS float* X = (LAS float*)lds;
    LAS float* Bs = X + 2048;
    LAS float* Cs = Bs + 4096;
    LAS float* DT = Cs + 4096;
    LAS float* DA = DT + 32;
    LAS float* PY = DA + 32;
    const int g = h >> 3, ci = tid;
    int cc = 0; LAS float* dst = X; int dstride = 64;
    if (ci < 64) { cc = h * 64 + ci; dst = X + ci; dstride = 64; } else if (ci < 192) { cc = 1024 + g * 128 + (ci - 64); dst = Bs + (ci - 64); dstride = 128; } else if (ci < 320) { cc = 1280 + g * 128 + (ci - 192); dst = Cs + (ci - 192); dstride = 128; }
    float hst[16];
#pragma unroll
    for (int j = 0; j < 4; ++j) { f32x4 v = (f32x4){0.f, 0.f, 0.f, 0.f}; if (s0) v = *(const f32x4*)(s0 + lane * 128 + 16 * wave + 4 * j); hst[4 * j] = v.x; hst[4 * j + 1] = v.y; hst[4 * j + 2] = v.z; hst[4 * j + 3] = v.w; }
    __syncthreads();
    const int nch = T / 32;
    for (int c = 0; c < nch; ++c) {
        const size_t rbase = (size_t)(row0 + c * 32);
        if (ci < 320) { const bf16* pc = XC + rbase * 1536 + cc;
            bf16 sv[32];
#pragma unroll
            for (int t = 0; t < 32; ++t) sv[t] = pc[(size_t)t * 1536];
#pragma unroll
            for (int t = 0; t < 32; ++t) dst[t * dstride] = bf1(sv[t]); }
        else if (ci < 352) { const int t = ci - 320; DT[t] = DTb[(rbase + t) * 16 + h]; DA[t] = __expf(ADT[(rbase + t) * 16 + h]); }
        unsigned zg[2];
#pragma unroll
        for (int j = 0; j < 2; ++j) { const int e = tid + 512 * j; zg[j] = *(const unsigned*)(P + (rbase + (e >> 5)) * NPAD + OFF_BZ + h * 64 + (e & 31) * 2); }
        __syncthreads();
#pragma unroll 2
        for (int t = 0; t < 32; ++t) {
            const float dA = DA[t], xdt = X[t * 64 + lane] * DT[t]; float py = 0.f;
#pragma unroll
            for (int n4 = 0; n4 < 4; ++n4) { const f32x4 b4 = *(const LAS f32x4*)(Bs + t * 128 + 16 * wave + 4 * n4), c4 = *(const LAS f32x4*)(Cs + t * 128 + 16 * wave + 4 * n4);
#pragma unroll
                for (int j = 0; j < 4; ++j) { const int nn = 4 * n4 + j; hst[nn] = fmaf(xdt, b4[j], dA * hst[nn]); py = fmaf(hst[nn], c4[j], py); } }
            PY[(t * 8 + wave) * 64 + lane] = py;
        }
        __syncthreads();
#pragma unroll
        for (int j = 0; j < 2; ++j) { const int e = tid + 512 * j, t = e >> 5, p2 = (e & 31) * 2; float y0 = 0.f, y1 = 0.f;
#pragma unroll
            for (int w = 0; w < 8; ++w) { const f32x2 p = *(const LAS f32x2*)(PY + (t * 8 + w) * 64 + p2); y0 += p.x; y1 += p.y; }
            const f32x2 xv = *(const LAS f32x2*)(X + t * 64 + p2); y0 += Dh * xv.x; y1 += Dh * xv.y;
            const size_t row = rbase + t; const unsigned z = zg[j];
            *(unsigned*)(YB + row * 1024 + h * 64 + p2) = pk2(y0 * siluf_(bflo(z)), y1 * siluf_(bfhi(z))); }
        __syncthreads();
    }
#pragma unroll
    for (int j = 0; j < 4; ++j) *(f32x4*)(sout + lane * 128 + 16 * wave + 4 * j) = (f32x4){hst[4 * j], hst[4 * j + 1], hst[4 * j + 2], hst[4 * j + 3]};
    __syncthreads();
}

__device__ __forceinline__ bf16 v4u_el(const v4u& d, int e) { const unsigned w = d[e >> 1]; return (bf16)((e & 1) ? (w >> 16) : (w & 0xffffu)); }
__device__ __forceinline__ void ssd_mfma_pair(LAS unsigned char* lds, int tid, int lane, int wave, const bf16* P, const bf16* XC, const float* DTb, const float* ACUM, bf16* YB, int row0, int h0, float Dh0, float Dh1, float* sout0) {
    constexpr int PC = 136, PS = 72;
    LAS bf16* Cm0 = (LAS bf16*)lds;
    LAS bf16* Bm = Cm0 + 2 * 64 * PC;
    LAS bf16* BmT = Bm + 64 * PC;
    LAS bf16* XT0 = BmT + 128 * PS;
    LAS bf16* Mm0 = XT0 + 4 * 64 * PS;
    LAS float* AC0 = (LAS float*)(Mm0 + 2 * 64 * PS);
    static_assert((2 * 64 * PC + 64 * PC + 128 * PS + 4 * 64 * PS + 2 * 64 * PS) * 2 + 4 * 192 * 4 <= RING_BYTES, "ssd pair LDS");
    const int fr = lane & 15, fq = lane >> 4, g = h0 >> 3;
    const int hw = wave >> 2, pt = wave & 3;
    __syncthreads();
    f32x4 hacc[8];
#pragma unroll
    for (int j = 0; j < 8; ++j) hacc[j] = (f32x4){0.f, 0.f, 0.f, 0.f};
    int pf_s[6], pf_c[6]; v4u pf[6];
#pragma unroll
    for (int j = 0; j < 6; ++j) { const int q = tid + 512 * j; pf_s[j] = q / 48; const int c16 = q - 48 * pf_s[j];
        const int col = c16 < 16 ? (h0 + (c16 >> 3)) * 64 + 8 * (c16 & 7) : (c16 < 32 ? 1024 + g * 128 + 8 * (c16 - 16) : 1280 + g * 128 + 8 * (c16 - 32));
        pf_c[j] = (c16 << 16) | col; pf[j] = *(const v4u*)((const char*)XC + (unsigned)(((unsigned)row0 + pf_s[j]) * 1536u + col) * 2u); }
    float pf_ac = 0.f, pf_dt = 0.f, pf_acl = 0.f; const int sh = tid >> 6, ssx = tid & 63;
    if (tid < 128) { pf_ac = *(const float*)((const char*)ACUM + (unsigned)(((unsigned)row0 + ssx) * 16u + h0 + sh) * 4u); pf_dt = *(const float*)((const char*)DTb + (unsigned)(((unsigned)row0 + ssx) * 16u + h0 + sh) * 4u); pf_acl = *(const float*)((const char*)ACUM + (unsigned)(((unsigned)row0 + 63u) * 16u + h0 + sh) * 4u); }
    for (int c = 0; c < 32; ++c) {
        const unsigned rbase = (unsigned)row0 + 64u * c;
        const int cb = c & 1;
        LAS bf16* Cm = Cm0 + cb * 64 * PC; LAS bf16* XTb = XT0 + cb * 2 * 64 * PS; LAS float* ACb = AC0 + cb * 2 * 192;
        if (tid < 128) { LAS float* A = ACb + sh * 192; A[ssx] = pf_ac; A[128 + ssx] = pf_dt; A[64 + ssx] = __expf(pf_acl - pf_ac) * pf_dt; }
#pragma unroll
        for (int j = 0; j < 6; ++j) { const int s = pf_s[j], c16 = pf_c[j] >> 16; const v4u d = pf[j];
            if (c16 < 16) { LAS bf16* XT = XTb + (c16 >> 3) * 64 * PS; const int cc = c16 & 7;
#pragma unroll
                for (int e = 0; e < 8; ++e) XT[(8 * cc + e) * PS + (s ^ (cc << 3))] = v4u_el(d, e); }
            else if (c16 < 32) { const int n0 = 8 * (c16 - 16); *(LAS v4u*)(Bm + s * PC + n0) = d;
#pragma unroll
                for (int e = 0; e < 8; ++e) BmT[(n0 + e) * PS + (s ^ (((c16 - 16) & 7) << 3))] = v4u_el(d, e); }
            else { *(LAS v4u*)(Cm + s * PC + 8 * (c16 - 32)) = d; } }
        if (c + 1 < 32) {
#pragma unroll
            for (int j = 0; j < 6; ++j) pf[j] = *(const v4u*)((const char*)XC + (unsigned)((rbase + 64u + pf_s[j]) * 1536u + (pf_c[j] & 0xffff)) * 2u);
            if (tid < 128) { pf_ac = *(const float*)((const char*)ACUM + (unsigned)((rbase + 64u + ssx) * 16u + h0 + sh) * 4u); pf_dt = *(const float*)((const char*)DTb + (unsigned)((rbase + 64u + ssx) * 16u + h0 + sh) * 4u); pf_acl = *(const float*)((const char*)ACUM + (unsigned)((rbase + 127u) * 16u + h0 + sh) * 4u); } }
        BAR_LDS();
        const LAS float* AC = ACb + hw * 192; const LAS bf16* XT = XTb + hw * 64 * PS;
        f32x4 yo[4];
        { bf16x8_t hb[4];
#pragma unroll
          for (int m = 0; m < 4; ++m) { v4u o; o.x = pk2(hacc[2 * m][0], hacc[2 * m][1]); o.y = pk2(hacc[2 * m][2], hacc[2 * m][3]); o.z = pk2(hacc[2 * m + 1][0], hacc[2 * m + 1][1]); o.w = pk2(hacc[2 * m + 1][2], hacc[2 * m + 1][3]);
              hb[m] = __builtin_bit_cast(bf16x8_t, o); }
#pragma unroll
          for (int li = 0; li < 4; ++li) { yo[li] = (f32x4){0.f, 0.f, 0.f, 0.f};
#pragma unroll
              for (int m = 0; m < 4; ++m) { const LAS bf16* cp = Cm + (16 * li + fr) * PC + 32 * m + 4 * fq; const v2u c0 = *(const LAS v2u*)cp, c1 = *(const LAS v2u*)(cp + 16);
                  v4u xo; xo.x = c0.x; xo.y = c0.y; xo.z = c1.x; xo.w = c1.y; yo[li] = MFMA16(__builtin_bit_cast(bf16x8_t, xo), hb[m], yo[li]); } } }
        { const LAS float* WU = AC + 64; const float dec = __expf(AC[63]);
          bf16x8_t xs[2];
#pragma unroll
          for (int ss = 0; ss < 2; ++ss) { const v4u d = *(const LAS v4u*)(XT + (16 * pt + fr) * PS + ((32 * ss + 8 * fq) ^ (((2 * pt + (fr >> 3)) & 7) << 3)));
              const f32x4 wa = *(const LAS f32x4*)(WU + 32 * ss + 8 * fq), wb = *(const LAS f32x4*)(WU + 32 * ss + 8 * fq + 4);
              v4u o; o.x = pk2(bflo(d.x) * wa.x, bfhi(d.x) * wa.y); o.y = pk2(bflo(d.y) * wa.z, bfhi(d.y) * wa.w); o.z = pk2(bflo(d.z) * wb.x, bfhi(d.z) * wb.y); o.w = pk2(bflo(d.w) * wb.z, bfhi(d.w) * wb.w);
              xs[ss] = __builtin_bit_cast(bf16x8_t, o); }
#pragma unroll
          for (int j = 0; j < 8; ++j) { hacc[j] = hacc[j] * dec;
#pragma unroll
              for (int ss = 0; ss < 2; ++ss) hacc[j] = MFMA16(LDFRAG(BmT, 16 * j + fr, PS, (32 * ss + 8 * fq) ^ (((2 * j + (fr >> 3)) & 7) << 3)), xs[ss], hacc[j]); } }
        {
            const int li = wave >> 1, si0 = 2 * (wave & 1);
#pragma unroll
            for (int tt = 0; tt < 2; ++tt) { const int si = si0 + tt; f32x4 acc = (f32x4){0.f, 0.f, 0.f, 0.f};
                if (si <= li) {
#pragma unroll
                    for (int ks = 0; ks < 4; ++ks) acc = MFMA16(LDFRAG(Cm, 16 * li + fr, PC, 32 * ks + 8 * fq), LDFRAG(Bm, 16 * si + fr, PC, 32 * ks + 8 * fq), acc); }
                const int s = 16 * si + fr;
#pragma unroll
                for (int hh = 0; hh < 2; ++hh) { const LAS float* A2 = ACb + hh * 192; LAS bf16* Mm = Mm0 + hh * 64 * PS; const float acs = A2[s], dts = A2[128 + s];
#pragma unroll
                    for (int r = 0; r < 4; ++r) { const int l = 16 * li + 4 * fq + r; const float m = (s <= l) ? acc[r] * __expf(A2[l] - acs) * dts : 0.f; Mm[l * PS + s] = (bf16)f2bf(m); } } }
        }
        bf16 zr[4][4];
#pragma unroll
        for (int li = 0; li < 4; ++li)
#pragma unroll
            for (int r = 0; r < 4; ++r) zr[li][r] = *(const bf16*)((const char*)P + (unsigned)((rbase + 16 * li + 4 * fq + r) * (unsigned)NPAD + OFF_BZ + (h0 + hw) * 64 + 16 * pt + fr) * 2u);
        BAR_LDS();
        {
            const LAS bf16* Mm = Mm0 + hw * 64 * PS; const int h = h0 + hw; const float Dh = hw ? Dh1 : Dh0; const int p = 16 * pt + fr;
            bf16x8_t xf[2];
#pragma unroll
            for (int ss = 0; ss < 2; ++ss) xf[ss] = LDFRAG(XT, 16 * pt + fr, PS, (32 * ss + 8 * fq) ^ (((2 * pt + (fr >> 3)) & 7) << 3));
#pragma unroll
            for (int li = 0; li < 4; ++li) { f32x4 yd = (f32x4){0.f, 0.f, 0.f, 0.f};
#pragma unroll
                for (int ss = 0; ss < 2; ++ss) { if (ss == 1 && li < 2) continue;
                    yd = MFMA16(LDFRAG(Mm, 16 * li + fr, PS, 32 * ss + 8 * fq), xf[ss], yd); }
#pragma unroll
                for (int r = 0; r < 4; ++r) { const int l = 16 * li + 4 * fq + r; const float y = yd[r] + __expf(AC[l]) * yo[li][r] + Dh * bf1(XT[p * PS + (l ^ (((p >> 3) & 7) << 3))]);
                    const float z = bf1(zr[li][r]);
                    *(bf16*)((char*)YB + (unsigned)((rbase + l) * 1024u + h * 64 + p) * 2u) = (bf16)f2bf(y * siluf_(z)); } }
        }
    }
#pragma unroll
    for (int j = 0; j < 8; ++j) *(f32x4*)(sout0 + (size_t)hw * 8192 + (16 * pt + fr) * 128 + 16 * j + 4 * fq) = hacc[j];
    __syncthreads();
}

__device__ __forceinline__ unsigned cm_off_b(unsigned row, unsigned ch) { return 256u * row + 16u * (ch ^ (((row & 3u) << 2) | ((row >> 2) & 3u))); }
__device__ __forceinline__ unsigned cm_tr_addr(unsigned lane, unsigned c, unsigned ks, unsigned t) { const unsigned g = lane >> 4, q = (lane & 15) >> 2, p = lane & 3; return cm_off_b(32 * ks + 8 * g + 4 * t + q, 2 * c + (p >> 1)) + 8 * (p & 1); }
__device__ __forceinline__ void cmlp_mfma_item(LAS unsigned char* lds, int tid, int lane, int wave, bf16* P, bf16* YC, int row0, const float* ln_g, const float* ln_b, const float* wsl, const float* bsl) {
    constexpr int PW = 136;
    LAS bf16* Wb = (LAS bf16*)lds;
    LAS unsigned char* Vimg = lds + 34816;
    LAS bf16* OUTb = (LAS bf16*)(lds + 67584);
    LAS float* ST = (LAS float*)(lds + ST_OFF);
    const int fr = lane & 15, fq = lane >> 4;
    __syncthreads();
    for (int i = 0; i < 16; ++i) { const int s = wave * 16 + i;
        v4u* p = (v4u*)(P + (size_t)(row0 + s) * NPAD + OFF_CV + 16 * lane); const v4u a = p[0], b = p[1];
        float v[16]; v[0] = bflo(a.x); v[1] = bfhi(a.x); v[2] = bflo(a.y); v[3] = bfhi(a.y); v[4] = bflo(a.z); v[5] = bfhi(a.z); v[6] = bflo(a.w); v[7] = bfhi(a.w);
        v[8] = bflo(b.x); v[9] = bfhi(b.x); v[10] = bflo(b.y); v[11] = bfhi(b.y); v[12] = bflo(b.z); v[13] = bfhi(b.z); v[14] = bflo(b.w); v[15] = bfhi(b.w);
        float sm = 0.f;
#pragma unroll
        for (int j = 0; j < 16; ++j) { v[j] = geluf_(v[j]); sm += v[j]; }
        v4u oa, ob; oa.x = pk2(v[0], v[1]); oa.y = pk2(v[2], v[3]); oa.z = pk2(v[4], v[5]); oa.w = pk2(v[6], v[7]); ob.x = pk2(v[8], v[9]); ob.y = pk2(v[10], v[11]); ob.z = pk2(v[12], v[13]); ob.w = pk2(v[14], v[15]);
        p[0] = oa; p[1] = ob;
        const float mean = wave_sum(sm) * (1.0f / 1024.0f); float sq = 0.f;
#pragma unroll
        for (int j = 0; j < 16; ++j) { const float d = v[j] - mean; sq += d * d; }
        const float rstd = rsqrtf_(wave_sum(sq) * (1.0f / 1024.0f) + NORM_EPS);
        if (lane == 0) { ST[2 * s] = mean; ST[2 * s + 1] = rstd; } }
    __syncthreads();
    f32x4 wreg[8]; v2u vreg[8];
#pragma unroll
    for (int e = 0; e < 8; ++e) { const int q = tid + 512 * e; wreg[e] = *(const f32x4*)(wsl + (size_t)(q >> 5) * 128 + 4 * (q & 31)); vreg[e] = *(const v2u*)(P + (size_t)(row0 + (q >> 5)) * NPAD + OFF_CV + 4 * (q & 31)); }
    for (int gh = 0; gh < 8; ++gh) { const int g = gh >> 1, c0 = gh * 128;
        if ((gh & 1) == 0) {
#pragma unroll
            for (int e = 0; e < 8; ++e) { const int q = tid + 512 * e, t = q >> 5, s4 = 4 * (q & 31); const f32x4 w = wreg[e];
                v2u o; o.x = pk2(s4 + 0 <= t ? w.x : 0.f, s4 + 1 <= t ? w.y : 0.f); o.y = pk2(s4 + 2 <= t ? w.z : 0.f, s4 + 3 <= t ? w.w : 0.f); *(LAS v2u*)(Wb + t * PW + s4) = o; } }
#pragma unroll
        for (int e = 0; e < 8; ++e) { const int q = tid + 512 * e, sr = q >> 5, c4 = 4 * (q & 31); const v2u cv = vreg[e]; const float mean = ST[2 * sr], rstd = ST[2 * sr + 1];
            const f32x4 lg = *(const f32x4*)(ln_g + c0 + c4), lb = *(const f32x4*)(ln_b + c0 + c4);
            v2u o; o.x = pk2((bflo(cv.x) - mean) * rstd * lg.x + lb.x, (bfhi(cv.x) - mean) * rstd * lg.y + lb.y); o.y = pk2((bflo(cv.y) - mean) * rstd * lg.z + lb.z, (bfhi(cv.y) - mean) * rstd * lg.w + lb.w);
            *(LAS v2u*)(Vimg + cm_off_b((unsigned)sr, (unsigned)(c4 >> 3)) + 2 * (c4 & 7)) = o; }
        v4u ureg[4];
#pragma unroll
        for (int e = 0; e < 4; ++e) { const int q = tid + 512 * e; ureg[e] = *(const v4u*)(P + (size_t)(row0 + (q >> 4)) * NPAD + OFF_CU + c0 + 8 * (q & 15)); }
        if (gh + 1 < 8) {
#pragma unroll
            for (int e = 0; e < 8; ++e) { const int q = tid + 512 * e; vreg[e] = *(const v2u*)(P + (size_t)(row0 + (q >> 5)) * NPAD + OFF_CV + c0 + 128 + 4 * (q & 31)); }
            if (gh & 1) {
#pragma unroll
                for (int e = 0; e < 8; ++e) { const int q = tid + 512 * e; wreg[e] = *(const f32x4*)(wsl + ((size_t)(g + 1) * 128 + (q >> 5)) * 128 + 4 * (q & 31)); } } }
        BAR_LDS();
        { f32x4 acc[8];
#pragma unroll
            for (int ti = 0; ti < 8; ++ti) acc[ti] = (f32x4){0.f, 0.f, 0.f, 0.f};
            const unsigned vb = (unsigned)(size_t)Vimg;
#pragma unroll
            for (int ks = 0; ks < 4; ++ks) { v2u y0, y1;
                asm volatile("ds_read_b64_tr_b16 %0, %2\n\tds_read_b64_tr_b16 %1, %3\n\ts_waitcnt lgkmcnt(0)" : "=&v"(y0), "=&v"(y1) : "v"(vb + cm_tr_addr((unsigned)lane, (unsigned)wave, (unsigned)ks, 0u)), "v"(vb + cm_tr_addr((unsigned)lane, (unsigned)wave, (unsigned)ks, 1u)) : "memory");
                v4u yy; yy.x = y0.x; yy.y = y0.y; yy.z = y1.x; yy.w = y1.y; const bf16x8_t yf = __builtin_bit_cast(bf16x8_t, yy);
#pragma unroll
                for (int ti = 2 * ks; ti < 8; ++ti) acc[ti] = MFMA16(LDFRAG(Wb, 16 * ti + fr, PW, 32 * ks + 8 * fq), yf, acc[ti]); }
#pragma unroll
            for (int ti = 0; ti < 8; ++ti)
#pragma unroll
                for (int r = 0; r < 4; ++r) OUTb[(16 * ti + 4 * fq + r) * PW + 16 * wave + fr] = (bf16)f2bf(acc[ti][r]); }
        BAR_LDS();
#pragma unroll
        for (int e = 0; e < 4; ++e) { const int q = tid + 512 * e, t = q >> 4, c8 = 8 * (q & 15); const v4u o = *(const LAS v4u*)(OUTb + t * PW + c8); const v4u u = ureg[e]; const float bsv = bsl[g * 128 + t];
            v4u y; y.x = pk2(geluf_(bflo(u.x)) * (bflo(o.x) + bsv), geluf_(bfhi(u.x)) * (bfhi(o.x) + bsv)); y.y = pk2(geluf_(bflo(u.y)) * (bflo(o.y) + bsv), geluf_(bfhi(u.y)) * (bfhi(o.y) + bsv));
            y.z = pk2(geluf_(bflo(u.z)) * (bflo(o.z) + bsv), geluf_(bfhi(u.z)) * (bfhi(o.z) + bsv)); y.w = pk2(geluf_(bflo(u.w)) * (bflo(o.w) + bsv), geluf_(bfhi(u.w)) * (bfhi(o.w) + bsv));
            *(v4u*)(YC + (size_t)(row0 + t) * 1024 + c0 + c8) = y; }
    }
    __syncthreads();
}

__device__ __forceinline__ void cmlp_item(LAS unsigned char* lds, int tid, int lane, int wave, const bf16* P, bf16* YC, int row0, int Lc,
                                          const float* ln_g, const float* ln_b, const float* wsl, const float* bsl, float* vout) {
    LAS float* WT = (LAS float*)lds;
    LAS float* V = WT + 16384;
    LAS float* ST = (LAS float*)(lds + ST_OFF);
    __syncthreads();
    for (int i = 0; i < 16; ++i) { const int s = wave * 16 + i; if (s < Lc) {
            const v4u* p = (const v4u*)(P + (size_t)(row0 + s) * NPAD + OFF_CV + 16 * lane); const v4u a = p[0], b = p[1];
            float v[16]; v[0] = bflo(a.x); v[1] = bfhi(a.x); v[2] = bflo(a.y); v[3] = bfhi(a.y); v[4] = bflo(a.z); v[5] = bfhi(a.z); v[6] = bflo(a.w); v[7] = bfhi(a.w);
            v[8] = bflo(b.x); v[9] = bfhi(b.x); v[10] = bflo(b.y); v[11] = bfhi(b.y); v[12] = bflo(b.z); v[13] = bfhi(b.z); v[14] = bflo(b.w); v[15] = bfhi(b.w);
            float sm = 0.f;
#pragma unroll
            for (int j = 0; j < 16; ++j) { v[j] = geluf_(v[j]); sm += v[j]; }
            const float mean = wave_sum(sm) * (1.0f / 1024.0f); float sq = 0.f;
#pragma unroll
            for (int j = 0; j < 16; ++j) { const float d = v[j] - mean; sq += d * d; }
            const float rstd = 1.0f / sqrtf(wave_sum(sq) * (1.0f / 1024.0f) + NORM_EPS);
            if (lane == 0) { ST[2 * s] = mean; ST[2 * s + 1] = rstd; } } }
    const int tg = tid >> 4, cg = tid & 15;
    for (int g = 0; g < 4; ++g) {
        __syncthreads();
#pragma unroll 1
        for (int j = 0; j < 8; ++j) { const int e = tid + 512 * j, s4 = (e >> 7) * 4, t = e & 127;
            f32x4 w = (f32x4){0.f, 0.f, 0.f, 0.f}; if (t < Lc && s4 < Lc) w = *(const f32x4*)(wsl + ((size_t)g * 128 + t) * 128 + s4);
#pragma unroll
            for (int jj = 0; jj < 4; ++jj) WT[(s4 + jj) * 128 + t] = (s4 + jj <= t) ? w[jj] : 0.f; }
        for (int half = 0; half < 2; ++half) { const int c0 = g * 256 + half * 128;
            if (half) __syncthreads();
#pragma unroll 2
            for (int j = 0; j < 8; ++j) { const int e = tid + 512 * j, s = e >> 5, c4 = (e & 31) * 4;
                if (s < Lc) { const v2u cv = *(const v2u*)(P + (size_t)(row0 + s) * NPAD + OFF_CV + c0 + c4); const float mean = ST[2 * s], rstd = ST[2 * s + 1];
                    const f32x4 lg = *(const f32x4*)(ln_g + c0 + c4), lb = *(const f32x4*)(ln_b + c0 + c4);
                    f32x4 v; v.x = (geluf_(bflo(cv.x)) - mean) * rstd * lg.x + lb.x; v.y = (geluf_(bfhi(cv.x)) - mean) * rstd * lg.y + lb.y; v.z = (geluf_(bflo(cv.y)) - mean) * rstd * lg.z + lb.z; v.w = (geluf_(bfhi(cv.y)) - mean) * rstd * lg.w + lb.w;
                    *(LAS f32x4*)(V + s * 128 + c4) = v; if (vout) *(f32x4*)(vout + (size_t)s * 1024 + c0 + c4) = v; } }
            __syncthreads();
            float acc[4][8];
#pragma unroll
            for (int i = 0; i < 4; ++i)
#pragma unroll
                for (int j = 0; j < 8; ++j) acc[i][j] = 0.f;
            for (int s = 0; s < Lc; ++s) { const f32x4 w4 = *(const LAS f32x4*)(WT + s * 128 + 4 * tg), va = *(const LAS f32x4*)(V + s * 128 + 4 * cg), vb = *(const LAS f32x4*)(V + s * 128 + 64 + 4 * cg);
#pragma unroll
                for (int i = 0; i < 4; ++i) {
#pragma unroll
                    for (int j = 0; j < 4; ++j) { acc[i][j] = fmaf(w4[i], va[j], acc[i][j]); acc[i][4 + j] = fmaf(w4[i], vb[j], acc[i][4 + j]); } } }
#pragma unroll
            for (int i = 0; i < 4; ++i) { const int t = 4 * tg + i; if (t < Lc) { const size_t row = (size_t)(row0 + t); const float bsv = bsl[g * 128 + t];
                    const v2u ua = *(const v2u*)(P + row * NPAD + OFF_CU + c0 + 4 * cg), ub = *(const v2u*)(P + row * NPAD + OFF_CU + c0 + 64 + 4 * cg);
                    v2u oa, ob; oa.x = pk2(geluf_(bflo(ua.x)) * (acc[i][0] + bsv), geluf_(bfhi(ua.x)) * (acc[i][1] + bsv)); oa.y = pk2(geluf_(bflo(ua.y)) * (acc[i][2] + bsv), geluf_(bfhi(ua.y)) * (acc[i][3] + bsv));
                    ob.x = pk2(geluf_(bflo(ub.x)) * (acc[i][4] + bsv), geluf_(bfhi(ub.x)) * (acc[i][5] + bsv)); ob.y = pk2(geluf_(bflo(ub.y)) * (acc[i][6] + bsv), geluf_(bfhi(ub.y)) * (acc[i][7] + bsv));
                    *(v2u*)(YC + row * 1024 + c0 + 4 * cg) = oa; *(v2u*)(YC + row * 1024 + c0 + 64 + 4 * cg) = ob; } }
        }
    }
    __syncthreads();
}

#ifndef DOWN_REV
#define DOWN_REV 1
#endif
#ifndef EPI_ALIGN_HEAVY
#define EPI_ALIGN_HEAVY true
#endif
#ifndef TAIL_SPLIT
#define TAIL_SPLIT 1
#endif
#ifndef MK_N_LAUNCHES
#define MK_N_LAUNCHES 1
#endif
constexpr int PH_PER_LAYER = 10, N_PHASES = 2 + DEPTH * PH_PER_LAYER;
constexpr int Q_NITEMS = 128 + 128 + 256 + 256 + 512 + 32;
struct Args { const float* in[29]; float* out; unsigned char* ws; int ph_lo, ph_hi; };
static_assert(sizeof(Args) == 29 * 8 + 8 + 8 + 8, "no padding in Args");

typedef const __attribute__((address_space(4))) unsigned long long* karg_t;
__device__ __forceinline__ unsigned long long ldarg(int i) { karg_t p = (karg_t)__builtin_amdgcn_kernarg_segment_ptr(); asm volatile("" : "+s"(p)); return p[i]; }
#define INP(i) ((const float*)ldarg(i))
#define OUTP() ((float*)ldarg(29))
#define WSP() ((unsigned char*)ldarg(30))

__device__ __forceinline__ int tid_now(int wave_s) { return (int)__builtin_amdgcn_mbcnt_hi(~0u, __builtin_amdgcn_mbcnt_lo(~0u, 0u)) + 64 * wave_s; }
__global__ void __launch_bounds__(NWAVES * 64, 2) fwd(Args args) {
    extern __shared__ __attribute__((aligned(16))) unsigned char lds_raw[];
    LAS unsigned char* lds = (LAS unsigned char*)lds_raw;
    volatile LAS unsigned* MISC = (volatile LAS unsigned*)(lds + MISC_OFF);
    const int wave_s = __builtin_amdgcn_readfirstlane((int)threadIdx.x >> 6);
    for (int u = threadIdx.x; u < 64; u += NWAVES * 64) MISC[u] = 0u;
    __syncthreads();
    XcdBarrier bar = xcd_barrier_post((unsigned*)WSP() + CW_BAR, MISC + 8, (int)threadIdx.x);
    const int lo = args.ph_lo, hi = args.ph_hi;
#define IN(k) (lo <= (k) && (k) < hi)
#define SEAM(k) do { if (IN((k) + 1)) { XcdBarrier b2_ = bar; b2_.bar = (unsigned*)WSP() + CW_BAR; asm volatile("" : "+s"(b2_.x)); xcd_barrier(b2_, tid_now(wave_s)); } } while (0)
#define GEOM() int tid = tid_now(wave_s); asm volatile("" : "+v"(tid)); int G = gridDim.x, bx = blockIdx.x; asm volatile("" : "+s"(G), "+s"(bx)); \
    const int lane = tid & 63, wave = __builtin_amdgcn_readfirstlane(tid >> 6); \
    const int vcu = (G % 8 == 0) ? (bx % 8) * (G / 8) + bx / 8 : bx; const int gw = vcu * NWAVES + wave, NGW = G * NWAVES; (void)lane; (void)gw; (void)NGW; (void)wave; (void)tid

    if (IN(0)) { GEOM();
        for (int it = bx; it < DEPTH * 96; it += G) mod_item(lds, tid, it, INP(5), INP(6), INP(9), INP(10), (float*)(WSP() + WS_MOD));
        { unsigned char* ws = WSP(); cvt_phase<true>(lds, wave, lane, 0, 0, 0, INP(11), INP(24), INP(25), INP(26), INP(27), ws + wofs(0), (unsigned*)ws + CW_QC); }
        SEAM(0);
    }
    for (int lc = 0; lc < DEPTH; ++lc) {
        const int pb = 1 + PH_PER_LAYER * lc;
        if (IN(pb + 0)) { GEOM(); int l = lc; asm volatile("" : "+s"(l)); unsigned char* ws = WSP(); bf16* X = (bf16*)(ws + WS_X);
            const bool comb = TAIL_SPLIT && l > 0; if (comb) build_tail_map((LAS int*)lds, tid, G, DOWN_REV);
            const float* modl = (const float*)(ws + WS_MOD) + (size_t)l * NSEQ * 12288;
            if (l == 0) norm_mod_phase<true>(lane, gw, NGW, INP(0), INP(1), X, INP(7), modl, 0, 1, (bf16*)(ws + WS_H), false, (const LAS int*)lds, (const float*)(ws + WS_SLAB), false);
            else norm_mod_phase<false>(lane, gw, NGW, nullptr, nullptr, X, INP(7) + l * DM, modl, 0, 1, (bf16*)(ws + WS_H), comb, (const LAS int*)lds, (const float*)(ws + WS_SLAB), false);
            SEAM(pb + 0);
        }
        if (IN(pb + 1)) { unsigned char* ws = WSP(); const int G = gridDim.x, bx = blockIdx.x;
            pg8::Gemm g{(const bf16*)(ws + WS_H), (const bf16*)(ws + wofs(lc) + WS_WIN), MT, NPAD, DM, DM}; pg8::StaticOrder S; S.init(MT, NPAD, G, bx);
            pg8::EpiStore<0> E{(bf16*)(ws + WS_P), NPAD};
#ifndef REP_P1
#define REP_P1 1
#endif
#pragma unroll 1
            for (int rp = 0; rp < REP_P1; ++rp)
#ifndef WIN_B_AUX
#define WIN_B_AUX 0
#endif
#ifdef SPLIT_WIN
            { S.nlim = (S.nwg / (2 * G)) * G; pg8::gemm_phase<pg8::EpiStore<0>, pg8::StaticOrder, true, true, 0, WIN_B_AUX>(lds, g, S, E, tid_now(wave_s));
              { XcdBarrier b2_ = bar; b2_.bar = (unsigned*)WSP() + CW_BAR; asm volatile("" : "+s"(b2_.x)); xcd_barrier(b2_, tid_now(wave_s)); }
              S.off = S.nlim; S.nlim = S.nwg; }
#endif
            pg8::gemm_phase<pg8::EpiStore<0>, pg8::StaticOrder, true, true, 0, WIN_B_AUX>(lds, g, S, E, tid_now(wave_s));
            SEAM(pb + 1);
        }
        if (IN(pb + 2)) { GEOM(); int l = lc; asm volatile("" : "+s"(l)); unsigned char* ws = WSP(); float* out = OUTP();
#ifndef REP_P2
#define REP_P2 1
#endif
#pragma unroll 1
            for (int rp = 0; rp < REP_P2; ++rp)
            ssd_pre_phase(lane, gw, NGW, (const bf16*)(ws + WS_P), (bf16*)(ws + WS_XC), (float*)(ws + WS_DT), (float*)(ws + WS_DT + DT_ARR), (float*)(ws + WS_DT + 2 * DT_ARR),
                          INP(14) + (size_t)l * 4 * 1536, INP(15) + l * 1536, INP(16) + l * 16, INP(17) + l * 16, INP(4) + (size_t)l * 32 * 4608, out + OUT_CONV_P + (size_t)l * 16 * 4608, out + OUT_CONV_S + (size_t)l * 32 * 4608);
            SEAM(pb + 2);
        }
        if (IN(pb + 3)) { GEOM(); int l = lc; asm volatile("" : "+s"(l));
#ifndef MIX_REPS
#define MIX_REPS 1
#endif
#pragma unroll 1
            for (int rep = 0; rep < MIX_REPS; ++rep)
            for (;;) {
                unsigned char* ws = WSP(); float* out = OUTP(); bf16* Pb = (bf16*)(ws + WS_P); bf16* Y3 = (bf16*)(ws + WS_Y3);
                __syncthreads();
                if (tid_now(wave_s) == 0) MISC[0] = __hip_atomic_fetch_add((unsigned*)ws + CW_Q + 64 * (l + 4 * rep), 1u, __ATOMIC_RELAXED, __HIP_MEMORY_SCOPE_AGENT);
                __syncthreads();
                int it = (int)MISC[0];
#ifdef EXTRA_BASE
                if (it >= Q_NITEMS && it < Q_NITEMS + EXTRA_N) it = EXTRA_BASE + (it - Q_NITEMS);
#endif
                if (it >= Q_NITEMS) break;
#define ITEM_GEOM() int tid_i = tid_now(wave_s); asm volatile("" : "+v"(tid_i)); const int lane_i = tid_i & 63, wave_i = __builtin_amdgcn_readfirstlane(tid_i >> 6)
                if (it < 128) {
                    const int b = 15 - (it >> 3), h = it & 7;
                    ITEM_GEOM(); hgrn_mfma_item(lds, tid_i, lane_i, wave_i, Pb, Y3, b * 2048, h, l, out + OUT_HGRN_P + (((size_t)l * 16 + b) * 8 + h) * 16384, INP(12), INP(13) + l * 1024);
                } else if (it < 256) {
                    const int j = it - 128, b = 15 - (j >> 3), h0 = 2 * (j & 7);
                    ITEM_GEOM(); ssd_mfma_pair(lds, tid_i, lane_i, wave_i, Pb, (const bf16*)(ws + WS_XC), (const float*)(ws + WS_DT), (const float*)(ws + WS_DT + 2 * DT_ARR), Y3 + (size_t)MT * 1024, b * 2048, h0, INP(18)[l * 16 + h0], INP(18)[l * 16 + h0 + 1],
                                  out + OUT_SSM_P + (((size_t)l * 16 + b) * 16 + h0) * 8192);
                } else if (it < 512) {
                    ITEM_GEOM(); cmlp_mfma_item(lds, tid_i, lane_i, wave_i, Pb, Y3 + (size_t)2 * MT * 1024, (255 - (it - 256)) * 128, INP(20) + l * 1024, INP(21) + l * 1024, INP(22) + (size_t)l * 4 * 16384, INP(23) + l * 512);
                } else if (it < 768) {
                    const int j = it - 512, b = j >> 3, h = j & 7;
                    ITEM_GEOM(); hgrn_item(lds, tid_i, lane_i, wave_i, Pb, Y3, NTOK_P + b * 32, 32, h, l, INP(2) + (((size_t)l * 32 + b) * 8 + h) * 16384, out + OUT_HGRN_S + (((size_t)l * 32 + b) * 8 + h) * 16384, INP(12), INP(13) + l * 1024);
                } else if (it < 1280) {
                    const int j = it - 768, b = j >> 4, h = j & 15;
                    ITEM_GEOM(); ssd_item(lds, tid_i, lane_i, wave_i, Pb, (const bf16*)(ws + WS_XC), (const float*)(ws + WS_DT), (const float*)(ws + WS_DT + DT_ARR), Y3 + (size_t)MT * 1024, NTOK_P + b * 32, 32, h,
                             INP(3) + (((size_t)l * 32 + b) * 16 + h) * 8192, out + OUT_SSM_S + (((size_t)l * 32 + b) * 16 + h) * 8192, INP(18)[l * 16 + h]);
                } else {
                    const int j = it - 1280;
                    ITEM_GEOM(); cmlp_item(lds, tid_i, lane_i, wave_i, Pb, Y3 + (size_t)2 * MT * 1024, NTOK_P + j * 32, 32, INP(20) + l * 1024, INP(21) + l * 1024, INP(22) + (size_t)l * 4 * 16384, INP(23) + l * 512, out + OUT_V_S + ((size_t)l * 32 + j) * 32 * 1024);
                }
            }
            SEAM(pb + 3);
        }
        if (IN(pb + 4)) { GEOM(); int l = lc; asm volatile("" : "+s"(l)); ssd_norm_phase(lane, gw, NGW, (bf16*)(WSP() + WS_Y3) + (size_t)MT * 1024, INP(19) + l * 1024); SEAM(pb + 4); }
        if (IN(pb + 5)) { unsigned char* ws = WSP(); const int G = gridDim.x, bx = blockIdx.x;
            pg8::Gemm g{(const bf16*)(ws + WS_Y3), (const bf16*)(ws + wofs(lc) + WS_WBR), 3 * MT, 3 * DM, 1024, 1024}; pg8::BranchOrder S; S.init(MT / 256, DM / 256, G, bx);
            pg8::EpiBranch E{(const bf16*)(ws + WS_P), NPAD, OFF_GATE, (bf16*)(ws + WS_H), DM, MT / 256, DM / 256};
#ifndef STAGGER_BR
#define STAGGER_BR 0
#endif
            if (STAGGER_BR && ((bx >> 3) & 1)) { for (int i = 0; i < STAGGER_BR; ++i) __builtin_amdgcn_s_sleep(127); }
#ifndef REP_P5
#define REP_P5 1
#endif
#pragma unroll 1
            for (int rp = 0; rp < REP_P5; ++rp)
            pg8::gemm_phase<pg8::EpiBranch, pg8::BranchOrder, EPI_ALIGN_HEAVY, true>(lds, g, S, E, tid_now(wave_s));
            if (lc + 1 < DEPTH) {
                GEOM(); int l1 = lc + 1; asm volatile("" : "+s"(l1)); unsigned char* ws2 = WSP();
                cvt_phase<true>(lds, wave, lane, 0, 0, l1, INP(11), INP(24), INP(25), INP(26), INP(27), ws2 + wofs(l1), (unsigned*)ws2 + CW_QC + 64 * l1);
#ifdef REP_CVT
                cvt_phase<true>(lds, wave, lane, 0, 0, l1, INP(11), INP(24), INP(25), INP(26), INP(27), ws2 + wofs(l1), (unsigned*)ws2 + CW_QC + 64 * (l1 + 4));
#endif
            }
            SEAM(pb + 5);
        }
        if (IN(pb + 6)) { int l = lc; asm volatile("" : "+s"(l)); unsigned char* ws = WSP(); bf16* X = (bf16*)(ws + WS_X); const int G = gridDim.x, bx = blockIdx.x;
            pg8::StaticOrder S; S.init(MT, DM, G, bx); S.wgm = WGM_N8; const int nfull = TAIL_SPLIT ? tail_nfull(S.nwg, G) : S.nwg; S.nlim = nfull;
            const float* gm = (const float*)(ws + WS_MOD) + (size_t)l * NSEQ * 12288 + 2 * DM;
            { pg8::Gemm g{(const bf16*)(ws + WS_H), (const bf16*)(ws + wofs(lc) + WS_WOUT), MT, DM, DM, DM};
#ifdef REP_P6
              { pg8::EpiRes E0{X, (const float*)(ws + 524288), 0}; pg8::gemm_phase<pg8::EpiRes, pg8::StaticOrder, EPI_ALIGN_HEAVY, true>(lds, g, S, E0, tid_now(wave_s)); }
#endif
              pg8::EpiRes E{X, gm, 12288};
              pg8::gemm_phase<pg8::EpiRes, pg8::StaticOrder, EPI_ALIGN_HEAVY, true>(lds, g, S, E, tid_now(wave_s)); }
            if (TAIL_SPLIT) { pg8::Gemm g{(const bf16*)(ws + WS_H), (const bf16*)(ws + wofs(lc) + WS_WOUT), MT, DM, DM / 8, DM}; pg8::TailOrder T; T.init(S, nfull, 8, DM / 8);
              pg8::EpiSlab E{(float*)(ws + WS_SLAB), gm};
              pg8::gemm_phase<pg8::EpiSlab, pg8::TailOrder, true, true>(lds, g, T, E, tid_now(wave_s)); }
            SEAM(pb + 6);
        }
        if (IN(pb + 7)) { GEOM(); int l = lc; asm volatile("" : "+s"(l)); unsigned char* ws = WSP(); bf16* X = (bf16*)(ws + WS_X);
            if (TAIL_SPLIT) build_tail_map((LAS int*)lds, tid, G, 0);
#ifdef REP_N7
            norm_mod_phase<false>(lane, gw, NGW, nullptr, nullptr, X, INP(8) + l * DM, (const float*)(ws + WS_MOD) + (size_t)l * NSEQ * 12288, 3, 4, (bf16*)(ws + WS_H), false, (const LAS int*)lds, (const float*)(ws + WS_SLAB), true);
#endif
            norm_mod_phase<false>(lane, gw, NGW, nullptr, nullptr, X, INP(8) + l * DM, (const float*)(ws + WS_MOD) + (size_t)l * NSEQ * 12288, 3, 4, (bf16*)(ws + WS_H), TAIL_SPLIT != 0, (const LAS int*)lds, (const float*)(ws + WS_SLAB), true); SEAM(pb + 7); }
        if (IN(pb + 8)) { unsigned char* ws = WSP(); const int G = gridDim.x, bx = blockIdx.x;
            pg8::Gemm g{(const bf16*)(ws + WS_H), (const bf16*)(ws + wofs(lc) + WS_WUP), MT, DFF, DM, DM}; pg8::StaticOrder S; S.init(MT, DFF, G, bx);
            pg8::EpiStore<1> E{(bf16*)(ws + WS_P), DFF};
#ifndef REP_P8
#define REP_P8 1
#endif
#pragma unroll 1
            for (int rp = 0; rp < REP_P8; ++rp)
            pg8::gemm_phase<pg8::EpiStore<1>, pg8::StaticOrder, true, true, 0, WIN_B_AUX>(lds, g, S, E, tid_now(wave_s));
            SEAM(pb + 8);
        }
        if (IN(pb + 9)) { int l = lc; asm volatile("" : "+s"(l)); unsigned char* ws = WSP(); bf16* X = (bf16*)(ws + WS_X); const int G = gridDim.x, bx = blockIdx.x;
            pg8::StaticOrder S; S.init(MT, DM, G, bx); S.wgm = WGM_N8; S.rev = DOWN_REV; const int nfull = TAIL_SPLIT ? tail_nfull(S.nwg, G) : S.nwg; S.nlim = nfull;
            const float* gm = (const float*)(ws + WS_MOD) + (size_t)l * NSEQ * 12288 + 5 * DM;
            { pg8::Gemm g{(const bf16*)(ws + WS_P), (const bf16*)(ws + wofs(lc) + WS_WDN), MT, DM, DFF, DFF};
#ifdef REP_P9
              { pg8::EpiRes E0{X, (const float*)(ws + 524288), 0}; pg8::gemm_phase<pg8::EpiRes, pg8::StaticOrder, EPI_ALIGN_HEAVY, true>(lds, g, S, E0, tid_now(wave_s)); }
#endif
              pg8::EpiRes E{X, gm, 12288};
#ifndef DOWN_A_AUX
#define DOWN_A_AUX 0
#endif
              pg8::gemm_phase<pg8::EpiRes, pg8::StaticOrder, EPI_ALIGN_HEAVY, true, DOWN_A_AUX>(lds, g, S, E, tid_now(wave_s)); }
            if (TAIL_SPLIT) { pg8::Gemm g{(const bf16*)(ws + WS_P), (const bf16*)(ws + wofs(lc) + WS_WDN), MT, DM, DFF / 8, DFF}; pg8::TailOrder T; T.init(S, nfull, 8, DFF / 8);
              pg8::EpiSlab E{(float*)(ws + WS_SLAB), gm};
              pg8::gemm_phase<pg8::EpiSlab, pg8::TailOrder, true, true>(lds, g, T, E, tid_now(wave_s)); }
            SEAM(pb + 9);
        }
    }
    if (IN(N_PHASES - 1)) { GEOM(); unsigned char* ws = WSP(); if (TAIL_SPLIT) build_tail_map((LAS int*)lds, tid, G, DOWN_REV);
        final_norm_phase(lane, gw, NGW, (const bf16*)(ws + WS_X), OUTP(), INP(28), TAIL_SPLIT != 0, (const LAS int*)lds, (const float*)(ws + WS_SLAB)); }
#undef IN
#undef SEAM
#undef GEOM
}

extern "C" void kernel_launch(void* const* d_in, const int* in_sizes, int n_in, void* d_out, int out_size, void* d_ws, size_t ws_size, hipStream_t stream) {
    static int grid = 0;
    if (grid == 0) {
        if (n_in != 29 || (size_t)out_size != OUT_TOTAL || ws_size < WS_END) { fprintf(stderr, "kernel_launch: unexpected shapes: n_in %d out %d ws %zu (need %zu)\n", n_in, out_size, ws_size, (size_t)WS_END); grid = -1; return; }
        int dev = 0, cus = 0, per_cu = 0;
        if (hipGetDevice(&dev) != hipSuccess || hipDeviceGetAttribute(&cus, hipDeviceAttributeMultiprocessorCount, dev) != hipSuccess) { grid = -1; return; }
        if (hipFuncSetAttribute((const void*)fwd, hipFuncAttributeMaxDynamicSharedMemorySize, LDS_BYTES) != hipSuccess) { fprintf(stderr, "kernel_launch: hipFuncSetAttribute failed\n"); grid = -1; return; }
        if (hipOccupancyMaxActiveBlocksPerMultiprocessor(&per_cu, (const void*)fwd, NWAVES * 64, LDS_BYTES) != hipSuccess || per_cu < 1) fprintf(stderr, "kernel_launch: occupancy query says %d\n", per_cu);
        (void)hipGetLastError();
        grid = cus;
    }
    if (grid < 0) return;
    if (hipMemsetAsync((char*)d_ws + WS_CTL, 0, CTL_ZERO_BYTES, stream) != hipSuccess) return;
    Args a{};
    for (int i = 0; i < 29; ++i) a.in[i] = (const float*)d_in[i];
    a.out = (float*)d_out; a.ws = (unsigned char*)d_ws;
#if MK_N_LAUNCHES == 1
    a.ph_lo = 0; a.ph_hi = N_PHASES;
    hipLaunchKernelGGL(fwd, dim3(grid), dim3(NWAVES * 64), LDS_BYTES, stream, a);
#else
    for (int p = 0; p < N_PHASES; ++p) { a.ph_lo = p; a.ph_hi = p + 1; hipLaunchKernelGGL(fwd, dim3(grid), dim3(NWAVES * 64), LDS_BYTES, stream, a); }
#endif
}
```

```cpp
#include <hip/hip_runtime.h>
#include <cstdio>
#include <cstdint>
namespace pg8 {
#define PG8_LAS __attribute__((address_space(3)))
typedef unsigned short bf16_t;
typedef short bf16x8 __attribute__((ext_vector_type(8)));
typedef float f32x4 __attribute__((ext_vector_type(4)));
typedef unsigned u32x4 __attribute__((ext_vector_type(4)));
constexpr int BM = 256, BK = 64, HALF = 128, HTB = HALF * BK * 2  , STAGE_BYTES = 8 * HTB, NXCD = 8, WGM = 4;

__host__ __device__ __forceinline__ int lds_byte(int r, int c) { const int st = (r >> 4) * 2 + (c >> 5), rr = r & 15, cc = c & 31, ob = rr * 64 + cc * 2; return st * 1024 + (ob ^ (((ob >> 9) & 1) << 5)); }
__host__ __device__ __forceinline__ void stage_rc(int b, int& R, int& C) { const int st = b / 1024, sb = b % 1024, swz = sb ^ (((sb >> 9) & 1) << 5); R = (st >> 1) * 16 + swz / 64; C = (st & 1) * 32 + (swz % 64) / 2; }
__host__ __device__ __forceinline__ int perm32(int rho) { const int n = rho >> 4, i = rho & 15; return 8 * (i >> 2) + 4 * n + (i & 3); }

struct Unit { int pm, pn, ko, aux; };
struct Gemm { const bf16_t* A; const bf16_t* Bt; int M, N, K, ld; };

struct StaticOrder {
    int nM, nN, nwg, G, c, nlim, rev, wgm, off;
    __host__ __device__ void init(int M, int N, int G_, int c_) { nM = M / BM; nN = N / BM; nwg = nM * nN; G = G_; c = c_; nlim = nwg; rev = 0; wgm = WGM; off = 0; }
    __host__ __device__ void tile_of(int wgid, Unit& u) const {
        { const int q = nwg / NXCD, r = nwg % NXCD, xcd = wgid % NXCD, off = wgid / NXCD; wgid = (xcd < r ? xcd * (q + 1) : r * (q + 1) + (xcd - r) * q) + off; }
        const int nig = wgm * nN, gid = wgid / nig, fm = gid * wgm, gsz = (nM - fm) < wgm ? (nM - fm) : wgm;
        u.pm = fm + ((wgid % nig) % gsz); u.pn = (wgid % nig) / gsz; u.ko = 0; u.aux = 0; if (rev) u.pm = nM - 1 - u.pm; }
    __host__ __device__ bool next(int i, Unit& u) const {
        const long L = (long)i * G + c + off; if (L >= nlim) return false;
        tile_of((int)L, u); return true;
    }
    __device__ __forceinline__ void a_ready(const Unit&) const {}
    __device__ __forceinline__ void done(const Unit&) const {}
};
typedef float pg8_f32x2 __attribute__((ext_vector_type(2))); typedef __bf16 pg8_bf16x2 __attribute__((ext_vector_type(2)));
__device__ __forceinline__ unsigned cvt_pk_bf16(float lo, float hi) { const pg8_f32x2 v = {lo, hi}; const pg8_bf16x2 b = __builtin_convertvector(v, pg8_bf16x2); return __builtin_bit_cast(unsigned, b); }
typedef unsigned u32x2 __attribute__((ext_vector_type(2)));
__device__ __forceinline__ float bf_lo(unsigned w) { return __uint_as_float(w << 16); }
__device__ __forceinline__ float bf_hi(unsigned w) { return __uint_as_float(w & 0xffff0000u); }
__device__ __forceinline__ float fast_sigmoid(float x) { return __builtin_amdgcn_rcpf(1.0f + __builtin_amdgcn_exp2f(-1.44269504089f * x)); }

#ifndef EPI_NT_STORE
#define EPI_NT_STORE 0
#endif
template <int ACT> struct EpiStore {
    static constexpr bool PERM = true, AFTER_DRAIN = false;
    bf16_t* O; int ldc;
    __device__ __forceinline__ void operator()(const f32x4 (&acc)[2][2][4][2], const Unit& u, int wr, int wc, int fr, int fq) const {
        const int row0 = u.pm * BM + wr * 64 + fr, col0 = u.pn * BM + wc * 32 + 8 * fq;
#pragma unroll
        for (int ai = 0; ai < 2; ++ai)
#pragma unroll
            for (int m = 0; m < 4; ++m) { bf16_t* rowp = O + (size_t)(row0 + ai * HALF + m * 16) * ldc + col0;
#pragma unroll
                for (int bj = 0; bj < 2; ++bj) { f32x4 v0 = acc[ai][bj][m][0], v1 = acc[ai][bj][m][1];
                    if (ACT == 1) {
#pragma unroll
                        for (int j = 0; j < 4; ++j) { const float a = fmaxf(v0[j], 0.f), b = fmaxf(v1[j], 0.f); v0[j] = a * a; v1[j] = b * b; } }
                    u32x4 w; w.x = cvt_pk_bf16(v0[0], v0[1]); w.y = cvt_pk_bf16(v0[2], v0[3]); w.z = cvt_pk_bf16(v1[0], v1[1]); w.w = cvt_pk_bf16(v1[2], v1[3]);
                    if (EPI_NT_STORE) __builtin_nontemporal_store(w, (u32x4*)(rowp + bj * HALF)); else *(u32x4*)(rowp + bj * HALF) = w; } }
    }
};

struct EpiBranch {
    static constexpr bool PERM = true, AFTER_DRAIN = false;
    const bf16_t* P; int ldp; int gate_off; bf16_t* MG; int ldm; int npm, npn;
    __device__ __forceinline__ void operator()(const f32x4 (&acc)[2][2][4][2], const Unit& u, int wr, int wc, int fr, int fq) const {
        const int k = u.pm / npm, pm = u.pm - k * npm, pn = u.pn - k * npn;
        const int row0 = pm * BM + wr * 64 + fr, col0 = pn * BM + wc * 32 + 8 * fq;
#pragma unroll
        for (int ai = 0; ai < 2; ++ai)
#pragma unroll
            for (int m = 0; m < 4; ++m) { const size_t r = (size_t)(row0 + ai * HALF + m * 16);
                const bf16_t* gp = P + r * ldp + gate_off + k * 2048 + col0; bf16_t* mp = MG + r * ldm + col0;
#pragma unroll
                for (int bj = 0; bj < 2; ++bj) { const u32x4 g = *(const u32x4*)(gp + bj * HALF);
                    f32x4 v0 = acc[ai][bj][m][0], v1 = acc[ai][bj][m][1];
                    v0[0] *= fast_sigmoid(bf_lo(g.x)); v0[1] *= fast_sigmoid(bf_hi(g.x)); v0[2] *= fast_sigmoid(bf_lo(g.y)); v0[3] *= fast_sigmoid(bf_hi(g.y));
                    v1[0] *= fast_sigmoid(bf_lo(g.z)); v1[1] *= fast_sigmoid(bf_hi(g.z)); v1[2] *= fast_sigmoid(bf_lo(g.w)); v1[3] *= fast_sigmoid(bf_hi(g.w));
                    if (k > 0) { const u32x4 p = *(const u32x4*)(mp + bj * HALF);
                        v0[0] += bf_lo(p.x); v0[1] += bf_hi(p.x); v0[2] += bf_lo(p.y); v0[3] += bf_hi(p.y);
                        v1[0] += bf_lo(p.z); v1[1] += bf_hi(p.z); v1[2] += bf_lo(p.w); v1[3] += bf_hi(p.w); }
                    u32x4 w; w.x = cvt_pk_bf16(v0[0], v0[1]); w.y = cvt_pk_bf16(v0[2], v0[3]); w.z = cvt_pk_bf16(v1[0], v1[1]); w.w = cvt_pk_bf16(v1[2], v1[3]);
                    *(u32x4*)(mp + bj * HALF) = w; }
                if (m == 3) asm volatile("" ::: "memory"); }
    }
};

struct EpiRes {
    static constexpr bool PERM = true, AFTER_DRAIN = false;
    bf16_t* X; const float* gmod; int gstride;
    __device__ __forceinline__ void operator()(const f32x4 (&acc)[2][2][4][2], const Unit& u, int wr, int wc, int fr, int fq) const {
        const int row0 = u.pm * BM + wr * 64 + fr, col0 = u.pn * BM + wc * 32 + 8 * fq;
#pragma unroll
        for (int ai = 0; ai < 2; ++ai)
#pragma unroll
            for (int m = 0; m < 4; ++m) { const int r = row0 + ai * HALF + m * 16;
                const int seq = r < 32768 ? (r >> 11) : 16 + ((r - 32768) >> 5);
                const float* gp = gmod + (size_t)seq * gstride + col0; bf16_t* xp = X + (size_t)r * 2048 + col0;
#pragma unroll
                for (int bj = 0; bj < 2; ++bj) { const f32x4 g0 = *(const f32x4*)(gp + bj * HALF), g1 = *(const f32x4*)(gp + bj * HALF + 4); const u32x4 b = *(const u32x4*)(xp + bj * HALF);
                    const f32x4 v0 = acc[ai][bj][m][0] * g0, v1 = acc[ai][bj][m][1] * g1;
                    u32x4 w; w.x = cvt_pk_bf16(bf_lo(b.x) + v0[0], bf_hi(b.x) + v0[1]); w.y = cvt_pk_bf16(bf_lo(b.y) + v0[2], bf_hi(b.y) + v0[3]);
                    w.z = cvt_pk_bf16(bf_lo(b.z) + v1[0], bf_hi(b.z) + v1[1]); w.w = cvt_pk_bf16(bf_lo(b.w) + v1[2], bf_hi(b.w) + v1[3]);
                    *(u32x4*)(xp + bj * HALF) = w; }
                if (m == 3) asm volatile("" ::: "memory"); }
    }
};

struct BranchOrder {
    int G, c, npm, npn, ntile;
    __device__ void init(int npm_, int npn_, int G_, int c_) { npm = npm_; npn = npn_; ntile = npm_ * npn_; G = G_; c = c_; }
    __device__ bool next(int i, Unit& u) const {
        const int ti = i / 3, k = i - 3 * ti; const long L = (long)ti * G + c; if (L >= ntile) return false;
        int wgid = (int)L; { const int q = ntile / NXCD, r = ntile % NXCD, xcd = wgid % NXCD, off = wgid / NXCD; wgid = (xcd < r ? xcd * (q + 1) : r * (q + 1) + (xcd - r) * q) + off; }
        const int nig = WGM * npn, gid = wgid / nig, fm = gid * WGM, gsz = (npm - fm) < WGM ? (npm - fm) : WGM;
        u.pm = k * npm + fm + ((wgid % nig) % gsz); u.pn = k * npn + (wgid % nig) / gsz; u.ko = 0; u.aux = 0; return true;
    }
    __device__ __forceinline__ void a_ready(const Unit&) const {}
    __device__ __forceinline__ void done(const Unit&) const {}
};


struct EpiResAtomic {
    static constexpr bool PERM = false, AFTER_DRAIN = false;
    float* out; const float* gmod;
    __device__ __forceinline__ void operator()(const f32x4 (&acc)[2][2][4][2], const Unit& u, int wr, int wc, int fr, int fq) const {
        const int row0 = u.pm * BM + wr * 64 + fr, col0 = u.pn * BM + wc * 32 + 4 * fq;
#pragma unroll
        for (int ai = 0; ai < 2; ++ai)
#pragma unroll
            for (int m = 0; m < 4; ++m) { const int r = row0 + ai * HALF + m * 16;
                const int seq = r < 32768 ? (r >> 11) : 16 + ((r - 32768) >> 5);
                const float* gp = gmod + (size_t)seq * 12288 + col0; float* op = out + (size_t)r * 2048 + col0;
#pragma unroll
                for (int bj = 0; bj < 2; ++bj)
#pragma unroll
                    for (int n = 0; n < 2; ++n) { const f32x4 g = *(const f32x4*)(gp + bj * HALF + n * 16); const f32x4 v = g * acc[ai][bj][m][n]; float* o = op + bj * HALF + n * 16;
                        typedef __attribute__((address_space(1))) float gfloat; gfloat* og = (gfloat*)o;
                        (void)__builtin_amdgcn_global_atomic_fadd_f32(og + 0, v.x); (void)__builtin_amdgcn_global_atomic_fadd_f32(og + 1, v.y); (void)__builtin_amdgcn_global_atomic_fadd_f32(og + 2, v.z); (void)__builtin_amdgcn_global_atomic_fadd_f32(og + 3, v.w); } }
    }
};
struct TailOrder {
    StaticOrder base; int nfull, SL, Ks;
    __device__ void init(const StaticOrder& b, int nfull_, int SL_, int Ks_) { base = b; nfull = nfull_; SL = SL_; Ks = Ks_; }
    __device__ bool next(int i, Unit& u) const { const long L = (long)i * base.G + base.c; if (L >= (long)(base.nwg - nfull) * SL) return false;
        const int t = (int)L / SL, sl = (int)L - t * SL; base.tile_of(nfull + t, u); u.ko = sl * Ks; u.aux = (int)L; return true; }
    __device__ __forceinline__ void a_ready(const Unit&) const {}
    __device__ __forceinline__ void done(const Unit&) const {}
};

struct EpiSlab {
    static constexpr bool PERM = false, AFTER_DRAIN = false;
    float* slab; const float* gmod;
    __device__ __forceinline__ void operator()(const f32x4 (&acc)[2][2][4][2], const Unit& u, int wr, int wc, int fr, int fq) const {
        const int rt0 = wr * 64 + fr, ct0 = wc * 32 + 4 * fq; float* sb = slab + (size_t)u.aux * 65536;
#pragma unroll
        for (int ai = 0; ai < 2; ++ai)
#pragma unroll
            for (int m = 0; m < 4; ++m) { const int rt = rt0 + ai * HALF + m * 16, r = u.pm * BM + rt;
                const int seq = r < 32768 ? (r >> 11) : 16 + ((r - 32768) >> 5);
                const float* gp = gmod + (size_t)seq * 12288 + u.pn * BM + ct0; float* op = sb + rt * 256 + ct0;
#pragma unroll
                for (int bj = 0; bj < 2; ++bj)
#pragma unroll
                    for (int n = 0; n < 2; ++n) { const f32x4 g = *(const f32x4*)(gp + bj * HALF + n * 16); *(f32x4*)(op + bj * HALF + n * 16) = g * acc[ai][bj][m][n]; } }
    }
};
template <class Epi, class Sched, bool ALIGN_EPI = false, bool SP2 = false, int A_AUX = 0, int B_AUX = 0>
__device__ __forceinline__ void gemm_phase(PG8_LAS unsigned char* lds, const Gemm g, const Sched& S, const Epi& E, int tid_in) {
    int tid_ = tid_in; asm volatile("" : "+v"(tid_));
    const int tid = tid_, wid = __builtin_amdgcn_readfirstlane(tid >> 6), lane = tid & 63, wr = wid >> 2, wc = wid & 3, fr = lane & 15, fq = lane >> 4;
    const int K = g.K, ld = g.ld, nt = K / BK;
    unsigned voffA[2], voffB[2];
#pragma unroll
    for (int i = 0; i < 2; ++i) { int R, C; stage_rc(tid * 16 + i * 8192, R, C); const int Rb = Epi::PERM ? ((R & ~31) + perm32(R & 31)) : R;
        voffA[i] = (unsigned)(R * ld + C) * 2u; voffB[i] = (unsigned)(Rb * ld + C) * 2u; }
    const size_t kstep = (size_t)(BK * 2);
    const size_t hstep = (size_t)HALF * ld * 2;
    const size_t tstep = 2 * hstep;
    const unsigned ldsw = (unsigned)wid * 1024u;
    const int aoff = lds_byte(wr * 64 + fr, fq * 8), boff = lds_byte(wc * 32 + fr, fq * 8);
#define PG8_SA(b, h) (((b) * 2 + (h)) * HTB)
#define PG8_SB(b, h) ((4 + (b) * 2 + (h)) * HTB)
#define PG8_STAGE(bufoff, gbase, voff) do { _Pragma("unroll") for (int _i = 0; _i < 2; ++_i) \
        __builtin_amdgcn_global_load_lds((const unsigned*)((const char*)(gbase) + (voff)[_i]), (PG8_LAS unsigned*)(lds + (bufoff) + ldsw + _i * 8192), 16, 0, B_AUX); } while (0)
#define PG8_STAGEA(bufoff, gbase, voff) do { _Pragma("unroll") for (int _i = 0; _i < 2; ++_i) \
        __builtin_amdgcn_global_load_lds((const unsigned*)((const char*)(gbase) + (voff)[_i]), (PG8_LAS unsigned*)(lds + (bufoff) + ldsw + _i * 8192), 16, 0, A_AUX); } while (0)
#define PG8_LDA(dst, b, h) do { _Pragma("unroll") for (int m = 0; m < 4; ++m) _Pragma("unroll") for (int k = 0; k < 2; ++k) dst[m][k] = *(const PG8_LAS bf16x8*)(lds + PG8_SA(b, h) + aoff + m * 2048 + k * 1024); } while (0)
#define PG8_LDB(dst, b, h) do { _Pragma("unroll") for (int n = 0; n < 2; ++n) _Pragma("unroll") for (int k = 0; k < 2; ++k) dst[n][k] = *(const PG8_LAS bf16x8*)(lds + PG8_SB(b, h) + boff + n * 2048 + k * 1024); } while (0)
#define PG8_MMA(ai, bj, At, Bt) do { __builtin_amdgcn_s_setprio(1); _Pragma("unroll") for (int m = 0; m < 4; ++m) _Pragma("unroll") for (int n = 0; n < 2; ++n) _Pragma("unroll") for (int k = 0; k < 2; ++k) \
        acc[ai][bj][m][n] = __builtin_amdgcn_mfma_f32_16x16x32_bf16(Bt[n][k], At[m][k], acc[ai][bj][m][n], 0, 0, 0); __builtin_amdgcn_s_setprio(0); } while (0)
#define PG8_WAIT_V(n) asm volatile("s_waitcnt vmcnt(" #n ")" ::: "memory")
#define PG8_WAIT_L(n) asm volatile("s_waitcnt lgkmcnt(" #n ")" ::: "memory")
#define PG8_BAR __builtin_amdgcn_s_barrier()
#define PG8_SCHED __builtin_amdgcn_sched_barrier(0)
    Unit cur, nxt; int ui = 0;
    if (!S.next(0, cur)) return;
    f32x4 acc[2][2][4][2];
#pragma unroll
    for (int a = 0; a < 2; ++a)
#pragma unroll
        for (int b = 0; b < 2; ++b)
#pragma unroll
            for (int m = 0; m < 4; ++m)
#pragma unroll
                for (int n = 0; n < 2; ++n) acc[a][b][m][n] = (f32x4){0.f, 0.f, 0.f, 0.f};
    bf16x8 At[4][2], B0[2][2], B1[2][2];
    const char* cA = (const char*)g.A + (size_t)cur.pm * tstep + (size_t)cur.ko * 2; const char* cB = (const char*)g.Bt + (size_t)cur.pn * tstep + (size_t)cur.ko * 2;
    S.a_ready(cur);
    if constexpr (SP2) {
        PG8_STAGE(PG8_SB(0, 0), cB, voffB); PG8_STAGE(PG8_SB(0, 1), cB + hstep, voffB); PG8_STAGEA(PG8_SA(0, 0), cA, voffA); PG8_STAGEA(PG8_SA(0, 1), cA + hstep, voffA);
        if (wr == 1) PG8_BAR;
        PG8_WAIT_V(2); PG8_BAR;
        PG8_STAGE(PG8_SB(1, 0), cB + kstep, voffB); PG8_STAGEA(PG8_SA(1, 0), cA + kstep, voffA); PG8_STAGE(PG8_SB(1, 1), cB + hstep + kstep, voffB);
        PG8_WAIT_V(6); PG8_BAR;
    } else {
        PG8_STAGE(PG8_SB(0, 0), cB, voffB); PG8_STAGEA(PG8_SA(0, 0), cA, voffA); PG8_STAGE(PG8_SB(0, 1), cB + hstep, voffB); PG8_STAGEA(PG8_SA(0, 1), cA + hstep, voffA);
        if (wr == 1) PG8_BAR;
        PG8_WAIT_V(4); PG8_BAR;
        PG8_STAGE(PG8_SB(1, 0), cB + kstep, voffB); PG8_STAGEA(PG8_SA(1, 0), cA + kstep, voffA); PG8_STAGE(PG8_SB(1, 1), cB + hstep + kstep, voffB);
        PG8_WAIT_V(6); PG8_BAR;
    }
    for (;;) {
        const bool has_next = S.next(ui + 1, nxt);
        const char* nA = has_next ? (const char*)g.A + (size_t)nxt.pm * tstep + (size_t)nxt.ko * 2 : cA; const char* nB = has_next ? (const char*)g.Bt + (size_t)nxt.pn * tstep + (size_t)nxt.ko * 2 : cB;
        for (int t = 0; t < nt; t += 2) {
            const bool last = (t == nt - 2);
            const char* a1 = cA + (size_t)(t + 1) * kstep;
            const char* a2 = last ? nA : cA + (size_t)(t + 2) * kstep; const char* b2 = last ? nB : cB + (size_t)(t + 2) * kstep;
            const char* a3 = a2 + kstep; const char* b3 = b2 + kstep;
            if (last && has_next) S.a_ready(nxt);
            if constexpr (SP2) {
            PG8_LDB(B0, 0, 0); PG8_LDB(B1, 0, 1); PG8_SCHED; PG8_LDA(At, 0, 0); PG8_STAGEA(PG8_SA(1, 1), a1 + hstep, voffA);
            PG8_WAIT_V(8); PG8_WAIT_L(0); PG8_BAR; PG8_MMA(0, 0, At, B0); PG8_MMA(0, 1, At, B1); PG8_BAR; PG8_SCHED;
            PG8_LDA(At, 0, 1); PG8_STAGE(PG8_SB(0, 0), b2, voffB); PG8_STAGE(PG8_SB(0, 1), b2 + hstep, voffB); PG8_STAGEA(PG8_SA(0, 0), a2, voffA);
            PG8_WAIT_V(8); PG8_WAIT_L(0); PG8_BAR; PG8_MMA(1, 0, At, B0); PG8_MMA(1, 1, At, B1); PG8_BAR; PG8_SCHED;
            PG8_LDB(B0, 1, 0); PG8_LDB(B1, 1, 1); PG8_SCHED; PG8_LDA(At, 1, 0); PG8_STAGEA(PG8_SA(0, 1), a2 + hstep, voffA);
            PG8_WAIT_V(8); PG8_WAIT_L(0); PG8_BAR; PG8_MMA(0, 0, At, B0); PG8_MMA(0, 1, At, B1); PG8_BAR; PG8_SCHED;
            PG8_LDA(At, 1, 1); PG8_STAGE(PG8_SB(1, 0), b3, voffB); PG8_STAGE(PG8_SB(1, 1), b3 + hstep, voffB); PG8_STAGEA(PG8_SA(1, 0), a3, voffA);
            PG8_WAIT_V(8); PG8_WAIT_L(0); PG8_BAR; PG8_MMA(1, 0, At, B0); PG8_MMA(1, 1, At, B1); PG8_BAR; PG8_SCHED;
            } else {
            PG8_LDB(B0, 0, 0); PG8_SCHED; PG8_LDA(At, 0, 0); PG8_STAGEA(PG8_SA(1, 1), a1 + hstep, voffA);
            PG8_WAIT_L(8); PG8_BAR; PG8_WAIT_L(0); PG8_MMA(0, 0, At, B0); PG8_BAR; PG8_SCHED;
            PG8_LDB(B1, 0, 1); PG8_STAGE(PG8_SB(0, 0), b2, voffB);
            PG8_BAR; PG8_WAIT_L(0); PG8_MMA(0, 1, At, B1); PG8_BAR;
            PG8_LDA(At, 0, 1); PG8_STAGEA(PG8_SA(0, 0), a2, voffA);
            PG8_BAR; PG8_WAIT_L(0); PG8_MMA(1, 0, At, B0); PG8_BAR; PG8_SCHED;
            PG8_STAGE(PG8_SB(0, 1), b2 + hstep, voffB);
            PG8_WAIT_V(6); PG8_BAR; PG8_MMA(1, 1, At, B1); PG8_BAR;
            PG8_LDB(B0, 1, 0); PG8_SCHED; PG8_LDA(At, 1, 0); PG8_STAGEA(PG8_SA(0, 1), a2 + hstep, voffA);
            PG8_WAIT_L(8); PG8_BAR; PG8_WAIT_L(0); PG8_MMA(0, 0, At, B0); PG8_BAR; PG8_SCHED;
            PG8_LDB(B1, 1, 1); PG8_STAGE(PG8_SB(1, 0), b3, voffB);
            PG8_BAR; PG8_WAIT_L(0); PG8_MMA(0, 1, At, B1); PG8_BAR;
            PG8_LDA(At, 1, 1); PG8_STAGEA(PG8_SA(1, 0), a3, voffA);
            PG8_BAR; PG8_WAIT_L(0); PG8_MMA(1, 0, At, B0); PG8_BAR; PG8_SCHED;
            PG8_STAGE(PG8_SB(1, 1), b3 + hstep, voffB);
            PG8_WAIT_V(6); PG8_BAR; PG8_MMA(1, 1, At, B1); PG8_BAR;
            }
        }
        if constexpr (ALIGN_EPI) { if (wr == 0) PG8_BAR; }
        if constexpr (!Epi::AFTER_DRAIN) { E(acc, cur, wr, wc, fr, fq); S.done(cur); }
        if (!has_next) break;
#pragma unroll
        for (int a = 0; a < 2; ++a)
#pragma unroll
            for (int b = 0; b < 2; ++b)
#pragma unroll
                for (int m = 0; m < 4; ++m)
#pragma unroll
                    for (int n = 0; n < 2; ++n) acc[a][b][m][n] = (f32x4){0.f, 0.f, 0.f, 0.f};
        cur = nxt; cA = nA; cB = nB; ++ui;
        if constexpr (ALIGN_EPI) { if (wr == 1) PG8_BAR; }
    }
    PG8_WAIT_V(0);
    if constexpr (!ALIGN_EPI) { if (wr == 0) PG8_BAR; }
    PG8_BAR;
    if constexpr (Epi::AFTER_DRAIN) { E.fused(acc, cur, wr, wc, fr, fq, lds, wid, lane); S.done(cur); }
#undef PG8_SA
#undef PG8_SB
#undef PG8_STAGE
#undef PG8_STAGEA
#undef PG8_LDA
#undef PG8_LDB
#undef PG8_MMA
#undef PG8_WAIT_V
#undef PG8_WAIT_L
#undef PG8_BAR
#undef PG8_SCHED
}
}

constexpr int NWAVES = 8;
constexpr int DM = 2048, NTOK_P = 32768, NTOK_S = 1024, MT = NTOK_P + NTOK_S  , NSEQ = 48, DEPTH = 4, DFF = 8192;
constexpr int IN_TOTAL = 14864, NPAD = 15104;
constexpr int OFF_AQ = 0, OFF_AF = 1024, OFF_AI = 2048, OFF_AG = 3072, OFF_BZ = 4096, OFF_XBC = 5120, OFF_CU = 6656, OFF_CV = 7680, OFF_GATE = 8704, OFF_DT = 14848;
constexpr float NORM_EPS = 1e-6f;
constexpr size_t OUT_X = 0, OUT_HGRN_P = 69206016, OUT_SSM_P = 77594624, OUT_CONV_P = 85983232, OUT_HGRN_S = 86278144, OUT_SSM_S = 103055360, OUT_CONV_S = 119832576, OUT_V_S = 120422400, OUT_TOTAL = 124616704;
constexpr size_t MiB = 1u << 20;
constexpr size_t WS_CTL = 0, CTL_ZERO_BYTES = 1 * MiB;
constexpr size_t WS_MOD = 1 * MiB;
constexpr size_t WS_WIN = 16 * MiB;
constexpr size_t WS_WBR = 76 * MiB;
constexpr size_t WS_WOUT = 88 * MiB;
constexpr size_t WS_WUP = 96 * MiB;
constexpr size_t WS_WDN = 128 * MiB;
constexpr size_t WS_H = 160 * MiB;
constexpr size_t WS_Y3 = 292 * MiB;
constexpr size_t WS_P = 490 * MiB;
constexpr size_t WS_XC = 1464 * MiB;
constexpr size_t WS_DT = 1564 * MiB;
constexpr size_t DT_ARR = (size_t)MT * 16 * 4;
constexpr size_t WS_WSET2 = 1576 * MiB;
constexpr size_t WSET_BYTES = WS_H - WS_WIN;
constexpr size_t WS_SLAB = WS_Y3;
constexpr size_t WS_X = WS_WSET2 + WSET_BYTES;
constexpr size_t WS_END = WS_X + (size_t)MT * DM * 2;
static_assert((size_t)32 * 8 * 65536 * 4 <= (size_t)3 * MT * 1024 * 2, "slabs fit the y_a|y_b|y_c region");
static_assert(WS_DT + 3 * DT_ARR <= WS_WSET2, "d_ws map 3");
__host__ __device__ constexpr size_t wofs(int l) { return (l & 1) ? (WS_WSET2 - WS_WIN) : 0; }
static_assert(WS_P + (size_t)MT * NPAD * 2 <= WS_XC && WS_XC + (size_t)MT * 1536 * 2 <= WS_DT, "d_ws map 2");
static_assert(WS_MOD + (size_t)DEPTH * NSEQ * 12288 * 4 <= WS_WIN && WS_WIN + (size_t)NPAD * DM * 2 <= WS_WBR && WS_H + (size_t)MT * DM * 2 <= WS_Y3 && WS_Y3 + (size_t)3 * MT * 1024 * 2 <= WS_P, "d_ws map");
constexpr int CW_BAR = 4096;
constexpr int CW_Q = 8192;
constexpr int CW_QC = 12288;
constexpr int RING_BYTES = 131072, ST_OFF = RING_BYTES  , MISC_OFF = RING_BYTES + 1024, LDS_BYTES = 147456;

#define GAS __attribute__((address_space(1)))
#define LAS __attribute__((address_space(3)))
typedef unsigned short bf16;
typedef unsigned v4u __attribute__((ext_vector_type(4)));
typedef unsigned v2u __attribute__((ext_vector_type(2)));
typedef float f32x4 __attribute__((ext_vector_type(4)));
typedef float f32x2 __attribute__((ext_vector_type(2)));
#define LDS_WAIT() asm volatile("s_waitcnt lgkmcnt(0)" ::: "memory")
#define VM_WAIT() asm volatile("s_waitcnt vmcnt(0)" ::: "memory")
typedef float cv_f32x2 __attribute__((ext_vector_type(2))); typedef __bf16 cv_bf16x2 __attribute__((ext_vector_type(2)));
__device__ __forceinline__ unsigned pk2(float lo, float hi) { const cv_f32x2 v = {lo, hi}; const cv_bf16x2 b = __builtin_convertvector(v, cv_bf16x2); return __builtin_bit_cast(unsigned, b); }
__device__ __forceinline__ unsigned f2bf(float f) { const __bf16 b = (__bf16)f; return (unsigned)__builtin_bit_cast(unsigned short, b); }
__device__ __forceinline__ float bflo(unsigned w) { return __uint_as_float(w << 16); }
__device__ __forceinline__ float bfhi(unsigned w) { return __uint_as_float(w & 0xffff0000u); }
__device__ __forceinline__ float bf1(bf16 v) { return __uint_as_float(((unsigned)v) << 16); }
__device__ __forceinline__ float sigmoidf_(float x) { return __builtin_amdgcn_rcpf(1.0f + __expf(-x)); }
__device__ __forceinline__ float siluf_(float x) { return x * __builtin_amdgcn_rcpf(1.0f + __expf(-x)); }
__device__ __forceinline__ float rsqrtf_(float x) { return __builtin_amdgcn_rsqf(x); }
__device__ __forceinline__ float geluf_(float v) {
    const float av = fabsf(v), t = __builtin_amdgcn_rcpf(1.0f + 0.2316418882f * av);
    float q = t * 0.5307027145f + (-0.7265760135f); q = q * t + 0.7107068705f; q = q * t + (-0.142248368f); q = q * t + 0.127414796f; q = q * t;
    const float e = __expf(-0.5f * v * v), m = v * (q * e);
    return v < 0.f ? m : v - m;
}
__device__ __forceinline__ float wave_sum(float v) {
#pragma unroll
    for (int o = 1; o < 64; o <<= 1) v += __shfl_xor(v, o);
    return v;
}
__device__ __forceinline__ float half_sum(float v) {
#pragma unroll
    for (int o = 1; o < 32; o <<= 1) v += __shfl_xor(v, o);
    return v;
}

#define XB_TMO      128
#define XB_XCNT(j)  (256  + 64 * (j))
#define XB_XSUB(j)  (1280 + 64 * (j))
#define XB_XGEN(j)  (2304 + 64 * (j))
#define XB_TOP      3328
#define XB_TOPGEN   3392
#define XCD_BAR_WORDS 3456
#define XB_SPIN_CAP (1u << 18)

__device__ __forceinline__ unsigned xb_ld(unsigned* p)              { return __hip_atomic_load(p, __ATOMIC_RELAXED, __HIP_MEMORY_SCOPE_AGENT); }
__device__ __forceinline__ unsigned xb_add(unsigned* p, unsigned v) { return __hip_atomic_fetch_add(p, v, __ATOMIC_RELAXED, __HIP_MEMORY_SCOPE_AGENT); }
__device__ __forceinline__ unsigned xb_xcc_id() { return (unsigned)__builtin_amdgcn_s_getreg((3 << 11) | 20) & 0xFu; }
#define XB_SPIN(cond, bar) do { unsigned _sp = 0; while (cond) { __builtin_amdgcn_s_sleep(1); \
    if ((++_sp & 255u) == 0u) { if (xb_ld(&(bar)[XB_TMO])) break; if (_sp > XB_SPIN_CAP) { atomicAdd(&(bar)[XB_TMO], 1u); break; } } } } while (0)

struct XcdBarrier {
    unsigned* bar; unsigned x;
    volatile LAS unsigned* st;
};

__device__ __forceinline__ XcdBarrier xcd_barrier_post(unsigned* bar, volatile LAS unsigned* st, int tid) {
    XcdBarrier b; b.bar = bar; b.x = xb_xcc_id(); b.st = st;
    if (tid == 0) (void)xb_add(&bar[XB_XCNT(b.x)], 1u);
    return b;
}
__device__ __forceinline__ void xcd_barrier_complete(unsigned* bar, unsigned x, unsigned& nloc, unsigned& nx) {
    const unsigned G = gridDim.x * gridDim.y * gridDim.z;
    unsigned sum, cnt, mine, sp = 0u;
    for (;;) {
        sum = 0u; cnt = 0u; mine = 0u;
#pragma unroll
        for (unsigned j = 0; j < 16; ++j) { const unsigned c = xb_ld(&bar[XB_XCNT(j)]); sum += c; cnt += (c > 0u) ? 1u : 0u; mine = (j == x) ? c : mine; }
        if (sum == G) break;
        __builtin_amdgcn_s_sleep(1);
        if ((++sp & 255u) == 0u) { if (xb_ld(&bar[XB_TMO])) break; if (sp > XB_SPIN_CAP) { atomicAdd(&bar[XB_TMO], 1u); break; } }
    }
    nloc = mine > 0u ? mine : 1u; nx = cnt > 0u ? cnt : 1u;
}

__device__ __forceinline__ void xcd_barrier(const XcdBarrier& b, int tid) {
    asm volatile("s_waitcnt vmcnt(0)" ::: "memory");
    __syncthreads();
    if (tid == 0) {
        unsigned* bar = b.bar;
        __builtin_amdgcn_s_waitcnt(0);
        unsigned nloc = b.st[0], nx = b.st[1];
        if (nloc == 0u) { xcd_barrier_complete(bar, b.x, nloc, nx); b.st[0] = nloc; b.st[1] = nx; }
        const unsigned old = xb_add(&bar[XB_XSUB(b.x)], 1u);
        const unsigned gen = old / nloc;
        if (old + 1u == (gen + 1u) * nloc) {
            __builtin_amdgcn_fence(__ATOMIC_RELEASE, "agent");
            asm volatile("s_waitcnt vmcnt(0)" ::: "memory");
            const unsigned og = xb_add(&bar[XB_TOP], 1u);
            const unsigned tg = og / nx;
            if (og + 1u == (tg + 1u) * nx) xb_add(&bar[XB_TOPGEN], 1u);
            else XB_SPIN(xb_ld(&bar[XB_TOPGEN]) == tg, bar);
            __builtin_amdgcn_fence(__ATOMIC_ACQUIRE, "agent");
            xb_add(&bar[XB_XGEN(b.x)], 1u);
            asm volatile("s_waitcnt vmcnt(0)" ::: "memory");
        } else {
            XB_SPIN(xb_ld(&bar[XB_XGEN(b.x)]) == gen, bar);
            __builtin_amdgcn_fence(__ATOMIC_ACQUIRE, "agent");
            asm volatile("s_waitcnt vmcnt(0)" ::: "memory");
        }
    }
    __syncthreads();
}


__device__ __forceinline__ void mod_item(LAS unsigned char* lds, int tid_in, int it, const float* c_prompt, const float* c_sample, const float* w_mod, const float* b_mod, float* MOD) {
    int tid = tid_in;
    const int l = it / 96, cb = it - l * 96, j0 = cb * 128;
    const int cq = tid & 31, sh = (tid >> 5) & 1, kq = tid >> 6;
    LAS float* CS = (LAS float*)lds;
    f32x2 acc[24][2];
#pragma unroll
    for (int s = 0; s < 24; ++s) { acc[s][0] = (f32x2){0.f, 0.f}; acc[s][1] = (f32x2){0.f, 0.f}; }
    const float* wbase = w_mod + (size_t)l * DM * 12288 + j0 + 4 * cq;
    for (int kt = 0; kt < 8; ++kt) {
        __syncthreads();
#pragma unroll 8
        for (int j = 0; j < 24; ++j) { const int e = tid + 512 * j, s = e >> 8, kidx = e & 255, kq2 = kidx >> 5, kk = kidx & 31, k = kq2 * 256 + kt * 32 + kk;
            const float cv = s < 16 ? c_prompt[s * DM + k] : c_sample[(s - 16) * DM + k];
            CS[(kq2 * 32 + kk) * 48 + s] = siluf_(cv); }
        __syncthreads();
        { const float* wr = wbase + (size_t)(kq * 256 + kt * 32) * 12288;
          f32x4 wn[4];
#pragma unroll
          for (int i = 0; i < 4; ++i) wn[i] = *(const f32x4*)(wr + (size_t)i * 12288);
#pragma unroll 1
          for (int kk = 0; kk < 32; kk += 4) { f32x4 wc[4];
#pragma unroll
              for (int i = 0; i < 4; ++i) wc[i] = wn[i];
              if (kk + 4 < 32) {
#pragma unroll
                  for (int i = 0; i < 4; ++i) wn[i] = *(const f32x4*)(wr + (size_t)(kk + 4 + i) * 12288); }
#pragma unroll
              for (int i = 0; i < 4; ++i) { const f32x2 w01 = (f32x2){wc[i].x, wc[i].y}, w23 = (f32x2){wc[i].z, wc[i].w}; const LAS f32x4* cr = (const LAS f32x4*)(CS + (kq * 32 + kk + i) * 48 + 24 * sh);
#pragma unroll
                  for (int s4 = 0; s4 < 6; ++s4) { const f32x4 c4 = cr[s4];
#pragma unroll
                      for (int q = 0; q < 4; ++q) { const f32x2 cc = (f32x2){c4[q], c4[q]};
                          acc[4 * s4 + q][0] = __builtin_elementwise_fma(w01, cc, acc[4 * s4 + q][0]); acc[4 * s4 + q][1] = __builtin_elementwise_fma(w23, cc, acc[4 * s4 + q][1]); } } } } }
    }
    LAS float* RED = (LAS float*)lds;
    asm volatile("" : "+v"(tid));
    const int cq2 = tid & 31, sh2 = (tid >> 5) & 1, kq2_ = tid >> 6;
#pragma unroll
    for (int sb = 0; sb < 4; ++sb) {
        __syncthreads();
        if (sh2 == (sb >> 1)) {
#pragma unroll
            for (int i = 0; i < 12; ++i) { const f32x2 a = acc[12 * (sb & 1) + i][0], b = acc[12 * (sb & 1) + i][1]; *(LAS f32x4*)(RED + (kq2_ * 12 + i) * 128 + 4 * cq2) = (f32x4){a.x, a.y, b.x, b.y}; } }
        __syncthreads();
#pragma unroll
        for (int j = 0; j < 3; ++j) { const int e = tid + 512 * j, s = e >> 7, col = e & 127; float v = 0.f;
#pragma unroll
            for (int q = 0; q < 8; ++q) v += RED[(q * 12 + s) * 128 + col];
            MOD[((size_t)l * NSEQ + 12 * sb + s) * 12288 + j0 + col] = v + b_mod[l * 12288 + j0 + col]; }
    }
    __syncthreads();
}

struct CvItem { const float* src; bf16* dst; int N, K, nv; };
constexpr int CV_A = 472 * 32, CV_B = 3 * 16 * 64, CV_C = 32 * 64, CV_D = 32 * 256, CV_E = 128 * 64, CV_ALL = CV_A + CV_B + CV_C + CV_D + CV_E;
__device__ __forceinline__ CvItem cvt_decode(int it, int l, const float* w_in, const float* w_branch, const float* w_out, const float* w_up, const float* w_down, unsigned char* ws) {
    CvItem c; int r = it;
    if (r < CV_A) { const int nb = r % 472, kb = r / 472; int n0s, nv;
        if (nb < 208) { n0s = 32 * nb; nv = 32; } else if (nb < 464) { n0s = 32 * nb + 16; nv = 32; } else if (nb == 464) { n0s = 6656; nv = 16; } else { n0s = 0; nv = 0; }
        c.N = IN_TOTAL; c.K = DM; c.nv = nv; c.src = w_in + (size_t)l * DM * IN_TOTAL + (size_t)(64 * kb) * IN_TOTAL + n0s; c.dst = (bf16*)(ws + WS_WIN) + (size_t)(32 * nb) * DM + 64 * kb; return c; }
    r -= CV_A;
    if (r < CV_B) { const int br = r / 1024, r2 = r % 1024, kb = r2 / 64, nb = r2 % 64;
        c.N = DM; c.K = 1024; c.nv = 32; c.src = w_branch + ((size_t)l * 3072 + br * 1024 + 64 * kb) * DM + 32 * nb; c.dst = (bf16*)(ws + WS_WBR) + (size_t)br * 2048 * 1024 + (size_t)(32 * nb) * 1024 + 64 * kb; return c; }
    r -= CV_B;
    if (r < CV_C) { const int kb = r / 64, nb = r % 64;
        c.N = DM; c.K = DM; c.nv = 32; c.src = w_out + (size_t)l * DM * DM + (size_t)(64 * kb) * DM + 32 * nb; c.dst = (bf16*)(ws + WS_WOUT) + (size_t)(32 * nb) * DM + 64 * kb; return c; }
    r -= CV_C;
    if (r < CV_D) { const int kb = r / 256, nb = r % 256;
        c.N = DFF; c.K = DM; c.nv = 32; c.src = w_up + (size_t)l * DM * DFF + (size_t)(64 * kb) * DFF + 32 * nb; c.dst = (bf16*)(ws + WS_WUP) + (size_t)(32 * nb) * DM + 64 * kb; return c; }
    r -= CV_D;
    { const int kb = r / 64, nb = r % 64;
        c.N = DM; c.K = DFF; c.nv = 32; c.src = w_down + (size_t)l * DFF * DM + (size_t)(64 * kb) * DM + 32 * nb; c.dst = (bf16*)(ws + WS_WDN) + (size_t)(32 * nb) * DFF + 64 * kb; return c; }
}
__device__ __forceinline__ void cvt_load(const CvItem& c, int lane, f32x4 (&v)[8]) {
    const int kk = lane >> 3, n4 = (lane & 7) * 4;
#pragma unroll
    for (int i = 0; i < 8; ++i) v[i] = (n4 < c.nv) ? *(const f32x4*)(c.src + (size_t)(8 * i + kk) * c.N + n4) : (f32x4){0.f, 0.f, 0.f, 0.f};
}
__device__ __forceinline__ void cvt_store(const CvItem& c, int lane, const f32x4 (&v)[8], LAS float* scr) {
    { const int kk = lane >> 3, n4 = (lane & 7) * 4;
#pragma unroll
        for (int i = 0; i < 8; ++i) { LAS float* d = scr + (8 * i + kk) * 33 + n4; d[0] = v[i].x; d[1] = v[i].y; d[2] = v[i].z; d[3] = v[i].w; } }
    LDS_WAIT(); asm volatile("" ::: "memory");
    const int cc = lane & 7;
#pragma unroll
    for (int j = 0; j < 4; ++j) { const int n = (lane >> 3) + 8 * j; const LAS float* s = scr + (8 * cc) * 33 + n;
        v4u o; o.x = pk2(s[0 * 33], s[1 * 33]); o.y = pk2(s[2 * 33], s[3 * 33]); o.z = pk2(s[4 * 33], s[5 * 33]); o.w = pk2(s[6 * 33], s[7 * 33]);
        *(v4u*)(c.dst + (size_t)n * c.K + 8 * cc) = o; }
    LDS_WAIT(); asm volatile("" ::: "memory");
}
template <bool QUEUE>
__device__ __forceinline__ void cvt_phase(LAS unsigned char* lds, int wave, int lane, int gw, int NGW, int l, const float* w_in, const float* w_branch, const float* w_out, const float* w_up, const float* w_down, unsigned char* ws, unsigned* qhead) {
    LAS float* scr = (LAS float*)(lds + wave * 16384);
    int it = gw, left = 0;
#define CV_NEXT() do { if (QUEUE) { if (left == 0) { unsigned t0 = 0; if (lane == 0) t0 = __hip_atomic_fetch_add(qhead, 4u, __ATOMIC_RELAXED, __HIP_MEMORY_SCOPE_AGENT); it = __builtin_amdgcn_readfirstlane((int)t0); left = 4; } else ++it; --left; } else it += NGW; } while (0)
    if (QUEUE) { it = 0; CV_NEXT(); }
    if (it >= CV_ALL) return;
    CvItem ca = cvt_decode(it, l, w_in, w_branch, w_out, w_up, w_down, ws), cb = ca; f32x4 va[8], vb[8];
    cvt_load(ca, lane, va);
    for (;;) {
        CV_NEXT(); const bool hb = it < CV_ALL;
        if (hb) { cb = cvt_decode(it, l, w_in, w_branch, w_out, w_up, w_down, ws); cvt_load(cb, lane, vb); }
        cvt_store(ca, lane, va, scr);
        if (!hb) break;
        CV_NEXT(); const bool ha = it < CV_ALL;
        if (ha) { ca = cvt_decode(it, l, w_in, w_branch, w_out, w_up, w_down, ws); cvt_load(ca, lane, va); }
        cvt_store(cb, lane, vb, scr);
        if (!ha) break;
    }
#undef CV_NEXT
}

#ifndef WGM_N8
#define WGM_N8 4
#endif
__device__ __forceinline__ int tail_nfull(int nwg, int G) { const int nf = (nwg / G) * G; return (nwg - nf) <= 32 ? nf : nwg; }
__device__ __forceinline__ void build_tail_map(LAS int* tmap, int tid, int G, int rev) {
    pg8::StaticOrder S; S.init(MT, DM, G, 0); S.rev = rev; S.wgm = WGM_N8; const int nfull = tail_nfull(S.nwg, G);
    for (int i = tid; i < S.nwg; i += NWAVES * 64) tmap[i] = -1;
    __syncthreads();
    for (int i = tid; i < S.nwg - nfull; i += NWAVES * 64) { pg8::Unit u; S.tile_of(nfull + i, u); tmap[u.pm * 8 + u.pn] = i; }
    __syncthreads();
}
template <bool SRC_F32>
__device__ __forceinline__ void norm_mod_phase(int lane, int gw, int NGW, const float* xP, const float* xS, bf16* X, const float* ng, const float* modl  , int part_sh, int part_sc, bf16* H,
                                               bool comb, const LAS int* tmap, const float* slab, bool desc) {
    const int g2 = desc ? NGW - 1 - gw : gw;
    const int ra = (int)(((unsigned)g2 * (unsigned)MT) / (unsigned)NGW), rb = (int)(((unsigned)(g2 + 1) * (unsigned)MT) / (unsigned)NGW);
    const int nr = rb - ra, rfirst = desc ? rb - 1 : ra, step = desc ? -1 : 1;
    if (nr <= 0) return;
    f32x4 ca[8], cb[8]; int cur_seq = -1;
    v2u xn[8];
    v2u xm[8];
    if (!SRC_F32) { const v2u* xb0 = (const v2u*)(X + (size_t)rfirst * DM) + lane;
#pragma unroll
        for (int j = 0; j < 8; ++j) xn[j] = xb0[64 * j];
        if (nr > 1) { const v2u* xb1 = (const v2u*)(X + (size_t)(rfirst + step) * DM) + lane;
#pragma unroll
            for (int j = 0; j < 8; ++j) xm[j] = xb1[64 * j]; } }
    for (int i = 0; i < nr; ++i) { const int r = rfirst + step * i;
        const int seq = r < NTOK_P ? (r >> 11) : 16 + ((r - NTOK_P) >> 5);
        if (seq != cur_seq) { cur_seq = seq; const float* mp = modl + (size_t)seq * 12288;
#pragma unroll
            for (int j = 0; j < 8; ++j) { const int c = 4 * lane + 256 * j; const f32x4 g = *(const f32x4*)(ng + c), sc = *(const f32x4*)(mp + part_sc * DM + c); ca[j] = g * (sc + 1.0f); cb[j] = *(const f32x4*)(mp + part_sh * DM + c); } }
        f32x4 v[8]; float ss = 0.f; v2u* xb = (v2u*)(X + (size_t)r * DM) + lane;
        if (SRC_F32) { const float* xr = (r < NTOK_P ? xP + (size_t)r * DM : xS + (size_t)(r - NTOK_P) * DM) + 4 * lane;
#pragma unroll
            for (int j = 0; j < 8; ++j) { v[j] = *(const f32x4*)(xr + 256 * j); v2u o; o.x = pk2(v[j].x, v[j].y); o.y = pk2(v[j].z, v[j].w); xb[64 * j] = o; } }
        else {
#pragma unroll
            for (int j = 0; j < 8; ++j) { const v2u o = xn[j]; v[j] = (f32x4){bflo(o.x), bfhi(o.x), bflo(o.y), bfhi(o.y)}; xn[j] = xm[j]; }
            if (i + 2 < nr) { const v2u* xb2 = (const v2u*)(X + (size_t)(r + 2 * step) * DM) + lane;
#pragma unroll
                for (int j = 0; j < 8; ++j) xm[j] = xb2[64 * j]; } }
        if (comb) {
#pragma unroll
            for (int j = 0; j < 8; ++j) { const int ti = tmap[(r >> 8) * 8 + j]; if (ti >= 0) { const float* sp = slab + (size_t)ti * 8 * 65536 + (r & 255) * 256 + 4 * lane;
#pragma unroll
                    for (int q = 0; q < 8; ++q) v[j] = v[j] + *(const f32x4*)(sp + (size_t)q * 65536);
                    v2u o; o.x = pk2(v[j].x, v[j].y); o.y = pk2(v[j].z, v[j].w); xb[64 * j] = o; } } }
#pragma unroll
        for (int j = 0; j < 8; ++j) ss += (v[j].x * v[j].x + v[j].y * v[j].y) + (v[j].z * v[j].z + v[j].w * v[j].w);
        const float rstd = 1.0f / sqrtf(wave_sum(ss) * (1.0f / DM) + NORM_EPS);
        unsigned long long* o8 = (unsigned long long*)(H + (size_t)r * DM) + lane;
#pragma unroll
        for (int j = 0; j < 8; ++j) { const f32x4 y = v[j] * rstd * ca[j] + cb[j]; o8[64 * j] = (unsigned long long)pk2(y.x, y.y) | ((unsigned long long)pk2(y.z, y.w) << 32); }
    }
}
__device__ __forceinline__ void final_norm_phase(int lane, int gw, int NGW, const bf16* X, float* Y, const float* fg, bool comb, const LAS int* tmap, const float* slab) {
    f32x4 g[8];
#pragma unroll
    for (int j = 0; j < 8; ++j) g[j] = *(const f32x4*)(fg + 4 * lane + 256 * j);
    v2u xn[8];
    if (gw < MT) { const v2u* xb0 = (const v2u*)(X + (size_t)gw * DM) + lane;
#pragma unroll
        for (int j = 0; j < 8; ++j) xn[j] = xb0[64 * j]; }
    for (int r = gw; r < MT; r += NGW) {
        float* yr = Y + (size_t)r * DM + 4 * lane; f32x4 v[8]; float ss = 0.f;
#pragma unroll
        for (int j = 0; j < 8; ++j) { const v2u o = xn[j]; v[j] = (f32x4){bflo(o.x), bfhi(o.x), bflo(o.y), bfhi(o.y)}; }
        if (r + NGW < MT) { const v2u* xb1 = (const v2u*)(X + (size_t)(r + NGW) * DM) + lane;
#pragma unroll
            for (int j = 0; j < 8; ++j) xn[j] = xb1[64 * j]; }
        if (comb) {
#pragma unroll
            for (int j = 0; j < 8; ++j) { const int ti = tmap[(r >> 8) * 8 + j]; if (ti >= 0) { const float* sp = slab + (size_t)ti * 8 * 65536 + (r & 255) * 256 + 4 * lane;
#pragma unroll
                    for (int q = 0; q < 8; ++q) v[j] = v[j] + *(const f32x4*)(sp + (size_t)q * 65536); } } }
#pragma unroll
        for (int j = 0; j < 8; ++j) ss += (v[j].x * v[j].x + v[j].y * v[j].y) + (v[j].z * v[j].z + v[j].w * v[j].w);
        const float rstd = 1.0f / sqrtf(wave_sum(ss) * (1.0f / DM) + NORM_EPS);
#pragma unroll
        for (int j = 0; j < 8; ++j) *(f32x4*)(yr + 256 * j) = v[j] * rstd * g[j];
    }
}
__device__ __forceinline__ void ssd_norm_phase(int lane, int gw, int NGW, bf16* YB, const float* g) {
    float gv[16];
#pragma unroll
    for (int j = 0; j < 4; ++j) { const f32x4 t = *(const f32x4*)(g + 16 * lane + 4 * j); gv[4 * j] = t.x; gv[4 * j + 1] = t.y; gv[4 * j + 2] = t.z; gv[4 * j + 3] = t.w; }
    v4u na = (v4u){0u, 0u, 0u, 0u}, nb = na;
    if (gw < MT) { const v4u* p0 = (const v4u*)(YB + (size_t)gw * 1024 + 16 * lane); na = p0[0]; nb = p0[1]; }
    for (int r = gw; r < MT; r += NGW) {
        v4u* p = (v4u*)(YB + (size_t)r * 1024 + 16 * lane); const v4u a = na, b = nb;
        if (r + NGW < MT) { const v4u* p1 = (const v4u*)(YB + (size_t)(r + NGW) * 1024 + 16 * lane); na = p1[0]; nb = p1[1]; }
        float v[16]; v[0] = bflo(a.x); v[1] = bfhi(a.x); v[2] = bflo(a.y); v[3] = bfhi(a.y); v[4] = bflo(a.z); v[5] = bfhi(a.z); v[6] = bflo(a.w); v[7] = bfhi(a.w);
        v[8] = bflo(b.x); v[9] = bfhi(b.x); v[10] = bflo(b.y); v[11] = bfhi(b.y); v[12] = bflo(b.z); v[13] = bfhi(b.z); v[14] = bflo(b.w); v[15] = bfhi(b.w);
        float ss = 0.f;
#pragma unroll
        for (int j = 0; j < 16; ++j) ss += v[j] * v[j];
        const float rstd = 1.0f / sqrtf(half_sum(ss) * (1.0f / 512.0f) + NORM_EPS);
#pragma unroll
        for (int j = 0; j < 16; ++j) v[j] = v[j] * rstd * gv[j];
        v4u oa, ob; oa.x = pk2(v[0], v[1]); oa.y = pk2(v[2], v[3]); oa.z = pk2(v[4], v[5]); oa.w = pk2(v[6], v[7]); ob.x = pk2(v[8], v[9]); ob.y = pk2(v[10], v[11]); ob.z = pk2(v[12], v[13]); ob.w = pk2(v[14], v[15]);
        p[0] = oa; p[1] = ob;
    }
}

__device__ __forceinline__ void hgrn_item(LAS unsigned char* lds, int tid, int lane, int wave, const bf16* P, bf16* YA, int row0, int T, int h, int l,
                                          const float* s0, float* sout, const float* lb_raw, const float* onorm_g) {
    LAS float* LBV = (LAS float*)lds;
    LAS float* GV = LBV + 128;
    LAS float* Q = GV + 128;
    LAS float* F = Q + 2048; LAS float* KN = F + 2048; LAS float* IV = KN + 2048;
    LAS float* PO = IV + 2048;
    __syncthreads();
    if (tid < 128) { const int ch = h * 128 + tid; const float a0 = lb_raw[ch], a1 = lb_raw[1024 + ch], a2 = lb_raw[2048 + ch], a3 = lb_raw[3072 + ch];
        const float mx = fmaxf(fmaxf(a0, a1), fmaxf(a2, a3)); const float e0 = __expf(a0 - mx), e1 = __expf(a1 - mx), e2 = __expf(a2 - mx), e3 = __expf(a3 - mx); const float inv = 1.0f / (e0 + e1 + e2 + e3);
        float lb = 0.f; if (l >= 1) lb += e1; if (l >= 2) lb += e2; if (l >= 3) lb += e3; LBV[tid] = lb * inv; GV[tid] = onorm_g[ch]; }
    v2u nq2, nf2, ni2;
    { const bf16* pr = P + (size_t)(row0 + (tid >> 5)) * NPAD + h * 128 + (tid & 31) * 4; nq2 = *(const v2u*)(pr + OFF_AQ); nf2 = *(const v2u*)(pr + OFF_AF); ni2 = *(const v2u*)(pr + OFF_AI); }
    float S0[16], S1[16];
#pragma unroll
    for (int kk = 0; kk < 16; ++kk) { if (s0) { const f32x2 v = *(const f32x2*)(s0 + (16 * wave + kk) * 128 + 2 * lane); S0[kk] = v.x; S1[kk] = v.y; } else { S0[kk] = 0.f; S1[kk] = 0.f; } }
    __syncthreads();
    const int nch = T / 16;
    for (int c = 0; c < nch; ++c) {
        unsigned agv[2];
#pragma unroll
        for (int tt = 0; tt < 2; ++tt) agv[tt] = *(const unsigned*)(P + (size_t)(row0 + c * 16 + 2 * wave + tt) * NPAD + OFF_AG + h * 128 + 2 * lane);
        { const int t = tid >> 5, k4 = (tid & 31) * 4;
            const v2u q2 = nq2, f2 = nf2, i2 = ni2;
            if (c + 1 < nch) { const bf16* pr = P + (size_t)(row0 + (c + 1) * 16 + t) * NPAD + h * 128 + k4; nq2 = *(const v2u*)(pr + OFF_AQ); nf2 = *(const v2u*)(pr + OFF_AF); ni2 = *(const v2u*)(pr + OFF_AI); }
            const f32x4 lb = *(const LAS f32x4*)(LBV + k4);
            const float aq[4] = {bflo(q2.x), bfhi(q2.x), bflo(q2.y), bfhi(q2.y)}, az[4] = {bflo(f2.x), bfhi(f2.x), bflo(f2.y), bfhi(f2.y)};
            f32x4 qv, fv, kv;
#pragma unroll
            for (int j = 0; j < 4; ++j) { qv[j] = siluf_(aq[j]); const float sg = sigmoidf_(az[j]); fv[j] = lb[j] + (1.0f - lb[j]) * sg; kv[j] = (1.0f - lb[j]) * (1.0f - sg); }
            *(LAS f32x4*)(Q + t * 128 + k4) = qv; *(LAS f32x4*)(F + t * 128 + k4) = fv; *(LAS f32x4*)(KN + t * 128 + k4) = kv;
            *(LAS f32x4*)(IV + t * 128 + k4) = (f32x4){bflo(i2.x), bfhi(i2.x), bflo(i2.y), bfhi(i2.y)}; }
        __syncthreads();
#pragma unroll 2
        for (int t = 0; t < 16; ++t) {
            const f32x2 iv = *(const LAS f32x2*)(IV + t * 128 + 2 * lane); float po0 = 0.f, po1 = 0.f;
#pragma unroll
            for (int k4 = 0; k4 < 4; ++k4) { const f32x4 f4 = *(const LAS f32x4*)(F + t * 128 + 16 * wave + 4 * k4), n4 = *(const LAS f32x4*)(KN + t * 128 + 16 * wave + 4 * k4), q4 = *(const LAS f32x4*)(Q + t * 128 + 16 * wave + 4 * k4);
#pragma unroll
                for (int j = 0; j < 4; ++j) { const int kk = 4 * k4 + j; S0[kk] = fmaf(f4[j], S0[kk], n4[j] * iv.x); S1[kk] = fmaf(f4[j], S1[kk], n4[j] * iv.y); po0 = fmaf(q4[j], S0[kk], po0); po1 = fmaf(q4[j], S1[kk], po1); } }
            *(LAS f32x2*)(PO + (t * 8 + wave) * 128 + 2 * lane) = (f32x2){po0, po1};
        }
        __syncthreads();
#pragma unroll
        for (int tt = 0; tt < 2; ++tt) { const int t = 2 * wave + tt; float o0 = 0.f, o1 = 0.f;
#pragma unroll
            for (int w = 0; w < 8; ++w) { const f32x2 p = *(const LAS f32x2*)(PO + (t * 8 + w) * 128 + 2 * lane); o0 += p.x; o1 += p.y; }
            const float rstd = 1.0f / sqrtf(wave_sum(o0 * o0 + o1 * o1) * (1.0f / 128.0f) + NORM_EPS);
            const size_t row = (size_t)(row0 + c * 16 + t);
            const unsigned ag = agv[tt];
            const f32x2 gg = *(const LAS f32x2*)(GV + 2 * lane);
            *(unsigned*)(YA + row * 1024 + h * 128 + 2 * lane) = pk2(o0 * rstd * gg.x * siluf_(bflo(ag)), o1 * rstd * gg.y * siluf_(bfhi(ag))); }
    }
#pragma unroll
    for (int kk = 0; kk < 16; ++kk) *(f32x2*)(sout + (16 * wave + kk) * 128 + 2 * lane) = (f32x2){S0[kk], S1[kk]};
    __syncthreads();
}

typedef short bf16x8_t __attribute__((ext_vector_type(8)));
#define BAR_LDS() do { asm volatile("s_waitcnt lgkmcnt(0)" ::: "memory"); __builtin_amdgcn_s_barrier(); asm volatile("" ::: "memory"); } while (0)
#define MFMA16(x, y, acc) __builtin_amdgcn_mfma_f32_16x16x32_bf16((x), (y), (acc), 0, 0, 0)
#define LDFRAG(base, row, pitch, koff) (*(const LAS bf16x8_t*)((base) + (row) * (pitch) + (koff)))
__device__ __forceinline__ void hgrn_mfma_item(LAS unsigned char* lds, int tid, int lane, int wave, const bf16* P, bf16* YA, int row0, int h, int l, float* sout, const float* lb_raw, const float* onorm_g) {
    constexpr int PQ = 136, PT = 40;
    LAS float* LBV = (LAS float*)lds;
    LAS float* GV = LBV + 128;
    LAS float* DEC = GV + 128;
    LAS float* SS = DEC + 128;
    LAS float* LF = SS + 256;
    LAS bf16* QB = (LAS bf16*)(LF + 4096);
    LAS bf16* KB = QB + 32 * PQ;
    LAS bf16* Qt = KB + 32 * PQ;
    LAS bf16* Qm = Qt + 32 * PQ;
    LAS bf16* Km = Qm + 32 * PQ;
    LAS bf16* Qr = Km + 32 * PQ;
    LAS bf16* Kr = Qr + 16 * PQ;
    LAS bf16* KtT = Kr + 16 * PQ;
    LAS bf16* VT = KtT + 128 * PT;
    LAS bf16* IVr = VT + 128 * PT;
    LAS float* RSW = (LAS float*)(IVr + 32 * 128);
    const int fr = lane & 15, fq = lane >> 4;
    __syncthreads();
    if (tid < 128) { const int ch = h * 128 + tid; const float a0 = lb_raw[ch], a1 = lb_raw[1024 + ch], a2 = lb_raw[2048 + ch], a3 = lb_raw[3072 + ch];
        const float mx = fmaxf(fmaxf(a0, a1), fmaxf(a2, a3)); const float e0 = __expf(a0 - mx), e1 = __expf(a1 - mx), e2 = __expf(a2 - mx), e3 = __expf(a3 - mx); const float inv = 1.0f / (e0 + e1 + e2 + e3);
        float lb = 0.f; if (l >= 1) lb += e1; if (l >= 2) lb += e2; if (l >= 3) lb += e3; LBV[tid] = lb * inv; GV[tid] = onorm_g[ch]; }
    for (int i = tid; i < (128 * PT * 2) / 2; i += 512) ((LAS unsigned*)KtT)[i] = 0u;
    f32x4 sacc[8];
#pragma unroll
    for (int j = 0; j < 8; ++j) sacc[j] = (f32x4){0.f, 0.f, 0.f, 0.f};
    const int st = tid >> 4, sk8 = (tid & 15) * 8;
    const unsigned pst = (unsigned)((unsigned)(row0 + st) * (unsigned)NPAD + h * 128 + sk8) * 2u;
#define HG_LD16(off_) (*(const v4u*)((const char*)P + (unsigned)(off_)))
    v4u nq = HG_LD16(pst + 2u * OFF_AQ), nf = HG_LD16(pst + 2u * OFF_AF), ni = HG_LD16(pst + 2u * OFF_AI);
    f32x4 po0 = (f32x4){0.f, 0.f, 0.f, 0.f}, po1 = po0; bf16 pag[2][4];
#pragma unroll
    for (int hh = 0; hh < 2; ++hh)
#pragma unroll
        for (int r = 0; r < 4; ++r) pag[hh][r] = 0;
    const float gvv = onorm_g[h * 128 + 16 * wave + fr];
    __syncthreads();
#define HG_OUT(rb_) do { { const int t_ = lane & 31; const f32x4 p0 = *(const LAS f32x4*)(SS + t_ * 8), p1 = *(const LAS f32x4*)(SS + t_ * 8 + 4); \
            RSW[wave * 32 + t_] = rsqrtf_(((p0.x + p0.y) + (p0.z + p0.w) + (p1.x + p1.y) + (p1.z + p1.w)) * (1.0f / 128.0f) + NORM_EPS); } \
        LDS_WAIT(); asm volatile("" ::: "memory"); \
        _Pragma("unroll") for (int hh = 0; hh < 2; ++hh) { const f32x4 rs4 = *(const LAS f32x4*)(RSW + wave * 32 + 16 * hh + 4 * fq); \
            _Pragma("unroll") for (int r = 0; r < 4; ++r) { const int t = 16 * hh + 4 * fq + r; const float ov = hh ? po1[r] : po0[r]; \
            *(bf16*)((char*)YA + (unsigned)(((unsigned)(rb_) + t) * 1024u + h * 128 + 16 * wave + fr) * 2u) = (bf16)f2bf(ov * rs4[r] * gvv * siluf_(bf1(pag[hh][r]))); } } } while (0)
    for (int c = 0; c < 64; ++c) {
        const unsigned rbase = (unsigned)row0 + 32u * c;
        bf16 ag[2][4];
        { const f32x4 lb0 = *(const LAS f32x4*)(LBV + sk8), lb1 = *(const LAS f32x4*)(LBV + sk8 + 4); const float lb[8] = {lb0.x, lb0.y, lb0.z, lb0.w, lb1.x, lb1.y, lb1.z, lb1.w};
            const float aq[8] = {bflo(nq.x), bfhi(nq.x), bflo(nq.y), bfhi(nq.y), bflo(nq.z), bfhi(nq.z), bflo(nq.w), bfhi(nq.w)}, az[8] = {bflo(nf.x), bfhi(nf.x), bflo(nf.y), bfhi(nf.y), bflo(nf.z), bfhi(nf.z), bflo(nf.w), bfhi(nf.w)};
            float qv[8], kv[8], lf[8];
#pragma unroll
            for (int j = 0; j < 8; ++j) { qv[j] = siluf_(aq[j]); const float sg = sigmoidf_(az[j]); const float f = fmaxf(lb[j] + (1.0f - lb[j]) * sg, 1e-30f); kv[j] = (1.0f - lb[j]) * (1.0f - sg); lf[j] = __log2f(f); }
            *(LAS f32x4*)(LF + st * 128 + sk8) = (f32x4){lf[0], lf[1], lf[2], lf[3]}; *(LAS f32x4*)(LF + st * 128 + sk8 + 4) = (f32x4){lf[4], lf[5], lf[6], lf[7]};
            v4u qo, ko; qo.x = pk2(qv[0], qv[1]); qo.y = pk2(qv[2], qv[3]); qo.z = pk2(qv[4], qv[5]); qo.w = pk2(qv[6], qv[7]); ko.x = pk2(kv[0], kv[1]); ko.y = pk2(kv[2], kv[3]); ko.z = pk2(kv[4], kv[5]); ko.w = pk2(kv[6], kv[7]);
            *(LAS v4u*)(QB + st * PQ + sk8) = qo; *(LAS v4u*)(KB + st * PQ + sk8) = ko; *(LAS v4u*)(IVr + st * 128 + sk8) = ni;
#pragma unroll
            for (int hh = 0; hh < 2; ++hh)
#pragma unroll
                for (int r = 0; r < 4; ++r) ag[hh][r] = *(const bf16*)((const char*)P + (unsigned)((rbase + 16 * hh + 4 * fq + r) * (unsigned)NPAD + OFF_AG + h * 128 + 16 * wave + fr) * 2u);
            if (c + 1 < 64) { const unsigned pn = pst + (unsigned)(c + 1) * 32u * (unsigned)NPAD * 2u; nq = HG_LD16(pn + 2u * OFF_AQ); nf = HG_LD16(pn + 2u * OFF_AF); ni = HG_LD16(pn + 2u * OFF_AI); } }
        BAR_LDS();
        { const int k = tid & 127, tq = tid >> 7; float b[32]; float run = 0.f;
#pragma unroll
            for (int t = 0; t < 32; ++t) { run += LF[t * 128 + k]; b[t] = run; }
#pragma unroll
            for (int tq2 = 0; tq2 < 4; ++tq2) if (tq2 == tq) { const float mh = (tq2 < 2) ? b[7] : b[23]; float kt[8]; bf16 iv[8];
#pragma unroll
                for (int i = 0; i < 8; ++i) { const int t = 8 * tq2 + i; const float qv = bf1(QB[t * PQ + k]), kv = bf1(KB[t * PQ + k]); iv[i] = IVr[t * 128 + k];
                    Qt[t * PQ + k] = (bf16)f2bf(qv * __builtin_amdgcn_exp2f(b[t])); kt[i] = kv * __builtin_amdgcn_exp2f(b[31] - b[t]);
                    Qm[t * PQ + k] = (bf16)f2bf(qv * __builtin_amdgcn_exp2f(fminf(b[t] - mh, 115.f))); Km[t * PQ + k] = (bf16)f2bf(kv * __builtin_amdgcn_exp2f(fminf(mh - b[t], 115.f)));
                    if (tq2 < 2) Kr[t * PQ + k] = (bf16)f2bf(kv * __builtin_amdgcn_exp2f(b[15] - b[t])); else Qr[(t - 16) * PQ + k] = (bf16)f2bf(qv * __builtin_amdgcn_exp2f(b[t] - b[15])); }
                v4u ko; ko.x = pk2(kt[0], kt[1]); ko.y = pk2(kt[2], kt[3]); ko.z = pk2(kt[4], kt[5]); ko.w = pk2(kt[6], kt[7]); *(LAS v4u*)(KtT + k * PT + 8 * tq2) = ko;
                v4u vo; vo.x = (unsigned)iv[0] | ((unsigned)iv[1] << 16); vo.y = (unsigned)iv[2] | ((unsigned)iv[3] << 16); vo.z = (unsigned)iv[4] | ((unsigned)iv[5] << 16); vo.w = (unsigned)iv[6] | ((unsigned)iv[7] << 16); *(LAS v4u*)(VT + k * PT + 8 * tq2) = vo; }
            if (tq == 0) DEC[k] = __builtin_amdgcn_exp2f(b[31]); }
        if (c > 0) HG_OUT(rbase - 32);
        BAR_LDS();
        f32x4 at0 = (f32x4){0.f, 0.f, 0.f, 0.f}, at1 = at0, at2 = at0, o0 = at0, o1 = at0;
#pragma unroll
        for (int ks = 0; ks < 4; ++ks) { const int ko = 32 * ks + 8 * fq;
            at0 = MFMA16(LDFRAG(Km, fr, PQ, ko), LDFRAG(Qm, fr, PQ, ko), at0);
            at1 = MFMA16(LDFRAG(Km, 16 + fr, PQ, ko), LDFRAG(Qm, 16 + fr, PQ, ko), at1);
            at2 = MFMA16(LDFRAG(Kr, fr, PQ, ko), LDFRAG(Qr, fr, PQ, ko), at2);
            v4u sy; sy.x = pk2(sacc[2 * ks][0], sacc[2 * ks][1]); sy.y = pk2(sacc[2 * ks][2], sacc[2 * ks][3]); sy.z = pk2(sacc[2 * ks + 1][0], sacc[2 * ks + 1][1]); sy.w = pk2(sacc[2 * ks + 1][2], sacc[2 * ks + 1][3]);
            const v2u xa0 = *(const LAS v2u*)(Qt + fr * PQ + 32 * ks + 4 * fq), xb0 = *(const LAS v2u*)(Qt + fr * PQ + 32 * ks + 16 + 4 * fq);
            const v2u xa1 = *(const LAS v2u*)(Qt + (16 + fr) * PQ + 32 * ks + 4 * fq), xb1 = *(const LAS v2u*)(Qt + (16 + fr) * PQ + 32 * ks + 16 + 4 * fq);
            v4u x0; x0.x = xa0.x; x0.y = xa0.y; x0.z = xb0.x; x0.w = xb0.y; v4u x1; x1.x = xa1.x; x1.y = xa1.y; x1.z = xb1.x; x1.w = xb1.y;
            o0 = MFMA16(__builtin_bit_cast(bf16x8_t, x0), __builtin_bit_cast(bf16x8_t, sy), o0); o1 = MFMA16(__builtin_bit_cast(bf16x8_t, x1), __builtin_bit_cast(bf16x8_t, sy), o1); }
        {
            v4u a0, a1, a2; a0.z = 0u; a0.w = 0u; a1.z = 0u; a1.w = 0u; a2.z = 0u; a2.w = 0u;
            a0.x = pk2(4 * fq + 0 <= fr ? at0[0] : 0.f, 4 * fq + 1 <= fr ? at0[1] : 0.f); a0.y = pk2(4 * fq + 2 <= fr ? at0[2] : 0.f, 4 * fq + 3 <= fr ? at0[3] : 0.f);
            a1.x = pk2(4 * fq + 0 <= fr ? at1[0] : 0.f, 4 * fq + 1 <= fr ? at1[1] : 0.f); a1.y = pk2(4 * fq + 2 <= fr ? at1[2] : 0.f, 4 * fq + 3 <= fr ? at1[3] : 0.f);
            a2.x = pk2(at2[0], at2[1]); a2.y = pk2(at2[2], at2[3]);
            const v2u y0 = *(const LAS v2u*)(VT + (16 * wave + fr) * PT + 4 * fq), y1 = *(const LAS v2u*)(VT + (16 * wave + fr) * PT + 16 + 4 * fq);
            v4u v0; v0.x = y0.x; v0.y = y0.y; v0.z = 0u; v0.w = 0u; v4u v1; v1.x = y1.x; v1.y = y1.y; v1.z = 0u; v1.w = 0u;
            o0 = MFMA16(__builtin_bit_cast(bf16x8_t, a0), __builtin_bit_cast(bf16x8_t, v0), o0);
            o1 = MFMA16(__builtin_bit_cast(bf16x8_t, a1), __builtin_bit_cast(bf16x8_t, v1), o1);
            o1 = MFMA16(__builtin_bit_cast(bf16x8_t, a2), __builtin_bit_cast(bf16x8_t, v0), o1); }
#pragma unroll
        for (int r = 0; r < 4; ++r) { float q0 = o0[r] * o0[r], q1 = o1[r] * o1[r];
            q0 += __shfl_xor(q0, 1); q1 += __shfl_xor(q1, 1); q0 += __shfl_xor(q0, 2); q1 += __shfl_xor(q1, 2); q0 += __shfl_xor(q0, 4); q1 += __shfl_xor(q1, 4); q0 += __shfl_xor(q0, 8); q1 += __shfl_xor(q1, 8);
            if (fr == 0) { SS[(4 * fq + r) * 8 + wave] = q0; SS[(16 + 4 * fq + r) * 8 + wave] = q1; } }
        {
            const bf16x8_t vy = LDFRAG(VT, 16 * wave + fr, PT, 8 * fq);
#pragma unroll
            for (int kt = 0; kt < 8; ++kt) { const f32x4 d4 = *(const LAS f32x4*)(DEC + 16 * kt + 4 * fq); sacc[kt] = sacc[kt] * d4; sacc[kt] = MFMA16(LDFRAG(KtT, 16 * kt + fr, PT, 8 * fq), vy, sacc[kt]); } }
        po0 = o0; po1 = o1;
#pragma unroll
        for (int hh = 0; hh < 2; ++hh)
#pragma unroll
            for (int r = 0; r < 4; ++r) pag[hh][r] = ag[hh][r];
    }
    BAR_LDS();
    HG_OUT((unsigned)row0 + 2048u - 32u);
#undef HG_OUT
#undef HG_LD16
#pragma unroll
    for (int kt = 0; kt < 8; ++kt)
#pragma unroll
        for (int r = 0; r < 4; ++r) sout[(16 * kt + 4 * fq + r) * 128 + 16 * wave + fr] = sacc[kt][r];
    __syncthreads();
}

__device__ __forceinline__ void ssd_pre_phase(int lane, int gw, int NGW, const bf16* P, bf16* XC, float* DTb, float* ADT, float* ACUM,
                                              const float* conv_w, const float* conv_b, const float* dt_bias, const float* a_log, const float* state_conv, float* conv_out_p, float* conv_out_s) {
    unsigned ua = (unsigned)(((unsigned long long)(unsigned)gw * (3u * MT)) / (unsigned)NGW); const unsigned ub = (unsigned)(((unsigned long long)((unsigned)gw + 1u) * (3u * MT)) / (unsigned)NGW);
#define PRE_UNPK(dst, u) do { dst[0] = bflo(u.x); dst[1] = bfhi(u.x); dst[2] = bflo(u.y); dst[3] = bfhi(u.y); dst[4] = bflo(u.z); dst[5] = bfhi(u.z); dst[6] = bflo(u.w); dst[7] = bfhi(u.w); } while (0)
    while (ua < ub) {
        const int cg = (int)(ua / (unsigned)MT); const unsigned ue = ub < (unsigned)(cg + 1) * MT ? ub : (unsigned)(cg + 1) * MT;
        const int t0 = (int)(ua - (unsigned)cg * MT), t1 = (int)(ue - (unsigned)cg * MT), cc = cg * 512 + 8 * lane; ua = ue;
        float w[4][8], cb[8], a0[8], a1[8], a2[8];
#pragma unroll
        for (int j = 0; j < 4; ++j) { const f32x4 u0 = *(const f32x4*)(conv_w + j * 1536 + cc), u1 = *(const f32x4*)(conv_w + j * 1536 + cc + 4);
            w[j][0] = u0.x; w[j][1] = u0.y; w[j][2] = u0.z; w[j][3] = u0.w; w[j][4] = u1.x; w[j][5] = u1.y; w[j][6] = u1.z; w[j][7] = u1.w; }
        { const f32x4 u0 = *(const f32x4*)(conv_b + cc), u1 = *(const f32x4*)(conv_b + cc + 4); cb[0] = u0.x; cb[1] = u0.y; cb[2] = u0.z; cb[3] = u0.w; cb[4] = u1.x; cb[5] = u1.y; cb[6] = u1.z; cb[7] = u1.w; }
#pragma unroll
        for (int e = 0; e < 8; ++e) { a0[e] = 0.f; a1[e] = 0.f; a2[e] = 0.f; }
        const int ts = t0 >= 3 ? t0 - 3 : 0;
        const bf16* pc = P + OFF_XBC + cc; bf16* xo = XC + cc;
        v4u un[4];
#pragma unroll
        for (int k = 0; k < 4; ++k) { const int tt = ts + k < t1 ? ts + k : t1 - 1; un[k] = *(const v4u*)(pc + (size_t)tt * NPAD); }
        for (int tb = ts; tb < t1; tb += 4) { v4u uc[4];
#pragma unroll
            for (int k = 0; k < 4; ++k) uc[k] = un[k];
            if (tb + 4 < t1) {
#pragma unroll
                for (int k = 0; k < 4; ++k) { const int tt = tb + 4 + k < t1 ? tb + 4 + k : t1 - 1; un[k] = *(const v4u*)(pc + (size_t)tt * NPAD); } }
#pragma unroll
            for (int k = 0; k < 4; ++k) { const int t = tb + k; if (t < t1) {
                const bool smp = t >= NTOK_P; const bool st = smp ? (((t - NTOK_P) & 31) == 0) : ((t & 2047) == 0);
                if (st) {
                    if (smp) { const float* cbuf = state_conv + (size_t)((t - NTOK_P) >> 5) * 4608 + cc;
#pragma unroll
                        for (int e = 0; e < 8; ++e) { a0[e] = cbuf[e]; a1[e] = cbuf[1536 + e]; a2[e] = cbuf[3072 + e]; } }
                    else {
#pragma unroll
                        for (int e = 0; e < 8; ++e) { a0[e] = 0.f; a1[e] = 0.f; a2[e] = 0.f; } } }
                float cur[8]; PRE_UNPK(cur, uc[k]);
                if (t >= t0) { float o[8];
#pragma unroll
                    for (int e = 0; e < 8; ++e) o[e] = siluf_(cb[e] + w[0][e] * a0[e] + w[1][e] * a1[e] + w[2][e] * a2[e] + w[3][e] * cur[e]);
                    v4u ov; ov.x = pk2(o[0], o[1]); ov.y = pk2(o[2], o[3]); ov.z = pk2(o[4], o[5]); ov.w = pk2(o[6], o[7]);
                    *(v4u*)(xo + (size_t)t * 1536) = ov; }
#pragma unroll
                for (int e = 0; e < 8; ++e) { a0[e] = a1[e]; a1[e] = a2[e]; a2[e] = cur[e]; } } }
        }
    }
#undef PRE_UNPK
    for (int it = gw; it < 528 * 16; it += NGW) {
        const int rb = it >> 4, h = it & 15; const size_t row = (size_t)rb * 64 + lane;
        const float xv = bf1(P[row * NPAD + OFF_DT + h]) + dt_bias[h]; const float dt = xv > 20.f ? xv : log1pf(__expf(xv)); const float a = -dt * __expf(a_log[h]);
        float cs = a;
#pragma unroll
        for (int o = 1; o < 64; o <<= 1) { const float t = __shfl_up(cs, o); if (lane >= o) cs += t; }
        DTb[row * 16 + h] = dt; ADT[row * 16 + h] = a; ACUM[row * 16 + h] = cs;
    }
    for (int e = gw * 64 + lane; e < 48 * 4608; e += NGW * 64) {
        const int sq = e / 4608, r = e - sq * 4608, j = r / 1536, cc = r - j * 1536;
        const size_t row = sq < 16 ? (size_t)sq * 2048 + 2045 + j : (size_t)NTOK_P + (sq - 16) * 32 + 29 + j;
        const float v = bf1(P[row * NPAD + OFF_XBC + cc]);
        if (sq < 16) conv_out_p[sq * 4608 + r] = v; else conv_out_s[(sq - 16) * 4608 + r] = v;
    }
}

__device__ __forceinline__ void ssd_item(LAS unsigned char* lds, int tid, int lane, int wave, const bf16* P, const bf16* XC, const float* DTb, const float* ADT, bf16* YB, int row0, int T, int h,
                                         const float* s0, float* sout, float Dh) {
    LAS float* X = (LAS float*)lds;
    LAS float* Bs = X + 2048;
    LAS float* Cs = Bs + 4096;
    LAS float* DT = Cs + 4096;
    LAS float* DA = DT + 32;
    LAS float* PY = DA + 32;
    const int g = h >> 3, ci = tid;
    int cc = 0; LAS float* dst = X; int dstride = 64;
    if (ci < 64) { cc = h * 64 + ci; dst = X + ci; dstride = 64; } else if (ci < 192) { cc = 1024 + g * 128 + (ci - 64); dst = Bs + (ci - 64); dstride = 128; } else if (ci < 320) { cc = 1280 + g * 128 + (ci - 192); dst = Cs + (ci - 192); dstride = 128; }
    float hst[16];
#pragma unroll
    for (int j = 0; j < 4; ++j) { f32x4 v = (f32x4){0.f, 0.f, 0.f, 0.f}; if (s0) v = *(const f32x4*)(s0 + lane * 128 + 16 * wave + 4 * j); hst[4 * j] = v.x; hst[4 * j + 1] = v.y; hst[4 * j + 2] = v.z; hst[4 * j + 3] = v.w; }
    __syncthreads();
    const int nch = T / 32;
    for (int c = 0; c < nch; ++c) {
        const size_t rbase = (size_t)(row0 + c * 32);
        if (ci < 320) { const bf16* pc = XC + rbase * 1536 + cc;
            bf16 sv[32];
#pragma unroll
            for (int t = 0; t < 32; ++t) sv[t] = pc[(size_t)t * 1536];
#pragma unroll
            for (int t = 0; t < 32; ++t) dst[t * dstride] = bf1(sv[t]); }
        else if (ci < 352) { const int t = ci - 320; DT[t] = DTb[(rbase + t) * 16 + h]; DA[t] = __expf(ADT[(rbase + t) * 16 + h]); }
        unsigned zg[2];
#pragma unroll
        for (int j = 0; j < 2; ++j) { const int e = tid + 512 * j; zg[j] = *(const unsigned*)(P + (rbase + (e >> 5)) * NPAD + OFF_BZ + h * 64 + (e & 31) * 2); }
        __syncthreads();
#pragma unroll 2
        for (int t = 0; t < 32; ++t) {
            const float dA = DA[t], xdt = X[t * 64 + lane] * DT[t]; float py = 0.f;
#pragma unroll
            for (int n4 = 0; n4 < 4; ++n4) { const f32x4 b4 = *(const LAS f32x4*)(Bs + t * 128 + 16 * wave + 4 * n4), c4 = *(const LAS f32x4*)(Cs + t * 128 + 16 * wave + 4 * n4);
#pragma unroll
                for (int j = 0; j < 4; ++j) { const int nn = 4 * n4 + j; hst[nn] = fmaf(xdt, b4[j], dA * hst[nn]); py = fmaf(hst[nn], c4[j], py); } }
            PY[(t * 8 + wave) * 64 + lane] = py;
        }
        __syncthreads();
#pragma unroll
        for (int j = 0; j < 2; ++j) { const int e = tid + 512 * j, t = e >> 5, p2 = (e & 31) * 2; float y0 = 0.f, y1 = 0.f;
#pragma unroll
            for (int w = 0; w < 8; ++w) { const f32x2 p = *(const LAS f32x2*)(PY + (t * 8 + w) * 64 + p2); y0 += p.x; y1 += p.y; }
            const f32x2 xv = *(const LAS f32x2*)(X + t * 64 + p2); y0 += Dh * xv.x; y1 += Dh * xv.y;
            const size_t row = rbase + t; const unsigned z = zg[j];
            *(unsigned*)(YB + row * 1024 + h * 64 + p2) = pk2(y0 * siluf_(bflo(z)), y1 * siluf_(bfhi(z))); }
        __syncthreads();
    }
#pragma unroll
    for (int j = 0; j < 4; ++j) *(f32x4*)(sout + lane * 128 + 16 * wave + 4 * j) = (f32x4){hst[4 * j], hst[4 * j + 1], hst[4 * j + 2], hst[4 * j + 3]};
    __syncthreads();
}

__device__ __forceinline__ bf16 v4u_el(const v4u& d, int e) { const unsigned w = d[e >> 1]; return (bf16)((e & 1) ? (w >> 16) : (w & 0xffffu)); }
__device__ __forceinline__ void ssd_mfma_pair(LAS unsigned char* lds, int tid, int lane, int wave, const bf16* P, const bf16* XC, const float* DTb, const float* ACUM, bf16* YB, int row0, int h0, float Dh0, float Dh1, float* sout0) {
    constexpr int PC = 136, PS = 72;
    LAS bf16* Cm0 = (LAS bf16*)lds;
    LAS bf16* Bm = Cm0 + 2 * 64 * PC;
    LAS bf16* BmT = Bm + 64 * PC;
    LAS bf16* XT0 = BmT + 128 * PS;
    LAS bf16* Mm0 = XT0 + 4 * 64 * PS;
    LAS float* AC0 = (LAS float*)(Mm0 + 2 * 64 * PS);
    static_assert((2 * 64 * PC + 64 * PC + 128 * PS + 4 * 64 * PS + 2 * 64 * PS) * 2 + 4 * 192 * 4 <= RING_BYTES, "ssd pair LDS");
    const int fr = lane & 15, fq = lane >> 4, g = h0 >> 3;
    const int hw = wave >> 2, pt = wave & 3;
    __syncthreads();
    f32x4 hacc[8];
#pragma unroll
    for (int j = 0; j < 8; ++j) hacc[j] = (f32x4){0.f, 0.f, 0.f, 0.f};
    int pf_s[6], pf_c[6]; v4u pf[6];
#pragma unroll
    for (int j = 0; j < 6; ++j) { const int q = tid + 512 * j; pf_s[j] = q / 48; const int c16 = q - 48 * pf_s[j];
        const int col = c16 < 16 ? (h0 + (c16 >> 3)) * 64 + 8 * (c16 & 7) : (c16 < 32 ? 1024 + g * 128 + 8 * (c16 - 16) : 1280 + g * 128 + 8 * (c16 - 32));
        pf_c[j] = (c16 << 16) | col; pf[j] = *(const v4u*)((const char*)XC + (unsigned)(((unsigned)row0 + pf_s[j]) * 1536u + col) * 2u); }
    float pf_ac = 0.f, pf_dt = 0.f, pf_acl = 0.f; const int sh = tid >> 6, ssx = tid & 63;
    if (tid < 128) { pf_ac = *(const float*)((const char*)ACUM + (unsigned)(((unsigned)row0 + ssx) * 16u + h0 + sh) * 4u); pf_dt = *(const float*)((const char*)DTb + (unsigned)(((unsigned)row0 + ssx) * 16u + h0 + sh) * 4u); pf_acl = *(const float*)((const char*)ACUM + (unsigned)(((unsigned)row0 + 63u) * 16u + h0 + sh) * 4u); }
    for (int c = 0; c < 32; ++c) {
        const unsigned rbase = (unsigned)row0 + 64u * c;
        const int cb = c & 1;
        LAS bf16* Cm = Cm0 + cb * 64 * PC; LAS bf16* XTb = XT0 + cb * 2 * 64 * PS; LAS float* ACb = AC0 + cb * 2 * 192;
        if (tid < 128) { LAS float* A = ACb + sh * 192; A[ssx] = pf_ac; A[128 + ssx] = pf_dt; A[64 + ssx] = __expf(pf_acl - pf_ac) * pf_dt; }
#pragma unroll
        for (int j = 0; j < 6; ++j) { const int s = pf_s[j], c16 = pf_c[j] >> 16; const v4u d = pf[j];
            if (c16 < 16) { LAS bf16* XT = XTb + (c16 >> 3) * 64 * PS; const int cc = c16 & 7;
#pragma unroll
                for (int e = 0; e < 8; ++e) XT[(8 * cc + e) * PS + (s ^ (cc << 3))] = v4u_el(d, e); }
            else if (c16 < 32) { const int n0 = 8 * (c16 - 16); *(LAS v4u*)(Bm + s * PC + n0) = d;
#pragma unroll
                for (int e = 0; e < 8; ++e) BmT[(n0 + e) * PS + (s ^ (((c16 - 16) & 7) << 3))] = v4u_el(d, e); }
            else { *(LAS v4u*)(Cm + s * PC + 8 * (c16 - 32)) = d; } }
        if (c + 1 < 32) {
#pragma unroll
            for (int j = 0; j < 6; ++j) pf[j] = *(const v4u*)((const char*)XC + (unsigned)((rbase + 64u + pf_s[j]) * 1536u + (pf_c[j] & 0xffff)) * 2u);
            if (tid < 128) { pf_ac = *(const float*)((const char*)ACUM + (unsigned)((rbase + 64u + ssx) * 16u + h0 + sh) * 4u); pf_dt = *(const float*)((const char*)DTb + (unsigned)((rbase + 64u + ssx) * 16u + h0 + sh) * 4u); pf_acl = *(const float*)((const char*)ACUM + (unsigned)((rbase + 127u) * 16u + h0 + sh) * 4u); } }
        BAR_LDS();
        const LAS float* AC = ACb + hw * 192; const LAS bf16* XT = XTb + hw * 64 * PS;
        f32x4 yo[4];
        { bf16x8_t hb[4];
#pragma unroll
          for (int m = 0; m < 4; ++m) { v4u o; o.x = pk2(hacc[2 * m][0], hacc[2 * m][1]); o.y = pk2(hacc[2 * m][2], hacc[2 * m][3]); o.z = pk2(hacc[2 * m + 1][0], hacc[2 * m + 1][1]); o.w = pk2(hacc[2 * m + 1][2], hacc[2 * m + 1][3]);
              hb[m] = __builtin_bit_cast(bf16x8_t, o); }
#pragma unroll
          for (int li = 0; li < 4; ++li) { yo[li] = (f32x4){0.f, 0.f, 0.f, 0.f};
#pragma unroll
              for (int m = 0; m < 4; ++m) { const LAS bf16* cp = Cm + (16 * li + fr) * PC + 32 * m + 4 * fq; const v2u c0 = *(const LAS v2u*)cp, c1 = *(const LAS v2u*)(cp + 16);
                  v4u xo; xo.x = c0.x; xo.y = c0.y; xo.z = c1.x; xo.w = c1.y; yo[li] = MFMA16(__builtin_bit_cast(bf16x8_t, xo), hb[m], yo[li]); } } }
        { const LAS float* WU = AC + 64; const float dec = __expf(AC[63]);
          bf16x8_t xs[2];
#pragma unroll
          for (int ss = 0; ss < 2; ++ss) { const v4u d = *(const LAS v4u*)(XT + (16 * pt + fr) * PS + ((32 * ss + 8 * fq) ^ (((2 * pt + (fr >> 3)) & 7) << 3)));
              const f32x4 wa = *(const LAS f32x4*)(WU + 32 * ss + 8 * fq), wb = *(const LAS f32x4*)(WU + 32 * ss + 8 * fq + 4);
              v4u o; o.x = pk2(bflo(d.x) * wa.x, bfhi(d.x) * wa.y); o.y = pk2(bflo(d.y) * wa.z, bfhi(d.y) * wa.w); o.z = pk2(bflo(d.z) * wb.x, bfhi(d.z) * wb.y); o.w = pk2(bflo(d.w) * wb.z, bfhi(d.w) * wb.w);
              xs[ss] = __builtin_bit_cast(bf16x8_t, o); }
#pragma unroll
          for (int j = 0; j < 8; ++j) { hacc[j] = hacc[j] * dec;
#pragma unroll
              for (int ss = 0; ss < 2; ++ss) hacc[j] = MFMA16(LDFRAG(BmT, 16 * j + fr, PS, (32 * ss + 8 * fq) ^ (((2 * j + (fr >> 3)) & 7) << 3)), xs[ss], hacc[j]); } }
        {
            const int li = wave >> 1, si0 = 2 * (wave & 1);
#pragma unroll
            for (int tt = 0; tt < 2; ++tt) { const int si = si0 + tt; f32x4 acc = (f32x4){0.f, 0.f, 0.f, 0.f};
                if (si <= li) {
#pragma unroll
                    for (int ks = 0; ks < 4; ++ks) acc = MFMA16(LDFRAG(Cm, 16 * li + fr, PC, 32 * ks + 8 * fq), LDFRAG(Bm, 16 * si + fr, PC, 32 * ks + 8 * fq), acc); }
                const int s = 16 * si + fr;
#pragma unroll
                for (int hh = 0; hh < 2; ++hh) { const LAS float* A2 = ACb + hh * 192; LAS bf16* Mm = Mm0 + hh * 64 * PS; const float acs = A2[s], dts = A2[128 + s];
#pragma unroll
                    for (int r = 0; r < 4; ++r) { const int l = 16 * li + 4 * fq + r; const float m = (s <= l) ? acc[r] * __expf(A2[l] - acs) * dts : 0.f; Mm[l * PS + s] = (bf16)f2bf(m); } } }
        }
        bf16 zr[4][4];
#pragma unroll
        for (int li = 0; li < 4; ++li)
#pragma unroll
            for (int r = 0; r < 4; ++r) zr[li][r] = *(const bf16*)((const char*)P + (unsigned)((rbase + 16 * li + 4 * fq + r) * (unsigned)NPAD + OFF_BZ + (h0 + hw) * 64 + 16 * pt + fr) * 2u);
        BAR_LDS();
        {
            const LAS bf16* Mm = Mm0 + hw * 64 * PS; const int h = h0 + hw; const float Dh = hw ? Dh1 : Dh0; const int p = 16 * pt + fr;
            bf16x8_t xf[2];
#pragma unroll
            for (int ss = 0; ss < 2; ++ss) xf[ss] = LDFRAG(XT, 16 * pt + fr, PS, (32 * ss + 8 * fq) ^ (((2 * pt + (fr >> 3)) & 7) << 3));
#pragma unroll
            for (int li = 0; li < 4; ++li) { f32x4 yd = (f32x4){0.f, 0.f, 0.f, 0.f};
#pragma unroll
                for (int ss = 0; ss < 2; ++ss) { if (ss == 1 && li < 2) continue;
                    yd = MFMA16(LDFRAG(Mm, 16 * li + fr, PS, 32 * ss + 8 * fq), xf[ss], yd); }
#pragma unroll
                for (int r = 0; r < 4; ++r) { const int l = 16 * li + 4 * fq + r; const float y = yd[r] + __expf(AC[l]) * yo[li][r] + Dh * bf1(XT[p * PS + (l ^ (((p >> 3) & 7) << 3))]);
                    const float z = bf1(zr[li][r]);
                    *(bf16*)((char*)YB + (unsigned)((rbase + l) * 1024u + h * 64 + p) * 2u) = (bf16)f2bf(y * siluf_(z)); } }
        }
    }
#pragma unroll
    for (int j = 0; j < 8; ++j) *(f32x4*)(sout0 + (size_t)hw * 8192 + (16 * pt + fr) * 128 + 16 * j + 4 * fq) = hacc[j];
    __syncthreads();
}

__device__ __forceinline__ unsigned cm_off_b(unsigned row, unsigned ch) { return 256u * row + 16u * (ch ^ (((row & 3u) << 2) | ((row >> 2) & 3u))); }
__device__ __forceinline__ unsigned cm_tr_addr(unsigned lane, unsigned c, unsigned ks, unsigned t) { const unsigned g = lane >> 4, q = (lane & 15) >> 2, p = lane & 3; return cm_off_b(32 * ks + 8 * g + 4 * t + q, 2 * c + (p >> 1)) + 8 * (p & 1); }
__device__ __forceinline__ void cmlp_mfma_item(LAS unsigned char* lds, int tid, int lane, int wave, bf16* P, bf16* YC, int row0, const float* ln_g, const float* ln_b, const float* wsl, const float* bsl) {
    constexpr int PW = 136;
    LAS bf16* Wb = (LAS bf16*)lds;
    LAS unsigned char* Vimg = lds + 34816;
    LAS bf16* OUTb = (LAS bf16*)(lds + 67584);
    LAS float* ST = (LAS float*)(lds + ST_OFF);
    const int fr = lane & 15, fq = lane >> 4;
    __syncthreads();
    for (int i = 0; i < 16; ++i) { const int s = wave * 16 + i;
        v4u* p = (v4u*)(P + (size_t)(row0 + s) * NPAD + OFF_CV + 16 * lane); const v4u a = p[0], b = p[1];
        float v[16]; v[0] = bflo(a.x); v[1] = bfhi(a.x); v[2] = bflo(a.y); v[3] = bfhi(a.y); v[4] = bflo(a.z); v[5] = bfhi(a.z); v[6] = bflo(a.w); v[7] = bfhi(a.w);
        v[8] = bflo(b.x); v[9] = bfhi(b.x); v[10] = bflo(b.y); v[11] = bfhi(b.y); v[12] = bflo(b.z); v[13] = bfhi(b.z); v[14] = bflo(b.w); v[15] = bfhi(b.w);
        float sm = 0.f;
#pragma unroll
        for (int j = 0; j < 16; ++j) { v[j] = geluf_(v[j]); sm += v[j]; }
        v4u oa, ob; oa.x = pk2(v[0], v[1]); oa.y = pk2(v[2], v[3]); oa.z = pk2(v[4], v[5]); oa.w = pk2(v[6], v[7]); ob.x = pk2(v[8], v[9]); ob.y = pk2(v[10], v[11]); ob.z = pk2(v[12], v[13]); ob.w = pk2(v[14], v[15]);
        p[0] = oa; p[1] = ob;
        const float mean = wave_sum(sm) * (1.0f / 1024.0f); float sq = 0.f;
#pragma unroll
        for (int j = 0; j < 16; ++j) { const float d = v[j] - mean; sq += d * d; }
        const float rstd = rsqrtf_(wave_sum(sq) * (1.0f / 1024.0f) + NORM_EPS);
        if (lane == 0) { ST[2 * s] = mean; ST[2 * s + 1] = rstd; } }
    __syncthreads();
    f32x4 wreg[8]; v2u vreg[8];
#pragma unroll
    for (int e = 0; e < 8; ++e) { const int q = tid + 512 * e; wreg[e] = *(const f32x4*)(wsl + (size_t)(q >> 5) * 128 + 4 * (q & 31)); vreg[e] = *(const v2u*)(P + (size_t)(row0 + (q >> 5)) * NPAD + OFF_CV + 4 * (q & 31)); }
    for (int gh = 0; gh < 8; ++gh) { const int g = gh >> 1, c0 = gh * 128;
        if ((gh & 1) == 0) {
#pragma unroll
            for (int e = 0; e < 8; ++e) { const int q = tid + 512 * e, t = q >> 5, s4 = 4 * (q & 31); const f32x4 w = wreg[e];
                v2u o; o.x = pk2(s4 + 0 <= t ? w.x : 0.f, s4 + 1 <= t ? w.y : 0.f); o.y = pk2(s4 + 2 <= t ? w.z : 0.f, s4 + 3 <= t ? w.w : 0.f); *(LAS v2u*)(Wb + t * PW + s4) = o; } }
#pragma unroll
        for (int e = 0; e < 8; ++e) { const int q = tid + 512 * e, sr = q >> 5, c4 = 4 * (q & 31); const v2u cv = vreg[e]; const float mean = ST[2 * sr], rstd = ST[2 * sr + 1];
            const f32x4 lg = *(const f32x4*)(ln_g + c0 + c4), lb = *(const f32x4*)(ln_b + c0 + c4);
            v2u o; o.x = pk2((bflo(cv.x) - mean) * rstd * lg.x + lb.x, (bfhi(cv.x) - mean) * rstd * lg.y + lb.y); o.y = pk2((bflo(cv.y) - mean) * rstd * lg.z + lb.z, (bfhi(cv.y) - mean) * rstd * lg.w + lb.w);
            *(LAS v2u*)(Vimg + cm_off_b((unsigned)sr, (unsigned)(c4 >> 3)) + 2 * (c4 & 7)) = o; }
        v4u ureg[4];
#pragma unroll
        for (int e = 0; e < 4; ++e) { const int q = tid + 512 * e; ureg[e] = *(const v4u*)(P + (size_t)(row0 + (q >> 4)) * NPAD + OFF_CU + c0 + 8 * (q & 15)); }
        if (gh + 1 < 8) {
#pragma unroll
            for (int e = 0; e < 8; ++e) { const int q = tid + 512 * e; vreg[e] = *(const v2u*)(P + (size_t)(row0 + (q >> 5)) * NPAD + OFF_CV + c0 + 128 + 4 * (q & 31)); }
            if (gh & 1) {
#pragma unroll
                for (int e = 0; e < 8; ++e) { const int q = tid + 512 * e; wreg[e] = *(const f32x4*)(wsl + ((size_t)(g + 1) * 128 + (q >> 5)) * 128 + 4 * (q & 31)); } } }
        BAR_LDS();
        { f32x4 acc[8];
#pragma unroll
            for (int ti = 0; ti < 8; ++ti) acc[ti] = (f32x4){0.f, 0.f, 0.f, 0.f};
            const unsigned vb = (unsigned)(size_t)Vimg;
#pragma unroll
            for (int ks = 0; ks < 4; ++ks) { v2u y0, y1;
                asm volatile("ds_read_b64_tr_b16 %0, %2\n\tds_read_b64_tr_b16 %1, %3\n\ts_waitcnt lgkmcnt(0)" : "=&v"(y0), "=&v"(y1) : "v"(vb + cm_tr_addr((unsigned)lane, (unsigned)wave, (unsigned)ks, 0u)), "v"(vb + cm_tr_addr((unsigned)lane, (unsigned)wave, (unsigned)ks, 1u)) : "memory");
                v4u yy; yy.x = y0.x; yy.y = y0.y; yy.z = y1.x; yy.w = y1.y; const bf16x8_t yf = __builtin_bit_cast(bf16x8_t, yy);
#pragma unroll
                for (int ti = 2 * ks; ti < 8; ++ti) acc[ti] = MFMA16(LDFRAG(Wb, 16 * ti + fr, PW, 32 * ks + 8 * fq), yf, acc[ti]); }
#pragma unroll
            for (int ti = 0; ti < 8; ++ti)
#pragma unroll
                for (int r = 0; r < 4; ++r) OUTb[(16 * ti + 4 * fq + r) * PW + 16 * wave + fr] = (bf16)f2bf(acc[ti][r]); }
        BAR_LDS();
#pragma unroll
        for (int e = 0; e < 4; ++e) { const int q = tid + 512 * e, t = q >> 4, c8 = 8 * (q & 15); const v4u o = *(const LAS v4u*)(OUTb + t * PW + c8); const v4u u = ureg[e]; const float bsv = bsl[g * 128 + t];
            v4u y; y.x = pk2(geluf_(bflo(u.x)) * (bflo(o.x) + bsv), geluf_(bfhi(u.x)) * (bfhi(o.x) + bsv)); y.y = pk2(geluf_(bflo(u.y)) * (bflo(o.y) + bsv), geluf_(bfhi(u.y)) * (bfhi(o.y) + bsv));
            y.z = pk2(geluf_(bflo(u.z)) * (bflo(o.z) + bsv), geluf_(bfhi(u.z)) * (bfhi(o.z) + bsv)); y.w = pk2(geluf_(bflo(u.w)) * (bflo(o.w) + bsv), geluf_(bfhi(u.w)) * (bfhi(o.w) + bsv));
            *(v4u*)(YC + (size_t)(row0 + t) * 1024 + c0 + c8) = y; }
    }
    __syncthreads();
}

__device__ __forceinline__ void cmlp_item(LAS unsigned char* lds, int tid, int lane, int wave, const bf16* P, bf16* YC, int row0, int Lc,
                                          const float* ln_g, const float* ln_b, const float* wsl, const float* bsl, float* vout) {
    LAS float* WT = (LAS float*)lds;
    LAS float* V = WT + 16384;
    LAS float* ST = (LAS float*)(lds + ST_OFF);
    __syncthreads();
    for (int i = 0; i < 16; ++i) { const int s = wave * 16 + i; if (s < Lc) {
            const v4u* p = (const v4u*)(P + (size_t)(row0 + s) * NPAD + OFF_CV + 16 * lane); const v4u a = p[0], b = p[1];
            float v[16]; v[0] = bflo(a.x); v[1] = bfhi(a.x); v[2] = bflo(a.y); v[3] = bfhi(a.y); v[4] = bflo(a.z); v[5] = bfhi(a.z); v[6] = bflo(a.w); v[7] = bfhi(a.w);
            v[8] = bflo(b.x); v[9] = bfhi(b.x); v[10] = bflo(b.y); v[11] = bfhi(b.y); v[12] = bflo(b.z); v[13] = bfhi(b.z); v[14] = bflo(b.w); v[15] = bfhi(b.w);
            float sm = 0.f;
#pragma unroll
            for (int j = 0; j < 16; ++j) { v[j] = geluf_(v[j]); sm += v[j]; }
            const float mean = wave_sum(sm) * (1.0f / 1024.0f); float sq = 0.f;
#pragma unroll
            for (int j = 0; j < 16; ++j) { const float d = v[j] - mean; sq += d * d; }
            const float rstd = 1.0f / sqrtf(wave_sum(sq) * (1.0f / 1024.0f) + NORM_EPS);
            if (lane == 0) { ST[2 * s] = mean; ST[2 * s + 1] = rstd; } } }
    const int tg = tid >> 4, cg = tid & 15;
    for (int g = 0; g < 4; ++g) {
        __syncthreads();
#pragma unroll 1
        for (int j = 0; j < 8; ++j) { const int e = tid + 512 * j, s4 = (e >> 7) * 4, t = e & 127;
            f32x4 w = (f32x4){0.f, 0.f, 0.f, 0.f}; if (t < Lc && s4 < Lc) w = *(const f32x4*)(wsl + ((size_t)g * 128 + t) * 128 + s4);
#pragma unroll
            for (int jj = 0; jj < 4; ++jj) WT[(s4 + jj) * 128 + t] = (s4 + jj <= t) ? w[jj] : 0.f; }
        for (int half = 0; half < 2; ++half) { const int c0 = g * 256 + half * 128;
            if (half) __syncthreads();
#pragma unroll 2
            for (int j = 0; j < 8; ++j) { const int e = tid + 512 * j, s = e >> 5, c4 = (e & 31) * 4;
                if (s < Lc) { const v2u cv = *(const v2u*)(P + (size_t)(row0 + s) * NPAD + OFF_CV + c0 + c4); const float mean = ST[2 * s], rstd = ST[2 * s + 1];
                    const f32x4 lg = *(const f32x4*)(ln_g + c0 + c4), lb = *(const f32x4*)(ln_b + c0 + c4);
                    f32x4 v; v.x = (geluf_(bflo(cv.x)) - mean) * rstd * lg.x + lb.x; v.y = (geluf_(bfhi(cv.x)) - mean) * rstd * lg.y + lb.y; v.z = (geluf_(bflo(cv.y)) - mean) * rstd * lg.z + lb.z; v.w = (geluf_(bfhi(cv.y)) - mean) * rstd * lg.w + lb.w;
                    *(LAS f32x4*)(V + s * 128 + c4) = v; if (vout) *(f32x4*)(vout + (size_t)s * 1024 + c0 + c4) = v; } }
            __syncthreads();
            float acc[4][8];
#pragma unroll
            for (int i = 0; i < 4; ++i)
#pragma unroll
                for (int j = 0; j < 8; ++j) acc[i][j] = 0.f;
            for (int s = 0; s < Lc; ++s) { const f32x4 w4 = *(const LAS f32x4*)(WT + s * 128 + 4 * tg), va = *(const LAS f32x4*)(V + s * 128 + 4 * cg), vb = *(const LAS f32x4*)(V + s * 128 + 64 + 4 * cg);
#pragma unroll
                for (int i = 0; i < 4; ++i) {
#pragma unroll
                    for (int j = 0; j < 4; ++j) { acc[i][j] = fmaf(w4[i], va[j], acc[i][j]); acc[i][4 + j] = fmaf(w4[i], vb[j], acc[i][4 + j]); } } }
#pragma unroll
            for (int i = 0; i < 4; ++i) { const int t = 4 * tg + i; if (t < Lc) { const size_t row = (size_t)(row0 + t); const float bsv = bsl[g * 128 + t];
                    const v2u ua = *(const v2u*)(P + row * NPAD + OFF_CU + c0 + 4 * cg), ub = *(const v2u*)(P + row * NPAD + OFF_CU + c0 + 64 + 4 * cg);
                    v2u oa, ob; oa.x = pk2(geluf_(bflo(ua.x)) * (acc[i][0] + bsv), geluf_(bfhi(ua.x)) * (acc[i][1] + bsv)); oa.y = pk2(geluf_(bflo(ua.y)) * (acc[i][2] + bsv), geluf_(bfhi(ua.y)) * (acc[i][3] + bsv));
                    ob.x = pk2(geluf_(bflo(ub.x)) * (acc[i][4] + bsv), geluf_(bfhi(ub.x)) * (acc[i][5] + bsv)); ob.y = pk2(geluf_(bflo(ub.y)) * (acc[i][6] + bsv), geluf_(bfhi(ub.y)) * (acc[i][7] + bsv));
                    *(v2u*)(YC + row * 1024 + c0 + 4 * cg) = oa; *(v2u*)(YC + row * 1024 + c0 + 64 + 4 * cg) = ob; } }
        }
    }
    __syncthreads();
}

#ifndef DOWN_REV
#define DOWN_REV 1
#endif
#ifndef EPI_ALIGN_HEAVY
#define EPI_ALIGN_HEAVY true
#endif
#ifndef TAIL_SPLIT
#define TAIL_SPLIT 1
#endif
#ifndef MK_N_LAUNCHES
#define MK_N_LAUNCHES 1
#endif
constexpr int PH_PER_LAYER = 10, N_PHASES = 2 + DEPTH * PH_PER_LAYER;
constexpr int Q_NITEMS = 128 + 128 + 256 + 256 + 512 + 32;
struct Args { const float* in[29]; float* out; unsigned char* ws; int ph_lo, ph_hi; };
static_assert(sizeof(Args) == 29 * 8 + 8 + 8 + 8, "no padding in Args");

typedef const __attribute__((address_space(4))) unsigned long long* karg_t;
__device__ __forceinline__ unsigned long long ldarg(int i) { karg_t p = (karg_t)__builtin_amdgcn_kernarg_segment_ptr(); asm volatile("" : "+s"(p)); return p[i]; }
#define INP(i) ((const float*)ldarg(i))
#define OUTP() ((float*)ldarg(29))
#define WSP() ((unsigned char*)ldarg(30))

__device__ __forceinline__ int tid_now(int wave_s) { return (int)__builtin_amdgcn_mbcnt_hi(~0u, __builtin_amdgcn_mbcnt_lo(~0u, 0u)) + 64 * wave_s; }
__global__ void __launch_bounds__(NWAVES * 64, 2) fwd(Args args) {
    extern __shared__ __attribute__((aligned(16))) unsigned char lds_raw[];
    LAS unsigned char* lds = (LAS unsigned char*)lds_raw;
    volatile LAS unsigned* MISC = (volatile LAS unsigned*)(lds + MISC_OFF);
    const int wave_s = __builtin_amdgcn_readfirstlane((int)threadIdx.x >> 6);
    for (int u = threadIdx.x; u < 64; u += NWAVES * 64) MISC[u] = 0u;
    __syncthreads();
    XcdBarrier bar = xcd_barrier_post((unsigned*)WSP() + CW_BAR, MISC + 8, (int)threadIdx.x);
    const int lo = args.ph_lo, hi = args.ph_hi;
#define IN(k) (lo <= (k) && (k) < hi)
#define SEAM(k) do { if (IN((k) + 1)) { XcdBarrier b2_ = bar; b2_.bar = (unsigned*)WSP() + CW_BAR; asm volatile("" : "+s"(b2_.x)); xcd_barrier(b2_, tid_now(wave_s)); } } while (0)
#define GEOM() int tid = tid_now(wave_s); asm volatile("" : "+v"(tid)); int G = gridDim.x, bx = blockIdx.x; asm volatile("" : "+s"(G), "+s"(bx)); \
    const int lane = tid & 63, wave = __builtin_amdgcn_readfirstlane(tid >> 6); \
    const int vcu = (G % 8 == 0) ? (bx % 8) * (G / 8) + bx / 8 : bx; const int gw = vcu * NWAVES + wave, NGW = G * NWAVES; (void)lane; (void)gw; (void)NGW; (void)wave; (void)tid

    if (IN(0)) { GEOM();
        for (int it = bx; it < DEPTH * 96; it += G) mod_item(lds, tid, it, INP(5), INP(6), INP(9), INP(10), (float*)(WSP() + WS_MOD));
        { unsigned char* ws = WSP(); cvt_phase<true>(lds, wave, lane, 0, 0, 0, INP(11), INP(24), INP(25), INP(26), INP(27), ws + wofs(0), (unsigned*)ws + CW_QC); }
        SEAM(0);
    }
    for (int lc = 0; lc < DEPTH; ++lc) {
        const int pb = 1 + PH_PER_LAYER * lc;
        if (IN(pb + 0)) { GEOM(); int l = lc; asm volatile("" : "+s"(l)); unsigned char* ws = WSP(); bf16* X = (bf16*)(ws + WS_X);
            const bool comb = TAIL_SPLIT && l > 0; if (comb) build_tail_map((LAS int*)lds, tid, G, DOWN_REV);
            const float* modl = (const float*)(ws + WS_MOD) + (size_t)l * NSEQ * 12288;
            if (l == 0) norm_mod_phase<true>(lane, gw, NGW, INP(0), INP(1), X, INP(7), modl, 0, 1, (bf16*)(ws + WS_H), false, (const LAS int*)lds, (const float*)(ws + WS_SLAB), false);
            else norm_mod_phase<false>(lane, gw, NGW, nullptr, nullptr, X, INP(7) + l * DM, modl, 0, 1, (bf16*)(ws + WS_H), comb, (const LAS int*)lds, (const float*)(ws + WS_SLAB), false);
            SEAM(pb + 0);
        }
        if (IN(pb + 1)) { unsigned char* ws = WSP(); const int G = gridDim.x, bx = blockIdx.x;
            pg8::Gemm g{(const bf16*)(ws + WS_H), (const bf16*)(ws + wofs(lc) + WS_WIN), MT, NPAD, DM, DM}; pg8::StaticOrder S; S.init(MT, NPAD, G, bx);
            pg8::EpiStore<0> E{(bf16*)(ws + WS_P), NPAD};
#ifndef REP_P1
#define REP_P1 1
#endif
#pragma unroll 1
            for (int rp = 0; rp < REP_P1; ++rp)
#ifndef WIN_B_AUX
#define WIN_B_AUX 0
#endif
#ifdef SPLIT_WIN
            { S.nlim = (S.nwg / (2 * G)) * G; pg8::gemm_phase<pg8::EpiStore<0>, pg8::StaticOrder, true, true, 0, WIN_B_AUX>(lds, g, S, E, tid_now(wave_s));
              { XcdBarrier b2_ = bar; b2_.bar = (unsigned*)WSP() + CW_BAR; asm volatile("" : "+s"(b2_.x)); xcd_barrier(b2_, tid_now(wave_s)); }
              S.off = S.nlim; S.nlim = S.nwg; }
#endif
            pg8::gemm_phase<pg8::EpiStore<0>, pg8::StaticOrder, true, true, 0, WIN_B_AUX>(lds, g, S, E, tid_now(wave_s));
            SEAM(pb + 1);
        }
        if (IN(pb + 2)) { GEOM(); int l = lc; asm volatile("" : "+s"(l)); unsigned char* ws = WSP(); float* out = OUTP();
#ifndef REP_P2
#define REP_P2 1
#endif
#pragma unroll 1
            for (int rp = 0; rp < REP_P2; ++rp)
            ssd_pre_phase(lane, gw, NGW, (const bf16*)(ws + WS_P), (bf16*)(ws + WS_XC), (float*)(ws + WS_DT), (float*)(ws + WS_DT + DT_ARR), (float*)(ws + WS_DT + 2 * DT_ARR),
                          INP(14) + (size_t)l * 4 * 1536, INP(15) + l * 1536, INP(16) + l * 16, INP(17) + l * 16, INP(4) + (size_t)l * 32 * 4608, out + OUT_CONV_P + (size_t)l * 16 * 4608, out + OUT_CONV_S + (size_t)l * 32 * 4608);
            SEAM(pb + 2);
        }
        if (IN(pb + 3)) { GEOM(); int l = lc; asm volatile("" : "+s"(l));
#ifndef MIX_REPS
#define MIX_REPS 1
#endif
#pragma unroll 1
            for (int rep = 0; rep < MIX_REPS; ++rep)
            for (;;) {
                unsigned char* ws = WSP(); float* out = OUTP(); bf16* Pb = (bf16*)(ws + WS_P); bf16* Y3 = (bf16*)(ws + WS_Y3);
                __syncthreads();
                if (tid_now(wave_s) == 0) MISC[0] = __hip_atomic_fetch_add((unsigned*)ws + CW_Q + 64 * (l + 4 * rep), 1u, __ATOMIC_RELAXED, __HIP_MEMORY_SCOPE_AGENT);
                __syncthreads();
                int it = (int)MISC[0];
#ifdef EXTRA_BASE
                if (it >= Q_NITEMS && it < Q_NITEMS + EXTRA_N) it = EXTRA_BASE + (it - Q_NITEMS);
#endif
                if (it >= Q_NITEMS) break;
#define ITEM_GEOM() int tid_i = tid_now(wave_s); asm volatile("" : "+v"(tid_i)); const int lane_i = tid_i & 63, wave_i = __builtin_amdgcn_readfirstlane(tid_i >> 6)
                if (it < 128) {
                    const int b = 15 - (it >> 3), h = it & 7;
                    ITEM_GEOM(); hgrn_mfma_item(lds, tid_i, lane_i, wave_i, Pb, Y3, b * 2048, h, l, out + OUT_HGRN_P + (((size_t)l * 16 + b) * 8 + h) * 16384, INP(12), INP(13) + l * 1024);
                } else if (it < 256) {
                    const int j = it - 128, b = 15 - (j >> 3), h0 = 2 * (j & 7);
                    ITEM_GEOM(); ssd_mfma_pair(lds, tid_i, lane_i, wave_i, Pb, (const bf16*)(ws + WS_XC), (const float*)(ws + WS_DT), (const float*)(ws + WS_DT + 2 * DT_ARR), Y3 + (size_t)MT * 1024, b * 2048, h0, INP(18)[l * 16 + h0], INP(18)[l * 16 + h0 + 1],
                                  out + OUT_SSM_P + (((size_t)l * 16 + b) * 16 + h0) * 8192);
                } else if (it < 512) {
                    ITEM_GEOM(); cmlp_mfma_item(lds, tid_i, lane_i, wave_i, Pb, Y3 + (size_t)2 * MT * 1024, (255 - (it - 256)) * 128, INP(20) + l * 1024, INP(21) + l * 1024, INP(22) + (size_t)l * 4 * 16384, INP(23) + l * 512);
                } else if (it < 768) {
                    const int j = it - 512, b = j >> 3, h = j & 7;
                    ITEM_GEOM(); hgrn_item(lds, tid_i, lane_i, wave_i, Pb, Y3, NTOK_P + b * 32, 32, h, l, INP(2) + (((size_t)l * 32 + b) * 8 + h) * 16384, out + OUT_HGRN_S + (((size_t)l * 32 + b) * 8 + h) * 16384, INP(12), INP(13) + l * 1024);
                } else if (it < 1280) {
                    const int j = it - 768, b = j >> 4, h = j & 15;
                    ITEM_GEOM(); ssd_item(lds, tid_i, lane_i, wave_i, Pb, (const bf16*)(ws + WS_XC), (const float*)(ws + WS_DT), (const float*)(ws + WS_DT + DT_ARR), Y3 + (size_t)MT * 1024, NTOK_P + b * 32, 32, h,
                             INP(3) + (((size_t)l * 32 + b) * 16 + h) * 8192, out + OUT_SSM_S + (((size_t)l * 32 + b) * 16 + h) * 8192, INP(18)[l * 16 + h]);
                } else {
                    const int j = it - 1280;
                    ITEM_GEOM(); cmlp_item(lds, tid_i, lane_i, wave_i, Pb, Y3 + (size_t)2 * MT * 1024, NTOK_P + j * 32, 32, INP(20) + l * 1024, INP(21) + l * 1024, INP(22) + (size_t)l * 4 * 16384, INP(23) + l * 512, out + OUT_V_S + ((size_t)l * 32 + j) * 32 * 1024);
                }
            }
            SEAM(pb + 3);
        }
        if (IN(pb + 4)) { GEOM(); int l = lc; asm volatile("" : "+s"(l)); ssd_norm_phase(lane, gw, NGW, (bf16*)(WSP() + WS_Y3) + (size_t)MT * 1024, INP(19) + l * 1024); SEAM(pb + 4); }
        if (IN(pb + 5)) { unsigned char* ws = WSP(); const int G = gridDim.x, bx = blockIdx.x;
            pg8::Gemm g{(const bf16*)(ws + WS_Y3), (const bf16*)(ws + wofs(lc) + WS_WBR), 3 * MT, 3 * DM, 1024, 1024}; pg8::BranchOrder S; S.init(MT / 256, DM / 256, G, bx);
            pg8::EpiBranch E{(const bf16*)(ws + WS_P), NPAD, OFF_GATE, (bf16*)(ws + WS_H), DM, MT / 256, DM / 256};
#ifndef STAGGER_BR
#define STAGGER_BR 0
#endif
            if (STAGGER_BR && ((bx >> 3) & 1)) { for (int i = 0; i < STAGGER_BR; ++i) __builtin_amdgcn_s_sleep(127); }
#ifndef REP_P5
#define REP_P5 1
#endif
#pragma unroll 1
            for (int rp = 0; rp < REP_P5; ++rp)
            pg8::gemm_phase<pg8::EpiBranch, pg8::BranchOrder, EPI_ALIGN_HEAVY, true>(lds, g, S, E, tid_now(wave_s));
            if (lc + 1 < DEPTH) {
                GEOM(); int l1 = lc + 1; asm volatile("" : "+s"(l1)); unsigned char* ws2 = WSP();
                cvt_phase<true>(lds, wave, lane, 0, 0, l1, INP(11), INP(24), INP(25), INP(26), INP(27), ws2 + wofs(l1), (unsigned*)ws2 + CW_QC + 64 * l1);
#ifdef REP_CVT
                cvt_phase<true>(lds, wave, lane, 0, 0, l1, INP(11), INP(24), INP(25), INP(26), INP(27), ws2 + wofs(l1), (unsigned*)ws2 + CW_QC + 64 * (l1 + 4));
#endif
            }
            SEAM(pb + 5);
        }
        if (IN(pb + 6)) { int l = lc; asm volatile("" : "+s"(l)); unsigned char* ws = WSP(); bf16* X = (bf16*)(ws + WS_X); const int G = gridDim.x, bx = blockIdx.x;
            pg8::StaticOrder S; S.init(MT, DM, G, bx); S.wgm = WGM_N8; const int nfull = TAIL_SPLIT ? tail_nfull(S.nwg, G) : S.nwg; S.nlim = nfull;
            const float* gm = (const float*)(ws + WS_MOD) + (size_t)l * NSEQ * 12288 + 2 * DM;
            { pg8::Gemm g{(const bf16*)(ws + WS_H), (const bf16*)(ws + wofs(lc) + WS_WOUT), MT, DM, DM, DM};
#ifdef REP_P6
              { pg8::EpiRes E0{X, (const float*)(ws + 524288), 0}; pg8::gemm_phase<pg8::EpiRes, pg8::StaticOrder, EPI_ALIGN_HEAVY, true>(lds, g, S, E0, tid_now(wave_s)); }
#endif
              pg8::EpiRes E{X, gm, 12288};
              pg8::gemm_phase<pg8::EpiRes, pg8::StaticOrder, EPI_ALIGN_HEAVY, true>(lds, g, S, E, tid_now(wave_s)); }
            if (TAIL_SPLIT) { pg8::Gemm g{(const bf16*)(ws + WS_H), (const bf16*)(ws + wofs(lc) + WS_WOUT), MT, DM, DM / 8, DM}; pg8::TailOrder T; T.init(S, nfull, 8, DM / 8);
              pg8::EpiSlab E{(float*)(ws + WS_SLAB), gm};
              pg8::gemm_phase<pg8::EpiSlab, pg8::TailOrder, true, true>(lds, g, T, E, tid_now(wave_s)); }
            SEAM(pb + 6);
        }
        if (IN(pb + 7)) { GEOM(); int l = lc; asm volatile("" : "+s"(l)); unsigned char* ws = WSP(); bf16* X = (bf16*)(ws + WS_X);
            if (TAIL_SPLIT) build_tail_map((LAS int*)lds, tid, G, 0);
#ifdef REP_N7
            norm_mod_phase<false>(lane, gw, NGW, nullptr, nullptr, X, INP(8) + l * DM, (const float*)(ws + WS_MOD) + (size_t)l * NSEQ * 12288, 3, 4, (bf16*)(ws + WS_H), false, (const LAS int*)lds, (const float*)(ws + WS_SLAB), true);
#endif
            norm_mod_phase<false>(lane, gw, NGW, nullptr, nullptr, X, INP(8) + l * DM, (const float*)(ws + WS_MOD) + (size_t)l * NSEQ * 12288, 3, 4, (bf16*)(ws + WS_H), TAIL_SPLIT != 0, (const LAS int*)lds, (const float*)(ws + WS_SLAB), true); SEAM(pb + 7); }
        if (IN(pb + 8)) { unsigned char* ws = WSP(); const int G = gridDim.x, bx = blockIdx.x;
            pg8::Gemm g{(const bf16*)(ws + WS_H), (const bf16*)(ws + wofs(lc) + WS_WUP), MT, DFF, DM, DM}; pg8::StaticOrder S; S.init(MT, DFF, G, bx);
            pg8::EpiStore<1> E{(bf16*)(ws + WS_P), DFF};
#ifndef REP_P8
#define REP_P8 1
#endif
#pragma unroll 1
            for (int rp = 0; rp < REP_P8; ++rp)
            pg8::gemm_phase<pg8::EpiStore<1>, pg8::StaticOrder, true, true, 0, WIN_B_AUX>(lds, g, S, E, tid_now(wave_s));
            SEAM(pb + 8);
        }
        if (IN(pb + 9)) { int l = lc; asm volatile("" : "+s"(l)); unsigned char* ws = WSP(); bf16* X = (bf16*)(ws + WS_X); const int G = gridDim.x, bx = blockIdx.x;
            pg8::StaticOrder S; S.init(MT, DM, G, bx); S.wgm = WGM_N8; S.rev = DOWN_REV; const int nfull = TAIL_SPLIT ? tail_nfull(S.nwg, G) : S.nwg; S.nlim = nfull;
            const float* gm = (const float*)(ws + WS_MOD) + (size_t)l * NSEQ * 12288 + 5 * DM;
            { pg8::Gemm g{(const bf16*)(ws + WS_P), (const bf16*)(ws + wofs(lc) + WS_WDN), MT, DM, DFF, DFF};
#ifdef REP_P9
              { pg8::EpiRes E0{X, (const float*)(ws + 524288), 0}; pg8::gemm_phase<pg8::EpiRes, pg8::StaticOrder, EPI_ALIGN_HEAVY, true>(lds, g, S, E0, tid_now(wave_s)); }
#endif
              pg8::EpiRes E{X, gm, 12288};
#ifndef DOWN_A_AUX
#define DOWN_A_AUX 0
#endif
              pg8::gemm_phase<pg8::EpiRes, pg8::StaticOrder, EPI_ALIGN_HEAVY, true, DOWN_A_AUX>(lds, g, S, E, tid_now(wave_s)); }
            if (TAIL_SPLIT) { pg8::Gemm g{(const bf16*)(ws + WS_P), (const bf16*)(ws + wofs(lc) + WS_WDN), MT, DM, DFF / 8, DFF}; pg8::TailOrder T; T.init(S, nfull, 8, DFF / 8);
              pg8::EpiSlab E{(float*)(ws + WS_SLAB), gm};
              pg8::gemm_phase<pg8::EpiSlab, pg8::TailOrder, true, true>(lds, g, T, E, tid_now(wave_s)); }
            SEAM(pb + 9);
        }
    }
    if (IN(N_PHASES - 1)) { GEOM(); unsigned char* ws = WSP(); if (TAIL_SPLIT) build_tail_map((LAS int*)lds, tid, G, DOWN_REV);
        final_norm_phase(lane, gw, NGW, (const bf16*)(ws + WS_X), OUTP(), INP(28), TAIL_SPLIT != 0, (const LAS int*)lds, (const float*)(ws + WS_SLAB)); }
#undef IN
#undef SEAM
#undef GEOM
}

extern "C" void kernel_launch(void* const* d_in, const int* in_sizes, int n_in, void* d_out, int out_size, void* d_ws, size_t ws_size, hipStream_t stream) {
    static int grid = 0;
    if (grid == 0) {
        if (n_in != 29 || (size_t)out_size != OUT_TOTAL || ws_size < WS_END) { fprintf(stderr, "kernel_launch: unexpected shapes: n_in %d out %d ws %zu (need %zu)\n", n_in, out_size, ws_size, (size_t)WS_END); grid = -1; return; }
        int dev = 0, cus = 0, per_cu = 0;
        if (hipGetDevice(&dev) != hipSuccess || hipDeviceGetAttribute(&cus, hipDeviceAttributeMultiprocessorCount, dev) != hipSuccess) { grid = -1; return; }
        if (hipFuncSetAttribute((const void*)fwd, hipFuncAttributeMaxDynamicSharedMemorySize, LDS_BYTES) != hipSuccess) { fprintf(stderr, "kernel_launch: hipFuncSetAttribute failed\n"); grid = -1; return; }
        if (hipOccupancyMaxActiveBlocksPerMultiprocessor(&per_cu, (const void*)fwd, NWAVES * 64, LDS_BYTES) != hipSuccess || per_cu < 1) fprintf(stderr, "kernel_launch: occupancy query says %d\n", per_cu);
        (void)hipGetLastError();
        grid = cus;
    }
    if (grid < 0) return;
    if (hipMemsetAsync((char*)d_ws + WS_CTL, 0, CTL_ZERO_BYTES, stream) != hipSuccess) return;
    Args a{};
    for (int i = 0; i < 29; ++i) a.in[i] = (const float*)d_in[i];
    a.out = (float*)d_out; a.ws = (unsigned char*)d_ws;
#if MK_N_LAUNCHES == 1
    a.ph_lo = 0; a.ph_hi = N_PHASES;
    hipLaunchKernelGGL(fwd, dim3(grid), dim3(NWAVES * 64), LDS_BYTES, stream, a);
#else
    for (int p = 0; p < N_PHASES; ++p) { a.ph_lo = p; a.ph_hi = p + 1; hipLaunchKernelGGL(fwd, dim3(grid), dim3(NWAVES * 64), LDS_BYTES, stream, a); }
#endif
}
```

```cpp
#include <hip/hip_runtime.h>
#include <cstdio>
#include <cstdint>
namespace pg8 {
#define PG8_LAS __attribute__((address_space(3)))
typedef unsigned short bf16_t;
typedef short bf16x8 __attribute__((ext_vector_type(8)));
typedef float f32x4 __attribute__((ext_vector_type(4)));
typedef unsigned u32x4 __attribute__((ext_vector_type(4)));
constexpr int BM = 256, BK = 64, HALF = 128, HTB = HALF * BK * 2  , STAGE_BYTES = 8 * HTB, NXCD = 8, WGM = 4;

__host__ __device__ __forceinline__ int lds_byte(int r, int c) { const int st = (r >> 4) * 2 + (c >> 5), rr = r & 15, cc = c & 31, ob = rr * 64 + cc * 2; return st * 1024 + (ob ^ (((ob >> 9) & 1) << 5)); }
__host__ __device__ __forceinline__ void stage_rc(int b, int& R, int& C) { const int st = b / 1024, sb = b % 1024, swz = sb ^ (((sb >> 9) & 1) << 5); R = (st >> 1) * 16 + swz / 64; C = (st & 1) * 32 + (swz % 64) / 2; }
__host__ __device__ __forceinline__ int perm32(int rho) { const int n = rho >> 4, i = rho & 15; return 8 * (i >> 2) + 4 * n + (i & 3); }

struct Unit { int pm, pn, ko, aux; };
struct Gemm { const bf16_t* A; const bf16_t* Bt; int M, N, K, ld; };

struct StaticOrder {
    int nM, nN, nwg, G, c, nlim, rev, wgm, off;
    __host__ __device__ void init(int M, int N, int G_, int c_) { nM = M / BM; nN = N / BM; nwg = nM * nN; G = G_; c = c_; nlim = nwg; rev = 0; wgm = WGM; off = 0; }
    __host__ __device__ void tile_of(int wgid, Unit& u) const {
        { const int q = nwg / NXCD, r = nwg % NXCD, xcd = wgid % NXCD, off = wgid / NXCD; wgid = (xcd < r ? xcd * (q + 1) : r * (q + 1) + (xcd - r) * q) + off; }
        const int nig = wgm * nN, gid = wgid / nig, fm = gid * wgm, gsz = (nM - fm) < wgm ? (nM - fm) : wgm;
        u.pm = fm + ((wgid % nig) % gsz); u.pn = (wgid % nig) / gsz; u.ko = 0; u.aux = 0; if (rev) u.pm = nM - 1 - u.pm; }
    __host__ __device__ bool next(int i, Unit& u) const {
        const long L = (long)i * G + c + off; if (L >= nlim) return false;
        tile_of((int)L, u); return true;
    }
    __device__ __forceinline__ void a_ready(const Unit&) const {}
    __device__ __forceinline__ void done(const Unit&) const {}
};
typedef float pg8_f32x2 __attribute__((ext_vector_type(2))); typedef __bf16 pg8_bf16x2 __attribute__((ext_vector_type(2)));
__device__ __forceinline__ unsigned cvt_pk_bf16(float lo, float hi) { const pg8_f32x2 v = {lo, hi}; const pg8_bf16x2 b = __builtin_convertvector(v, pg8_bf16x2); return __builtin_bit_cast(unsigned, b); }
typedef unsigned u32x2 __attribute__((ext_vector_type(2)));
__device__ __forceinline__ float bf_lo(unsigned w) { return __uint_as_float(w << 16); }
__device__ __forceinline__ float bf_hi(unsigned w) { return __uint_as_float(w & 0xffff0000u); }
__device__ __forceinline__ float fast_sigmoid(float x) { return __builtin_amdgcn_rcpf(1.0f + __builtin_amdgcn_exp2f(-1.44269504089f * x)); }

#ifndef EPI_NT_STORE
#define EPI_NT_STORE 0
#endif
template <int ACT> struct EpiStore {
    static constexpr bool PERM = true, AFTER_DRAIN = false;
    bf16_t* O; int ldc;
    __device__ __forceinline__ void operator()(const f32x4 (&acc)[2][2][4][2], const Unit& u, int wr, int wc, int fr, int fq) const {
        const int row0 = u.pm * BM + wr * 64 + fr, col0 = u.pn * BM + wc * 32 + 8 * fq;
#pragma unroll
        for (int ai = 0; ai < 2; ++ai)
#pragma unroll
            for (int m = 0; m < 4; ++m) { bf16_t* rowp = O + (size_t)(row0 + ai * HALF + m * 16) * ldc + col0;
#pragma unroll
                for (int bj = 0; bj < 2; ++bj) { f32x4 v0 = acc[ai][bj][m][0], v1 = acc[ai][bj][m][1];
                    if (ACT == 1) {
#pragma unroll
                        for (int j = 0; j < 4; ++j) { const float a = fmaxf(v0[j], 0.f), b = fmaxf(v1[j], 0.f); v0[j] = a * a; v1[j] = b * b; } }
                    u32x4 w; w.x = cvt_pk_bf16(v0[0], v0[1]); w.y = cvt_pk_bf16(v0[2], v0[3]); w.z = cvt_pk_bf16(v1[0], v1[1]); w.w = cvt_pk_bf16(v1[2], v1[3]);
                    if (EPI_NT_STORE) __builtin_nontemporal_store(w, (u32x4*)(rowp + bj * HALF)); else *(u32x4*)(rowp + bj * HALF) = w; } }
    }
};

struct EpiBranch {
    static constexpr bool PERM = true, AFTER_DRAIN = false;
    const bf16_t* P; int ldp; int gate_off; bf16_t* MG; int ldm; int npm, npn;
    __device__ __forceinline__ void operator()(const f32x4 (&acc)[2][2][4][2], const Unit& u, int wr, int wc, int fr, int fq) const {
        const int k = u.pm / npm, pm = u.pm - k * npm, pn = u.pn - k * npn;
        const int row0 = pm * BM + wr * 64 + fr, col0 = pn * BM + wc * 32 + 8 * fq;
#pragma unroll
        for (int ai = 0; ai < 2; ++ai)
#pragma unroll
            for (int m = 0; m < 4; ++m) { const size_t r = (size_t)(row0 + ai * HALF + m * 16);
                const bf16_t* gp = P + r * ldp + gate_off + k * 2048 + col0; bf16_t* mp = MG + r * ldm + col0;
#pragma unroll
                for (int bj = 0; bj < 2; ++bj) { const u32x4 g = *(const u32x4*)(gp + bj * HALF);
                    f32x4 v0 = acc[ai][bj][m][0], v1 = acc[ai][bj][m][1];
                    v0[0] *= fast_sigmoid(bf_lo(g.x)); v0[1] *= fast_sigmoid(bf_hi(g.x)); v0[2] *= fast_sigmoid(bf_lo(g.y)); v0[3] *= fast_sigmoid(bf_hi(g.y));
                    v1[0] *= fast_sigmoid(bf_lo(g.z)); v1[1] *= fast_sigmoid(bf_hi(g.z)); v1[2] *= fast_sigmoid(bf_lo(g.w)); v1[3] *= fast_sigmoid(bf_hi(g.w));
                    if (k > 0) { const u32x4 p = *(const u32x4*)(mp + bj * HALF);
                        v0[0] += bf_lo(p.x); v0[1] += bf_hi(p.x); v0[2] += bf_lo(p.y); v0[3] += bf_hi(p.y);
                        v1[0] += bf_lo(p.z); v1[1] += bf_hi(p.z); v1[2] += bf_lo(p.w); v1[3] += bf_hi(p.w); }
                    u32x4 w; w.x = cvt_pk_bf16(v0[0], v0[1]); w.y = cvt_pk_bf16(v0[2], v0[3]); w.z = cvt_pk_bf16(v1[0], v1[1]); w.w = cvt_pk_bf16(v1[2], v1[3]);
                    *(u32x4*)(mp + bj * HALF) = w; }
                if (m == 3) asm volatile("" ::: "memory"); }
    }
};

struct EpiRes {
    static constexpr bool PERM = true, AFTER_DRAIN = false;
    bf16_t* X; const float* gmod; int gstride;
    __device__ __forceinline__ void operator()(const f32x4 (&acc)[2][2][4][2], const Unit& u, int wr, int wc, int fr, int fq) const {
        const int row0 = u.pm * BM + wr * 64 + fr, col0 = u.pn * BM + wc * 32 + 8 * fq;
#pragma unroll
        for (int ai = 0; ai < 2; ++ai)
#pragma unroll
            for (int m = 0; m < 4; ++m) { const int r = row0 + ai * HALF + m * 16;
                const int seq = r < 32768 ? (r >> 11) : 16 + ((r - 32768) >> 5);
                const float* gp = gmod + (size_t)seq * gstride + col0; bf16_t* xp = X + (size_t)r * 2048 + col0;
#pragma unroll
                for (int bj = 0; bj < 2; ++bj) { const f32x4 g0 = *(const f32x4*)(gp + bj * HALF), g1 = *(const f32x4*)(gp + bj * HALF + 4); const u32x4 b = *(const u32x4*)(xp + bj * HALF);
                    const f32x4 v0 = acc[ai][bj][m][0] * g0, v1 = acc[ai][bj][m][1] * g1;
                    u32x4 w; w.x = cvt_pk_bf16(bf_lo(b.x) + v0[0], bf_hi(b.x) + v0[1]); w.y = cvt_pk_bf16(bf_lo(b.y) + v0[2], bf_hi(b.y) + v0[3]);
                    w.z = cvt_pk_bf16(bf_lo(b.z) + v1[0], bf_hi(b.z) + v1[1]); w.w = cvt_pk_bf16(bf_lo(b.w) + v1[2], bf_hi(b.w) + v1[3]);
                    *(u32x4*)(xp + bj * HALF) = w; }
                if (m == 3) asm volatile("" ::: "memory"); }
    }
};

struct BranchOrder {
    int G, c, npm, npn, ntile;
    __device__ void init(int npm_, int npn_, int G_, int c_) { npm = npm_; npn = npn_; ntile = npm_ * npn_; G = G_; c = c_; }
    __device__ bool next(int i, Unit& u) const {
        const int ti = i / 3, k = i - 3 * ti; const long L = (long)ti * G + c; if (L >= ntile) return false;
        int wgid = (int)L; { const int q = ntile / NXCD, r = ntile % NXCD, xcd = wgid % NXCD, off = wgid / NXCD; wgid = (xcd < r ? xcd * (q + 1) : r * (q + 1) + (xcd - r) * q) + off; }
        const int nig = WGM * npn, gid = wgid / nig, fm = gid * WGM, gsz = (npm - fm) < WGM ? (npm - fm) : WGM;
        u.pm = k * npm + fm + ((wgid % nig) % gsz); u.pn = k * npn + (wgid % nig) / gsz; u.ko = 0; u.aux = 0; return true;
    }
    __device__ __forceinline__ void a_ready(const Unit&) const {}
    __device__ __forceinline__ void done(const Unit&) const {}
};


struct EpiResAtomic {
    static constexpr bool PERM = false, AFTER_DRAIN = false;
    float* out; const float* gmod;
    __device__ __forceinline__ void operator()(const f32x4 (&acc)[2][2][4][2], const Unit& u, int wr, int wc, int fr, int fq) const {
        const int row0 = u.pm * BM + wr * 64 + fr, col0 = u.pn * BM + wc * 32 + 4 * fq;
#pragma unroll
        for (int ai = 0; ai < 2; ++ai)
#pragma unroll
            for (int m = 0; m < 4; ++m) { const int r = row0 + ai * HALF + m * 16;
                const int seq = r < 32768 ? (r >> 11) : 16 + ((r - 32768) >> 5);
                const float* gp = gmod + (size_t)seq * 12288 + col0; float* op = out + (size_t)r * 2048 + col0;
#pragma unroll
                for (int bj = 0; bj < 2; ++bj)
#pragma unroll
                    for (int n = 0; n < 2; ++n) { const f32x4 g = *(const f32x4*)(gp + bj * HALF + n * 16); const f32x4 v = g * acc[ai][bj][m][n]; float* o = op + bj * HALF + n * 16;
                        typedef __attribute__((address_space(1))) float gfloat; gfloat* og = (gfloat*)o;
                        (void)__builtin_amdgcn_global_atomic_fadd_f32(og + 0, v.x); (void)__builtin_amdgcn_global_atomic_fadd_f32(og + 1, v.y); (void)__builtin_amdgcn_global_atomic_fadd_f32(og + 2, v.z); (void)__builtin_amdgcn_global_atomic_fadd_f32(og + 3, v.w); } }
    }
};
struct TailOrder {
    StaticOrder base; int nfull, SL, Ks;
    __device__ void init(const StaticOrder& b, int nfull_, int SL_, int Ks_) { base = b; nfull = nfull_; SL = SL_; Ks = Ks_; }
    __device__ bool next(int i, Unit& u) const { const long L = (long)i * base.G + base.c; if (L >= (long)(base.nwg - nfull) * SL) return false;
        const int t = (int)L / SL, sl = (int)L - t * SL; base.tile_of(nfull + t, u); u.ko = sl * Ks; u.aux = (int)L; return true; }
    __device__ __forceinline__ void a_ready(const Unit&) const {}
    __device__ __forceinline__ void done(const Unit&) const {}
};

struct EpiSlab {
    static constexpr bool PERM = false, AFTER_DRAIN = false;
    float* slab; const float* gmod;
    __device__ __forceinline__ void operator()(const f32x4 (&acc)[2][2][4][2], const Unit& u, int wr, int wc, int fr, int fq) const {
        const int rt0 = wr * 64 + fr, ct0 = wc * 32 + 4 * fq; float* sb = slab + (size_t)u.aux * 65536;
#pragma unroll
        for (int ai = 0; ai < 2; ++ai)
#pragma unroll
            for (int m = 0; m < 4; ++m) { const int rt = rt0 + ai * HALF + m * 16, r = u.pm * BM + rt;
                const int seq = r < 32768 ? (r >> 11) : 16 + ((r - 32768) >> 5);
                const float* gp = gmod + (size_t)seq * 12288 + u.pn * BM + ct0; float* op = sb + rt * 256 + ct0;
#pragma unroll
                for (int bj = 0; bj < 2; ++bj)
#pragma unroll
                    for (int n = 0; n < 2; ++n) { const f32x4 g = *(const f32x4*)(gp + bj * HALF + n * 16); *(f32x4*)(op + bj * HALF + n * 16) = g * acc[ai][bj][m][n]; } }
    }
};
template <class Epi, class Sched, bool ALIGN_EPI = false, bool SP2 = false, int A_AUX = 0, int B_AUX = 0>
__device__ __forceinline__ void gemm_phase(PG8_LAS unsigned char* lds, const Gemm g, const Sched& S, const Epi& E, int tid_in) {
    int tid_ = tid_in; asm volatile("" : "+v"(tid_));
    const int tid = tid_, wid = __builtin_amdgcn_readfirstlane(tid >> 6), lane = tid & 63, wr = wid >> 2, wc = wid & 3, fr = lane & 15, fq = lane >> 4;
    const int K = g.K, ld = g.ld, nt = K / BK;
    unsigned voffA[2], voffB[2];
#pragma unroll
    for (int i = 0; i < 2; ++i) { int R, C; stage_rc(tid * 16 + i * 8192, R, C); const int Rb = Epi::PERM ? ((R & ~31) + perm32(R & 31)) : R;
        voffA[i] = (unsigned)(R * ld + C) * 2u; voffB[i] = (unsigned)(Rb * ld + C) * 2u; }
    const size_t kstep = (size_t)(BK * 2);
    const size_t hstep = (size_t)HALF * ld * 2;
    const size_t tstep = 2 * hstep;
    const unsigned ldsw = (unsigned)wid * 1024u;
    const int aoff = lds_byte(wr * 64 + fr, fq * 8), boff = lds_byte(wc * 32 + fr, fq * 8);
#define PG8_SA(b, h) (((b) * 2 + (h)) * HTB)
#define PG8_SB(b, h) ((4 + (b) * 2 + (h)) * HTB)
#define PG8_STAGE(bufoff, gbase, voff) do { _Pragma("unroll") for (int _i = 0; _i < 2; ++_i) \
        __builtin_amdgcn_global_load_lds((const unsigned*)((const char*)(gbase) + (voff)[_i]), (PG8_LAS unsigned*)(lds + (bufoff) + ldsw + _i * 8192), 16, 0, B_AUX); } while (0)
#define PG8_STAGEA(bufoff, gbase, voff) do { _Pragma("unroll") for (int _i = 0; _i < 2; ++_i) \
        __builtin_amdgcn_global_load_lds((const unsigned*)((const char*)(gbase) + (voff)[_i]), (PG8_LAS unsigned*)(lds + (bufoff) + ldsw + _i * 8192), 16, 0, A_AUX); } while (0)
#define PG8_LDA(dst, b, h) do { _Pragma("unroll") for (int m = 0; m < 4; ++m) _Pragma("unroll") for (int k = 0; k < 2; ++k) dst[m][k] = *(const PG8_LAS bf16x8*)(lds + PG8_SA(b, h) + aoff + m * 2048 + k * 1024); } while (0)
#define PG8_LDB(dst, b, h) do { _Pragma("unroll") for (int n = 0; n < 2; ++n) _Pragma("unroll") for (int k = 0; k < 2; ++k) dst[n][k] = *(const PG8_LAS bf16x8*)(lds + PG8_SB(b, h) + boff + n * 2048 + k * 1024); } while (0)
#define PG8_MMA(ai, bj, At, Bt) do { __builtin_amdgcn_s_setprio(1); _Pragma("unroll") for (int m = 0; m < 4; ++m) _Pragma("unroll") for (int n = 0; n < 2; ++n) _Pragma("unroll") for (int k = 0; k < 2; ++k) \
        acc[ai][bj][m][n] = __builtin_amdgcn_mfma_f32_16x16x32_bf16(Bt[n][k], At[m][k], acc[ai][bj][m][n], 0, 0, 0); __builtin_amdgcn_s_setprio(0); } while (0)
#define PG8_WAIT_V(n) asm volatile("s_waitcnt vmcnt(" #n ")" ::: "memory")
#define PG8_WAIT_L(n) asm volatile("s_waitcnt lgkmcnt(" #n ")" ::: "memory")
#define PG8_BAR __builtin_amdgcn_s_barrier()
#define PG8_SCHED __builtin_amdgcn_sched_barrier(0)
    Unit cur, nxt; int ui = 0;
    if (!S.next(0, cur)) return;
    f32x4 acc[2][2][4][2];
#pragma unroll
    for (int a = 0; a < 2; ++a)
#pragma unroll
        for (int b = 0; b < 2; ++b)
#pragma unroll
            for (int m = 0; m < 4; ++m)
#pragma unroll
                for (int n = 0; n < 2; ++n) acc[a][b][m][n] = (f32x4){0.f, 0.f, 0.f, 0.f};
    bf16x8 At[4][2], B0[2][2], B1[2][2];
    const char* cA = (const char*)g.A + (size_t)cur.pm * tstep + (size_t)cur.ko * 2; const char* cB = (const char*)g.Bt + (size_t)cur.pn * tstep + (size_t)cur.ko * 2;
    S.a_ready(cur);
    if constexpr (SP2) {
        PG8_STAGE(PG8_SB(0, 0), cB, voffB); PG8_STAGE(PG8_SB(0, 1), cB + hstep, voffB); PG8_STAGEA(PG8_SA(0, 0), cA, voffA); PG8_STAGEA(PG8_SA(0, 1), cA + hstep, voffA);
        if (wr == 1) PG8_BAR;
        PG8_WAIT_V(2); PG8_BAR;
        PG8_STAGE(PG8_SB(1, 0), cB + kstep, voffB); PG8_STAGEA(PG8_SA(1, 0), cA + kstep, voffA); PG8_STAGE(PG8_SB(1, 1), cB + hstep + kstep, voffB);
        PG8_WAIT_V(6); PG8_BAR;
    } else {
        PG8_STAGE(PG8_SB(0, 0), cB, voffB); PG8_STAGEA(PG8_SA(0, 0), cA, voffA); PG8_STAGE(PG8_SB(0, 1), cB + hstep, voffB); PG8_STAGEA(PG8_SA(0, 1), cA + hstep, voffA);
        if (wr == 1) PG8_BAR;
        PG8_WAIT_V(4); PG8_BAR;
        PG8_STAGE(PG8_SB(1, 0), cB + kstep, voffB); PG8_STAGEA(PG8_SA(1, 0), cA + kstep, voffA); PG8_STAGE(PG8_SB(1, 1), cB + hstep + kstep, voffB);
        PG8_WAIT_V(6); PG8_BAR;
    }
    for (;;) {
        const bool has_next = S.next(ui + 1, nxt);
        const char* nA = has_next ? (const char*)g.A + (size_t)nxt.pm * tstep + (size_t)nxt.ko * 2 : cA; const char* nB = has_next ? (const char*)g.Bt + (size_t)nxt.pn * tstep + (size_t)nxt.ko * 2 : cB;
        for (int t = 0; t < nt; t += 2) {
            const bool last = (t == nt - 2);
            const char* a1 = cA + (size_t)(t + 1) * kstep;
            const char* a2 = last ? nA : cA + (size_t)(t + 2) * kstep; const char* b2 = last ? nB : cB + (size_t)(t + 2) * kstep;
            const char* a3 = a2 + kstep; const char* b3 = b2 + kstep;
            if (last && has_next) S.a_ready(nxt);
            if constexpr (SP2) {
            PG8_LDB(B0, 0, 0); PG8_LDB(B1, 0, 1); PG8_SCHED; PG8_LDA(At, 0, 0); PG8_STAGEA(PG8_SA(1, 1), a1 + hstep, voffA);
            PG8_WAIT_V(8); PG8_WAIT_L(0); PG8_BAR; PG8_MMA(0, 0, At, B0); PG8_MMA(0, 1, At, B1); PG8_BAR; PG8_SCHED;
            PG8_LDA(At, 0, 1); PG8_STAGE(PG8_SB(0, 0), b2, voffB); PG8_STAGE(PG8_SB(0, 1), b2 + hstep, voffB); PG8_STAGEA(PG8_SA(0, 0), a2, voffA);
            PG8_WAIT_V(8); PG8_WAIT_L(0); PG8_BAR; PG8_MMA(1, 0, At, B0); PG8_MMA(1, 1, At, B1); PG8_BAR; PG8_SCHED;
            PG8_LDB(B0, 1, 0); PG8_LDB(B1, 1, 1); PG8_SCHED; PG8_LDA(At, 1, 0); PG8_STAGEA(PG8_SA(0, 1), a2 + hstep, voffA);
            PG8_WAIT_V(8); PG8_WAIT_L(0); PG8_BAR; PG8_MMA(0, 0, At, B0); PG8_MMA(0, 1, At, B1); PG8_BAR; PG8_SCHED;
            PG8_LDA(At, 1, 1); PG8_STAGE(PG8_SB(1, 0), b3, voffB); PG8_STAGE(PG8_SB(1, 1), b3 + hstep, voffB); PG8_STAGEA(PG8_SA(1, 0), a3, voffA);
            PG8_WAIT_V(8); PG8_WAIT_L(0); PG8_BAR; PG8_MMA(1, 0, At, B0); PG8_MMA(1, 1, At, B1); PG8_BAR; PG8_SCHED;
            } else {
            PG8_LDB(B0, 0, 0); PG8_SCHED; PG8_LDA(At, 0, 0); PG8_STAGEA(PG8_SA(1, 1), a1 + hstep, voffA);
            PG8_WAIT_L(8); PG8_BAR; PG8_WAIT_L(0); PG8_MMA(0, 0, At, B0); PG8_BAR; PG8_SCHED;
            PG8_LDB(B1, 0, 1); PG8_STAGE(PG8_SB(0, 0), b2, voffB);
            PG8_BAR; PG8_WAIT_L(0); PG8_MMA(0, 1, At, B1); PG8_BAR;
            PG8_LDA(At, 0, 1); PG8_STAGEA(PG8_SA(0, 0), a2, voffA);
            PG8_BAR; PG8_WAIT_L(0); PG8_MMA(1, 0, At, B0); PG8_BAR; PG8_SCHED;
            PG8_STAGE(PG8_SB(0, 1), b2 + hstep, voffB);
            PG8_WAIT_V(6); PG8_BAR; PG8_MMA(1, 1, At, B1); PG8_BAR;
            PG8_LDB(B0, 1, 0); PG8_SCHED; PG8_LDA(At, 1, 0); PG8_STAGEA(PG8_SA(0, 1), a2 + hstep, voffA);
            PG8_WAIT_L(8); PG8_BAR; PG8_WAIT_L(0); PG8_MMA(0, 0, At, B0); PG8_BAR; PG8_SCHED;
            PG8_LDB(B1, 1, 1); PG8_STAGE(PG8_SB(1, 0), b3, voffB);
            PG8_BAR; PG8_WAIT_L(0); PG8_MMA(0, 1, At, B1); PG8_BAR;
            PG8_LDA(At, 1, 1); PG8_STAGEA(PG8_SA(1, 0), a3, voffA);
            PG8_BAR; PG8_WAIT_L(0); PG8_MMA(1, 0, At, B0); PG8_BAR; PG8_SCHED;
            PG8_STAGE(PG8_SB(1, 1), b3 + hstep, voffB);
            PG8_WAIT_V(6); PG8_BAR; PG8_MMA(1, 1, At, B1); PG8_BAR;
            }
        }
        if constexpr (ALIGN_EPI) { if (wr == 0) PG8_BAR; }
        if constexpr (!Epi::AFTER_DRAIN) { E(acc, cur, wr, wc, fr, fq); S.done(cur); }
        if (!has_next) break;
#pragma unroll
        for (int a = 0; a < 2; ++a)
#pragma unroll
            for (int b = 0; b < 2; ++b)
#pragma unroll
                for (int m = 0; m < 4; ++m)
#pragma unroll
                    for (int n = 0; n < 2; ++n) acc[a][b][m][n] = (f32x4){0.f, 0.f, 0.f, 0.f};
        cur = nxt; cA = nA; cB = nB; ++ui;
        if constexpr (ALIGN_EPI) { if (wr == 1) PG8_BAR; }
    }
    PG8_WAIT_V(0);
    if constexpr (!ALIGN_EPI) { if (wr == 0) PG8_BAR; }
    PG8_BAR;
    if constexpr (Epi::AFTER_DRAIN) { E.fused(acc, cur, wr, wc, fr, fq, lds, wid, lane); S.done(cur); }
#undef PG8_SA
#undef PG8_SB
#undef PG8_STAGE
#undef PG8_STAGEA
#undef PG8_LDA
#undef PG8_LDB
#undef PG8_MMA
#undef PG8_WAIT_V
#undef PG8_WAIT_L
#undef PG8_BAR
#undef PG8_SCHED
}
}

constexpr int NWAVES = 8;
constexpr int DM = 2048, NTOK_P = 32768, NTOK_S = 1024, MT = NTOK_P + NTOK_S  , NSEQ = 48, DEPTH = 4, DFF = 8192;
constexpr int IN_TOTAL = 14864, NPAD = 15104;
constexpr int OFF_AQ = 0, OFF_AF = 1024, OFF_AI = 2048, OFF_AG = 3072, OFF_BZ = 4096, OFF_XBC = 5120, OFF_CU = 6656, OFF_CV = 7680, OFF_GATE = 8704, OFF_DT = 14848;
constexpr float NORM_EPS = 1e-6f;
constexpr size_t OUT_X = 0, OUT_HGRN_P = 69206016, OUT_SSM_P = 77594624, OUT_CONV_P = 85983232, OUT_HGRN_S = 86278144, OUT_SSM_S = 103055360, OUT_CONV_S = 119832576, OUT_V_S = 120422400, OUT_TOTAL = 124616704;
constexpr size_t MiB = 1u << 20;
constexpr size_t WS_CTL = 0, CTL_ZERO_BYTES = 1 * MiB;
constexpr size_t WS_MOD = 1 * MiB;
constexpr size_t WS_WIN = 16 * MiB;
constexpr size_t WS_WBR = 76 * MiB;
constexpr size_t WS_WOUT = 88 * MiB;
constexpr size_t WS_WUP = 96 * MiB;
constexpr size_t WS_WDN = 128 * MiB;
constexpr size_t WS_H = 160 * MiB;
constexpr size_t WS_Y3 = 292 * MiB;
constexpr size_t WS_P = 490 * MiB;
constexpr size_t WS_XC = 1464 * MiB;
constexpr size_t WS_DT = 1564 * MiB;
constexpr size_t DT_ARR = (size_t)MT * 16 * 4;
constexpr size_t WS_WSET2 = 1576 * MiB;
constexpr size_t WSET_BYTES = WS_H - WS_WIN;
constexpr size_t WS_SLAB = WS_Y3;
constexpr size_t WS_X = WS_WSET2 + WSET_BYTES;
constexpr size_t WS_END = WS_X + (size_t)MT * DM * 2;
static_assert((size_t)32 * 8 * 65536 * 4 <= (size_t)3 * MT * 1024 * 2, "slabs fit the y_a|y_b|y_c region");
static_assert(WS_DT + 3 * DT_ARR <= WS_WSET2, "d_ws map 3");
__host__ __device__ constexpr size_t wofs(int l) { return (l & 1) ? (WS_WSET2 - WS_WIN) : 0; }
static_assert(WS_P + (size_t)MT * NPAD * 2 <= WS_XC && WS_XC + (size_t)MT * 1536 * 2 <= WS_DT, "d_ws map 2");
static_assert(WS_MOD + (size_t)DEPTH * NSEQ * 12288 * 4 <= WS_WIN && WS_WIN + (size_t)NPAD * DM * 2 <= WS_WBR && WS_H + (size_t)MT * DM * 2 <= WS_Y3 && WS_Y3 + (size_t)3 * MT * 1024 * 2 <= WS_P, "d_ws map");
constexpr int CW_BAR = 4096;
constexpr int CW_Q = 8192;
constexpr int CW_QC = 12288;
constexpr int RING_BYTES = 131072, ST_OFF = RING_BYTES  , MISC_OFF = RING_BYTES + 1024, LDS_BYTES = 147456;

#define GAS __attribute__((address_space(1)))
#define LAS __attribute__((address_space(3)))
typedef unsigned short bf16;
typedef unsigned v4u __attribute__((ext_vector_type(4)));
typedef unsigned v2u __attribute__((ext_vector_type(2)));
typedef float f32x4 __attribute__((ext_vector_type(4)));
typedef float f32x2 __attribute__((ext_vector_type(2)));
#define LDS_WAIT() asm volatile("s_waitcnt lgkmcnt(0)" ::: "memory")
#define VM_WAIT() asm volatile("s_waitcnt vmcnt(0)" ::: "memory")
typedef float cv_f32x2 __attribute__((ext_vector_type(2))); typedef __bf16 cv_bf16x2 __attribute__((ext_vector_type(2)));
__device__ __forceinline__ unsigned pk2(float lo, float hi) { const cv_f32x2 v = {lo, hi}; const cv_bf16x2 b = __builtin_convertvector(v, cv_bf16x2); return __builtin_bit_cast(unsigned, b); }
__device__ __forceinline__ unsigned f2bf(float f) { const __bf16 b = (__bf16)f; return (unsigned)__builtin_bit_cast(unsigned short, b); }
__device__ __forceinline__ float bflo(unsigned w) { return __uint_as_float(w << 16); }
__device__ __forceinline__ float bfhi(unsigned w) { return __uint_as_float(w & 0xffff0000u); }
__device__ __forceinline__ float bf1(bf16 v) { return __uint_as_float(((unsigned)v) << 16); }
__device__ __forceinline__ float sigmoidf_(float x) { return __builtin_amdgcn_rcpf(1.0f + __expf(-x)); }
__device__ __forceinline__ float siluf_(float x) { return x * __builtin_amdgcn_rcpf(1.0f + __expf(-x)); }
__device__ __forceinline__ float rsqrtf_(float x) { return __builtin_amdgcn_rsqf(x); }
__device__ __forceinline__ float geluf_(float v) {
    const float av = fabsf(v), t = __builtin_amdgcn_rcpf(1.0f + 0.2316418882f * av);
    float q = t * 0.5307027145f + (-0.7265760135f); q = q * t + 0.7107068705f; q = q * t + (-0.142248368f); q = q * t + 0.127414796f; q = q * t;
    const float e = __expf(-0.5f * v * v), m = v * (q * e);
    return v < 0.f ? m : v - m;
}
__device__ __forceinline__ float wave_sum(float v) {
#pragma unroll
    for (int o = 1; o < 64; o <<= 1) v += __shfl_xor(v, o);
    return v;
}
__device__ __forceinline__ float half_sum(float v) {
#pragma unroll
    for (int o = 1; o < 32; o <<= 1) v += __shfl_xor(v, o);
    return v;
}

#define XB_TMO      128
#define XB_XCNT(j)  (256  + 64 * (j))
#define XB_XSUB(j)  (1280 + 64 * (j))
#define XB_XGEN(j)  (2304 + 64 * (j))
#define XB_TOP      3328
#define XB_TOPGEN   3392
#define XCD_BAR_WORDS 3456
#define XB_SPIN_CAP (1u << 18)

__device__ __forceinline__ unsigned xb_ld(unsigned* p)              { return __hip_atomic_load(p, __ATOMIC_RELAXED, __HIP_MEMORY_SCOPE_AGENT); }
__device__ __forceinline__ unsigned xb_add(unsigned* p, unsigned v) { return __hip_atomic_fetch_add(p, v, __ATOMIC_RELAXED, __HIP_MEMORY_SCOPE_AGENT); }
__device__ __forceinline__ unsigned xb_xcc_id() { return (unsigned)__builtin_amdgcn_s_getreg((3 << 11) | 20) & 0xFu; }
#define XB_SPIN(cond, bar) do { unsigned _sp = 0; while (cond) { __builtin_amdgcn_s_sleep(1); \
    if ((++_sp & 255u) == 0u) { if (xb_ld(&(bar)[XB_TMO])) break; if (_sp > XB_SPIN_CAP) { atomicAdd(&(bar)[XB_TMO], 1u); break; } } } } while (0)

struct XcdBarrier {
    unsigned* bar; unsigned x;
    volatile LAS unsigned* st;
};

__device__ __forceinline__ XcdBarrier xcd_barrier_post(unsigned* bar, volatile LAS unsigned* st, int tid) {
    XcdBarrier b; b.bar = bar; b.x = xb_xcc_id(); b.st = st;
    if (tid == 0) (void)xb_add(&bar[XB_XCNT(b.x)], 1u);
    return b;
}
__device__ __forceinline__ void xcd_barrier_complete(unsigned* bar, unsigned x, unsigned& nloc, unsigned& nx) {
    const unsigned G = gridDim.x * gridDim.y * gridDim.z;
    unsigned sum, cnt, mine, sp = 0u;
    for (;;) {
        sum = 0u; cnt = 0u; mine = 0u;
#pragma unroll
        for (unsigned j = 0; j < 16; ++j) { const unsigned c = xb_ld(&bar[XB_XCNT(j)]); sum += c; cnt += (c > 0u) ? 1u : 0u; mine = (j == x) ? c : mine; }
        if (sum == G) break;
        __builtin_amdgcn_s_sleep(1);
        if ((++sp & 255u) == 0u) { if (xb_ld(&bar[XB_TMO])) break; if (sp > XB_SPIN_CAP) { atomicAdd(&bar[XB_TMO], 1u); break; } }
    }
    nloc = mine > 0u ? mine : 1u; nx = cnt > 0u ? cnt : 1u;
}

__device__ __forceinline__ void xcd_barrier(const XcdBarrier& b, int tid) {
    asm volatile("s_waitcnt vmcnt(0)" ::: "memory");
    __syncthreads();
    if (tid == 0) {
        unsigned* bar = b.bar;
        __builtin_amdgcn_s_waitcnt(0);
        unsigned nloc = b.st[0], nx = b.st[1];
        if (nloc == 0u) { xcd_barrier_complete(bar, b.x, nloc, nx); b.st[0] = nloc; b.st[1] = nx; }
        const unsigned old = xb_add(&bar[XB_XSUB(b.x)], 1u);
        const unsigned gen = old / nloc;
        if (old + 1u == (gen + 1u) * nloc) {
            __builtin_amdgcn_fence(__ATOMIC_RELEASE, "agent");
            asm volatile("s_waitcnt vmcnt(0)" ::: "memory");
            const unsigned og = xb_add(&bar[XB_TOP], 1u);
            const unsigned tg = og / nx;
            if (og + 1u == (tg + 1u) * nx) xb_add(&bar[XB_TOPGEN], 1u);
            else XB_SPIN(xb_ld(&bar[XB_TOPGEN]) == tg, bar);
            __builtin_amdgcn_fence(__ATOMIC_ACQUIRE, "agent");
            xb_add(&bar[XB_XGEN(b.x)], 1u);
            asm volatile("s_waitcnt vmcnt(0)" ::: "memory");
        } else {
            XB_SPIN(xb_ld(&bar[XB_XGEN(b.x)]) == gen, bar);
            __builtin_amdgcn_fence(__ATOMIC_ACQUIRE, "agent");
            asm volatile("s_waitcnt vmcnt(0)" ::: "memory");
        }
    }
    __syncthreads();
}


__device__ __forceinline__ void mod_item(LAS unsigned char* lds, int tid_in, int it, const float* c_prompt, const float* c_sample, const float* w_mod, const float* b_mod, float* MOD) {
    int tid = tid_in;
    const int l = it / 96, cb = it - l * 96, j0 = cb * 128;
    const int cq = tid & 31, sh = (tid >> 5) & 1, kq = tid >> 6;
    LAS float* CS = (LAS float*)lds;
    f32x2 acc[24][2];
#pragma unroll
    for (int s = 0; s < 24; ++s) { acc[s][0] = (f32x2){0.f, 0.f}; acc[s][1] = (f32x2){0.f, 0.f}; }
    const float* wbase = w_mod + (size_t)l * DM * 12288 + j0 + 4 * cq;
    for (int kt = 0; kt < 8; ++kt) {
        __syncthreads();
#pragma unroll 8
        for (int j = 0; j < 24; ++j) { const int e = tid + 512 * j, s = e >> 8, kidx = e & 255, kq2 = kidx >> 5, kk = kidx & 31, k = kq2 * 256 + kt * 32 + kk;
            const float cv = s < 16 ? c_prompt[s * DM + k] : c_sample[(s - 16) * DM + k];
            CS[(kq2 * 32 + kk) * 48 + s] = siluf_(cv); }
        __syncthreads();
        { const float* wr = wbase + (size_t)(kq * 256 + kt * 32) * 12288;
          f32x4 wn[4];
#pragma unroll
          for (int i = 0; i < 4; ++i) wn[i] = *(const f32x4*)(wr + (size_t)i * 12288);
#pragma unroll 1
          for (int kk = 0; kk < 32; kk += 4) { f32x4 wc[4];
#pragma unroll
              for (int i = 0; i < 4; ++i) wc[i] = wn[i];
              if (kk + 4 < 32) {
#pragma unroll
                  for (int i = 0; i < 4; ++i) wn[i] = *(const f32x4*)(wr + (size_t)(kk + 4 + i) * 12288); }
#pragma unroll
              for (int i = 0; i < 4; ++i) { const f32x2 w01 = (f32x2){wc[i].x, wc[i].y}, w23 = (f32x2){wc[i].z, wc[i].w}; const LAS f32x4* cr = (const LAS f32x4*)(CS + (kq * 32 + kk + i) * 48 + 24 * sh);
#pragma unroll
                  for (int s4 = 0; s4 < 6; ++s4) { const f32x4 c4 = cr[s4];
#pragma unroll
                      for (int q = 0; q < 4; ++q) { const f32x2 cc = (f32x2){c4[q], c4[q]};
                          acc[4 * s4 + q][0] = __builtin_elementwise_fma(w01, cc, acc[4 * s4 + q][0]); acc[4 * s4 + q][1] = __builtin_elementwise_fma(w23, cc, acc[4 * s4 + q][1]); } } } } }
    }
    LAS float* RED = (LAS float*)lds;
    asm volatile("" : "+v"(tid));
    const int cq2 = tid & 31, sh2 = (tid >> 5) & 1, kq2_ = tid >> 6;
#pragma unroll
    for (int sb = 0; sb < 4; ++sb) {
        __syncthreads();
        if (sh2 == (sb >> 1)) {
#pragma unroll
            for (int i = 0; i < 12; ++i) { const f32x2 a = acc[12 * (sb & 1) + i][0], b = acc[12 * (sb & 1) + i][1]; *(LAS f32x4*)(RED + (kq2_ * 12 + i) * 128 + 4 * cq2) = (f32x4){a.x, a.y, b.x, b.y}; } }
        __syncthreads();
#pragma unroll
        for (int j = 0; j < 3; ++j) { const int e = tid + 512 * j, s = e >> 7, col = e & 127; float v = 0.f;
#pragma unroll
            for (int q = 0; q < 8; ++q) v += RED[(q * 12 + s) * 128 + col];
            MOD[((size_t)l * NSEQ + 12 * sb + s) * 12288 + j0 + col] = v + b_mod[l * 12288 + j0 + col]; }
    }
    __syncthreads();
}

struct CvItem { const float* src; bf16* dst; int N, K, nv; };
constexpr int CV_A = 472 * 32, CV_B = 3 * 16 * 64, CV_C = 32 * 64, CV_D = 32 * 256, CV_E = 128 * 64, CV_ALL = CV_A + CV_B + CV_C + CV_D + CV_E;
__device__ __forceinline__ CvItem cvt_decode(int it, int l, const float* w_in, const float* w_branch, const float* w_out, const float* w_up, const float* w_down, unsigned char* ws) {
    CvItem c; int r = it;
    if (r < CV_A) { const int nb = r % 472, kb = r / 472; int n0s, nv;
        if (nb < 208) { n0s = 32 * nb; nv = 32; } else if (nb < 464) { n0s = 32 * nb + 16; nv = 32; } else if (nb == 464) { n0s = 6656; nv = 16; } else { n0s = 0; nv = 0; }
        c.N = IN_TOTAL; c.K = DM; c.nv = nv; c.src = w_in + (size_t)l * DM * IN_TOTAL + (size_t)(64 * kb) * IN_TOTAL + n0s; c.dst = (bf16*)(ws + WS_WIN) + (size_t)(32 * nb) * DM + 64 * kb; return c; }
    r -= CV_A;
    if (r < CV_B) { const int br = r / 1024, r2 = r % 1024, kb = r2 / 64, nb = r2 % 64;
        c.N = DM; c.K = 1024; c.nv = 32; c.src = w_branch + ((size_t)l * 3072 + br * 1024 + 64 * kb) * DM + 32 * nb; c.dst = (bf16*)(ws + WS_WBR) + (size_t)br * 2048 * 1024 + (size_t)(32 * nb) * 1024 + 64 * kb; return c; }
    r -= CV_B;
    if (r < CV_C) { const int kb = r / 64, nb = r % 64;
        c.N = DM; c.K = DM; c.nv = 32; c.src = w_out + (size_t)l * DM * DM + (size_t)(64 * kb) * DM + 32 * nb; c.dst = (bf16*)(ws + WS_WOUT) + (size_t)(32 * nb) * DM + 64 * kb; return c; }
    r -= CV_C;
    if (r < CV_D) { const int kb = r / 256, nb = r % 256;
        c.N = DFF; c.K = DM; c.nv = 32; c.src = w_up + (size_t)l * DM * DFF + (size_t)(64 * kb) * DFF + 32 * nb; c.dst = (bf16*)(ws + WS_WUP) + (size_t)(32 * nb) * DM + 64 * kb; return c; }
    r -= CV_D;
    { const int kb = r / 64, nb = r % 64;
        c.N = DM; c.K = DFF; c.nv = 32; c.src = w_down + (size_t)l * DFF * DM + (size_t)(64 * kb) * DM + 32 * nb; c.dst = (bf16*)(ws + WS_WDN) + (size_t)(32 * nb) * DFF + 64 * kb; return c; }
}
__device__ __forceinline__ void cvt_load(const CvItem& c, int lane, f32x4 (&v)[8]) {
    const int kk = lane >> 3, n4 = (lane & 7) * 4;
#pragma unroll
    for (int i = 0; i < 8; ++i) v[i] = (n4 < c.nv) ? *(const f32x4*)(c.src + (size_t)(8 * i + kk) * c.N + n4) : (f32x4){0.f, 0.f, 0.f, 0.f};
}
__device__ __forceinline__ void cvt_store(const CvItem& c, int lane, const f32x4 (&v)[8], LAS float* scr) {
    { const int kk = lane >> 3, n4 = (lane & 7) * 4;
#pragma unroll
        for (int i = 0; i < 8; ++i) { LAS float* d = scr + (8 * i + kk) * 33 + n4; d[0] = v[i].x; d[1] = v[i].y; d[2] = v[i].z; d[3] = v[i].w; } }
    LDS_WAIT(); asm volatile("" ::: "memory");
    const int cc = lane & 7;
#pragma unroll
    for (int j = 0; j < 4; ++j) { const int n = (lane >> 3) + 8 * j; const LAS float* s = scr + (8 * cc) * 33 + n;
        v4u o; o.x = pk2(s[0 * 33], s[1 * 33]); o.y = pk2(s[2 * 33], s[3 * 33]); o.z = pk2(s[4 * 33], s[5 * 33]); o.w = pk2(s[6 * 33], s[7 * 33]);
        *(v4u*)(c.dst + (size_t)n * c.K + 8 * cc) = o; }
    LDS_WAIT(); asm volatile("" ::: "memory");
}
template <bool QUEUE>
__device__ __forceinline__ void cvt_phase(LAS unsigned char* lds, int wave, int lane, int gw, int NGW, int l, const float* w_in, const float* w_branch, const float* w_out, const float* w_up, const float* w_down, unsigned char* ws, unsigned* qhead) {
    LAS float* scr = (LAS float*)(lds + wave * 16384);
    int it = gw, left = 0;
#define CV_NEXT() do { if (QUEUE) { if (left == 0) { unsigned t0 = 0; if (lane == 0) t0 = __hip_atomic_fetch_add(qhead, 4u, __ATOMIC_RELAXED, __HIP_MEMORY_SCOPE_AGENT); it = __builtin_amdgcn_readfirstlane((int)t0); left = 4; } else ++it; --left; } else it += NGW; } while (0)
    if (QUEUE) { it = 0; CV_NEXT(); }
    if (it >= CV_ALL) return;
    CvItem ca = cvt_decode(it, l, w_in, w_branch, w_out, w_up, w_down, ws), cb = ca; f32x4 va[8], vb[8];
    cvt_load(ca, lane, va);
    for (;;) {
        CV_NEXT(); const bool hb = it < CV_ALL;
        if (hb) { cb = cvt_decode(it, l, w_in, w_branch, w_out, w_up, w_down, ws); cvt_load(cb, lane, vb); }
        cvt_store(ca, lane, va, scr);
        if (!hb) break;
        CV_NEXT(); const bool ha = it < CV_ALL;
        if (ha) { ca = cvt_decode(it, l, w_in, w_branch, w_out, w_up, w_down, ws); cvt_load(ca, lane, va); }
        cvt_store(cb, lane, vb, scr);
        if (!ha) break;
    }
#undef CV_NEXT
}

#ifndef WGM_N8
#define WGM_N8 4
#endif
__device__ __forceinline__ int tail_nfull(int nwg, int G) { const int nf = (nwg / G) * G; return (nwg - nf) <= 32 ? nf : nwg; }
__device__ __forceinline__ void build_tail_map(LAS int* tmap, int tid, int G, int rev) {
    pg8::StaticOrder S; S.init(MT, DM, G, 0); S.rev = rev; S.wgm = WGM_N8; const int nfull = tail_nfull(S.nwg, G);
    for (int i = tid; i < S.nwg; i += NWAVES * 64) tmap[i] = -1;
    __syncthreads();
    for (int i = tid; i < S.nwg - nfull; i += NWAVES * 64) { pg8::Unit u; S.tile_of(nfull + i, u); tmap[u.pm * 8 + u.pn] = i; }
    __syncthreads();
}
template <bool SRC_F32>
__device__ __forceinline__ void norm_mod_phase(int lane, int gw, int NGW, const float* xP, const float* xS, bf16* X, const float* ng, const float* modl  , int part_sh, int part_sc, bf16* H,
                                               bool comb, const LAS int* tmap, const float* slab, bool desc) {
    const int g2 = desc ? NGW - 1 - gw : gw;
    const int ra = (int)(((unsigned)g2 * (unsigned)MT) / (unsigned)NGW), rb = (int)(((unsigned)(g2 + 1) * (unsigned)MT) / (unsigned)NGW);
    const int nr = rb - ra, rfirst = desc ? rb - 1 : ra, step = desc ? -1 : 1;
    if (nr <= 0) return;
    f32x4 ca[8], cb[8]; int cur_seq = -1;
    v2u xn[8];
    v2u xm[8];
    if (!SRC_F32) { const v2u* xb0 = (const v2u*)(X + (size_t)rfirst * DM) + lane;
#pragma unroll
        for (int j = 0; j < 8; ++j) xn[j] = xb0[64 * j];
        if (nr > 1) { const v2u* xb1 = (const v2u*)(X + (size_t)(rfirst + step) * DM) + lane;
#pragma unroll
            for (int j = 0; j < 8; ++j) xm[j] = xb1[64 * j]; } }
    for (int i = 0; i < nr; ++i) { const int r = rfirst + step * i;
        const int seq = r < NTOK_P ? (r >> 11) : 16 + ((r - NTOK_P) >> 5);
        if (seq != cur_seq) { cur_seq = seq; const float* mp = modl + (size_t)seq * 12288;
#pragma unroll
            for (int j = 0; j < 8; ++j) { const int c = 4 * lane + 256 * j; const f32x4 g = *(const f32x4*)(ng + c), sc = *(const f32x4*)(mp + part_sc * DM + c); ca[j] = g * (sc + 1.0f); cb[j] = *(const f32x4*)(mp + part_sh * DM + c); } }
        f32x4 v[8]; float ss = 0.f; v2u* xb = (v2u*)(X + (size_t)r * DM) + lane;
        if (SRC_F32) { const float* xr = (r < NTOK_P ? xP + (size_t)r * DM : xS + (size_t)(r - NTOK_P) * DM) + 4 * lane;
#pragma unroll
            for (int j = 0; j < 8; ++j) { v[j] = *(const f32x4*)(xr + 256 * j); v2u o; o.x = pk2(v[j].x, v[j].y); o.y = pk2(v[j].z, v[j].w); xb[64 * j] = o; } }
        else {
#pragma unroll
            for (int j = 0; j < 8; ++j) { const v2u o = xn[j]; v[j] = (f32x4){bflo(o.x), bfhi(o.x), bflo(o.y), bfhi(o.y)}; xn[j] = xm[j]; }
            if (i + 2 < nr) { const v2u* xb2 = (const v2u*)(X + (size_t)(r + 2 * step) * DM) + lane;
#pragma unroll
                for (int j = 0; j < 8; ++j) xm[j] = xb2[64 * j]; } }
        if (comb) {
#pragma unroll
            for (int j = 0; j < 8; ++j) { const int ti = tmap[(r >> 8) * 8 + j]; if (ti >= 0) { const float* sp = slab + (size_t)ti * 8 * 65536 + (r & 255) * 256 + 4 * lane;
#pragma unroll
                    for (int q = 0; q < 8; ++q) v[j] = v[j] + *(const f32x4*)(sp + (size_t)q * 65536);
                    v2u o; o.x = pk2(v[j].x, v[j].y); o.y = pk2(v[j].z, v[j].w); xb[64 * j] = o; } } }
#pragma unroll
        for (int j = 0; j < 8; ++j) ss += (v[j].x * v[j].x + v[j].y * v[j].y) + (v[j].z * v[j].z + v[j].w * v[j].w);
        const float rstd = 1.0f / sqrtf(wave_sum(ss) * (1.0f / DM) + NORM_EPS);
        unsigned long long* o8 = (unsigned long long*)(H + (size_t)r * DM) + lane;
#pragma unroll
        for (int j = 0; j < 8; ++j) { const f32x4 y = v[j] * rstd * ca[j] + cb[j]; o8[64 * j] = (unsigned long long)pk2(y.x, y.y) | ((unsigned long long)pk2(y.z, y.w) << 32); }
    }
}
__device__ __forceinline__ void final_norm_phase(int lane, int gw, int NGW, const bf16* X, float* Y, const float* fg, bool comb, const LAS int* tmap, const float* slab) {
    f32x4 g[8];
#pragma unroll
    for (int j = 0; j < 8; ++j) g[j] = *(const f32x4*)(fg + 4 * lane + 256 * j);
    v2u xn[8];
    if (gw < MT) { const v2u* xb0 = (const v2u*)(X + (size_t)gw * DM) + lane;
#pragma unroll
        for (int j = 0; j < 8; ++j) xn[j] = xb0[64 * j]; }
    for (int r = gw; r < MT; r += NGW) {
        float* yr = Y + (size_t)r * DM + 4 * lane; f32x4 v[8]; float ss = 0.f;
#pragma unroll
        for (int j = 0; j < 8; ++j) { const v2u o = xn[j]; v[j] = (f32x4){bflo(o.x), bfhi(o.x), bflo(o.y), bfhi(o.y)}; }
        if (r + NGW < MT) { const v2u* xb1 = (const v2u*)(X + (size_t)(r + NGW) * DM) + lane;
#pragma unroll
            for (int j = 0; j < 8; ++j) xn[j] = xb1[64 * j]; }
        if (comb) {
#pragma unroll
            for (int j = 0; j < 8; ++j) { const int ti = tmap[(r >> 8) * 8 + j]; if (ti >= 0) { const float* sp = slab + (size_t)ti * 8 * 65536 + (r & 255) * 256 + 4 * lane;
#pragma unroll
                    for (int q = 0; q < 8; ++q) v[j] = v[j] + *(const f32x4*)(sp + (size_t)q * 65536); } } }
#pragma unroll
        for (int j = 0; j < 8; ++j) ss += (v[j].x * v[j].x + v[j].y * v[j].y) + (v[j].z * v[j].z + v[j].w * v[j].w);
        const float rstd = 1.0f / sqrtf(wave_sum(ss) * (1.0f / DM) + NORM_EPS);
#pragma unroll
        for (int j = 0; j < 8; ++j) *(f32x4*)(yr + 256 * j) = v[j] * rstd * g[j];
    }
}
__device__ __forceinline__ void ssd_norm_phase(int lane, int gw, int NGW, bf16* YB, const float* g) {
    float gv[16];
#pragma unroll
    for (int j = 0; j < 4; ++j) { const f32x4 t = *(const f32x4*)(g + 16 * lane + 4 * j); gv[4 * j] = t.x; gv[4 * j + 1] = t.y; gv[4 * j + 2] = t.z; gv[4 * j + 3] = t.w; }
    v4u na = (v4u){0u, 0u, 0u, 0u}, nb = na;
    if (gw < MT) { const v4u* p0 = (const v4u*)(YB + (size_t)gw * 1024 + 16 * lane); na = p0[0]; nb = p0[1]; }
    for (int r = gw; r < MT; r += NGW) {
        v4u* p = (v4u*)(YB + (size_t)r * 1024 + 16 * lane); const v4u a = na, b = nb;
        if (r + NGW < MT) { const v4u* p1 = (const v4u*)(YB + (size_t)(r + NGW) * 1024 + 16 * lane); na = p1[0]; nb = p1[1]; }
        float v[16]; v[0] = bflo(a.x); v[1] = bfhi(a.x); v[2] = bflo(a.y); v[3] = bfhi(a.y); v[4] = bflo(a.z); v[5] = bfhi(a.z); v[6] = bflo(a.w); v[7] = bfhi(a.w);
        v[8] = bflo(b.x); v[9] = bfhi(b.x); v[10] = bflo(b.y); v[11] = bfhi(b.y); v[12] = bflo(b.z); v[13] = bfhi(b.z); v[14] = bflo(b.w); v[15] = bfhi(b.w);
        float ss = 0.f;
#pragma unroll
        for (int j = 0; j < 16; ++j) ss += v[j] * v[j];
        const float rstd = 1.0f / sqrtf(half_sum(ss) * (1.0f / 512.0f) + NORM_EPS);
#pragma unroll
        for (int j = 0; j < 16; ++j) v[j] = v[j] * rstd * gv[j];
        v4u oa, ob; oa.x = pk2(v[0], v[1]); oa.y = pk2(v[2], v[3]); oa.z = pk2(v[4], v[5]); oa.w = pk2(v[6], v[7]); ob.x = pk2(v[8], v[9]); ob.y = pk2(v[10], v[11]); ob.z = pk2(v[12], v[13]); ob.w = pk2(v[14], v[15]);
        p[0] = oa; p[1] = ob;
    }
}

__device__ __forceinline__ void hgrn_item(LAS unsigned char* lds, int tid, int lane, int wave, const bf16* P, bf16* YA, int row0, int T, int h, int l,
                                          const float* s0, float* sout, const float* lb_raw, const float* onorm_g) {
    LAS float* LBV = (LAS float*)lds;
    LAS float* GV = LBV + 128;
    LAS float* Q = GV + 128;
    LAS float* F = Q + 2048; LAS float* KN = F + 2048; LAS float* IV = KN + 2048;
    LAS float* PO = IV + 2048;
    __syncthreads();
    if (tid < 128) { const int ch = h * 128 + tid; const float a0 = lb_raw[ch], a1 = lb_raw[1024 + ch], a2 = lb_raw[2048 + ch], a3 = lb_raw[3072 + ch];
        const float mx = fmaxf(fmaxf(a0, a1), fmaxf(a2, a3)); const float e0 = __expf(a0 - mx), e1 = __expf(a1 - mx), e2 = __expf(a2 - mx), e3 = __expf(a3 - mx); const float inv = 1.0f / (e0 + e1 + e2 + e3);
        float lb = 0.f; if (l >= 1) lb += e1; if (l >= 2) lb += e2; if (l >= 3) lb += e3; LBV[tid] = lb * inv; GV[tid] = onorm_g[ch]; }
    v2u nq2, nf2, ni2;
    { const bf16* pr = P + (size_t)(row0 + (tid >> 5)) * NPAD + h * 128 + (tid & 31) * 4; nq2 = *(const v2u*)(pr + OFF_AQ); nf2 = *(const v2u*)(pr + OFF_AF); ni2 = *(const v2u*)(pr + OFF_AI); }
    float S0[16], S1[16];
#pragma unroll
    for (int kk = 0; kk < 16; ++kk) { if (s0) { const f32x2 v = *(const f32x2*)(s0 + (16 * wave + kk) * 128 + 2 * lane); S0[kk] = v.x; S1[kk] = v.y; } else { S0[kk] = 0.f; S1[kk] = 0.f; } }
    __syncthreads();
    const int nch = T / 16;
    for (int c = 0; c < nch; ++c) {
        unsigned agv[2];
#pragma unroll
        for (int tt = 0; tt < 2; ++tt) agv[tt] = *(const unsigned*)(P + (size_t)(row0 + c * 16 + 2 * wave + tt) * NPAD + OFF_AG + h * 128 + 2 * lane);
        { const int t = tid >> 5, k4 = (tid & 31) * 4;
            const v2u q2 = nq2, f2 = nf2, i2 = ni2;
            if (c + 1 < nch) { const bf16* pr = P + (size_t)(row0 + (c + 1) * 16 + t) * NPAD + h * 128 + k4; nq2 = *(const v2u*)(pr + OFF_AQ); nf2 = *(const v2u*)(pr + OFF_AF); ni2 = *(const v2u*)(pr + OFF_AI); }
            const f32x4 lb = *(const LAS f32x4*)(LBV + k4);
            const float aq[4] = {bflo(q2.x), bfhi(q2.x), bflo(q2.y), bfhi(q2.y)}, az[4] = {bflo(f2.x), bfhi(f2.x), bflo(f2.y), bfhi(f2.y)};
            f32x4 qv, fv, kv;
#pragma unroll
            for (int j = 0; j < 4; ++j) { qv[j] = siluf_(aq[j]); const float sg = sigmoidf_(az[j]); fv[j] = lb[j] + (1.0f - lb[j]) * sg; kv[j] = (1.0f - lb[j]) * (1.0f - sg); }
            *(LAS f32x4*)(Q + t * 128 + k4) = qv; *(LAS f32x4*)(F + t * 128 + k4) = fv; *(LAS f32x4*)(KN + t * 128 + k4) = kv;
            *(LAS f32x4*)(IV + t * 128 + k4) = (f32x4){bflo(i2.x), bfhi(i2.x), bflo(i2.y), bfhi(i2.y)}; }
        __syncthreads();
#pragma unroll 2
        for (int t = 0; t < 16; ++t) {
            const f32x2 iv = *(const LAS f32x2*)(IV + t * 128 + 2 * lane); float po0 = 0.f, po1 = 0.f;
#pragma unroll
            for (int k4 = 0; k4 < 4; ++k4) { const f32x4 f4 = *(const LAS f32x4*)(F + t * 128 + 16 * wave + 4 * k4), n4 = *(const LAS f32x4*)(KN + t * 128 + 16 * wave + 4 * k4), q4 = *(const LAS f32x4*)(Q + t * 128 + 16 * wave + 4 * k4);
#pragma unroll
                for (int j = 0; j < 4; ++j) { const int kk = 4 * k4 + j; S0[kk] = fmaf(f4[j], S0[kk], n4[j] * iv.x); S1[kk] = fmaf(f4[j], S1[kk], n4[j] * iv.y); po0 = fmaf(q4[j], S0[kk], po0); po1 = fmaf(q4[j], S1[kk], po1); } }
            *(LAS f32x2*)(PO + (t * 8 + wave) * 128 + 2 * lane) = (f32x2){po0, po1};
        }
        __syncthreads();
#pragma unroll
        for (int tt = 0; tt < 2; ++tt) { const int t = 2 * wave + tt; float o0 = 0.f, o1 = 0.f;
#pragma unroll
            for (int w = 0; w < 8; ++w) { const f32x2 p = *(const LAS f32x2*)(PO + (t * 8 + w) * 128 + 2 * lane); o0 += p.x; o1 += p.y; }
            const float rstd = 1.0f / sqrtf(wave_sum(o0 * o0 + o1 * o1) * (1.0f / 128.0f) + NORM_EPS);
            const size_t row = (size_t)(row0 + c * 16 + t);
            const unsigned ag = agv[tt];
            const f32x2 gg = *(const LAS f32x2*)(GV + 2 * lane);
            *(unsigned*)(YA + row * 1024 + h * 128 + 2 * lane) = pk2(o0 * rstd * gg.x * siluf_(bflo(ag)), o1 * rstd * gg.y * siluf_(bfhi(ag))); }
    }
#pragma unroll
    for (int kk = 0; kk < 16; ++kk) *(f32x2*)(sout + (16 * wave + kk) * 128 + 2 * lane) = (f32x2){S0[kk], S1[kk]};
    __syncthreads();
}

typedef short bf16x8_t __attribute__((ext_vector_type(8)));
#define BAR_LDS() do { asm volatile("s_waitcnt lgkmcnt(0)" ::: "memory"); __builtin_amdgcn_s_barrier(); asm volatile("" ::: "memory"); } while (0)
#define MFMA16(x, y, acc) __builtin_amdgcn_mfma_f32_16x16x32_bf16((x), (y), (acc), 0, 0, 0)
#define LDFRAG(base, row, pitch, koff) (*(const LAS bf16x8_t*)((base) + (row) * (pitch) + (koff)))
__device__ __forceinline__ void hgrn_mfma_item(LAS unsigned char* lds, int tid, int lane, int wave, const bf16* P, bf16* YA, int row0, int h, int l, float* sout, const float* lb_raw, const float* onorm_g) {
    constexpr int PQ = 136, PT = 40;
    LAS float* LBV = (LAS float*)lds;
    LAS float* GV = LBV + 128;
    LAS float* DEC = GV + 128;
    LAS float* SS = DEC + 128;
    LAS float* LF = SS + 256;
    LAS bf16* QB = (LAS bf16*)(LF + 4096);
    LAS bf16* KB = QB + 32 * PQ;
    LAS bf16* Qt = KB + 32 * PQ;
    LAS bf16* Qm = Qt + 32 * PQ;
    LAS bf16* Km = Qm + 32 * PQ;
    LAS bf16* Qr = Km + 32 * PQ;
    LAS bf16* Kr = Qr + 16 * PQ;
    LAS bf16* KtT = Kr + 16 * PQ;
    LAS bf16* VT = KtT + 128 * PT;
    LAS bf16* IVr = VT + 128 * PT;
    LAS float* RSW = (LAS float*)(IVr + 32 * 128);
    const int fr = lane & 15, fq = lane >> 4;
    __syncthreads();
    if (tid < 128) { const int ch = h * 128 + tid; const float a0 = lb_raw[ch], a1 = lb_raw[1024 + ch], a2 = lb_raw[2048 + ch], a3 = lb_raw[3072 + ch];
        const float mx = fmaxf(fmaxf(a0, a1), fmaxf(a2, a3)); const float e0 = __expf(a0 - mx), e1 = __expf(a1 - mx), e2 = __expf(a2 - mx), e3 = __expf(a3 - mx); const float inv = 1.0f / (e0 + e1 + e2 + e3);
        float lb = 0.f; if (l >= 1) lb += e1; if (l >= 2) lb += e2; if (l >= 3) lb += e3; LBV[tid] = lb * inv; GV[tid] = onorm_g[ch]; }
    for (int i = tid; i < (128 * PT * 2) / 2; i += 512) ((LAS unsigned*)KtT)[i] = 0u;
    f32x4 sacc[8];
#pragma unroll
    for (int j = 0; j < 8; ++j) sacc[j] = (f32x4){0.f, 0.f, 0.f, 0.f};
    const int st = tid >> 4, sk8 = (tid & 15) * 8;
    const unsigned pst = (unsigned)((unsigned)(row0 + st) * (unsigned)NPAD + h * 128 + sk8) * 2u;
#define HG_LD16(off_) (*(const v4u*)((const char*)P + (unsigned)(off_)))
    v4u nq = HG_LD16(pst + 2u * OFF_AQ), nf = HG_LD16(pst + 2u * OFF_AF), ni = HG_LD16(pst + 2u * OFF_AI);
    f32x4 po0 = (f32x4){0.f, 0.f, 0.f, 0.f}, po1 = po0; bf16 pag[2][4];
#pragma unroll
    for (int hh = 0; hh < 2; ++hh)
#pragma unroll
        for (int r = 0; r < 4; ++r) pag[hh][r] = 0;
    const float gvv = onorm_g[h * 128 + 16 * wave + fr];
    __syncthreads();
#define HG_OUT(rb_) do { { const int t_ = lane & 31; const f32x4 p0 = *(const LAS f32x4*)(SS + t_ * 8), p1 = *(const LAS f32x4*)(SS + t_ * 8 + 4); \
            RSW[wave * 32 + t_] = rsqrtf_(((p0.x + p0.y) + (p0.z + p0.w) + (p1.x + p1.y) + (p1.z + p1.w)) * (1.0f / 128.0f) + NORM_EPS); } \
        LDS_WAIT(); asm volatile("" ::: "memory"); \
        _Pragma("unroll") for (int hh = 0; hh < 2; ++hh) { const f32x4 rs4 = *(const LAS f32x4*)(RSW + wave * 32 + 16 * hh + 4 * fq); \
            _Pragma("unroll") for (int r = 0; r < 4; ++r) { const int t = 16 * hh + 4 * fq + r; const float ov = hh ? po1[r] : po0[r]; \
            *(bf16*)((char*)YA + (unsigned)(((unsigned)(rb_) + t) * 1024u + h * 128 + 16 * wave + fr) * 2u) = (bf16)f2bf(ov * rs4[r] * gvv * siluf_(bf1(pag[hh][r]))); } } } while (0)
    for (int c = 0; c < 64; ++c) {
        const unsigned rbase = (unsigned)row0 + 32u * c;
        bf16 ag[2][4];
        { const f32x4 lb0 = *(const LAS f32x4*)(LBV + sk8), lb1 = *(const LAS f32x4*)(LBV + sk8 + 4); const float lb[8] = {lb0.x, lb0.y, lb0.z, lb0.w, lb1.x, lb1.y, lb1.z, lb1.w};
            const float aq[8] = {bflo(nq.x), bfhi(nq.x), bflo(nq.y), bfhi(nq.y), bflo(nq.z), bfhi(nq.z), bflo(nq.w), bfhi(nq.w)}, az[8] = {bflo(nf.x), bfhi(nf.x), bflo(nf.y), bfhi(nf.y), bflo(nf.z), bfhi(nf.z), bflo(nf.w), bfhi(nf.w)};
            float qv[8], kv[8], lf[8];
#pragma unroll
            for (int j = 0; j < 8; ++j) { qv[j] = siluf_(aq[j]); const float sg = sigmoidf_(az[j]); const float f = fmaxf(lb[j] + (1.0f - lb[j]) * sg, 1e-30f); kv[j] = (1.0f - lb[j]) * (1.0f - sg); lf[j] = __log2f(f); }
            *(LAS f32x4*)(LF + st * 128 + sk8) = (f32x4){lf[0], lf[1], lf[2], lf[3]}; *(LAS f32x4*)(LF + st * 128 + sk8 + 4) = (f32x4){lf[4], lf[5], lf[6], lf[7]};
            v4u qo, ko; qo.x = pk2(qv[0], qv[1]); qo.y = pk2(qv[2], qv[3]); qo.z = pk2(qv[4], qv[5]); qo.w = pk2(qv[6], qv[7]); ko.x = pk2(kv[0], kv[1]); ko.y = pk2(kv[2], kv[3]); ko.z = pk2(kv[4], kv[5]); ko.w = pk2(kv[6], kv[7]);
            *(LAS v4u*)(QB + st * PQ + sk8) = qo; *(LAS v4u*)(KB + st * PQ + sk8) = ko; *(LAS v4u*)(IVr + st * 128 + sk8) = ni;
#pragma unroll
            for (int hh = 0; hh < 2; ++hh)
#pragma unroll
                for (int r = 0; r < 4; ++r) ag[hh][r] = *(const bf16*)((const char*)P + (unsigned)((rbase + 16 * hh + 4 * fq + r) * (unsigned)NPAD + OFF_AG + h * 128 + 16 * wave + fr) * 2u);
            if (c + 1 < 64) { const unsigned pn = pst + (unsigned)(c + 1) * 32u * (unsigned)NPAD * 2u; nq = HG_LD16(pn + 2u * OFF_AQ); nf = HG_LD16(pn + 2u * OFF_AF); ni = HG_LD16(pn + 2u * OFF_AI); } }
        BAR_LDS();
        { const int k = tid & 127, tq = tid >> 7; float b[32]; float run = 0.f;
#pragma unroll
            for (int t = 0; t < 32; ++t) { run += LF[t * 128 + k]; b[t] = run; }
#pragma unroll
            for (int tq2 = 0; tq2 < 4; ++tq2) if (tq2 == tq) { const float mh = (tq2 < 2) ? b[7] : b[23]; float kt[8]; bf16 iv[8];
#pragma unroll
                for (int i = 0; i < 8; ++i) { const int t = 8 * tq2 + i; const float qv = bf1(QB[t * PQ + k]), kv = bf1(KB[t * PQ + k]); iv[i] = IVr[t * 128 + k];
                    Qt[t * PQ + k] = (bf16)f2bf(qv * __builtin_amdgcn_exp2f(b[t])); kt[i] = kv * __builtin_amdgcn_exp2f(b[31] - b[t]);
                    Qm[t * PQ + k] = (bf16)f2bf(qv * __builtin_amdgcn_exp2f(fminf(b[t] - mh, 115.f))); Km[t * PQ + k] = (bf16)f2bf(kv * __builtin_amdgcn_exp2f(fminf(mh - b[t], 115.f)));
                    if (tq2 < 2) Kr[t * PQ + k] = (bf16)f2bf(kv * __builtin_amdgcn_exp2f(b[15] - b[t])); else Qr[(t - 16) * PQ + k] = (bf16)f2bf(qv * __builtin_amdgcn_exp2f(b[t] - b[15])); }
                v4u ko; ko.x = pk2(kt[0], kt[1]); ko.y = pk2(kt[2], kt[3]); ko.z = pk2(kt[4], kt[5]); ko.w = pk2(kt[6], kt[7]); *(LAS v4u*)(KtT + k * PT + 8 * tq2) = ko;
                v4u vo; vo.x = (unsigned)iv[0] | ((unsigned)iv[1] << 16); vo.y = (unsigned)iv[2] | ((unsigned)iv[3] << 16); vo.z = (unsigned)iv[4] | ((unsigned)iv[5] << 16); vo.w = (unsigned)iv[6] | ((unsigned)iv[7] << 16); *(LAS v4u*)(VT + k * PT + 8 * tq2) = vo; }
            if (tq == 0) DEC[k] = __builtin_amdgcn_exp2f(b[31]); }
        if (c > 0) HG_OUT(rbase - 32);
        BAR_LDS();
        f32x4 at0 = (f32x4){0.f, 0.f, 0.f, 0.f}, at1 = at0, at2 = at0, o0 = at0, o1 = at0;
#pragma unroll
        for (int ks = 0; ks < 4; ++ks) { const int ko = 32 * ks + 8 * fq;
            at0 = MFMA16(LDFRAG(Km, fr, PQ, ko), LDFRAG(Qm, fr, PQ, ko), at0);
            at1 = MFMA16(LDFRAG(Km, 16 + fr, PQ, ko), LDFRAG(Qm, 16 + fr, PQ, ko), at1);
            at2 = MFMA16(LDFRAG(Kr, fr, PQ, ko), LDFRAG(Qr, fr, PQ, ko), at2);
            v4u sy; sy.x = pk2(sacc[2 * ks][0], sacc[2 * ks][1]); sy.y = pk2(sacc[2 * ks][2], sacc[2 * ks][3]); sy.z = pk2(sacc[2 * ks + 1][0], sacc[2 * ks + 1][1]); sy.w = pk2(sacc[2 * ks + 1][2], sacc[2 * ks + 1][3]);
            const v2u xa0 = *(const LAS v2u*)(Qt + fr * PQ + 32 * ks + 4 * fq), xb0 = *(const LAS v2u*)(Qt + fr * PQ + 32 * ks + 16 + 4 * fq);
            const v2u xa1 = *(const LAS v2u*)(Qt + (16 + fr) * PQ + 32 * ks + 4 * fq), xb1 = *(const LAS v2u*)(Qt + (16 + fr) * PQ + 32 * ks + 16 + 4 * fq);
            v4u x0; x0.x = xa0.x; x0.y = xa0.y; x0.z = xb0.x; x0.w = xb0.y; v4u x1; x1.x = xa1.x; x1.y = xa1.y; x1.z = xb1.x; x1.w = xb1.y;
            o0 = MFMA16(__builtin_bit_cast(bf16x8_t, x0), __builtin_bit_cast(bf16x8_t, sy), o0); o1 = MFMA16(__builtin_bit_cast(bf16x8_t, x1), __builtin_bit_cast(bf16x8_t, sy), o1); }
        {
            v4u a0, a1, a2; a0.z = 0u; a0.w = 0u; a1.z = 0u; a1.w = 0u; a2.z = 0u; a2.w = 0u;
            a0.x = pk2(4 * fq + 0 <= fr ? at0[0] : 0.f, 4 * fq + 1 <= fr ? at0[1] : 0.f); a0.y = pk2(4 * fq + 2 <= fr ? at0[2] : 0.f, 4 * fq + 3 <= fr ? at0[3] : 0.f);
            a1.x = pk2(4 * fq + 0 <= fr ? at1[0] : 0.f, 4 * fq + 1 <= fr ? at1[1] : 0.f); a1.y = pk2(4 * fq + 2 <= fr ? at1[2] : 0.f, 4 * fq + 3 <= fr ? at1[3] : 0.f);
            a2.x = pk2(at2[0], at2[1]); a2.y = pk2(at2[2], at2[3]);
            const v2u y0 = *(const LAS v2u*)(VT + (16 * wave + fr) * PT + 4 * fq), y1 = *(const LAS v2u*)(VT + (16 * wave + fr) * PT + 16 + 4 * fq);
            v4u v0; v0.x = y0.x; v0.y = y0.y; v0.z = 0u; v0.w = 0u; v4u v1; v1.x = y1.x; v1.y = y1.y; v1.z = 0u; v1.w = 0u;
            o0 = MFMA16(__builtin_bit_cast(bf16x8_t, a0), __builtin_bit_cast(bf16x8_t, v0), o0);
            o1 = MFMA16(__builtin_bit_cast(bf16x8_t, a1), __builtin_bit_cast(bf16x8_t, v1), o1);
            o1 = MFMA16(__builtin_bit_cast(bf16x8_t, a2), __builtin_bit_cast(bf16x8_t, v0), o1); }
#pragma unroll
        for (int r = 0; r < 4; ++r) { float q0 = o0[r] * o0[r], q1 = o1[r] * o1[r];
            q0 += __shfl_xor(q0, 1); q1 += __shfl_xor(q1, 1); q0 += __shfl_xor(q0, 2); q1 += __shfl_xor(q1, 2); q0 += __shfl_xor(q0, 4); q1 += __shfl_xor(q1, 4); q0 += __shfl_xor(q0, 8); q1 += __shfl_xor(q1, 8);
            if (fr == 0) { SS[(4 * fq + r) * 8 + wave] = q0; SS[(16 + 4 * fq + r) * 8 + wave] = q1; } }
        {
            const bf16x8_t vy = LDFRAG(VT, 16 * wave + fr, PT, 8 * fq);
#pragma unroll
            for (int kt = 0; kt < 8; ++kt) { const f32x4 d4 = *(const LAS f32x4*)(DEC + 16 * kt + 4 * fq); sacc[kt] = sacc[kt] * d4; sacc[kt] = MFMA16(LDFRAG(KtT, 16 * kt + fr, PT, 8 * fq), vy, sacc[kt]); } }
        po0 = o0; po1 = o1;
#pragma unroll
        for (int hh = 0; hh < 2; ++hh)
#pragma unroll
            for (int r = 0; r < 4; ++r) pag[hh][r] = ag[hh][r];
    }
    BAR_LDS();
    HG_OUT((unsigned)row0 + 2048u - 32u);
#undef HG_OUT
#undef HG_LD16
#pragma unroll
    for (int kt = 0; kt < 8; ++kt)
#pragma unroll
        for (int r = 0; r < 4; ++r) sout[(16 * kt + 4 * fq + r) * 128 + 16 * wave + fr] = sacc[kt][r];
    __syncthreads();
}

__device__ __forceinline__ void ssd_pre_phase(int lane, int gw, int NGW, const bf16* P, bf16* XC, float* DTb, float* ADT, float* ACUM,
                                              const float* conv_w, const float* conv_b, const float* dt_bias, const float* a_log, const float* state_conv, float* conv_out_p, float* conv_out_s) {
    unsigned ua = (unsigned)(((unsigned long long)(unsigned)gw * (3u * MT)) / (unsigned)NGW); const unsigned ub = (unsigned)(((unsigned long long)((unsigned)gw + 1u) * (3u * MT)) / (unsigned)NGW);
#define PRE_UNPK(dst, u) do { dst[0] = bflo(u.x); dst[1] = bfhi(u.x); dst[2] = bflo(u.y); dst[3] = bfhi(u.y); dst[4] = bflo(u.z); dst[5] = bfhi(u.z); dst[6] = bflo(u.w); dst[7] = bfhi(u.w); } while (0)
    while (ua < ub) {
        const int cg = (int)(ua / (unsigned)MT); const unsigned ue = ub < (unsigned)(cg + 1) * MT ? ub : (unsigned)(cg + 1) * MT;
        const int t0 = (int)(ua - (unsigned)cg * MT), t1 = (int)(ue - (unsigned)cg * MT), cc = cg * 512 + 8 * lane; ua = ue;
        float w[4][8], cb[8], a0[8], a1[8], a2[8];
#pragma unroll
        for (int j = 0; j < 4; ++j) { const f32x4 u0 = *(const f32x4*)(conv_w + j * 1536 + cc), u1 = *(const f32x4*)(conv_w + j * 1536 + cc + 4);
            w[j][0] = u0.x; w[j][1] = u0.y; w[j][2] = u0.z; w[j][3] = u0.w; w[j][4] = u1.x; w[j][5] = u1.y; w[j][6] = u1.z; w[j][7] = u1.w; }
        { const f32x4 u0 = *(const f32x4*)(conv_b + cc), u1 = *(const f32x4*)(conv_b + cc + 4); cb[0] = u0.x; cb[1] = u0.y; cb[2] = u0.z; cb[3] = u0.w; cb[4] = u1.x; cb[5] = u1.y; cb[6] = u1.z; cb[7] = u1.w; }
#pragma unroll
        for (int e = 0; e < 8; ++e) { a0[e] = 0.f; a1[e] = 0.f; a2[e] = 0.f; }
        const int ts = t0 >= 3 ? t0 - 3 : 0;
        const bf16* pc = P + OFF_XBC + cc; bf16* xo = XC + cc;
        v4u un[4];
#pragma unroll
        for (int k = 0; k < 4; ++k) { const int tt = ts + k < t1 ? ts + k : t1 - 1; un[k] = *(const v4u*)(pc + (size_t)tt * NPAD); }
        for (int tb = ts; tb < t1; tb += 4) { v4u uc[4];
#pragma unroll
            for (int k = 0; k < 4; ++k) uc[k] = un[k];
            if (tb + 4 < t1) {
#pragma unroll
                for (int k = 0; k < 4; ++k) { const int tt = tb + 4 + k < t1 ? tb + 4 + k : t1 - 1; un[k] = *(const v4u*)(pc + (size_t)tt * NPAD); } }
#pragma unroll
            for (int k = 0; k < 4; ++k) { const int t = tb + k; if (t < t1) {
                const bool smp = t >= NTOK_P; const bool st = smp ? (((t - NTOK_P) & 31) == 0) : ((t & 2047) == 0);
                if (st) {
                    if (smp) { const float* cbuf = state_conv + (size_t)((t - NTOK_P) >> 5) * 4608 + cc;
#pragma unroll
                        for (int e = 0; e < 8; ++e) { a0[e] = cbuf[e]; a1[e] = cbuf[1536 + e]; a2[e] = cbuf[3072 + e]; } }
                    else {
#pragma unroll
                        for (int e = 0; e < 8; ++e) { a0[e] = 0.f; a1[e] = 0.f; a2[e] = 0.f; } } }
                float cur[8]; PRE_UNPK(cur, uc[k]);
                if (t >= t0) { float o[8];
#pragma unroll
                    for (int e = 0; e < 8; ++e) o[e] = siluf_(cb[e] + w[0][e] * a0[e] + w[1][e] * a1[e] + w[2][e] * a2[e] + w[3][e] * cur[e]);
                    v4u ov; ov.x = pk2(o[0], o[1]); ov.y = pk2(o[2], o[3]); ov.z = pk2(o[4], o[5]); ov.w = pk2(o[6], o[7]);
                    *(v4u*)(xo + (size_t)t * 1536) = ov; }
#pragma unroll
                for (int e = 0; e < 8; ++e) { a0[e] = a1[e]; a1[e] = a2[e]; a2[e] = cur[e]; } } }
        }
    }
#undef PRE_UNPK
    for (int it = gw; it < 528 * 16; it += NGW) {
        const int rb = it >> 4, h = it & 15; const size_t row = (size_t)rb * 64 + lane;
        const float xv = bf1(P[row * NPAD + OFF_DT + h]) + dt_bias[h]; const float dt = xv > 20.f ? xv : log1pf(__expf(xv)); const float a = -dt * __expf(a_log[h]);
        float cs = a;
#pragma unroll
        for (int o = 1; o < 64; o <<= 1) { const float t = __shfl_up(cs, o); if (lane >= o) cs += t; }
        DTb[row * 16 + h] = dt; ADT[row * 16 + h] = a; ACUM[row * 16 + h] = cs;
    }
    for (int e = gw * 64 + lane; e < 48 * 4608; e += NGW * 64) {
        const int sq = e / 4608, r = e - sq * 4608, j = r / 1536, cc = r - j * 1536;
        const size_t row = sq < 16 ? (size_t)sq * 2048 + 2045 + j : (size_t)NTOK_P + (sq - 16) * 32 + 29 + j;
        const float v = bf1(P[row * NPAD + OFF_XBC + cc]);
        if (sq < 16) conv_out_p[sq * 4608 + r] = v; else conv_out_s[(sq - 16) * 4608 + r] = v;
    }
}

__device__ __forceinline__ void ssd_item(LAS unsigned char* lds, int tid, int lane, int wave, const bf16* P, const bf16* XC, const float* DTb, const float* ADT, bf16* YB, int row0, int T, int h,
                                         const float* s0, float* sout, float Dh) {
    LAS float* X = (LAS float*)lds;
    LAS float* Bs = X + 2048;
    LAS float* Cs = Bs + 4096;
    LAS float* DT = Cs + 4096;
    LAS float* DA = DT + 32;
    LAS float* PY = DA + 32;
    const int g = h >> 3, ci = tid;
    int cc = 0; LAS float* dst = X; int dstride = 64;
    if (ci < 64) { cc = h * 64 + ci; dst = X + ci; dstride = 64; } else if (ci < 192) { cc = 1024 + g * 128 + (ci - 64); dst = Bs + (ci - 64); dstride = 128; } else if (ci < 320) { cc = 1280 + g * 128 + (ci - 192); dst = Cs + (ci - 192); dstride = 128; }
    float hst[16];
#pragma unroll
    for (int j = 0; j < 4; ++j) { f32x4 v = (f32x4){0.f, 0.f, 0.f, 0.f}; if (s0) v = *(const f32x4*)(s0 + lane * 128 + 16 * wave + 4 * j); hst[4 * j] = v.x; hst[4 * j + 1] = v.y; hst[4 * j + 2] = v.z; hst[4 * j + 3] = v.w; }
    __syncthreads();
    const int nch = T / 32;
    for (int c = 0; c < nch; ++c) {
        const size_t rbase = (size_t)(row0 + c * 32);
        if (ci < 320) { const bf16* pc = XC + rbase * 1536 + cc;
            bf16 sv[32];
#pragma unroll
            for (int t = 0; t < 32; ++t) sv[t] = pc[(size_t)t * 1536];
#pragma unroll
            for (int t = 0; t < 32; ++t) dst[t * dstride] = bf1(sv[t]); }
        else if (ci < 352) { const int t = ci - 320; DT[t] = DTb[(rbase + t) * 16 + h]; DA[t] = __expf(ADT[(rbase + t) * 16 + h]); }
        unsigned zg[2];
#pragma unroll
        for (int j = 0; j < 2; ++j) { const int e = tid + 512 * j; zg[j] = *(const unsigned*)(P + (rbase + (e >> 5)) * NPAD + OFF_BZ + h * 64 + (e & 31) * 2); }
        __syncthreads();
#pragma unroll 2
        for (int t = 0; t < 32; ++t) {
            const float dA = DA[t], xdt = X[t * 64 + lane] * DT[t]; float py = 0.f;
#pragma unroll
            for (int n4 = 0; n4 < 4; ++n4) { const f32x4 b4 = *(const LAS f32x4*)(Bs + t * 128 + 16 * wave + 4 * n4), c4 = *(const LAS f32x4*)(Cs + t * 128 + 16 * wave + 4 * n4);
#pragma unroll
                for (int j = 0; j < 4; ++j) { const int nn = 4 * n4 + j; hst[nn] = fmaf(xdt, b4[j], dA * hst[nn]); py = fmaf(hst[nn], c4[j], py); } }
            PY[(t * 8 + wave) * 64 + lane] = py;
        }
        __syncthreads();
#pragma unroll
        for (int j = 0; j < 2; ++j) { const int e = tid + 512 * j, t = e >> 5, p2 = (e & 31) * 2; float y0 = 0.f, y1 = 0.f;
#pragma unroll
            for (int w = 0; w < 8; ++w) { const f32x2 p = *(const LAS f32x2*)(PY + (t * 8 + w) * 64 + p2); y0 += p.x; y1 += p.y; }
            const f32x2 xv = *(const LAS f32x2*)(X + t * 64 + p2); y0 += Dh * xv.x; y1 += Dh * xv.y;
            const size_t row = rbase + t; const unsigned z = zg[j];
            *(unsigned*)(YB + row * 1024 + h * 64 + p2) = pk2(y0 * siluf_(bflo(z)), y1 * siluf_(bfhi(z))); }
        __syncthreads();
    }
#pragma unroll
    for (int j = 0; j < 4; ++j) *(f32x4*)(sout + lane * 128 + 16 * wave + 4 * j) = (f32x4){hst[4 * j], hst[4 * j + 1], hst[4 * j + 2], hst[4 * j + 3]};
    __syncthreads();
}

__device__ __forceinline__ bf16 v4u_el(const v4u& d, int e) { const unsigned w = d[e >> 1]; return (bf16)((e & 1) ? (w >> 16) : (w & 0xffffu)); }
__device__ __forceinline__ void ssd_mfma_pair(LAS unsigned char* lds, int tid, int lane, int wave, const bf16* P, const bf16* XC, const float* DTb, const float* ACUM, bf16* YB, int row0, int h0, float Dh0, float Dh1, float* sout0) {
    constexpr int PC = 136, PS = 72;
    LAS bf16* Cm0 = (LAS bf16*)lds;
    LAS bf16* Bm = Cm0 + 2 * 64 * PC;
    LAS bf16* BmT = Bm + 64 * PC;
    LAS bf16* XT0 = BmT + 128 * PS;
    LAS bf16* Mm0 = XT0 + 4 * 64 * PS;
    LAS float* AC0 = (LAS float*)(Mm0 + 2 * 64 * PS);
    static_assert((2 * 64 * PC + 64 * PC + 128 * PS + 4 * 64 * PS + 2 * 64 * PS) * 2 + 4 * 192 * 4 <= RING_BYTES, "ssd pair LDS");
    const int fr = lane & 15, fq = lane >> 4, g = h0 >> 3;
    const int hw = wave >> 2, pt = wave & 3;
    __syncthreads();
    f32x4 hacc[8];
#pragma unroll
    for (int j = 0; j < 8; ++j) hacc[j] = (f32x4){0.f, 0.f, 0.f, 0.f};
    int pf_s[6], pf_c[6]; v4u pf[6];
#pragma unroll
    for (int j = 0; j < 6; ++j) { const int q = tid + 512 * j; pf_s[j] = q / 48; const int c16 = q - 48 * pf_s[j];
        const int col = c16 < 16 ? (h0 + (c16 >> 3)) * 64 + 8 * (c16 & 7) : (c16 < 32 ? 1024 + g * 128 + 8 * (c16 - 16) : 1280 + g * 128 + 8 * (c16 - 32));
        pf_c[j] = (c16 << 16) | col; pf[j] = *(const v4u*)((const char*)XC + (unsigned)(((unsigned)row0 + pf_s[j]) * 1536u + col) * 2u); }
    float pf_ac = 0.f, pf_dt = 0.f, pf_acl = 0.f; const int sh = tid >> 6, ssx = tid & 63;
    if (tid < 128) { pf_ac = *(const float*)((const char*)ACUM + (unsigned)(((unsigned)row0 + ssx) * 16u + h0 + sh) * 4u); pf_dt = *(const float*)((const char*)DTb + (unsigned)(((unsigned)row0 + ssx) * 16u + h0 + sh) * 4u); pf_acl = *(const float*)((const char*)ACUM + (unsigned)(((unsigned)row0 + 63u) * 16u + h0 + sh) * 4u); }
    for (int c = 0; c < 32; ++c) {
        const unsigned rbase = (unsigned)row0 + 64u * c;
        const int cb = c & 1;
        LAS bf16* Cm = Cm0 + cb * 64 * PC; LAS bf16* XTb = XT0 + cb * 2 * 64 * PS; LAS float* ACb = AC0 + cb * 2 * 192;
        if (tid < 128) { LAS float* A = ACb + sh * 192; A[ssx] = pf_ac; A[128 + ssx] = pf_dt; A[64 + ssx] = __expf(pf_acl - pf_ac) * pf_dt; }
#pragma unroll
        for (int j = 0; j < 6; ++j) { const int s = pf_s[j], c16 = pf_c[j] >> 16; const v4u d = pf[j];
            if (c16 < 16) { LAS bf16* XT = XTb + (c16 >> 3) * 64 * PS; const int cc = c16 & 7;
#pragma unroll
                for (int e = 0; e < 8; ++e) XT[(8 * cc + e) * PS + (s ^ (cc << 3))] = v4u_el(d, e); }
            else if (c16 < 32) { const int n0 = 8 * (c16 - 16); *(LAS v4u*)(Bm + s * PC + n0) = d;
#pragma unroll
                for (int e = 0; e < 8; ++e) BmT[(n0 + e) * PS + (s ^ (((c16 - 16) & 7) << 3))] = v4u_el(d, e); }
            else { *(LAS v4u*)(Cm + s * PC + 8 * (c16 - 32)) = d; } }
        if (c + 1 < 32) {
#pragma unroll
            for (int j = 0; j < 6; ++j) pf[j] = *(const v4u*)((const char*)XC + (unsigned)((rbase + 64u + pf_s[j]) * 1536u + (pf_c[j] & 0xffff)) * 2u);
            if (tid < 128) { pf_ac = *(const float*)((const char*)ACUM + (unsigned)((rbase + 64u + ssx) * 16u + h0 + sh) * 4u); pf_dt = *(const float*)((const char*)DTb + (unsigned)((rbase + 64u + ssx) * 16u + h0 + sh) * 4u); pf_acl = *(const float*)((const char*)ACUM + (unsigned)((rbase + 127u) * 16u + h0 + sh) * 4u); } }
        BAR_LDS();
        const LAS float* AC = ACb + hw * 192; const LAS bf16* XT = XTb + hw * 64 * PS;
        f32x4 yo[4];
        { bf16x8_t hb[4];
#pragma unroll
          for (int m = 0; m < 4; ++m) { v4u o; o.x = pk2(hacc[2 * m][0], hacc[2 * m][1]); o.y = pk2(hacc[2 * m][2], hacc[2 * m][3]); o.z = pk2(hacc[2 * m + 1][0], hacc[2 * m + 1][1]); o.w = pk2(hacc[2 * m + 1][2], hacc[2 * m + 1][3]);
              hb[m] = __builtin_bit_cast(bf16x8_t, o); }
#pragma unroll
          for (int li = 0; li < 4; ++li) { yo[li] = (f32x4){0.f, 0.f, 0.f, 0.f};
#pragma unroll
              for (int m = 0; m < 4; ++m) { const LAS bf16* cp = Cm + (16 * li + fr) * PC + 32 * m + 4 * fq; const v2u c0 = *(const LAS v2u*)cp, c1 = *(const LAS v2u*)(cp + 16);
                  v4u xo; xo.x = c0.x; xo.y = c0.y; xo.z = c1.x; xo.w = c1.y; yo[li] = MFMA16(__builtin_bit_cast(bf16x8_t, xo), hb[m], yo[li]); } } }
        { const LAS float* WU = AC + 64; const float dec = __expf(AC[63]);
          bf16x8_t xs[2];
#pragma unroll
          for (int ss = 0; ss < 2; ++ss) { const v4u d = *(const LAS v4u*)(XT + (16 * pt + fr) * PS + ((32 * ss + 8 * fq) ^ (((2 * pt + (fr >> 3)) & 7) << 3)));
              const f32x4 wa = *(const LAS f32x4*)(WU + 32 * ss + 8 * fq), wb = *(const LAS f32x4*)(WU + 32 * ss + 8 * fq + 4);
              v4u o; o.x = pk2(bflo(d.x) * wa.x, bfhi(d.x) * wa.y); o.y = pk2(bflo(d.y) * wa.z, bfhi(d.y) * wa.w); o.z = pk2(bflo(d.z) * wb.x, bfhi(d.z) * wb.y); o.w = pk2(bflo(d.w) * wb.z, bfhi(d.w) * wb.w);
              xs[ss] = __builtin_bit_cast(bf16x8_t, o); }
#pragma unroll
          for (int j = 0; j < 8; ++j) { hacc[j] = hacc[j] * dec;
#pragma unroll
              for (int ss = 0; ss < 2; ++ss) hacc[j] = MFMA16(LDFRAG(BmT, 16 * j + fr, PS, (32 * ss + 8 * fq) ^ (((2 * j + (fr >> 3)) & 7) << 3)), xs[ss], hacc[j]); } }
        {
            const int li = wave >> 1, si0 = 2 * (wave & 1);
#pragma unroll
            for (int tt = 0; tt < 2; ++tt) { const int si = si0 + tt; f32x4 acc = (f32x4){0.f, 0.f, 0.f, 0.f};
                if (si <= li) {
#pragma unroll
                    for (int ks = 0; ks < 4; ++ks) acc = MFMA16(LDFRAG(Cm, 16 * li + fr, PC, 32 * ks + 8 * fq), LDFRAG(Bm, 16 * si + fr, PC, 32 * ks + 8 * fq), acc); }
                const int s = 16 * si + fr;
#pragma unroll
                for (int hh = 0; hh < 2; ++hh) { const LAS float* A2 = ACb + hh * 192; LAS bf16* Mm = Mm0 + hh * 64 * PS; const float acs = A2[s], dts = A2[128 + s];
#pragma unroll
                    for (int r = 0; r < 4; ++r) { const int l = 16 * li + 4 * fq + r; const float m = (s <= l) ? acc[r] * __expf(A2[l] - acs) * dts : 0.f; Mm[l * PS + s] = (bf16)f2bf(m); } } }
        }
        bf16 zr[4][4];
#pragma unroll
        for (int li = 0; li < 4; ++li)
#pragma unroll
            for (int r = 0; r < 4; ++r) zr[li][r] = *(const bf16*)((const char*)P + (unsigned)((rbase + 16 * li + 4 * fq + r) * (unsigned)NPAD + OFF_BZ + (h0 + hw) * 64 + 16 * pt + fr) * 2u);
        BAR_LDS();
        {
            const LAS bf16* Mm = Mm0 + hw * 64 * PS; const int h = h0 + hw; const float Dh = hw ? Dh1 : Dh0; const int p = 16 * pt + fr;
            bf16x8_t xf[2];
#pragma unroll
            for (int ss = 0; ss < 2; ++ss) xf[ss] = LDFRAG(XT, 16 * pt + fr, PS, (32 * ss + 8 * fq) ^ (((2 * pt + (fr >> 3)) & 7) << 3));
#pragma unroll
            for (int li = 0; li < 4; ++li) { f32x4 yd = (f32x4){0.f, 0.f, 0.f, 0.f};
#pragma unroll
                for (int ss = 0; ss < 2; ++ss) { if (ss == 1 && li < 2) continue;
                    yd = MFMA16(LDFRAG(Mm, 16 * li + fr, PS, 32 * ss + 8 * fq), xf[ss], yd); }
#pragma unroll
                for (int r = 0; r < 4; ++r) { const int l = 16 * li + 4 * fq + r; const float y = yd[r] + __expf(AC[l]) * yo[li][r] + Dh * bf1(XT[p * PS + (l ^ (((p >> 3) & 7) << 3))]);
                    const float z = bf1(zr[li][r]);
                    *(bf16*)((char*)YB + (unsigned)((rbase + l) * 1024u + h * 64 + p) * 2u) = (bf16)f2bf(y * siluf_(z)); } }
        }
    }
#pragma unroll
    for (int j = 0; j < 8; ++j) *(f32x4*)(sout0 + (size_t)hw * 8192 + (16 * pt + fr) * 128 + 16 * j + 4 * fq) = hacc[j];
    __syncthreads();
}

__device__ __forceinline__ unsigned cm_off_b(unsigned row, unsigned ch) { return 256u * row + 16u * (ch ^ (((row & 3u) << 2) | ((row >> 2) & 3u))); }
__device__ __forceinline__ unsigned cm_tr_addr(unsigned lane, unsigned c, unsigned ks, unsigned t) { const unsigned g = lane >> 4, q = (lane & 15) >> 2, p = lane & 3; return cm_off_b(32 * ks + 8 * g + 4 * t + q, 2 * c + (p >> 1)) + 8 * (p & 1); }
__device__ __forceinline__ void cmlp_mfma_item(LAS unsigned char* lds, int tid, int lane, int wave, bf16* P, bf16* YC, int row0, const float* ln_g, const float* ln_b, const float* wsl, const float* bsl) {
    constexpr int PW = 136;
    LAS bf16* Wb = (LAS bf16*)lds;
    LAS unsigned char* Vimg = lds + 34816;
    LAS bf16* OUTb = (LAS bf16*)(lds + 67584);
    LAS float* ST = (LAS float*)(lds + ST_OFF);
    const int fr = lane & 15, fq = lane >> 4;
    __syncthreads();
    for (int i = 0; i < 16; ++i) { const int s = wave * 16 + i;
        v4u* p = (v4u*)(P + (size_t)(row0 + s) * NPAD + OFF_CV + 16 * lane); const v4u a = p[0], b = p[1];
        float v[16]; v[0] = bflo(a.x); v[1] = bfhi(a.x); v[2] = bflo(a.y); v[3] = bfhi(a.y); v[4] = bflo(a.z); v[5] = bfhi(a.z); v[6] = bflo(a.w); v[7] = bfhi(a.w);
        v[8] = bflo(b.x); v[9] = bfhi(b.x); v[10] = bflo(b.y); v[11] = bfhi(b.y); v[12] = bflo(b.z); v[13] = bfhi(b.z); v[14] = bflo(b.w); v[15] = bfhi(b.w);
        float sm = 0.f;
#pragma unroll
        for (int j = 0; j < 16; ++j) { v[j] = geluf_(v[j]); sm += v[j]; }
        v4u oa, ob; oa.x = pk2(v[0], v[1]); oa.y = pk2(v[2], v[3]); oa.z = pk2(v[4], v[5]); oa.w = pk2(v[6], v[7]); ob.x = pk2(v[8], v[9]); ob.y = pk2(v[10], v[11]); ob.z = pk2(v[12], v[13]); ob.w = pk2(v[14], v[15]);
        p[0] = oa; p[1] = ob;
        const float mean = wave_sum(sm) * (1.0f / 1024.0f); float sq = 0.f;
#pragma unroll
        for (int j = 0; j < 16; ++j) { const float d = v[j] - mean; sq += d * d; }
        const float rstd = rsqrtf_(wave_sum(sq) * (1.0f / 1024.0f) + NORM_EPS);
        if (lane == 0) { ST[2 * s] = mean; ST[2 * s + 1] = rstd; } }
    __syncthreads();
    f32x4 wreg[8]; v2u vreg[8];
#pragma unroll
    for (int e = 0; e < 8; ++e) { const int q = tid + 512 * e; wreg[e] = *(const f32x4*)(wsl + (size_t)(q >> 5) * 128 + 4 * (q & 31)); vreg[e] = *(const v2u*)(P + (size_t)(row0 + (q >> 5)) * NPAD + OFF_CV + 4 * (q & 31)); }
    for (int gh = 0; gh < 8; ++gh) { const int g = gh >> 1, c0 = gh * 128;
        if ((gh & 1) == 0) {
#pragma unroll
            for (int e = 0; e < 8; ++e) { const int q = tid + 512 * e, t = q >> 5, s4 = 4 * (q & 31); const f32x4 w = wreg[e];
                v2u o; o.x = pk2(s4 + 0 <= t ? w.x : 0.f, s4 + 1 <= t ? w.y : 0.f); o.y = pk2(s4 + 2 <= t ? w.z : 0.f, s4 + 3 <= t ? w.w : 0.f); *(LAS v2u*)(Wb + t * PW + s4) = o; } }
#pragma unroll
        for (int e = 0; e < 8; ++e) { const int q = tid + 512 * e, sr = q >> 5, c4 = 4 * (q & 31); const v2u cv = vreg[e]; const float mean = ST[2 * sr], rstd = ST[2 * sr + 1];
            const f32x4 lg = *(const f32x4*)(ln_g + c0 + c4), lb = *(const f32x4*)(ln_b + c0 + c4);
            v2u o; o.x = pk2((bflo(cv.x) - mean) * rstd * lg.x + lb.x, (bfhi(cv.x) - mean) * rstd * lg.y + lb.y); o.y = pk2((bflo(cv.y) - mean) * rstd * lg.z + lb.z, (bfhi(cv.y) - mean) * rstd * lg.w + lb.w);
            *(LAS v2u*)(Vimg + cm_off_b((unsigned)sr, (unsigned)(c4 >> 3)) + 2 * (c4 & 7)) = o; }
        v4u ureg[4];
#pragma unroll
        for (int e = 0; e < 4; ++e) { const int q = tid + 512 * e; ureg[e] = *(const v4u*)(P + (size_t)(row0 + (q >> 4)) * NPAD + OFF_CU + c0 + 8 * (q & 15)); }
        if (gh + 1 < 8) {
#pragma unroll
            for (int e = 0; e < 8; ++e) { const int q = tid + 512 * e; vreg[e] = *(const v2u*)(P + (size_t)(row0 + (q >> 5)) * NPAD + OFF_CV + c0 + 128 + 4 * (q & 31)); }
            if (gh & 1) {
#pragma unroll
                for (int e = 0; e < 8; ++e) { const int q = tid + 512 * e; wreg[e] = *(const f32x4*)(wsl + ((size_t)(g + 1) * 128 + (q >> 5)) * 128 + 4 * (q & 31)); } } }
        BAR_LDS();
        { f32x4 acc[8];
#pragma unroll
            for (int ti = 0; ti < 8; ++ti) acc[ti] = (f32x4){0.f, 0.f, 0.f, 0.f};
            const unsigned vb = (unsigned)(size_t)Vimg;
#pragma unroll
            for (int ks = 0; ks < 4; ++ks) { v2u y0, y1;
                asm volatile("ds_read_b64_tr_b16 %0, %2\n\tds_read_b64_tr_b16 %1, %3\n\ts_waitcnt lgkmcnt(0)" : "=&v"(y0), "=&v"(y1) : "v"(vb + cm_tr_addr((unsigned)lane, (unsigned)wave, (unsigned)ks, 0u)), "v"(vb + cm_tr_addr((unsigned)lane, (unsigned)wave, (unsigned)ks, 1u)) : "memory");
                v4u yy; yy.x = y0.x; yy.y = y0.y; yy.z = y1.x; yy.w = y1.y; const bf16x8_t yf = __builtin_bit_cast(bf16x8_t, yy);
#pragma unroll
                for (int ti = 2 * ks; ti < 8; ++ti) acc[ti] = MFMA16(LDFRAG(Wb, 16 * ti + fr, PW, 32 * ks + 8 * fq), yf, acc[ti]); }
#pragma unroll
            for (int ti = 0; ti < 8; ++ti)
#pragma unroll
                for (int r = 0; r < 4; ++r) OUTb[(16 * ti + 4 * fq + r) * PW + 16 * wave + fr] = (bf16)f2bf(acc[ti][r]); }
        BAR_LDS();
#pragma unroll
        for (int e = 0; e < 4; ++e) { const int q = tid + 512 * e, t = q >> 4, c8 = 8 * (q & 15); const v4u o = *(const LAS v4u*)(OUTb + t * PW + c8); const v4u u = ureg[e]; const float bsv = bsl[g * 128 + t];
            v4u y; y.x = pk2(geluf_(bflo(u.x)) * (bflo(o.x) + bsv), geluf_(bfhi(u.x)) * (bfhi(o.x) + bsv)); y.y = pk2(geluf_(bflo(u.y)) * (bflo(o.y) + bsv), geluf_(bfhi(u.y)) * (bfhi(o.y) + bsv));
            y.z = pk2(geluf_(bflo(u.z)) * (bflo(o.z) + bsv), geluf_(bfhi(u.z)) * (bfhi(o.z) + bsv)); y.w = pk2(geluf_(bflo(u.w)) * (bflo(o.w) + bsv), geluf_(bfhi(u.w)) * (bfhi(o.w) + bsv));
            *(v4u*)(YC + (size_t)(row0 + t) * 1024 + c0 + c8) = y; }
    }
    __syncthreads();
}

__device__ __forceinline__ void cmlp_item(LAS unsigned char* lds, int tid, int lane, int wave, const bf16* P, bf16* YC, int row0, int Lc,
                                          const float* ln_g, const float* ln_b, const float* wsl, const float* bsl, float* vout) {
    LAS float* WT = (LAS float*)lds;
    LAS float* V = WT + 16384;
    LAS float* ST = (LAS float*)(lds + ST_OFF);
    __syncthreads();
    for (int i = 0; i < 16; ++i) { const int s = wave * 16 + i; if (s < Lc) {
            const v4u* p = (const v4u*)(P + (size_t)(row0 + s) * NPAD + OFF_CV + 16 * lane); const v4u a = p[0], b = p[1];
            float v[16]; v[0] = bflo(a.x); v[1] = bfhi(a.x); v[2] = bflo(a.y); v[3] = bfhi(a.y); v[4] = bflo(a.z); v[5] = bfhi(a.z); v[6] = bflo(a.w); v[7] = bfhi(a.w);
            v[8] = bflo(b.x); v[9] = bfhi(b.x); v[10] = bflo(b.y); v[11] = bfhi(b.y); v[12] = bflo(b.z); v[13] = bfhi(b.z); v[14] = bflo(b.w); v[15] = bfhi(b.w);
            float sm = 0.f;
#pragma unroll
            for (int j = 0; j < 16; ++j) { v[j] = geluf_(v[j]); sm += v[j]; }
            const float mean = wave_sum(sm) * (1.0f / 1024.0f); float sq = 0.f;
#pragma unroll
            for (int j = 0; j < 16; ++j) { const float d = v[j] - mean; sq += d * d; }
            const float rstd = 1.0f / sqrtf(wave_sum(sq) * (1.0f / 1024.0f) + NORM_EPS);
            if (lane == 0) { ST[2 * s] = mean; ST[2 * s + 1] = rstd; } } }
    const int tg = tid >> 4, cg = tid & 15;
    for (int g = 0; g < 4; ++g) {
        __syncthreads();
#pragma unroll 1
        for (int j = 0; j < 8; ++j) { const int e = tid + 512 * j, s4 = (e >> 7) * 4, t = e & 127;
            f32x4 w = (f32x4){0.f, 0.f, 0.f, 0.f}; if (t < Lc && s4 < Lc) w = *(const f32x4*)(wsl + ((size_t)g * 128 + t) * 128 + s4);
#pragma unroll
            for (int jj = 0; jj < 4; ++jj) WT[(s4 + jj) * 128 + t] = (s4 + jj <= t) ? w[jj] : 0.f; }
        for (int half = 0; half < 2; ++half) { const int c0 = g * 256 + half * 128;
            if (half) __syncthreads();
#pragma unroll 2
            for (int j = 0; j < 8; ++j) { const int e = tid + 512 * j, s = e >> 5, c4 = (e & 31) * 4;
                if (s < Lc) { const v2u cv = *(const v2u*)(P + (size_t)(row0 + s) * NPAD + OFF_CV + c0 + c4); const float mean = ST[2 * s], rstd = ST[2 * s + 1];
                    const f32x4 lg = *(const f32x4*)(ln_g + c0 + c4), lb = *(const f32x4*)(ln_b + c0 + c4);
                    f32x4 v; v.x = (geluf_(bflo(cv.x)) - mean) * rstd * lg.x + lb.x; v.y = (geluf_(bfhi(cv.x)) - mean) * rstd * lg.y + lb.y; v.z = (geluf_(bflo(cv.y)) - mean) * rstd * lg.z + lb.z; v.w = (geluf_(bfhi(cv.y)) - mean) * rstd * lg.w + lb.w;
                    *(LAS f32x4*)(V + s * 128 + c4) = v; if (vout) *(f32x4*)(vout + (size_t)s * 1024 + c0 + c4) = v; } }
            __syncthreads();
            float acc[4][8];
#pragma unroll
            for (int i = 0; i < 4; ++i)
#pragma unroll
                for (int j = 0; j < 8; ++j) acc[i][j] = 0.f;
            for (int s = 0; s < Lc; ++s) { const f32x4 w4 = *(const LAS f32x4*)(WT + s * 128 + 4 * tg), va = *(const LAS f32x4*)(V + s * 128 + 4 * cg), vb = *(const LAS f32x4*)(V + s * 128 + 64 + 4 * cg);
#pragma unroll
                for (int i = 0; i < 4; ++i) {
#pragma unroll
                    for (int j = 0; j < 4; ++j) { acc[i][j] = fmaf(w4[i], va[j], acc[i][j]); acc[i][4 + j] = fmaf(w4[i], vb[j], acc[i][4 + j]); } } }
#pragma unroll
            for (int i = 0; i < 4; ++i) { const int t = 4 * tg + i; if (t < Lc) { const size_t row = (size_t)(row0 + t); const float bsv = bsl[g * 128 + t];
                    const v2u ua = *(const v2u*)(P + row * NPAD + OFF_CU + c0 + 4 * cg), ub = *(const v2u*)(P + row * NPAD + OFF_CU + c0 + 64 + 4 * cg);
                    v2u oa, ob; oa.x = pk2(geluf_(bflo(ua.x)) * (acc[i][0] + bsv), geluf_(bfhi(ua.x)) * (acc[i][1] + bsv)); oa.y = pk2(geluf_(bflo(ua.y)) * (acc[i][2] + bsv), geluf_(bfhi(ua.y)) * (acc[i][3] + bsv));
                    ob.x = pk2(geluf_(bflo(ub.x)) * (acc[i][4] + bsv), geluf_(bfhi(ub.x)) * (acc[i][5] + bsv)); ob.y = pk2(geluf_(bflo(ub.y)) * (acc[i][6] + bsv), geluf_(bfhi(ub.y)) * (acc[i][7] + bsv));
                    *(v2u*)(YC + row * 1024 + c0 + 4 * cg) = oa; *(v2u*)(YC + row * 1024 + c0 + 64 + 4 * cg) = ob; } }
        }
    }
    __syncthreads();
}

#ifndef DOWN_REV
#define DOWN_REV 1
#endif
#ifndef EPI_ALIGN_HEAVY
#define EPI_ALIGN_HEAVY true
#endif
#ifndef TAIL_SPLIT
#define TAIL_SPLIT 1
#endif
#ifndef MK_N_LAUNCHES
#define MK_N_LAUNCHES 1
#endif
constexpr int PH_PER_LAYER = 10, N_PHASES = 2 + DEPTH * PH_PER_LAYER;
constexpr int Q_NITEMS = 128 + 128 + 256 + 256 + 512 + 32;
struct Args { const float* in[29]; float* out; unsigned char* ws; int ph_lo, ph_hi; };
static_assert(sizeof(Args) == 29 * 8 + 8 + 8 + 8, "no padding in Args");

typedef const __attribute__((address_space(4))) unsigned long long* karg_t;
__device__ __forceinline__ unsigned long long ldarg(int i) { karg_t p = (karg_t)__builtin_amdgcn_kernarg_segment_ptr(); asm volatile("" : "+s"(p)); return p[i]; }
#define INP(i) ((const float*)(const GAS float*)ldarg(i))
#define OUTP() ((float*)(GAS float*)ldarg(29))
#define WSP() ((unsigned char*)(GAS unsigned char*)ldarg(30))

__device__ __forceinline__ int tid_now(int wave_s) { return (int)__builtin_amdgcn_mbcnt_hi(~0u, __builtin_amdgcn_mbcnt_lo(~0u, 0u)) + 64 * wave_s; }
__global__ void __launch_bounds__(NWAVES * 64, 2) fwd(Args args) {
    extern __shared__ __attribute__((aligned(16))) unsigned char lds_raw[];
    LAS unsigned char* lds = (LAS unsigned char*)lds_raw;
    volatile LAS unsigned* MISC = (volatile LAS unsigned*)(lds + MISC_OFF);
    const int wave_s = __builtin_amdgcn_readfirstlane((int)threadIdx.x >> 6);
    for (int u = threadIdx.x; u < 64; u += NWAVES * 64) MISC[u] = 0u;
    __syncthreads();
    XcdBarrier bar = xcd_barrier_post((unsigned*)WSP() + CW_BAR, MISC + 8, (int)threadIdx.x);
    const int lo = args.ph_lo, hi = args.ph_hi;
#define IN(k) (lo <= (k) && (k) < hi)
#define SEAM(k) do { if (IN((k) + 1)) { XcdBarrier b2_ = bar; b2_.bar = (unsigned*)WSP() + CW_BAR; asm volatile("" : "+s"(b2_.x)); xcd_barrier(b2_, tid_now(wave_s)); } } while (0)
#define GEOM() int tid = tid_now(wave_s); asm volatile("" : "+v"(tid)); int G = gridDim.x, bx = blockIdx.x; asm volatile("" : "+s"(G), "+s"(bx)); \
    const int lane = tid & 63, wave = __builtin_amdgcn_readfirstlane(tid >> 6); \
    const int vcu = (G % 8 == 0) ? (bx % 8) * (G / 8) + bx / 8 : bx; const int gw = vcu * NWAVES + wave, NGW = G * NWAVES; (void)lane; (void)gw; (void)NGW; (void)wave; (void)tid

    if (IN(0)) { GEOM();
        for (int it = bx; it < DEPTH * 96; it += G) mod_item(lds, tid, it, INP(5), INP(6), INP(9), INP(10), (float*)(WSP() + WS_MOD));
        { unsigned char* ws = WSP(); cvt_phase<true>(lds, wave, lane, 0, 0, 0, INP(11), INP(24), INP(25), INP(26), INP(27), ws + wofs(0), (unsigned*)ws + CW_QC); }
        SEAM(0);
    }
    for (int lc = 0; lc < DEPTH; ++lc) {
        const int pb = 1 + PH_PER_LAYER * lc;
        if (IN(pb + 0)) { GEOM(); int l = lc; asm volatile("" : "+s"(l)); unsigned char* ws = WSP(); bf16* X = (bf16*)(ws + WS_X);
            const bool comb = TAIL_SPLIT && l > 0; if (comb) build_tail_map((LAS int*)lds, tid, G, DOWN_REV);
            const float* modl = (const float*)(ws + WS_MOD) + (size_t)l * NSEQ * 12288;
            if (l == 0) norm_mod_phase<true>(lane, gw, NGW, INP(0), INP(1), X, INP(7), modl, 0, 1, (bf16*)(ws + WS_H), false, (const LAS int*)lds, (const float*)(ws + WS_SLAB), false);
            else norm_mod_phase<false>(lane, gw, NGW, nullptr, nullptr, X, INP(7) + l * DM, modl, 0, 1, (bf16*)(ws + WS_H), comb, (const LAS int*)lds, (const float*)(ws + WS_SLAB), false);
            SEAM(pb + 0);
        }
        if (IN(pb + 1)) { unsigned char* ws = WSP(); const int G = gridDim.x, bx = blockIdx.x;
            pg8::Gemm g{(const bf16*)(ws + WS_H), (const bf16*)(ws + wofs(lc) + WS_WIN), MT, NPAD, DM, DM}; pg8::StaticOrder S; S.init(MT, NPAD, G, bx);
            pg8::EpiStore<0> E{(bf16*)(ws + WS_P), NPAD};
#ifndef REP_P1
#define REP_P1 1
#endif
#pragma unroll 1
            for (int rp = 0; rp < REP_P1; ++rp)
#ifndef WIN_B_AUX
#define WIN_B_AUX 0
#endif
#ifdef SPLIT_WIN
            { S.nlim = (S.nwg / (2 * G)) * G; pg8::gemm_phase<pg8::EpiStore<0>, pg8::StaticOrder, true, true, 0, WIN_B_AUX>(lds, g, S, E, tid_now(wave_s));
              { XcdBarrier b2_ = bar; b2_.bar = (unsigned*)WSP() + CW_BAR; asm volatile("" : "+s"(b2_.x)); xcd_barrier(b2_, tid_now(wave_s)); }
              S.off = S.nlim; S.nlim = S.nwg; }
#endif
            pg8::gemm_phase<pg8::EpiStore<0>, pg8::StaticOrder, true, true, 0, WIN_B_AUX>(lds, g, S, E, tid_now(wave_s));
            SEAM(pb + 1);
        }
        if (IN(pb + 2)) { GEOM(); int l = lc; asm volatile("" : "+s"(l)); unsigned char* ws = WSP(); float* out = OUTP();
#ifndef REP_P2
#define REP_P2 1
#endif
#pragma unroll 1
            for (int rp = 0; rp < REP_P2; ++rp)
            ssd_pre_phase(lane, gw, NGW, (const bf16*)(ws + WS_P), (bf16*)(ws + WS_XC), (float*)(ws + WS_DT), (float*)(ws + WS_DT + DT_ARR), (float*)(ws + WS_DT + 2 * DT_ARR),
                          INP(14) + (size_t)l * 4 * 1536, INP(15) + l * 1536, INP(16) + l * 16, INP(17) + l * 16, INP(4) + (size_t)l * 32 * 4608, out + OUT_CONV_P + (size_t)l * 16 * 4608, out + OUT_CONV_S + (size_t)l * 32 * 4608);
            SEAM(pb + 2);
        }
        if (IN(pb + 3)) { GEOM(); int l = lc; asm volatile("" : "+s"(l));
#ifndef MIX_REPS
#define MIX_REPS 1
#endif
#pragma unroll 1
            for (int rep = 0; rep < MIX_REPS; ++rep)
            for (;;) {
                unsigned char* ws = WSP(); float* out = OUTP(); bf16* Pb = (bf16*)(ws + WS_P); bf16* Y3 = (bf16*)(ws + WS_Y3);
                __syncthreads();
                if (tid_now(wave_s) == 0) MISC[0] = __hip_atomic_fetch_add((unsigned*)ws + CW_Q + 64 * (l + 4 * rep), 1u, __ATOMIC_RELAXED, __HIP_MEMORY_SCOPE_AGENT);
                __syncthreads();
                int it = (int)MISC[0];
#ifdef EXTRA_BASE
                if (it >= Q_NITEMS && it < Q_NITEMS + EXTRA_N) it = EXTRA_BASE + (it - Q_NITEMS);
#endif
                if (it >= Q_NITEMS) break;
#define ITEM_GEOM() int tid_i = tid_now(wave_s); asm volatile("" : "+v"(tid_i)); const int lane_i = tid_i & 63, wave_i = __builtin_amdgcn_readfirstlane(tid_i >> 6)
                if (it < 128) {
                    const int b = 15 - (it >> 3), h = it & 7;
                    ITEM_GEOM(); hgrn_mfma_item(lds, tid_i, lane_i, wave_i, Pb, Y3, b * 2048, h, l, out + OUT_HGRN_P + (((size_t)l * 16 + b) * 8 + h) * 16384, INP(12), INP(13) + l * 1024);
                } else if (it < 256) {
                    const int j = it - 128, b = 15 - (j >> 3), h0 = 2 * (j & 7);
                    ITEM_GEOM(); ssd_mfma_pair(lds, tid_i, lane_i, wave_i, Pb, (const bf16*)(ws + WS_XC), (const float*)(ws + WS_DT), (const float*)(ws + WS_DT + 2 * DT_ARR), Y3 + (size_t)MT * 1024, b * 2048, h0, INP(18)[l * 16 + h0], INP(18)[l * 16 + h0 + 1],
                                  out + OUT_SSM_P + (((size_t)l * 16 + b) * 16 + h0) * 8192);
                } else if (it < 512) {
                    ITEM_GEOM(); cmlp_mfma_item(lds, tid_i, lane_i, wave_i, Pb, Y3 + (size_t)2 * MT * 1024, (255 - (it - 256)) * 128, INP(20) + l * 1024, INP(21) + l * 1024, INP(22) + (size_t)l * 4 * 16384, INP(23) + l * 512);
                } else if (it < 768) {
                    const int j = it - 512, b = j >> 3, h = j & 7;
                    ITEM_GEOM(); hgrn_item(lds, tid_i, lane_i, wave_i, Pb, Y3, NTOK_P + b * 32, 32, h, l, INP(2) + (((size_t)l * 32 + b) * 8 + h) * 16384, out + OUT_HGRN_S + (((size_t)l * 32 + b) * 8 + h) * 16384, INP(12), INP(13) + l * 1024);
                } else if (it < 1280) {
                    const int j = it - 768, b = j >> 4, h = j & 15;
                    ITEM_GEOM(); ssd_item(lds, tid_i, lane_i, wave_i, Pb, (const bf16*)(ws + WS_XC), (const float*)(ws + WS_DT), (const float*)(ws + WS_DT + DT_ARR), Y3 + (size_t)MT * 1024, NTOK_P + b * 32, 32, h,
                             INP(3) + (((size_t)l * 32 + b) * 16 + h) * 8192, out + OUT_SSM_S + (((size_t)l * 32 + b) * 16 + h) * 8192, INP(18)[l * 16 + h]);
                } else {
                    const int j = it - 1280;
                    ITEM_GEOM(); cmlp_item(lds, tid_i, lane_i, wave_i, Pb, Y3 + (size_t)2 * MT * 1024, NTOK_P + j * 32, 32, INP(20) + l * 1024, INP(21) + l * 1024, INP(22) + (size_t)l * 4 * 16384, INP(23) + l * 512, out + OUT_V_S + ((size_t)l * 32 + j) * 32 * 1024);
                }
            }
            SEAM(pb + 3);
        }
        if (IN(pb + 4)) { GEOM(); int l = lc; asm volatile("" : "+s"(l)); ssd_norm_phase(lane, gw, NGW, (bf16*)(WSP() + WS_Y3) + (size_t)MT * 1024, INP(19) + l * 1024); SEAM(pb + 4); }
        if (IN(pb + 5)) { unsigned char* ws = WSP(); const int G = gridDim.x, bx = blockIdx.x;
            pg8::Gemm g{(const bf16*)(ws + WS_Y3), (const bf16*)(ws + wofs(lc) + WS_WBR), 3 * MT, 3 * DM, 1024, 1024}; pg8::BranchOrder S; S.init(MT / 256, DM / 256, G, bx);
            pg8::EpiBranch E{(const bf16*)(ws + WS_P), NPAD, OFF_GATE, (bf16*)(ws + WS_H), DM, MT / 256, DM / 256};
#ifndef STAGGER_BR
#define STAGGER_BR 0
#endif
            if (STAGGER_BR && ((bx >> 3) & 1)) { for (int i = 0; i < STAGGER_BR; ++i) __builtin_amdgcn_s_sleep(127); }
#ifndef REP_P5
#define REP_P5 1
#endif
#pragma unroll 1
            for (int rp = 0; rp < REP_P5; ++rp)
            pg8::gemm_phase<pg8::EpiBranch, pg8::BranchOrder, EPI_ALIGN_HEAVY, true>(lds, g, S, E, tid_now(wave_s));
            if (lc + 1 < DEPTH) {
                GEOM(); int l1 = lc + 1; asm volatile("" : "+s"(l1)); unsigned char* ws2 = WSP();
                cvt_phase<true>(lds, wave, lane, 0, 0, l1, INP(11), INP(24), INP(25), INP(26), INP(27), ws2 + wofs(l1), (unsigned*)ws2 + CW_QC + 64 * l1);
#ifdef REP_CVT
                cvt_phase<true>(lds, wave, lane, 0, 0, l1, INP(11), INP(24), INP(25), INP(26), INP(27), ws2 + wofs(l1), (unsigned*)ws2 + CW_QC + 64 * (l1 + 4));
#endif
            }
            SEAM(pb + 5);
        }
        if (IN(pb + 6)) { int l = lc; asm volatile("" : "+s"(l)); unsigned char* ws = WSP(); bf16* X = (bf16*)(ws + WS_X); const int G = gridDim.x, bx = blockIdx.x;
            pg8::StaticOrder S; S.init(MT, DM, G, bx); S.wgm = WGM_N8; const int nfull = TAIL_SPLIT ? tail_nfull(S.nwg, G) : S.nwg; S.nlim = nfull;
            const float* gm = (const float*)(ws + WS_MOD) + (size_t)l * NSEQ * 12288 + 2 * DM;
            { pg8::Gemm g{(const bf16*)(ws + WS_H), (const bf16*)(ws + wofs(lc) + WS_WOUT), MT, DM, DM, DM};
#ifdef REP_P6
              { pg8::EpiRes E0{X, (const float*)(ws + 524288), 0}; pg8::gemm_phase<pg8::EpiRes, pg8::StaticOrder, EPI_ALIGN_HEAVY, true>(lds, g, S, E0, tid_now(wave_s)); }
#endif
              pg8::EpiRes E{X, gm, 12288};
              pg8::gemm_phase<pg8::EpiRes, pg8::StaticOrder, EPI_ALIGN_HEAVY, true>(lds, g, S, E, tid_now(wave_s)); }
            if (TAIL_SPLIT) { pg8::Gemm g{(const bf16*)(ws + WS_H), (const bf16*)(ws + wofs(lc) + WS_WOUT), MT, DM, DM / 8, DM}; pg8::TailOrder T; T.init(S, nfull, 8, DM / 8);
              pg8::EpiSlab E{(float*)(ws + WS_SLAB), gm};
              pg8::gemm_phase<pg8::EpiSlab, pg8::TailOrder, true, true>(lds, g, T, E, tid_now(wave_s)); }
            SEAM(pb + 6);
        }
        if (IN(pb + 7)) { GEOM(); int l = lc; asm volatile("" : "+s"(l)); unsigned char* ws = WSP(); bf16* X = (bf16*)(ws + WS_X);
            if (TAIL_SPLIT) build_tail_map((LAS int*)lds, tid, G, 0);
#ifdef REP_N7
            norm_mod_phase<false>(lane, gw, NGW, nullptr, nullptr, X, INP(8) + l * DM, (const float*)(ws + WS_MOD) + (size_t)l * NSEQ * 12288, 3, 4, (bf16*)(ws + WS_H), false, (const LAS int*)lds, (const float*)(ws + WS_SLAB), true);
#endif
            norm_mod_phase<false>(lane, gw, NGW, nullptr, nullptr, X, INP(8) + l * DM, (const float*)(ws + WS_MOD) + (size_t)l * NSEQ * 12288, 3, 4, (bf16*)(ws + WS_H), TAIL_SPLIT != 0, (const LAS int*)lds, (const float*)(ws + WS_SLAB), true); SEAM(pb + 7); }
        if (IN(pb + 8)) { unsigned char* ws = WSP(); const int G = gridDim.x, bx = blockIdx.x;
            pg8::Gemm g{(const bf16*)(ws + WS_H), (const bf16*)(ws + wofs(lc) + WS_WUP), MT, DFF, DM, DM}; pg8::StaticOrder S; S.init(MT, DFF, G, bx);
            pg8::EpiStore<1> E{(bf16*)(ws + WS_P), DFF};
#ifndef REP_P8
#define REP_P8 1
#endif
#pragma unroll 1
            for (int rp = 0; rp < REP_P8; ++rp)
            pg8::gemm_phase<pg8::EpiStore<1>, pg8::StaticOrder, true, true, 0, WIN_B_AUX>(lds, g, S, E, tid_now(wave_s));
            SEAM(pb + 8);
        }
        if (IN(pb + 9)) { int l = lc; asm volatile("" : "+s"(l)); unsigned char* ws = WSP(); bf16* X = (bf16*)(ws + WS_X); const int G = gridDim.x, bx = blockIdx.x;
            pg8::StaticOrder S; S.init(MT, DM, G, bx); S.wgm = WGM_N8; S.rev = DOWN_REV; const int nfull = TAIL_SPLIT ? tail_nfull(S.nwg, G) : S.nwg; S.nlim = nfull;
            const float* gm = (const float*)(ws + WS_MOD) + (size_t)l * NSEQ * 12288 + 5 * DM;
            { pg8::Gemm g{(const bf16*)(ws + WS_P), (const bf16*)(ws + wofs(lc) + WS_WDN), MT, DM, DFF, DFF};
#ifdef REP_P9
              { pg8::EpiRes E0{X, (const float*)(ws + 524288), 0}; pg8::gemm_phase<pg8::EpiRes, pg8::StaticOrder, EPI_ALIGN_HEAVY, true>(lds, g, S, E0, tid_now(wave_s)); }
#endif
              pg8::EpiRes E{X, gm, 12288};
#ifndef DOWN_A_AUX
#define DOWN_A_AUX 0
#endif
              pg8::gemm_phase<pg8::EpiRes, pg8::StaticOrder, EPI_ALIGN_HEAVY, true, DOWN_A_AUX>(lds, g, S, E, tid_now(wave_s)); }
            if (TAIL_SPLIT) { pg8::Gemm g{(const bf16*)(ws + WS_P), (const bf16*)(ws + wofs(lc) + WS_WDN), MT, DM, DFF / 8, DFF}; pg8::TailOrder T; T.init(S, nfull, 8, DFF / 8);
              pg8::EpiSlab E{(float*)(ws + WS_SLAB), gm};
              pg8::gemm_phase<pg8::EpiSlab, pg8::TailOrder, true, true>(lds, g, T, E, tid_now(wave_s)); }
            SEAM(pb + 9);
        }
    }
    if (IN(N_PHASES - 1)) { GEOM(); unsigned char* ws = WSP(); if (TAIL_SPLIT) build_tail_map((LAS int*)lds, tid, G, DOWN_REV);
        final_norm_phase(lane, gw, NGW, (const bf16*)(ws + WS_X), OUTP(), INP(28), TAIL_SPLIT != 0, (const LAS int*)lds, (const float*)(ws + WS_SLAB)); }
#undef IN
#undef SEAM
#undef GEOM
}

extern "C" void kernel_launch(void* const* d_in, const int* in_sizes, int n_in, void* d_out, int out_size, void* d_ws, size_t ws_size, hipStream_t stream) {
    static int grid = 0;
    if (grid == 0) {
        if (n_in != 29 || (size_t)out_size != OUT_TOTAL || ws_size < WS_END) { fprintf(stderr, "kernel_launch: unexpected shapes: n_in %d out %d ws %zu (need %zu)\n", n_in, out_size, ws_size, (size_t)WS_END); grid = -1; return; }
        int dev = 0, cus = 0, per_cu = 0;
        if (hipGetDevice(&dev) != hipSuccess || hipDeviceGetAttribute(&cus, hipDeviceAttributeMultiprocessorCount, dev) != hipSuccess) { grid = -1; return; }
        if (hipFuncSetAttribute((const void*)fwd, hipFuncAttributeMaxDynamicSharedMemorySize, LDS_BYTES) != hipSuccess) { fprintf(stderr, "kernel_launch: hipFuncSetAttribute failed\n"); grid = -1; return; }
        if (hipOccupancyMaxActiveBlocksPerMultiprocessor(&per_cu, (const void*)fwd, NWAVES * 64, LDS_BYTES) != hipSuccess || per_cu < 1) fprintf(stderr, "kernel_launch: occupancy query says %d\n", per_cu);
        (void)hipGetLastError();
        grid = cus;
    }
    if (grid < 0) return;
    if (hipMemsetAsync((char*)d_ws + WS_CTL, 0, CTL_ZERO_BYTES, stream) != hipSuccess) return;
    Args a{};
    for (int i = 0; i < 29; ++i) a.in[i] = (const float*)d_in[i];
    a.out = (float*)d_out; a.ws = (unsigned char*)d_ws;
#if MK_N_LAUNCHES == 1
    a.ph_lo = 0; a.ph_hi = N_PHASES;
    hipLaunchKernelGGL(fwd, dim3(grid), dim3(NWAVES * 64), LDS_BYTES, stream, a);
#else
    for (int p = 0; p < N_PHASES; ++p) { a.ph_lo = p; a.ph_hi = p + 1; hipLaunchKernelGGL(fwd, dim3(grid), dim3(NWAVES * 64), LDS_BYTES, stream, a); }
#endif
}
```

```cpp
#include <hip/hip_runtime.h>
#include <cstdio>
#include <cstdint>
namespace pg8 {
#define PG8_LAS __attribute__((address_space(3)))
typedef unsigned short bf16_t;
typedef short bf16x8 __attribute__((ext_vector_type(8)));
typedef float f32x4 __attribute__((ext_vector_type(4)));
typedef unsigned u32x4 __attribute__((ext_vector_type(4)));
constexpr int BM = 256, BK = 64, HALF = 128, HTB = HALF * BK * 2  , STAGE_BYTES = 8 * HTB, NXCD = 8, WGM = 4;

__host__ __device__ __forceinline__ int lds_byte(int r, int c) { const int st = (r >> 4) * 2 + (c >> 5), rr = r & 15, cc = c & 31, ob = rr * 64 + cc * 2; return st * 1024 + (ob ^ (((ob >> 9) & 1) << 5)); }
__host__ __device__ __forceinline__ void stage_rc(int b, int& R, int& C) { const int st = b / 1024, sb = b % 1024, swz = sb ^ (((sb >> 9) & 1) << 5); R = (st >> 1) * 16 + swz / 64; C = (st & 1) * 32 + (swz % 64) / 2; }
__host__ __device__ __forceinline__ int perm32(int rho) { const int n = rho >> 4, i = rho & 15; return 8 * (i >> 2) + 4 * n + (i & 3); }

struct Unit { int pm, pn, ko, aux; };
struct Gemm { const bf16_t* A; const bf16_t* Bt; int M, N, K, ld; };

struct StaticOrder {
    int nM, nN, nwg, G, c, nlim, rev, wgm, off;
    __host__ __device__ void init(int M, int N, int G_, int c_) { nM = M / BM; nN = N / BM; nwg = nM * nN; G = G_; c = c_; nlim = nwg; rev = 0; wgm = WGM; off = 0; }
    __host__ __device__ void tile_of(int wgid, Unit& u) const {
        { const int q = nwg / NXCD, r = nwg % NXCD, xcd = wgid % NXCD, off = wgid / NXCD; wgid = (xcd < r ? xcd * (q + 1) : r * (q + 1) + (xcd - r) * q) + off; }
        const int nig = wgm * nN, gid = wgid / nig, fm = gid * wgm, gsz = (nM - fm) < wgm ? (nM - fm) : wgm;
        u.pm = fm + ((wgid % nig) % gsz); u.pn = (wgid % nig) / gsz; u.ko = 0; u.aux = 0; if (rev) u.pm = nM - 1 - u.pm; }
    __host__ __device__ bool next(int i, Unit& u) const {
        const long L = (long)i * G + c + off; if (L >= nlim) return false;
        tile_of((int)L, u); return true;
    }
    __device__ __forceinline__ void a_ready(const Unit&) const {}
    __device__ __forceinline__ void done(const Unit&) const {}
};
typedef float pg8_f32x2 __attribute__((ext_vector_type(2))); typedef __bf16 pg8_bf16x2 __attribute__((ext_vector_type(2)));
__device__ __forceinline__ unsigned cvt_pk_bf16(float lo, float hi) { const pg8_f32x2 v = {lo, hi}; const pg8_bf16x2 b = __builtin_convertvector(v, pg8_bf16x2); return __builtin_bit_cast(unsigned, b); }
typedef unsigned u32x2 __attribute__((ext_vector_type(2)));
__device__ __forceinline__ float bf_lo(unsigned w) { return __uint_as_float(w << 16); }
__device__ __forceinline__ float bf_hi(unsigned w) { return __uint_as_float(w & 0xffff0000u); }
__device__ __forceinline__ float fast_sigmoid(float x) { return __builtin_amdgcn_rcpf(1.0f + __builtin_amdgcn_exp2f(-1.44269504089f * x)); }

#ifndef EPI_NT_STORE
#define EPI_NT_STORE 0
#endif
template <int ACT> struct EpiStore {
    static constexpr bool PERM = true, AFTER_DRAIN = false;
    bf16_t* O; int ldc;
    __device__ __forceinline__ void operator()(const f32x4 (&acc)[2][2][4][2], const Unit& u, int wr, int wc, int fr, int fq) const {
        const int row0 = u.pm * BM + wr * 64 + fr, col0 = u.pn * BM + wc * 32 + 8 * fq;
#pragma unroll
        for (int ai = 0; ai < 2; ++ai)
#pragma unroll
            for (int m = 0; m < 4; ++m) { bf16_t* rowp = O + (size_t)(row0 + ai * HALF + m * 16) * ldc + col0;
#pragma unroll
                for (int bj = 0; bj < 2; ++bj) { f32x4 v0 = acc[ai][bj][m][0], v1 = acc[ai][bj][m][1];
                    if (ACT == 1) {
#pragma unroll
                        for (int j = 0; j < 4; ++j) { const float a = fmaxf(v0[j], 0.f), b = fmaxf(v1[j], 0.f); v0[j] = a * a; v1[j] = b * b; } }
                    u32x4 w; w.x = cvt_pk_bf16(v0[0], v0[1]); w.y = cvt_pk_bf16(v0[2], v0[3]); w.z = cvt_pk_bf16(v1[0], v1[1]); w.w = cvt_pk_bf16(v1[2], v1[3]);
                    if (EPI_NT_STORE) __builtin_nontemporal_store(w, (u32x4*)(rowp + bj * HALF)); else *(u32x4*)(rowp + bj * HALF) = w; } }
    }
};

struct EpiBranch {
    static constexpr bool PERM = true, AFTER_DRAIN = false;
    const bf16_t* P; int ldp; int gate_off; bf16_t* MG; int ldm; int npm, npn;
    __device__ __forceinline__ void operator()(const f32x4 (&acc)[2][2][4][2], const Unit& u, int wr, int wc, int fr, int fq) const {
        const int k = u.pm / npm, pm = u.pm - k * npm, pn = u.pn - k * npn;
        const int row0 = pm * BM + wr * 64 + fr, col0 = pn * BM + wc * 32 + 8 * fq;
#pragma unroll
        for (int ai = 0; ai < 2; ++ai)
#pragma unroll
            for (int m = 0; m < 4; ++m) { const size_t r = (size_t)(row0 + ai * HALF + m * 16);
                const bf16_t* gp = P + r * ldp + gate_off + k * 2048 + col0; bf16_t* mp = MG + r * ldm + col0;
#pragma unroll
                for (int bj = 0; bj < 2; ++bj) { const u32x4 g = *(const u32x4*)(gp + bj * HALF);
                    f32x4 v0 = acc[ai][bj][m][0], v1 = acc[ai][bj][m][1];
                    v0[0] *= fast_sigmoid(bf_lo(g.x)); v0[1] *= fast_sigmoid(bf_hi(g.x)); v0[2] *= fast_sigmoid(bf_lo(g.y)); v0[3] *= fast_sigmoid(bf_hi(g.y));
                    v1[0] *= fast_sigmoid(bf_lo(g.z)); v1[1] *= fast_sigmoid(bf_hi(g.z)); v1[2] *= fast_sigmoid(bf_lo(g.w)); v1[3] *= fast_sigmoid(bf_hi(g.w));
                    if (k > 0) { const u32x4 p = *(const u32x4*)(mp + bj * HALF);
                        v0[0] += bf_lo(p.x); v0[1] += bf_hi(p.x); v0[2] += bf_lo(p.y); v0[3] += bf_hi(p.y);
                        v1[0] += bf_lo(p.z); v1[1] += bf_hi(p.z); v1[2] += bf_lo(p.w); v1[3] += bf_hi(p.w); }
                    u32x4 w; w.x = cvt_pk_bf16(v0[0], v0[1]); w.y = cvt_pk_bf16(v0[2], v0[3]); w.z = cvt_pk_bf16(v1[0], v1[1]); w.w = cvt_pk_bf16(v1[2], v1[3]);
                    *(u32x4*)(mp + bj * HALF) = w; }
                if (m == 3) asm volatile("" ::: "memory"); }
    }
};

struct EpiRes {
    static constexpr bool PERM = true, AFTER_DRAIN = false;
    bf16_t* X; const float* gmod; int gstride;
    __device__ __forceinline__ void operator()(const f32x4 (&acc)[2][2][4][2], const Unit& u, int wr, int wc, int fr, int fq) const {
        const int row0 = u.pm * BM + wr * 64 + fr, col0 = u.pn * BM + wc * 32 + 8 * fq;
#pragma unroll
        for (int ai = 0; ai < 2; ++ai)
#pragma unroll
            for (int m = 0; m < 4; ++m) { const int r = row0 + ai * HALF + m * 16;
                const int seq = r < 32768 ? (r >> 11) : 16 + ((r - 32768) >> 5);
                const float* gp = gmod + (size_t)seq * gstride + col0; bf16_t* xp = X + (size_t)r * 2048 + col0;
#pragma unroll
                for (int bj = 0; bj < 2; ++bj) { const f32x4 g0 = *(const f32x4*)(gp + bj * HALF), g1 = *(const f32x4*)(gp + bj * HALF + 4); const u32x4 b = *(const u32x4*)(xp + bj * HALF);
                    const f32x4 v0 = acc[ai][bj][m][0] * g0, v1 = acc[ai][bj][m][1] * g1;
                    u32x4 w; w.x = cvt_pk_bf16(bf_lo(b.x) + v0[0], bf_hi(b.x) + v0[1]); w.y = cvt_pk_bf16(bf_lo(b.y) + v0[2], bf_hi(b.y) + v0[3]);
                    w.z = cvt_pk_bf16(bf_lo(b.z) + v1[0], bf_hi(b.z) + v1[1]); w.w = cvt_pk_bf16(bf_lo(b.w) + v1[2], bf_hi(b.w) + v1[3]);
                    *(u32x4*)(xp + bj * HALF) = w; }
                if (m == 3) asm volatile("" ::: "memory"); }
    }
};

struct BranchOrder {
    int G, c, npm, npn, ntile;
    __device__ void init(int npm_, int npn_, int G_, int c_) { npm = npm_; npn = npn_; ntile = npm_ * npn_; G = G_; c = c_; }
    __device__ bool next(int i, Unit& u) const {
        const int ti = i / 3, k = i - 3 * ti; const long L = (long)ti * G + c; if (L >= ntile) return false;
        int wgid = (int)L; { const int q = ntile / NXCD, r = ntile % NXCD, xcd = wgid % NXCD, off = wgid / NXCD; wgid = (xcd < r ? xcd * (q + 1) : r * (q + 1) + (xcd - r) * q) + off; }
        const int nig = WGM * npn, gid = wgid / nig, fm = gid * WGM, gsz = (npm - fm) < WGM ? (npm - fm) : WGM;
        u.pm = k * npm + fm + ((wgid % nig) % gsz); u.pn = k * npn + (wgid % nig) / gsz; u.ko = 0; u.aux = 0; return true;
    }
    __device__ __forceinline__ void a_ready(const Unit&) const {}
    __device__ __forceinline__ void done(const Unit&) const {}
};


struct EpiResAtomic {
    static constexpr bool PERM = false, AFTER_DRAIN = false;
    float* out; const float* gmod;
    __device__ __forceinline__ void operator()(const f32x4 (&acc)[2][2][4][2], const Unit& u, int wr, int wc, int fr, int fq) const {
        const int row0 = u.pm * BM + wr * 64 + fr, col0 = u.pn * BM + wc * 32 + 4 * fq;
#pragma unroll
        for (int ai = 0; ai < 2; ++ai)
#pragma unroll
            for (int m = 0; m < 4; ++m) { const int r = row0 + ai * HALF + m * 16;
                const int seq = r < 32768 ? (r >> 11) : 16 + ((r - 32768) >> 5);
                const float* gp = gmod + (size_t)seq * 12288 + col0; float* op = out + (size_t)r * 2048 + col0;
#pragma unroll
                for (int bj = 0; bj < 2; ++bj)
#pragma unroll
                    for (int n = 0; n < 2; ++n) { const f32x4 g = *(const f32x4*)(gp + bj * HALF + n * 16); const f32x4 v = g * acc[ai][bj][m][n]; float* o = op + bj * HALF + n * 16;
                        typedef __attribute__((address_space(1))) float gfloat; gfloat* og = (gfloat*)o;
                        (void)__builtin_amdgcn_global_atomic_fadd_f32(og + 0, v.x); (void)__builtin_amdgcn_global_atomic_fadd_f32(og + 1, v.y); (void)__builtin_amdgcn_global_atomic_fadd_f32(og + 2, v.z); (void)__builtin_amdgcn_global_atomic_fadd_f32(og + 3, v.w); } }
    }
};
struct TailOrder {
    StaticOrder base; int nfull, SL, Ks;
    __device__ void init(const StaticOrder& b, int nfull_, int SL_, int Ks_) { base = b; nfull = nfull_; SL = SL_; Ks = Ks_; }
    __device__ bool next(int i, Unit& u) const { const long L = (long)i * base.G + base.c; if (L >= (long)(base.nwg - nfull) * SL) return false;
        const int t = (int)L / SL, sl = (int)L - t * SL; base.tile_of(nfull + t, u); u.ko = sl * Ks; u.aux = (int)L; return true; }
    __device__ __forceinline__ void a_ready(const Unit&) const {}
    __device__ __forceinline__ void done(const Unit&) const {}
};

struct EpiSlab {
    static constexpr bool PERM = false, AFTER_DRAIN = false;
    float* slab; const float* gmod;
    __device__ __forceinline__ void operator()(const f32x4 (&acc)[2][2][4][2], const Unit& u, int wr, int wc, int fr, int fq) const {
        const int rt0 = wr * 64 + fr, ct0 = wc * 32 + 4 * fq; float* sb = slab + (size_t)u.aux * 65536;
#pragma unroll
        for (int ai = 0; ai < 2; ++ai)
#pragma unroll
            for (int m = 0; m < 4; ++m) { const int rt = rt0 + ai * HALF + m * 16, r = u.pm * BM + rt;
                const int seq = r < 32768 ? (r >> 11) : 16 + ((r - 32768) >> 5);
                const float* gp = gmod + (size_t)seq * 12288 + u.pn * BM + ct0; float* op = sb + rt * 256 + ct0;
#pragma unroll
                for (int bj = 0; bj < 2; ++bj)
#pragma unroll
                    for (int n = 0; n < 2; ++n) { const f32x4 g = *(const f32x4*)(gp + bj * HALF + n * 16); *(f32x4*)(op + bj * HALF + n * 16) = g * acc[ai][bj][m][n]; } }
    }
};
template <class Epi, class Sched, bool ALIGN_EPI = false, bool SP2 = false, int A_AUX = 0, int B_AUX = 0>
__device__ __forceinline__ void gemm_phase(PG8_LAS unsigned char* lds, const Gemm g, const Sched& S, const Epi& E, int tid_in) {
    int tid_ = tid_in; asm volatile("" : "+v"(tid_));
    const int tid = tid_, wid = __builtin_amdgcn_readfirstlane(tid >> 6), lane = tid & 63, wr = wid >> 2, wc = wid & 3, fr = lane & 15, fq = lane >> 4;
    const int K = g.K, ld = g.ld, nt = K / BK;
    unsigned voffA[2], voffB[2];
#pragma unroll
    for (int i = 0; i < 2; ++i) { int R, C; stage_rc(tid * 16 + i * 8192, R, C); const int Rb = Epi::PERM ? ((R & ~31) + perm32(R & 31)) : R;
        voffA[i] = (unsigned)(R * ld + C) * 2u; voffB[i] = (unsigned)(Rb * ld + C) * 2u; }
    const size_t kstep = (size_t)(BK * 2);
    const size_t hstep = (size_t)HALF * ld * 2;
    const size_t tstep = 2 * hstep;
    const unsigned ldsw = (unsigned)wid * 1024u;
    const int aoff = lds_byte(wr * 64 + fr, fq * 8), boff = lds_byte(wc * 32 + fr, fq * 8);
#define PG8_SA(b, h) (((b) * 2 + (h)) * HTB)
#define PG8_SB(b, h) ((4 + (b) * 2 + (h)) * HTB)
#define PG8_STAGE(bufoff, gbase, voff) do { _Pragma("unroll") for (int _i = 0; _i < 2; ++_i) \
        __builtin_amdgcn_global_load_lds((const unsigned*)((const char*)(gbase) + (voff)[_i]), (PG8_LAS unsigned*)(lds + (bufoff) + ldsw + _i * 8192), 16, 0, B_AUX); } while (0)
#define PG8_STAGEA(bufoff, gbase, voff) do { _Pragma("unroll") for (int _i = 0; _i < 2; ++_i) \
        __builtin_amdgcn_global_load_lds((const unsigned*)((const char*)(gbase) + (voff)[_i]), (PG8_LAS unsigned*)(lds + (bufoff) + ldsw + _i * 8192), 16, 0, A_AUX); } while (0)
#define PG8_LDA(dst, b, h) do { _Pragma("unroll") for (int m = 0; m < 4; ++m) _Pragma("unroll") for (int k = 0; k < 2; ++k) dst[m][k] = *(const PG8_LAS bf16x8*)(lds + PG8_SA(b, h) + aoff + m * 2048 + k * 1024); } while (0)
#define PG8_LDB(dst, b, h) do { _Pragma("unroll") for (int n = 0; n < 2; ++n) _Pragma("unroll") for (int k = 0; k < 2; ++k) dst[n][k] = *(const PG8_LAS bf16x8*)(lds + PG8_SB(b, h) + boff + n * 2048 + k * 1024); } while (0)
#define PG8_MMA(ai, bj, At, Bt) do { __builtin_amdgcn_s_setprio(1); _Pragma("unroll") for (int m = 0; m < 4; ++m) _Pragma("unroll") for (int n = 0; n < 2; ++n) _Pragma("unroll") for (int k = 0; k < 2; ++k) \
        acc[ai][bj][m][n] = __builtin_amdgcn_mfma_f32_16x16x32_bf16(Bt[n][k], At[m][k], acc[ai][bj][m][n], 0, 0, 0); __builtin_amdgcn_s_setprio(0); } while (0)
#define PG8_WAIT_V(n) asm volatile("s_waitcnt vmcnt(" #n ")" ::: "memory")
#define PG8_WAIT_L(n) asm volatile("s_waitcnt lgkmcnt(" #n ")" ::: "memory")
#define PG8_BAR __builtin_amdgcn_s_barrier()
#define PG8_SCHED __builtin_amdgcn_sched_barrier(0)
    Unit cur, nxt; int ui = 0;
    if (!S.next(0, cur)) return;
    f32x4 acc[2][2][4][2];
#pragma unroll
    for (int a = 0; a < 2; ++a)
#pragma unroll
        for (int b = 0; b < 2; ++b)
#pragma unroll
            for (int m = 0; m < 4; ++m)
#pragma unroll
                for (int n = 0; n < 2; ++n) acc[a][b][m][n] = (f32x4){0.f, 0.f, 0.f, 0.f};
    bf16x8 At[4][2], B0[2][2], B1[2][2];
    const char* cA = (const char*)g.A + (size_t)cur.pm * tstep + (size_t)cur.ko * 2; const char* cB = (const char*)g.Bt + (size_t)cur.pn * tstep + (size_t)cur.ko * 2;
    S.a_ready(cur);
    if constexpr (SP2) {
        PG8_STAGE(PG8_SB(0, 0), cB, voffB); PG8_STAGE(PG8_SB(0, 1), cB + hstep, voffB); PG8_STAGEA(PG8_SA(0, 0), cA, voffA); PG8_STAGEA(PG8_SA(0, 1), cA + hstep, voffA);
        if (wr == 1) PG8_BAR;
        PG8_WAIT_V(2); PG8_BAR;
        PG8_STAGE(PG8_SB(1, 0), cB + kstep, voffB); PG8_STAGEA(PG8_SA(1, 0), cA + kstep, voffA); PG8_STAGE(PG8_SB(1, 1), cB + hstep + kstep, voffB);
        PG8_WAIT_V(6); PG8_BAR;
    } else {
        PG8_STAGE(PG8_SB(0, 0), cB, voffB); PG8_STAGEA(PG8_SA(0, 0), cA, voffA); PG8_STAGE(PG8_SB(0, 1), cB + hstep, voffB); PG8_STAGEA(PG8_SA(0, 1), cA + hstep, voffA);
        if (wr == 1) PG8_BAR;
        PG8_WAIT_V(4); PG8_BAR;
        PG8_STAGE(PG8_SB(1, 0), cB + kstep, voffB); PG8_STAGEA(PG8_SA(1, 0), cA + kstep, voffA); PG8_STAGE(PG8_SB(1, 1), cB + hstep + kstep, voffB);
        PG8_WAIT_V(6); PG8_BAR;
    }
    for (;;) {
        const bool has_next = S.next(ui + 1, nxt);
        const char* nA = has_next ? (const char*)g.A + (size_t)nxt.pm * tstep + (size_t)nxt.ko * 2 : cA; const char* nB = has_next ? (const char*)g.Bt + (size_t)nxt.pn * tstep + (size_t)nxt.ko * 2 : cB;
        for (int t = 0; t < nt; t += 2) {
            const bool last = (t == nt - 2);
            const char* a1 = cA + (size_t)(t + 1) * kstep;
            const char* a2 = last ? nA : cA + (size_t)(t + 2) * kstep; const char* b2 = last ? nB : cB + (size_t)(t + 2) * kstep;
            const char* a3 = a2 + kstep; const char* b3 = b2 + kstep;
            if (last && has_next) S.a_ready(nxt);
            if constexpr (SP2) {
            PG8_LDB(B0, 0, 0); PG8_LDB(B1, 0, 1); PG8_SCHED; PG8_LDA(At, 0, 0); PG8_STAGEA(PG8_SA(1, 1), a1 + hstep, voffA);
            PG8_WAIT_V(8); PG8_WAIT_L(0); PG8_BAR; PG8_MMA(0, 0, At, B0); PG8_MMA(0, 1, At, B1); PG8_BAR; PG8_SCHED;
            PG8_LDA(At, 0, 1); PG8_STAGE(PG8_SB(0, 0), b2, voffB); PG8_STAGE(PG8_SB(0, 1), b2 + hstep, voffB); PG8_STAGEA(PG8_SA(0, 0), a2, voffA);
            PG8_WAIT_V(8); PG8_WAIT_L(0); PG8_BAR; PG8_MMA(1, 0, At, B0); PG8_MMA(1, 1, At, B1); PG8_BAR; PG8_SCHED;
            PG8_LDB(B0, 1, 0); PG8_LDB(B1, 1, 1); PG8_SCHED; PG8_LDA(At, 1, 0); PG8_STAGEA(PG8_SA(0, 1), a2 + hstep, voffA);
            PG8_WAIT_V(8); PG8_WAIT_L(0); PG8_BAR; PG8_MMA(0, 0, At, B0); PG8_MMA(0, 1, At, B1); PG8_BAR; PG8_SCHED;
            PG8_LDA(At, 1, 1); PG8_STAGE(PG8_SB(1, 0), b3, voffB); PG8_STAGE(PG8_SB(1, 1), b3 + hstep, voffB); PG8_STAGEA(PG8_SA(1, 0), a3, voffA);
            PG8_WAIT_V(8); PG8_WAIT_L(0); PG8_BAR; PG8_MMA(1, 0, At, B0); PG8_MMA(1, 1, At, B1); PG8_BAR; PG8_SCHED;
            } else {
            PG8_LDB(B0, 0, 0); PG8_SCHED; PG8_LDA(At, 0, 0); PG8_STAGEA(PG8_SA(1, 1), a1 + hstep, voffA);
            PG8_WAIT_L(8); PG8_BAR; PG8_WAIT_L(0); PG8_MMA(0, 0, At, B0); PG8_BAR; PG8_SCHED;
            PG8_LDB(B1, 0, 1); PG8_STAGE(PG8_SB(0, 0), b2, voffB);
            PG8_BAR; PG8_WAIT_L(0); PG8_MMA(0, 1, At, B1); PG8_BAR;
            PG8_LDA(At, 0, 1); PG8_STAGEA(PG8_SA(0, 0), a2, voffA);
            PG8_BAR; PG8_WAIT_L(0); PG8_MMA(1, 0, At, B0); PG8_BAR; PG8_SCHED;
            PG8_STAGE(PG8_SB(0, 1), b2 + hstep, voffB);
            PG8_WAIT_V(6); PG8_BAR; PG8_MMA(1, 1, At, B1); PG8_BAR;
            PG8_LDB(B0, 1, 0); PG8_SCHED; PG8_LDA(At, 1, 0); PG8_STAGEA(PG8_SA(0, 1), a2 + hstep, voffA);
            PG8_WAIT_L(8); PG8_BAR; PG8_WAIT_L(0); PG8_MMA(0, 0, At, B0); PG8_BAR; PG8_SCHED;
            PG8_LDB(B1, 1, 1); PG8_STAGE(PG8_SB(1, 0), b3, voffB);
            PG8_BAR; PG8_WAIT_L(0); PG8_MMA(0, 1, At, B1); PG8_BAR;
            PG8_LDA(At, 1, 1); PG8_STAGEA(PG8_SA(1, 0), a3, voffA);
            PG8_BAR; PG8_WAIT_L(0); PG8_MMA(1, 0, At, B0); PG8_BAR; PG8_SCHED;
            PG8_STAGE(PG8_SB(1, 1), b3 + hstep, voffB);
            PG8_WAIT_V(6); PG8_BAR; PG8_MMA(1, 1, At, B1); PG8_BAR;
            }
        }
        if constexpr (ALIGN_EPI) { if (wr == 0) PG8_BAR; }
        if constexpr (!Epi::AFTER_DRAIN) { E(acc, cur, wr, wc, fr, fq); S.done(cur); }
        if (!has_next) break;
#pragma unroll
        for (int a = 0; a < 2; ++a)
#pragma unroll
            for (int b = 0; b < 2; ++b)
#pragma unroll
                for (int m = 0; m < 4; ++m)
#pragma unroll
                    for (int n = 0; n < 2; ++n) acc[a][b][m][n] = (f32x4){0.f, 0.f, 0.f, 0.f};
        cur = nxt; cA = nA; cB = nB; ++ui;
        if constexpr (ALIGN_EPI) { if (wr == 1) PG8_BAR; }
    }
    PG8_WAIT_V(0);
    if constexpr (!ALIGN_EPI) { if (wr == 0) PG8_BAR; }
    PG8_BAR;
    if constexpr (Epi::AFTER_DRAIN) { E.fused(acc, cur, wr, wc, fr, fq, lds, wid, lane); S.done(cur); }
#undef PG8_SA
#undef PG8_SB
#undef PG8_STAGE
#undef PG8_STAGEA
#undef PG8_LDA
#undef PG8_LDB
#undef PG8_MMA
#undef PG8_WAIT_V
#undef PG8_WAIT_L
#undef PG8_BAR
#undef PG8_SCHED
}
}

constexpr int NWAVES = 8;
constexpr int DM = 2048, NTOK_P = 32768, NTOK_S = 1024, MT = NTOK_P + NTOK_S  , NSEQ = 48, DEPTH = 4, DFF = 8192;
constexpr int IN_TOTAL = 14864, NPAD = 15104;
constexpr int OFF_AQ = 0, OFF_AF = 1024, OFF_AI = 2048, OFF_AG = 3072, OFF_BZ = 4096, OFF_XBC = 5120, OFF_CU = 6656, OFF_CV = 7680, OFF_GATE = 8704, OFF_DT = 14848;
constexpr float NORM_EPS = 1e-6f;
constexpr size_t OUT_X = 0, OUT_HGRN_P = 69206016, OUT_SSM_P = 77594624, OUT_CONV_P = 85983232, OUT_HGRN_S = 86278144, OUT_SSM_S = 103055360, OUT_CONV_S = 119832576, OUT_V_S = 120422400, OUT_TOTAL = 124616704;
constexpr size_t MiB = 1u << 20;
constexpr size_t WS_CTL = 0, CTL_ZERO_BYTES = 1 * MiB;
constexpr size_t WS_MOD = 1 * MiB;
constexpr size_t WS_WIN = 16 * MiB;
constexpr size_t WS_WBR = 76 * MiB;
constexpr size_t WS_WOUT = 88 * MiB;
constexpr size_t WS_WUP = 96 * MiB;
constexpr size_t WS_WDN = 128 * MiB;
constexpr size_t WS_H = 160 * MiB;
constexpr size_t WS_Y3 = 292 * MiB;
constexpr size_t WS_P = 490 * MiB;
constexpr size_t WS_XC = 1464 * MiB;
constexpr size_t WS_DT = 1564 * MiB;
constexpr size_t DT_ARR = (size_t)MT * 16 * 4;
constexpr size_t WS_WSET2 = 1576 * MiB;
constexpr size_t WSET_BYTES = WS_H - WS_WIN;
constexpr size_t WS_SLAB = WS_Y3;
constexpr size_t WS_X = WS_WSET2 + WSET_BYTES;
constexpr size_t WS_END = WS_X + (size_t)MT * DM * 2;
static_assert((size_t)32 * 8 * 65536 * 4 <= (size_t)3 * MT * 1024 * 2, "slabs fit the y_a|y_b|y_c region");
static_assert(WS_DT + 3 * DT_ARR <= WS_WSET2, "d_ws map 3");
__host__ __device__ constexpr size_t wofs(int l) { return (l & 1) ? (WS_WSET2 - WS_WIN) : 0; }
static_assert(WS_P + (size_t)MT * NPAD * 2 <= WS_XC && WS_XC + (size_t)MT * 1536 * 2 <= WS_DT, "d_ws map 2");
static_assert(WS_MOD + (size_t)DEPTH * NSEQ * 12288 * 4 <= WS_WIN && WS_WIN + (size_t)NPAD * DM * 2 <= WS_WBR && WS_H + (size_t)MT * DM * 2 <= WS_Y3 && WS_Y3 + (size_t)3 * MT * 1024 * 2 <= WS_P, "d_ws map");
constexpr int CW_BAR = 4096;
constexpr int CW_Q = 8192;
constexpr int CW_QC = 12288;
constexpr int RING_BYTES = 131072, ST_OFF = RING_BYTES  , MISC_OFF = RING_BYTES + 1024, LDS_BYTES = 147456;

#define GAS __attribute__((address_space(1)))
#define LAS __attribute__((address_space(3)))
typedef unsigned short bf16;
typedef unsigned v4u __attribute__((ext_vector_type(4)));
typedef unsigned v2u __attribute__((ext_vector_type(2)));
typedef float f32x4 __attribute__((ext_vector_type(4)));
typedef float f32x2 __attribute__((ext_vector_type(2)));
#define LDS_WAIT() asm volatile("s_waitcnt lgkmcnt(0)" ::: "memory")
#define VM_WAIT() asm volatile("s_waitcnt vmcnt(0)" ::: "memory")
typedef float cv_f32x2 __attribute__((ext_vector_type(2))); typedef __bf16 cv_bf16x2 __attribute__((ext_vector_type(2)));
__device__ __forceinline__ unsigned pk2(float lo, float hi) { const cv_f32x2 v = {lo, hi}; const cv_bf16x2 b = __builtin_convertvector(v, cv_bf16x2); return __builtin_bit_cast(unsigned, b); }
__device__ __forceinline__ unsigned f2bf(float f) { const __bf16 b = (__bf16)f; return (unsigned)__builtin_bit_cast(unsigned short, b); }
__device__ __forceinline__ float bflo(unsigned w) { return __uint_as_float(w << 16); }
__device__ __forceinline__ float bfhi(unsigned w) { return __uint_as_float(w & 0xffff0000u); }
__device__ __forceinline__ float bf1(bf16 v) { return __uint_as_float(((unsigned)v) << 16); }
__device__ __forceinline__ float sigmoidf_(float x) { return __builtin_amdgcn_rcpf(1.0f + __expf(-x)); }
__device__ __forceinline__ float siluf_(float x) { return x * __builtin_amdgcn_rcpf(1.0f + __expf(-x)); }
__device__ __forceinline__ float rsqrtf_(float x) { return __builtin_amdgcn_rsqf(x); }
__device__ __forceinline__ float geluf_(float v) {
    const float av = fabsf(v), t = __builtin_amdgcn_rcpf(1.0f + 0.2316418882f * av);
    float q = t * 0.5307027145f + (-0.7265760135f); q = q * t + 0.7107068705f; q = q * t + (-0.142248368f); q = q * t + 0.127414796f; q = q * t;
    const float e = __expf(-0.5f * v * v), m = v * (q * e);
    return v < 0.f ? m : v - m;
}
__device__ __forceinline__ float wave_sum(float v) {
#pragma unroll
    for (int o = 1; o < 64; o <<= 1) v += __shfl_xor(v, o);
    return v;
}
__device__ __forceinline__ float half_sum(float v) {
#pragma unroll
    for (int o = 1; o < 32; o <<= 1) v += __shfl_xor(v, o);
    return v;
}

#define XB_TMO      128
#define XB_XCNT(j)  (256  + 64 * (j))
#define XB_XSUB(j)  (1280 + 64 * (j))
#define XB_XGEN(j)  (2304 + 64 * (j))
#define XB_TOP      3328
#define XB_TOPGEN   3392
#define XCD_BAR_WORDS 3456
#define XB_SPIN_CAP (1u << 18)

__device__ __forceinline__ unsigned xb_ld(unsigned* p)              { return __hip_atomic_load(p, __ATOMIC_RELAXED, __HIP_MEMORY_SCOPE_AGENT); }
__device__ __forceinline__ unsigned xb_add(unsigned* p, unsigned v) { return __hip_atomic_fetch_add(p, v, __ATOMIC_RELAXED, __HIP_MEMORY_SCOPE_AGENT); }
__device__ __forceinline__ unsigned xb_xcc_id() { return (unsigned)__builtin_amdgcn_s_getreg((3 << 11) | 20) & 0xFu; }
#define XB_SPIN(cond, bar) do { unsigned _sp = 0; while (cond) { __builtin_amdgcn_s_sleep(1); \
    if ((++_sp & 255u) == 0u) { if (xb_ld(&(bar)[XB_TMO])) break; if (_sp > XB_SPIN_CAP) { atomicAdd(&(bar)[XB_TMO], 1u); break; } } } } while (0)

struct XcdBarrier {
    unsigned* bar; unsigned x;
    volatile LAS unsigned* st;
};

__device__ __forceinline__ XcdBarrier xcd_barrier_post(unsigned* bar, volatile LAS unsigned* st, int tid) {
    XcdBarrier b; b.bar = bar; b.x = xb_xcc_id(); b.st = st;
    if (tid == 0) (void)xb_add(&bar[XB_XCNT(b.x)], 1u);
    return b;
}
__device__ __forceinline__ void xcd_barrier_complete(unsigned* bar, unsigned x, unsigned& nloc, unsigned& nx) {
    const unsigned G = gridDim.x * gridDim.y * gridDim.z;
    unsigned sum, cnt, mine, sp = 0u;
    for (;;) {
        sum = 0u; cnt = 0u; mine = 0u;
#pragma unroll
        for (unsigned j = 0; j < 16; ++j) { const unsigned c = xb_ld(&bar[XB_XCNT(j)]); sum += c; cnt += (c > 0u) ? 1u : 0u; mine = (j == x) ? c : mine; }
        if (sum == G) break;
        __builtin_amdgcn_s_sleep(1);
        if ((++sp & 255u) == 0u) { if (xb_ld(&bar[XB_TMO])) break; if (sp > XB_SPIN_CAP) { atomicAdd(&bar[XB_TMO], 1u); break; } }
    }
    nloc = mine > 0u ? mine : 1u; nx = cnt > 0u ? cnt : 1u;
}

__device__ __forceinline__ void xcd_barrier(const XcdBarrier& b, int tid) {
    asm volatile("s_waitcnt vmcnt(0)" ::: "memory");
    __syncthreads();
    if (tid == 0) {
        unsigned* bar = b.bar;
        __builtin_amdgcn_s_waitcnt(0);
        unsigned nloc = b.st[0], nx = b.st[1];
        if (nloc == 0u) { xcd_barrier_complete(bar, b.x, nloc, nx); b.st[0] = nloc; b.st[1] = nx; }
        const unsigned old = xb_add(&bar[XB_XSUB(b.x)], 1u);
        const unsigned gen = old / nloc;
        if (old + 1u == (gen + 1u) * nloc) {
            __builtin_amdgcn_fence(__ATOMIC_RELEASE, "agent");
            asm volatile("s_waitcnt vmcnt(0)" ::: "memory");
            const unsigned og = xb_add(&bar[XB_TOP], 1u);
            const unsigned tg = og / nx;
            if (og + 1u == (tg + 1u) * nx) xb_add(&bar[XB_TOPGEN], 1u);
            else XB_SPIN(xb_ld(&bar[XB_TOPGEN]) == tg, bar);
            __builtin_amdgcn_fence(__ATOMIC_ACQUIRE, "agent");
            xb_add(&bar[XB_XGEN(b.x)], 1u);
            asm volatile("s_waitcnt vmcnt(0)" ::: "memory");
        } else {
            XB_SPIN(xb_ld(&bar[XB_XGEN(b.x)]) == gen, bar);
            __builtin_amdgcn_fence(__ATOMIC_ACQUIRE, "agent");
            asm volatile("s_waitcnt vmcnt(0)" ::: "memory");
        }
    }
    __syncthreads();
}


__device__ __forceinline__ void mod_item(LAS unsigned char* lds, int tid_in, int it, const float* c_prompt, const float* c_sample, const float* w_mod, const float* b_mod, float* MOD) {
    int tid = tid_in;
    const int l = it / 96, cb = it - l * 96, j0 = cb * 128;
    const int cq = tid & 31, sh = (tid >> 5) & 1, kq = tid >> 6;
    LAS float* CS = (LAS float*)lds;
    f32x2 acc[24][2];
#pragma unroll
    for (int s = 0; s < 24; ++s) { acc[s][0] = (f32x2){0.f, 0.f}; acc[s][1] = (f32x2){0.f, 0.f}; }
    const float* wbase = w_mod + (size_t)l * DM * 12288 + j0 + 4 * cq;
    for (int kt = 0; kt < 8; ++kt) {
        __syncthreads();
#pragma unroll 8
        for (int j = 0; j < 24; ++j) { const int e = tid + 512 * j, s = e >> 8, kidx = e & 255, kq2 = kidx >> 5, kk = kidx & 31, k = kq2 * 256 + kt * 32 + kk;
            const float cv = s < 16 ? c_prompt[s * DM + k] : c_sample[(s - 16) * DM + k];
            CS[(kq2 * 32 + kk) * 48 + s] = siluf_(cv); }
        __syncthreads();
        { const float* wr = wbase + (size_t)(kq * 256 + kt * 32) * 12288;
          f32x4 wn[4];
#pragma unroll
          for (int i = 0; i < 4; ++i) wn[i] = *(const f32x4*)(wr + (size_t)i * 12288);
#pragma unroll 1
          for (int kk = 0; kk < 32; kk += 4) { f32x4 wc[4];
#pragma unroll
              for (int i = 0; i < 4; ++i) wc[i] = wn[i];
              if (kk + 4 < 32) {
#pragma unroll
                  for (int i = 0; i < 4; ++i) wn[i] = *(const f32x4*)(wr + (size_t)(kk + 4 + i) * 12288); }
#pragma unroll
              for (int i = 0; i < 4; ++i) { const f32x2 w01 = (f32x2){wc[i].x, wc[i].y}, w23 = (f32x2){wc[i].z, wc[i].w}; const LAS f32x4* cr = (const LAS f32x4*)(CS + (kq * 32 + kk + i) * 48 + 24 * sh);
#pragma unroll
                  for (int s4 = 0; s4 < 6; ++s4) { const f32x4 c4 = cr[s4];
#pragma unroll
                      for (int q = 0; q < 4; ++q) { const f32x2 cc = (f32x2){c4[q], c4[q]};
                          acc[4 * s4 + q][0] = __builtin_elementwise_fma(w01, cc, acc[4 * s4 + q][0]); acc[4 * s4 + q][1] = __builtin_elementwise_fma(w23, cc, acc[4 * s4 + q][1]); } } } } }
    }
    LAS float* RED = (LAS float*)lds;
    asm volatile("" : "+v"(tid));
    const int cq2 = tid & 31, sh2 = (tid >> 5) & 1, kq2_ = tid >> 6;
#pragma unroll
    for (int sb = 0; sb < 4; ++sb) {
        __syncthreads();
        if (sh2 == (sb >> 1)) {
#pragma unroll
            for (int i = 0; i < 12; ++i) { const f32x2 a = acc[12 * (sb & 1) + i][0], b = acc[12 * (sb & 1) + i][1]; *(LAS f32x4*)(RED + (kq2_ * 12 + i) * 128 + 4 * cq2) = (f32x4){a.x, a.y, b.x, b.y}; } }
        __syncthreads();
#pragma unroll
        for (int j = 0; j < 3; ++j) { const int e = tid + 512 * j, s = e >> 7, col = e & 127; float v = 0.f;
#pragma unroll
            for (int q = 0; q < 8; ++q) v += RED[(q * 12 + s) * 128 + col];
            MOD[((size_t)l * NSEQ + 12 * sb + s) * 12288 + j0 + col] = v + b_mod[l * 12288 + j0 + col]; }
    }
    __syncthreads();
}

struct CvItem { const float* src; bf16* dst; int N, K, nv; };
constexpr int CV_A = 472 * 32, CV_B = 3 * 16 * 64, CV_C = 32 * 64, CV_D = 32 * 256, CV_E = 128 * 64, CV_ALL = CV_A + CV_B + CV_C + CV_D + CV_E;
__device__ __forceinline__ CvItem cvt_decode(int it, int l, const float* w_in, const float* w_branch, const float* w_out, const float* w_up, const float* w_down, unsigned char* ws) {
    CvItem c; int r = it;
    if (r < CV_A) { const int nb = r % 472, kb = r / 472; int n0s, nv;
        if (nb < 208) { n0s = 32 * nb; nv = 32; } else if (nb < 464) { n0s = 32 * nb + 16; nv = 32; } else if (nb == 464) { n0s = 6656; nv = 16; } else { n0s = 0; nv = 0; }
        c.N = IN_TOTAL; c.K = DM; c.nv = nv; c.src = w_in + (size_t)l * DM * IN_TOTAL + (size_t)(64 * kb) * IN_TOTAL + n0s; c.dst = (bf16*)(ws + WS_WIN) + (size_t)(32 * nb) * DM + 64 * kb; return c; }
    r -= CV_A;
    if (r < CV_B) { const int br = r / 1024, r2 = r % 1024, kb = r2 / 64, nb = r2 % 64;
        c.N = DM; c.K = 1024; c.nv = 32; c.src = w_branch + ((size_t)l * 3072 + br * 1024 + 64 * kb) * DM + 32 * nb; c.dst = (bf16*)(ws + WS_WBR) + (size_t)br * 2048 * 1024 + (size_t)(32 * nb) * 1024 + 64 * kb; return c; }
    r -= CV_B;
    if (r < CV_C) { const int kb = r / 64, nb = r % 64;
        c.N = DM; c.K = DM; c.nv = 32; c.src = w_out + (size_t)l * DM * DM + (size_t)(64 * kb) * DM + 32 * nb; c.dst = (bf16*)(ws + WS_WOUT) + (size_t)(32 * nb) * DM + 64 * kb; return c; }
    r -= CV_C;
    if (r < CV_D) { const int kb = r / 256, nb = r % 256;
        c.N = DFF; c.K = DM; c.nv = 32; c.src = w_up + (size_t)l * DM * DFF + (size_t)(64 * kb) * DFF + 32 * nb; c.dst = (bf16*)(ws + WS_WUP) + (size_t)(32 * nb) * DM + 64 * kb; return c; }
    r -= CV_D;
    { const int kb = r / 64, nb = r % 64;
        c.N = DM; c.K = DFF; c.nv = 32; c.src = w_down + (size_t)l * DFF * DM + (size_t)(64 * kb) * DM + 32 * nb; c.dst = (bf16*)(ws + WS_WDN) + (size_t)(32 * nb) * DFF + 64 * kb; return c; }
}
__device__ __forceinline__ void cvt_load(const CvItem& c, int lane, f32x4 (&v)[8]) {
    const int kk = lane >> 3, n4 = (lane & 7) * 4;
#pragma unroll
    for (int i = 0; i < 8; ++i) v[i] = (n4 < c.nv) ? *(const f32x4*)(c.src + (size_t)(8 * i + kk) * c.N + n4) : (f32x4){0.f, 0.f, 0.f, 0.f};
}
__device__ __forceinline__ void cvt_store(const CvItem& c, int lane, const f32x4 (&v)[8], LAS float* scr) {
    { const int kk = lane >> 3, n4 = (lane & 7) * 4;
#pragma unroll
        for (int i = 0; i < 8; ++i) { LAS float* d = scr + (8 * i + kk) * 33 + n4; d[0] = v[i].x; d[1] = v[i].y; d[2] = v[i].z; d[3] = v[i].w; } }
    LDS_WAIT(); asm volatile("" ::: "memory");
    const int cc = lane & 7;
#pragma unroll
    for (int j = 0; j < 4; ++j) { const int n = (lane >> 3) + 8 * j; const LAS float* s = scr + (8 * cc) * 33 + n;
        v4u o; o.x = pk2(s[0 * 33], s[1 * 33]); o.y = pk2(s[2 * 33], s[3 * 33]); o.z = pk2(s[4 * 33], s[5 * 33]); o.w = pk2(s[6 * 33], s[7 * 33]);
        *(v4u*)(c.dst + (size_t)n * c.K + 8 * cc) = o; }
    LDS_WAIT(); asm volatile("" ::: "memory");
}
template <bool QUEUE>
__device__ __forceinline__ void cvt_phase(LAS unsigned char* lds, int wave, int lane, int gw, int NGW, int l, const float* w_in, const float* w_branch, const float* w_out, const float* w_up, const float* w_down, unsigned char* ws, unsigned* qhead) {
    LAS float* scr = (LAS float*)(lds + wave * 16384);
    int it = gw, left = 0;
#define CV_NEXT() do { if (QUEUE) { if (left == 0) { unsigned t0 = 0; if (lane == 0) t0 = __hip_atomic_fetch_add(qhead, 4u, __ATOMIC_RELAXED, __HIP_MEMORY_SCOPE_AGENT); it = __builtin_amdgcn_readfirstlane((int)t0); left = 4; } else ++it; --left; } else it += NGW; } while (0)
    if (QUEUE) { it = 0; CV_NEXT(); }
    if (it >= CV_ALL) return;
    CvItem ca = cvt_decode(it, l, w_in, w_branch, w_out, w_up, w_down, ws), cb = ca; f32x4 va[8], vb[8];
    cvt_load(ca, lane, va);
    for (;;) {
        CV_NEXT(); const bool hb = it < CV_ALL;
        if (hb) { cb = cvt_decode(it, l, w_in, w_branch, w_out, w_up, w_down, ws); cvt_load(cb, lane, vb); }
        cvt_store(ca, lane, va, scr);
        if (!hb) break;
        CV_NEXT(); const bool ha = it < CV_ALL;
        if (ha) { ca = cvt_decode(it, l, w_in, w_branch, w_out, w_up, w_down, ws); cvt_load(ca, lane, va); }
        cvt_store(cb, lane, vb, scr);
        if (!ha) break;
    }
#undef CV_NEXT
}

#ifndef WGM_N8
#define WGM_N8 4
#endif
__device__ __forceinline__ int tail_nfull(int nwg, int G) { const int nf = (nwg / G) * G; return (nwg - nf) <= 32 ? nf : nwg; }
__device__ __forceinline__ void build_tail_map(LAS int* tmap, int tid, int G, int rev) {
    pg8::StaticOrder S; S.init(MT, DM, G, 0); S.rev = rev; S.wgm = WGM_N8; const int nfull = tail_nfull(S.nwg, G);
    for (int i = tid; i < S.nwg; i += NWAVES * 64) tmap[i] = -1;
    __syncthreads();
    for (int i = tid; i < S.nwg - nfull; i += NWAVES * 64) { pg8::Unit u; S.tile_of(nfull + i, u); tmap[u.pm * 8 + u.pn] = i; }
    __syncthreads();
}
template <bool SRC_F32>
__device__ __forceinline__ void norm_mod_phase(int lane, int gw, int NGW, const float* xP, const float* xS, bf16* X, const float* ng, const float* modl  , int part_sh, int part_sc, bf16* H,
                                               bool comb, const LAS int* tmap, const float* slab, bool desc) {
    const int g2 = desc ? NGW - 1 - gw : gw;
    const int ra = (int)(((unsigned)g2 * (unsigned)MT) / (unsigned)NGW), rb = (int)(((unsigned)(g2 + 1) * (unsigned)MT) / (unsigned)NGW);
    const int nr = rb - ra, rfirst = desc ? rb - 1 : ra, step = desc ? -1 : 1;
    if (nr <= 0) return;
    f32x4 ca[8], cb[8]; int cur_seq = -1;
    v2u xn[8];
    v2u xm[8];
    f32x4 xf[8];
    if (SRC_F32) { const float* xr = (rfirst < NTOK_P ? xP + (size_t)rfirst * DM : xS + (size_t)(rfirst - NTOK_P) * DM) + 4 * lane;
#pragma unroll
        for (int j = 0; j < 8; ++j) xf[j] = *(const f32x4*)(xr + 256 * j); }
    if (!SRC_F32) { const v2u* xb0 = (const v2u*)(X + (size_t)rfirst * DM) + lane;
#pragma unroll
        for (int j = 0; j < 8; ++j) xn[j] = xb0[64 * j];
        if (nr > 1) { const v2u* xb1 = (const v2u*)(X + (size_t)(rfirst + step) * DM) + lane;
#pragma unroll
            for (int j = 0; j < 8; ++j) xm[j] = xb1[64 * j]; } }
    for (int i = 0; i < nr; ++i) { const int r = rfirst + step * i;
        const int seq = r < NTOK_P ? (r >> 11) : 16 + ((r - NTOK_P) >> 5);
        if (seq != cur_seq) { cur_seq = seq; const float* mp = modl + (size_t)seq * 12288;
#pragma unroll
            for (int j = 0; j < 8; ++j) { const int c = 4 * lane + 256 * j; const f32x4 g = *(const f32x4*)(ng + c), sc = *(const f32x4*)(mp + part_sc * DM + c); ca[j] = g * (sc + 1.0f); cb[j] = *(const f32x4*)(mp + part_sh * DM + c); } }
        f32x4 v[8]; float ss = 0.f; v2u* xb = (v2u*)(X + (size_t)r * DM) + lane;
        if (SRC_F32) {
#pragma unroll
            for (int j = 0; j < 8; ++j) { v[j] = xf[j]; v2u o; o.x = pk2(v[j].x, v[j].y); o.y = pk2(v[j].z, v[j].w); xb[64 * j] = o; }
            if (i + 1 < nr) { const int r1 = r + step; const float* xr = (r1 < NTOK_P ? xP + (size_t)r1 * DM : xS + (size_t)(r1 - NTOK_P) * DM) + 4 * lane;
#pragma unroll
                for (int j = 0; j < 8; ++j) xf[j] = *(const f32x4*)(xr + 256 * j); } }
        else {
#pragma unroll
            for (int j = 0; j < 8; ++j) { const v2u o = xn[j]; v[j] = (f32x4){bflo(o.x), bfhi(o.x), bflo(o.y), bfhi(o.y)}; xn[j] = xm[j]; }
            if (i + 2 < nr) { const v2u* xb2 = (const v2u*)(X + (size_t)(r + 2 * step) * DM) + lane;
#pragma unroll
                for (int j = 0; j < 8; ++j) xm[j] = xb2[64 * j]; } }
        if (comb) {
#pragma unroll
            for (int j = 0; j < 8; ++j) { const int ti = tmap[(r >> 8) * 8 + j]; if (ti >= 0) { const float* sp = slab + (size_t)ti * 8 * 65536 + (r & 255) * 256 + 4 * lane;
#pragma unroll
                    for (int q = 0; q < 8; ++q) v[j] = v[j] + *(const f32x4*)(sp + (size_t)q * 65536);
                    v2u o; o.x = pk2(v[j].x, v[j].y); o.y = pk2(v[j].z, v[j].w); xb[64 * j] = o; } } }
#pragma unroll
        for (int j = 0; j < 8; ++j) ss += (v[j].x * v[j].x + v[j].y * v[j].y) + (v[j].z * v[j].z + v[j].w * v[j].w);
        const float rstd = 1.0f / sqrtf(wave_sum(ss) * (1.0f / DM) + NORM_EPS);
        unsigned long long* o8 = (unsigned long long*)(H + (size_t)r * DM) + lane;
#pragma unroll
        for (int j = 0; j < 8; ++j) { const f32x4 y = v[j] * rstd * ca[j] + cb[j]; o8[64 * j] = (unsigned long long)pk2(y.x, y.y) | ((unsigned long long)pk2(y.z, y.w) << 32); }
    }
}
__device__ __forceinline__ void final_norm_phase(int lane, int gw, int NGW, const bf16* X, float* Y, const float* fg, bool comb, const LAS int* tmap, const float* slab) {
    f32x4 g[8];
#pragma unroll
    for (int j = 0; j < 8; ++j) g[j] = *(const f32x4*)(fg + 4 * lane + 256 * j);
    v2u xn[8], xm[8];
    if (gw < MT) { const v2u* xb0 = (const v2u*)(X + (size_t)gw * DM) + lane;
#pragma unroll
        for (int j = 0; j < 8; ++j) xn[j] = xb0[64 * j]; }
    if (gw + NGW < MT) { const v2u* xb0 = (const v2u*)(X + (size_t)(gw + NGW) * DM) + lane;
#pragma unroll
        for (int j = 0; j < 8; ++j) xm[j] = xb0[64 * j]; }
    for (int r = gw; r < MT; r += NGW) {
        float* yr = Y + (size_t)r * DM + 4 * lane; f32x4 v[8]; float ss = 0.f;
#pragma unroll
        for (int j = 0; j < 8; ++j) { const v2u o = xn[j]; v[j] = (f32x4){bflo(o.x), bfhi(o.x), bflo(o.y), bfhi(o.y)}; xn[j] = xm[j]; }
        if (r + 2 * NGW < MT) { const v2u* xb1 = (const v2u*)(X + (size_t)(r + 2 * NGW) * DM) + lane;
#pragma unroll
            for (int j = 0; j < 8; ++j) xm[j] = xb1[64 * j]; }
        if (comb) {
#pragma unroll
            for (int j = 0; j < 8; ++j) { const int ti = tmap[(r >> 8) * 8 + j]; if (ti >= 0) { const float* sp = slab + (size_t)ti * 8 * 65536 + (r & 255) * 256 + 4 * lane;
#pragma unroll
                    for (int q = 0; q < 8; ++q) v[j] = v[j] + *(const f32x4*)(sp + (size_t)q * 65536); } } }
#pragma unroll
        for (int j = 0; j < 8; ++j) ss += (v[j].x * v[j].x + v[j].y * v[j].y) + (v[j].z * v[j].z + v[j].w * v[j].w);
        const float rstd = 1.0f / sqrtf(wave_sum(ss) * (1.0f / DM) + NORM_EPS);
#pragma unroll
        for (int j = 0; j < 8; ++j) *(f32x4*)(yr + 256 * j) = v[j] * rstd * g[j];
    }
}
__device__ __forceinline__ void ssd_norm_phase(int lane, int gw, int NGW, bf16* YB, const float* g) {
    float gv[16];
#pragma unroll
    for (int j = 0; j < 4; ++j) { const f32x4 t = *(const f32x4*)(g + 16 * lane + 4 * j); gv[4 * j] = t.x; gv[4 * j + 1] = t.y; gv[4 * j + 2] = t.z; gv[4 * j + 3] = t.w; }
    v4u na = (v4u){0u, 0u, 0u, 0u}, nb = na, ma = na, mb = na;
    if (gw < MT) { const v4u* p0 = (const v4u*)(YB + (size_t)gw * 1024 + 16 * lane); na = p0[0]; nb = p0[1]; }
    if (gw + NGW < MT) { const v4u* p0 = (const v4u*)(YB + (size_t)(gw + NGW) * 1024 + 16 * lane); ma = p0[0]; mb = p0[1]; }
    for (int r = gw; r < MT; r += NGW) {
        v4u* p = (v4u*)(YB + (size_t)r * 1024 + 16 * lane); const v4u a = na, b = nb; na = ma; nb = mb;
        if (r + 2 * NGW < MT) { const v4u* p1 = (const v4u*)(YB + (size_t)(r + 2 * NGW) * 1024 + 16 * lane); ma = p1[0]; mb = p1[1]; }
        float v[16]; v[0] = bflo(a.x); v[1] = bfhi(a.x); v[2] = bflo(a.y); v[3] = bfhi(a.y); v[4] = bflo(a.z); v[5] = bfhi(a.z); v[6] = bflo(a.w); v[7] = bfhi(a.w);
        v[8] = bflo(b.x); v[9] = bfhi(b.x); v[10] = bflo(b.y); v[11] = bfhi(b.y); v[12] = bflo(b.z); v[13] = bfhi(b.z); v[14] = bflo(b.w); v[15] = bfhi(b.w);
        float ss = 0.f;
#pragma unroll
        for (int j = 0; j < 16; ++j) ss += v[j] * v[j];
        const float rstd = 1.0f / sqrtf(half_sum(ss) * (1.0f / 512.0f) + NORM_EPS);
#pragma unroll
        for (int j = 0; j < 16; ++j) v[j] = v[j] * rstd * gv[j];
        v4u oa, ob; oa.x = pk2(v[0], v[1]); oa.y = pk2(v[2], v[3]); oa.z = pk2(v[4], v[5]); oa.w = pk2(v[6], v[7]); ob.x = pk2(v[8], v[9]); ob.y = pk2(v[10], v[11]); ob.z = pk2(v[12], v[13]); ob.w = pk2(v[14], v[15]);
        p[0] = oa; p[1] = ob;
    }
}

__device__ __forceinline__ void hgrn_item(LAS unsigned char* lds, int tid, int lane, int wave, const bf16* P, bf16* YA, int row0, int T, int h, int l,
                                          const float* s0, float* sout, const float* lb_raw, const float* onorm_g) {
    LAS float* LBV = (LAS float*)lds;
    LAS float* GV = LBV + 128;
    LAS float* Q = GV + 128;
    LAS float* F = Q + 2048; LAS float* KN = F + 2048; LAS float* IV = KN + 2048;
    LAS float* PO = IV + 2048;
    __syncthreads();
    if (tid < 128) { const int ch = h * 128 + tid; const float a0 = lb_raw[ch], a1 = lb_raw[1024 + ch], a2 = lb_raw[2048 + ch], a3 = lb_raw[3072 + ch];
        const float mx = fmaxf(fmaxf(a0, a1), fmaxf(a2, a3)); const float e0 = __expf(a0 - mx), e1 = __expf(a1 - mx), e2 = __expf(a2 - mx), e3 = __expf(a3 - mx); const float inv = 1.0f / (e0 + e1 + e2 + e3);
        float lb = 0.f; if (l >= 1) lb += e1; if (l >= 2) lb += e2; if (l >= 3) lb += e3; LBV[tid] = lb * inv; GV[tid] = onorm_g[ch]; }
    v2u nq2, nf2, ni2;
    { const bf16* pr = P + (size_t)(row0 + (tid >> 5)) * NPAD + h * 128 + (tid & 31) * 4; nq2 = *(const v2u*)(pr + OFF_AQ); nf2 = *(const v2u*)(pr + OFF_AF); ni2 = *(const v2u*)(pr + OFF_AI); }
    float S0[16], S1[16];
#pragma unroll
    for (int kk = 0; kk < 16; ++kk) { if (s0) { const f32x2 v = *(const f32x2*)(s0 + (16 * wave + kk) * 128 + 2 * lane); S0[kk] = v.x; S1[kk] = v.y; } else { S0[kk] = 0.f; S1[kk] = 0.f; } }
    __syncthreads();
    const int nch = T / 16;
    for (int c = 0; c < nch; ++c) {
        unsigned agv[2];
#pragma unroll
        for (int tt = 0; tt < 2; ++tt) agv[tt] = *(const unsigned*)(P + (size_t)(row0 + c * 16 + 2 * wave + tt) * NPAD + OFF_AG + h * 128 + 2 * lane);
        { const int t = tid >> 5, k4 = (tid & 31) * 4;
            const v2u q2 = nq2, f2 = nf2, i2 = ni2;
            if (c + 1 < nch) { const bf16* pr = P + (size_t)(row0 + (c + 1) * 16 + t) * NPAD + h * 128 + k4; nq2 = *(const v2u*)(pr + OFF_AQ); nf2 = *(const v2u*)(pr + OFF_AF); ni2 = *(const v2u*)(pr + OFF_AI); }
            const f32x4 lb = *(const LAS f32x4*)(LBV + k4);
            const float aq[4] = {bflo(q2.x), bfhi(q2.x), bflo(q2.y), bfhi(q2.y)}, az[4] = {bflo(f2.x), bfhi(f2.x), bflo(f2.y), bfhi(f2.y)};
            f32x4 qv, fv, kv;
#pragma unroll
            for (int j = 0; j < 4; ++j) { qv[j] = siluf_(aq[j]); const float sg = sigmoidf_(az[j]); fv[j] = lb[j] + (1.0f - lb[j]) * sg; kv[j] = (1.0f - lb[j]) * (1.0f - sg); }
            *(LAS f32x4*)(Q + t * 128 + k4) = qv; *(LAS f32x4*)(F + t * 128 + k4) = fv; *(LAS f32x4*)(KN + t * 128 + k4) = kv;
            *(LAS f32x4*)(IV + t * 128 + k4) = (f32x4){bflo(i2.x), bfhi(i2.x), bflo(i2.y), bfhi(i2.y)}; }
        __syncthreads();
#pragma unroll 2
        for (int t = 0; t < 16; ++t) {
            const f32x2 iv = *(const LAS f32x2*)(IV + t * 128 + 2 * lane); float po0 = 0.f, po1 = 0.f;
#pragma unroll
            for (int k4 = 0; k4 < 4; ++k4) { const f32x4 f4 = *(const LAS f32x4*)(F + t * 128 + 16 * wave + 4 * k4), n4 = *(const LAS f32x4*)(KN + t * 128 + 16 * wave + 4 * k4), q4 = *(const LAS f32x4*)(Q + t * 128 + 16 * wave + 4 * k4);
#pragma unroll
                for (int j = 0; j < 4; ++j) { const int kk = 4 * k4 + j; S0[kk] = fmaf(f4[j], S0[kk], n4[j] * iv.x); S1[kk] = fmaf(f4[j], S1[kk], n4[j] * iv.y); po0 = fmaf(q4[j], S0[kk], po0); po1 = fmaf(q4[j], S1[kk], po1); } }
            *(LAS f32x2*)(PO + (t * 8 + wave) * 128 + 2 * lane) = (f32x2){po0, po1};
        }
        __syncthreads();
#pragma unroll
        for (int tt = 0; tt < 2; ++tt) { const int t = 2 * wave + tt; float o0 = 0.f, o1 = 0.f;
#pragma unroll
            for (int w = 0; w < 8; ++w) { const f32x2 p = *(const LAS f32x2*)(PO + (t * 8 + w) * 128 + 2 * lane); o0 += p.x; o1 += p.y; }
            const float rstd = 1.0f / sqrtf(wave_sum(o0 * o0 + o1 * o1) * (1.0f / 128.0f) + NORM_EPS);
            const size_t row = (size_t)(row0 + c * 16 + t);
            const unsigned ag = agv[tt];
            const f32x2 gg = *(const LAS f32x2*)(GV + 2 * lane);
            *(unsigned*)(YA + row * 1024 + h * 128 + 2 * lane) = pk2(o0 * rstd * gg.x * siluf_(bflo(ag)), o1 * rstd * gg.y * siluf_(bfhi(ag))); }
    }
#pragma unroll
    for (int kk = 0; kk < 16; ++kk) *(f32x2*)(sout + (16 * wave + kk) * 128 + 2 * lane) = (f32x2){S0[kk], S1[kk]};
    __syncthreads();
}

typedef short bf16x8_t __attribute__((ext_vector_type(8)));
#define BAR_LDS() do { asm volatile("s_waitcnt lgkmcnt(0)" ::: "memory"); __builtin_amdgcn_s_barrier(); asm volatile("" ::: "memory"); } while (0)
#define MFMA16(x, y, acc) __builtin_amdgcn_mfma_f32_16x16x32_bf16((x), (y), (acc), 0, 0, 0)
#define LDFRAG(base, row, pitch, koff) (*(const LAS bf16x8_t*)((base) + (row) * (pitch) + (koff)))
__device__ __forceinline__ void hgrn_mfma_item(LAS unsigned char* lds, int tid, int lane, int wave, const bf16* P, bf16* YA, int row0, int h, int l, float* sout, const float* lb_raw, const float* onorm_g) {
    constexpr int PQ = 136, PT = 40;
    LAS float* LBV = (LAS float*)lds;
    LAS float* GV = LBV + 128;
    LAS float* DEC = GV + 128;
    LAS float* SS = DEC + 128;
    LAS float* LF = SS + 256;
    LAS bf16* QB = (LAS bf16*)(LF + 4096);
    LAS bf16* KB = QB + 32 * PQ;
    LAS bf16* Qt = KB + 32 * PQ;
    LAS bf16* Qm = Qt + 32 * PQ;
    LAS bf16* Km = Qm + 32 * PQ;
    LAS bf16* Qr = Km + 32 * PQ;
    LAS bf16* Kr = Qr + 16 * PQ;
    LAS bf16* KtT = Kr + 16 * PQ;
    LAS bf16* VT = KtT + 128 * PT;
    LAS bf16* IVr = VT + 128 * PT;
    LAS float* RSW = (LAS float*)(IVr + 32 * 128);
    const int fr = lane & 15, fq = lane >> 4;
    __syncthreads();
    if (tid < 128) { const int ch = h * 128 + tid; const float a0 = lb_raw[ch], a1 = lb_raw[1024 + ch], a2 = lb_raw[2048 + ch], a3 = lb_raw[3072 + ch];
        const float mx = fmaxf(fmaxf(a0, a1), fmaxf(a2, a3)); const float e0 = __expf(a0 - mx), e1 = __expf(a1 - mx), e2 = __expf(a2 - mx), e3 = __expf(a3 - mx); const float inv = 1.0f / (e0 + e1 + e2 + e3);
        float lb = 0.f; if (l >= 1) lb += e1; if (l >= 2) lb += e2; if (l >= 3) lb += e3; LBV[tid] = lb * inv; GV[tid] = onorm_g[ch]; }
    for (int i = tid; i < (128 * PT * 2) / 2; i += 512) ((LAS unsigned*)KtT)[i] = 0u;
    f32x4 sacc[8];
#pragma unroll
    for (int j = 0; j < 8; ++j) sacc[j] = (f32x4){0.f, 0.f, 0.f, 0.f};
    const int st = tid >> 4, sk8 = (tid & 15) * 8;
    const unsigned pst = (unsigned)((unsigned)(row0 + st) * (unsigned)NPAD + h * 128 + sk8) * 2u;
#define HG_LD16(off_) (*(const v4u*)((const char*)P + (unsigned)(off_)))
    v4u nq = HG_LD16(pst + 2u * OFF_AQ), nf = HG_LD16(pst + 2u * OFF_AF), ni = HG_LD16(pst + 2u * OFF_AI);
    f32x4 po0 = (f32x4){0.f, 0.f, 0.f, 0.f}, po1 = po0; bf16 pag[2][4];
#pragma unroll
    for (int hh = 0; hh < 2; ++hh)
#pragma unroll
        for (int r = 0; r < 4; ++r) pag[hh][r] = 0;
    const float gvv = onorm_g[h * 128 + 16 * wave + fr];
    __syncthreads();
#define HG_OUT(rb_) do { { const int t_ = lane & 31; const f32x4 p0 = *(const LAS f32x4*)(SS + t_ * 8), p1 = *(const LAS f32x4*)(SS + t_ * 8 + 4); \
            RSW[wave * 32 + t_] = rsqrtf_(((p0.x + p0.y) + (p0.z + p0.w) + (p1.x + p1.y) + (p1.z + p1.w)) * (1.0f / 128.0f) + NORM_EPS); } \
        LDS_WAIT(); asm volatile("" ::: "memory"); \
        _Pragma("unroll") for (int hh = 0; hh < 2; ++hh) { const f32x4 rs4 = *(const LAS f32x4*)(RSW + wave * 32 + 16 * hh + 4 * fq); \
            _Pragma("unroll") for (int r = 0; r < 4; ++r) { const int t = 16 * hh + 4 * fq + r; const float ov = hh ? po1[r] : po0[r]; \
            *(bf16*)((char*)YA + (unsigned)(((unsigned)(rb_) + t) * 1024u + h * 128 + 16 * wave + fr) * 2u) = (bf16)f2bf(ov * rs4[r] * gvv * siluf_(bf1(pag[hh][r]))); } } } while (0)
    for (int c = 0; c < 64; ++c) {
        const unsigned rbase = (unsigned)row0 + 32u * c;
        bf16 ag[2][4];
        { const f32x4 lb0 = *(const LAS f32x4*)(LBV + sk8), lb1 = *(const LAS f32x4*)(LBV + sk8 + 4); const float lb[8] = {lb0.x, lb0.y, lb0.z, lb0.w, lb1.x, lb1.y, lb1.z, lb1.w};
            const float aq[8] = {bflo(nq.x), bfhi(nq.x), bflo(nq.y), bfhi(nq.y), bflo(nq.z), bfhi(nq.z), bflo(nq.w), bfhi(nq.w)}, az[8] = {bflo(nf.x), bfhi(nf.x), bflo(nf.y), bfhi(nf.y), bflo(nf.z), bfhi(nf.z), bflo(nf.w), bfhi(nf.w)};
            float qv[8], kv[8], lf[8];
#pragma unroll
            for (int j = 0; j < 8; ++j) { qv[j] = siluf_(aq[j]); const float sg = sigmoidf_(az[j]); const float f = fmaxf(lb[j] + (1.0f - lb[j]) * sg, 1e-30f); kv[j] = (1.0f - lb[j]) * (1.0f - sg); lf[j] = __log2f(f); }
            *(LAS f32x4*)(LF + st * 128 + sk8) = (f32x4){lf[0], lf[1], lf[2], lf[3]}; *(LAS f32x4*)(LF + st * 128 + sk8 + 4) = (f32x4){lf[4], lf[5], lf[6], lf[7]};
            v4u qo, ko; qo.x = pk2(qv[0], qv[1]); qo.y = pk2(qv[2], qv[3]); qo.z = pk2(qv[4], qv[5]); qo.w = pk2(qv[6], qv[7]); ko.x = pk2(kv[0], kv[1]); ko.y = pk2(kv[2], kv[3]); ko.z = pk2(kv[4], kv[5]); ko.w = pk2(kv[6], kv[7]);
            *(LAS v4u*)(QB + st * PQ + sk8) = qo; *(LAS v4u*)(KB + st * PQ + sk8) = ko; *(LAS v4u*)(IVr + st * 128 + sk8) = ni;
#pragma unroll
            for (int hh = 0; hh < 2; ++hh)
#pragma unroll
                for (int r = 0; r < 4; ++r) ag[hh][r] = *(const bf16*)((const char*)P + (unsigned)((rbase + 16 * hh + 4 * fq + r) * (unsigned)NPAD + OFF_AG + h * 128 + 16 * wave + fr) * 2u);
            if (c + 1 < 64) { const unsigned pn = pst + (unsigned)(c + 1) * 32u * (unsigned)NPAD * 2u; nq = HG_LD16(pn + 2u * OFF_AQ); nf = HG_LD16(pn + 2u * OFF_AF); ni = HG_LD16(pn + 2u * OFF_AI); } }
        BAR_LDS();
        { const int k = tid & 127, tq = tid >> 7; float b[32]; float run = 0.f;
#pragma unroll
            for (int t = 0; t < 32; ++t) { run += LF[t * 128 + k]; b[t] = run; }
#pragma unroll
            for (int tq2 = 0; tq2 < 4; ++tq2) if (tq2 == tq) { const float mh = (tq2 < 2) ? b[7] : b[23]; float kt[8]; bf16 iv[8];
#pragma unroll
                for (int i = 0; i < 8; ++i) { const int t = 8 * tq2 + i; const float qv = bf1(QB[t * PQ + k]), kv = bf1(KB[t * PQ + k]); iv[i] = IVr[t * 128 + k];
                    Qt[t * PQ + k] = (bf16)f2bf(qv * __builtin_amdgcn_exp2f(b[t])); kt[i] = kv * __builtin_amdgcn_exp2f(b[31] - b[t]);
                    Qm[t * PQ + k] = (bf16)f2bf(qv * __builtin_amdgcn_exp2f(fminf(b[t] - mh, 115.f))); Km[t * PQ + k] = (bf16)f2bf(kv * __builtin_amdgcn_exp2f(fminf(mh - b[t], 115.f)));
                    if (tq2 < 2) Kr[t * PQ + k] = (bf16)f2bf(kv * __builtin_amdgcn_exp2f(b[15] - b[t])); else Qr[(t - 16) * PQ + k] = (bf16)f2bf(qv * __builtin_amdgcn_exp2f(b[t] - b[15])); }
                v4u ko; ko.x = pk2(kt[0], kt[1]); ko.y = pk2(kt[2], kt[3]); ko.z = pk2(kt[4], kt[5]); ko.w = pk2(kt[6], kt[7]); *(LAS v4u*)(KtT + k * PT + 8 * tq2) = ko;
                v4u vo; vo.x = (unsigned)iv[0] | ((unsigned)iv[1] << 16); vo.y = (unsigned)iv[2] | ((unsigned)iv[3] << 16); vo.z = (unsigned)iv[4] | ((unsigned)iv[5] << 16); vo.w = (unsigned)iv[6] | ((unsigned)iv[7] << 16); *(LAS v4u*)(VT + k * PT + 8 * tq2) = vo; }
            if (tq == 0) DEC[k] = __builtin_amdgcn_exp2f(b[31]); }
        if (c > 0) HG_OUT(rbase - 32);
        BAR_LDS();
        f32x4 at0 = (f32x4){0.f, 0.f, 0.f, 0.f}, at1 = at0, at2 = at0, o0 = at0, o1 = at0;
#pragma unroll
        for (int ks = 0; ks < 4; ++ks) { const int ko = 32 * ks + 8 * fq;
            at0 = MFMA16(LDFRAG(Km, fr, PQ, ko), LDFRAG(Qm, fr, PQ, ko), at0);
            at1 = MFMA16(LDFRAG(Km, 16 + fr, PQ, ko), LDFRAG(Qm, 16 + fr, PQ, ko), at1);
            at2 = MFMA16(LDFRAG(Kr, fr, PQ, ko), LDFRAG(Qr, fr, PQ, ko), at2);
            v4u sy; sy.x = pk2(sacc[2 * ks][0], sacc[2 * ks][1]); sy.y = pk2(sacc[2 * ks][2], sacc[2 * ks][3]); sy.z = pk2(sacc[2 * ks + 1][0], sacc[2 * ks + 1][1]); sy.w = pk2(sacc[2 * ks + 1][2], sacc[2 * ks + 1][3]);
            const v2u xa0 = *(const LAS v2u*)(Qt + fr * PQ + 32 * ks + 4 * fq), xb0 = *(const LAS v2u*)(Qt + fr * PQ + 32 * ks + 16 + 4 * fq);
            const v2u xa1 = *(const LAS v2u*)(Qt + (16 + fr) * PQ + 32 * ks + 4 * fq), xb1 = *(const LAS v2u*)(Qt + (16 + fr) * PQ + 32 * ks + 16 + 4 * fq);
            v4u x0; x0.x = xa0.x; x0.y = xa0.y; x0.z = xb0.x; x0.w = xb0.y; v4u x1; x1.x = xa1.x; x1.y = xa1.y; x1.z = xb1.x; x1.w = xb1.y;
            o0 = MFMA16(__builtin_bit_cast(bf16x8_t, x0), __builtin_bit_cast(bf16x8_t, sy), o0); o1 = MFMA16(__builtin_bit_cast(bf16x8_t, x1), __builtin_bit_cast(bf16x8_t, sy), o1); }
        {
            v4u a0, a1, a2; a0.z = 0u; a0.w = 0u; a1.z = 0u; a1.w = 0u; a2.z = 0u; a2.w = 0u;
            a0.x = pk2(4 * fq + 0 <= fr ? at0[0] : 0.f, 4 * fq + 1 <= fr ? at0[1] : 0.f); a0.y = pk2(4 * fq + 2 <= fr ? at0[2] : 0.f, 4 * fq + 3 <= fr ? at0[3] : 0.f);
            a1.x = pk2(4 * fq + 0 <= fr ? at1[0] : 0.f, 4 * fq + 1 <= fr ? at1[1] : 0.f); a1.y = pk2(4 * fq + 2 <= fr ? at1[2] : 0.f, 4 * fq + 3 <= fr ? at1[3] : 0.f);
            a2.x = pk2(at2[0], at2[1]); a2.y = pk2(at2[2], at2[3]);
            const v2u y0 = *(const LAS v2u*)(VT + (16 * wave + fr) * PT + 4 * fq), y1 = *(const LAS v2u*)(VT + (16 * wave + fr) * PT + 16 + 4 * fq);
            v4u v0; v0.x = y0.x; v0.y = y0.y; v0.z = 0u; v0.w = 0u; v4u v1; v1.x = y1.x; v1.y = y1.y; v1.z = 0u; v1.w = 0u;
            o0 = MFMA16(__builtin_bit_cast(bf16x8_t, a0), __builtin_bit_cast(bf16x8_t, v0), o0);
            o1 = MFMA16(__builtin_bit_cast(bf16x8_t, a1), __builtin_bit_cast(bf16x8_t, v1), o1);
            o1 = MFMA16(__builtin_bit_cast(bf16x8_t, a2), __builtin_bit_cast(bf16x8_t, v0), o1); }
#pragma unroll
        for (int r = 0; r < 4; ++r) { float q0 = o0[r] * o0[r], q1 = o1[r] * o1[r];
            q0 += __shfl_xor(q0, 1); q1 += __shfl_xor(q1, 1); q0 += __shfl_xor(q0, 2); q1 += __shfl_xor(q1, 2); q0 += __shfl_xor(q0, 4); q1 += __shfl_xor(q1, 4); q0 += __shfl_xor(q0, 8); q1 += __shfl_xor(q1, 8);
            if (fr == 0) { SS[(4 * fq + r) * 8 + wave] = q0; SS[(16 + 4 * fq + r) * 8 + wave] = q1; } }
        {
            const bf16x8_t vy = LDFRAG(VT, 16 * wave + fr, PT, 8 * fq);
#pragma unroll
            for (int kt = 0; kt < 8; ++kt) { const f32x4 d4 = *(const LAS f32x4*)(DEC + 16 * kt + 4 * fq); sacc[kt] = sacc[kt] * d4; sacc[kt] = MFMA16(LDFRAG(KtT, 16 * kt + fr, PT, 8 * fq), vy, sacc[kt]); } }
        po0 = o0; po1 = o1;
#pragma unroll
        for (int hh = 0; hh < 2; ++hh)
#pragma unroll
            for (int r = 0; r < 4; ++r) pag[hh][r] = ag[hh][r];
    }
    BAR_LDS();
    HG_OUT((unsigned)row0 + 2048u - 32u);
#undef HG_OUT
#undef HG_LD16
#pragma unroll
    for (int kt = 0; kt < 8; ++kt)
#pragma unroll
        for (int r = 0; r < 4; ++r) sout[(16 * kt + 4 * fq + r) * 128 + 16 * wave + fr] = sacc[kt][r];
    __syncthreads();
}

__device__ __forceinline__ void ssd_pre_phase(int lane, int gw, int NGW, const bf16* P, bf16* XC, float* DTb, float* ADT, float* ACUM,
                                              const float* conv_w, const float* conv_b, const float* dt_bias, const float* a_log, const float* state_conv, float* conv_out_p, float* conv_out_s) {
    unsigned ua = (unsigned)(((unsigned long long)(unsigned)gw * (3u * MT)) / (unsigned)NGW); const unsigned ub = (unsigned)(((unsigned long long)((unsigned)gw + 1u) * (3u * MT)) / (unsigned)NGW);
#define PRE_UNPK(dst, u) do { dst[0] = bflo(u.x); dst[1] = bfhi(u.x); dst[2] = bflo(u.y); dst[3] = bfhi(u.y); dst[4] = bflo(u.z); dst[5] = bfhi(u.z); dst[6] = bflo(u.w); dst[7] = bfhi(u.w); } while (0)
    while (ua < ub) {
        const int cg = (int)(ua / (unsigned)MT); const unsigned ue = ub < (unsigned)(cg + 1) * MT ? ub : (unsigned)(cg + 1) * MT;
        const int t0 = (int)(ua - (unsigned)cg * MT), t1 = (int)(ue - (unsigned)cg * MT), cc = cg * 512 + 8 * lane; ua = ue;
        float w[4][8], cb[8], a0[8], a1[8], a2[8];
#pragma unroll
        for (int j = 0; j < 4; ++j) { const f32x4 u0 = *(const f32x4*)(conv_w + j * 1536 + cc), u1 = *(const f32x4*)(conv_w + j * 1536 + cc + 4);
            w[j][0] = u0.x; w[j][1] = u0.y; w[j][2] = u0.z; w[j][3] = u0.w; w[j][4] = u1.x; w[j][5] = u1.y; w[j][6] = u1.z; w[j][7] = u1.w; }
        { const f32x4 u0 = *(const f32x4*)(conv_b + cc), u1 = *(const f32x4*)(conv_b + cc + 4); cb[0] = u0.x; cb[1] = u0.y; cb[2] = u0.z; cb[3] = u0.w; cb[4] = u1.x; cb[5] = u1.y; cb[6] = u1.z; cb[7] = u1.w; }
#pragma unroll
        for (int e = 0; e < 8; ++e) { a0[e] = 0.f; a1[e] = 0.f; a2[e] = 0.f; }
        const int ts = t0 >= 3 ? t0 - 3 : 0;
        const bf16* pc = P + OFF_XBC + cc; bf16* xo = XC + cc;
        v4u un[4];
#pragma unroll
        for (int k = 0; k < 4; ++k) { const int tt = ts + k < t1 ? ts + k : t1 - 1; un[k] = *(const v4u*)(pc + (size_t)tt * NPAD); }
        for (int tb = ts; tb < t1; tb += 4) { v4u uc[4];
#pragma unroll
            for (int k = 0; k < 4; ++k) uc[k] = un[k];
            if (tb + 4 < t1) {
#pragma unroll
                for (int k = 0; k < 4; ++k) { const int tt = tb + 4 + k < t1 ? tb + 4 + k : t1 - 1; un[k] = *(const v4u*)(pc + (size_t)tt * NPAD); } }
#pragma unroll
            for (int k = 0; k < 4; ++k) { const int t = tb + k; if (t < t1) {
                const bool smp = t >= NTOK_P; const bool st = smp ? (((t - NTOK_P) & 31) == 0) : ((t & 2047) == 0);
                if (st) {
                    if (smp) { const float* cbuf = state_conv + (size_t)((t - NTOK_P) >> 5) * 4608 + cc;
#pragma unroll
                        for (int e = 0; e < 8; ++e) { a0[e] = cbuf[e]; a1[e] = cbuf[1536 + e]; a2[e] = cbuf[3072 + e]; } }
                    else {
#pragma unroll
                        for (int e = 0; e < 8; ++e) { a0[e] = 0.f; a1[e] = 0.f; a2[e] = 0.f; } } }
                float cur[8]; PRE_UNPK(cur, uc[k]);
                if (t >= t0) { float o[8];
#pragma unroll
                    for (int e = 0; e < 8; ++e) o[e] = siluf_(cb[e] + w[0][e] * a0[e] + w[1][e] * a1[e] + w[2][e] * a2[e] + w[3][e] * cur[e]);
                    v4u ov; ov.x = pk2(o[0], o[1]); ov.y = pk2(o[2], o[3]); ov.z = pk2(o[4], o[5]); ov.w = pk2(o[6], o[7]);
                    *(v4u*)(xo + (size_t)t * 1536) = ov; }
#pragma unroll
                for (int e = 0; e < 8; ++e) { a0[e] = a1[e]; a1[e] = a2[e]; a2[e] = cur[e]; } } }
        }
    }
#undef PRE_UNPK
    const int dsp = NGW >= 528 * 2 ? NGW / (528 * 2) : 1;
    for (int it = (gw % dsp == 0) ? gw / dsp : 1056; it < 1056; it += NGW / dsp) {
        const int rb = it >> 1, h0 = (it & 1) * 8; const size_t row = (size_t)rb * 64 + lane;
        const v4u d0 = *(const v4u*)(P + row * NPAD + OFF_DT + h0);
        const float xr[8] = {bflo(d0.x), bfhi(d0.x), bflo(d0.y), bfhi(d0.y), bflo(d0.z), bfhi(d0.z), bflo(d0.w), bfhi(d0.w)};
        float dtv[8], av[8], csv[8];
#pragma unroll
        for (int h = 0; h < 8; ++h) { const float xv = xr[h] + dt_bias[h0 + h]; const float eu = __expf(-fabsf(xv)), ew = 1.0f + eu;
            const float l1p = (ew == 1.0f) ? eu : __logf(ew) * (eu * __builtin_amdgcn_rcpf(ew - 1.0f)); const float dt = fmaxf(xv, 0.f) + l1p; const float a = -dt * __expf(a_log[h0 + h]); dtv[h] = dt; av[h] = a; csv[h] = a; }
#pragma unroll
        for (int o = 1; o < 64; o <<= 1) {
#pragma unroll
            for (int h = 0; h < 8; ++h) { const float t = __shfl_up(csv[h], o); if (lane >= o) csv[h] += t; } }
#pragma unroll
        for (int q = 0; q < 2; ++q) { *(f32x4*)(DTb + row * 16 + h0 + 4 * q) = (f32x4){dtv[4 * q], dtv[4 * q + 1], dtv[4 * q + 2], dtv[4 * q + 3]};
            *(f32x4*)(ADT + row * 16 + h0 + 4 * q) = (f32x4){av[4 * q], av[4 * q + 1], av[4 * q + 2], av[4 * q + 3]};
            *(f32x4*)(ACUM + row * 16 + h0 + 4 * q) = (f32x4){csv[4 * q], csv[4 * q + 1], csv[4 * q + 2], csv[4 * q + 3]}; }
    }
    for (int e = gw * 64 + lane; e < 48 * 4608; e += NGW * 64) {
        const int sq = e / 4608, r = e - sq * 4608, j = r / 1536, cc = r - j * 1536;
        const size_t row = sq < 16 ? (size_t)sq * 2048 + 2045 + j : (size_t)NTOK_P + (sq - 16) * 32 + 29 + j;
        const float v = bf1(P[row * NPAD + OFF_XBC + cc]);
        if (sq < 16) conv_out_p[sq * 4608 + r] = v; else conv_out_s[(sq - 16) * 4608 + r] = v;
    }
}

__device__ __forceinline__ void ssd_item(LAS unsigned char* lds, int tid, int lane, int wave, const bf16* P, const bf16* XC, const float* DTb, const float* ADT, bf16* YB, int row0, int T, int h,
                                         const float* s0, float* sout, float Dh) {
    LAS float* X = (LAS float*)lds;
    LAS float* Bs = X + 2048;
    LAS float* Cs = Bs + 4096;
    LAS float* DT = Cs + 4096;
    LAS float* DA = DT + 32;
    LAS float* PY = DA + 32;
    const int g = h >> 3, ci = tid;
    int cc = 0; LAS float* dst = X; int dstride = 64;
    if (ci < 64) { cc = h * 64 + ci; dst = X + ci; dstride = 64; } else if (ci < 192) { cc = 1024 + g * 128 + (ci - 64); dst = Bs + (ci - 64); dstride = 128; } else if (ci < 320) { cc = 1280 + g * 128 + (ci - 192); dst = Cs + (ci - 192); dstride = 128; }
    float hst[16];
#pragma unroll
    for (int j = 0; j < 4; ++j) { f32x4 v = (f32x4){0.f, 0.f, 0.f, 0.f}; if (s0) v = *(const f32x4*)(s0 + lane * 128 + 16 * wave + 4 * j); hst[4 * j] = v.x; hst[4 * j + 1] = v.y; hst[4 * j + 2] = v.z; hst[4 * j + 3] = v.w; }
    __syncthreads();
    const int nch = T / 32;
    for (int c = 0; c < nch; ++c) {
        const size_t rbase = (size_t)(row0 + c * 32);
        if (ci < 320) { const bf16* pc = XC + rbase * 1536 + cc;
            bf16 sv[32];
#pragma unroll
            for (int t = 0; t < 32; ++t) sv[t] = pc[(size_t)t * 1536];
#pragma unroll
            for (int t = 0; t < 32; ++t) dst[t * dstride] = bf1(sv[t]); }
        else if (ci < 352) { const int t = ci - 320; DT[t] = DTb[(rbase + t) * 16 + h]; DA[t] = __expf(ADT[(rbase + t) * 16 + h]); }
        unsigned zg[2];
#pragma unroll
        for (int j = 0; j < 2; ++j) { const int e = tid + 512 * j; zg[j] = *(const unsigned*)(P + (rbase + (e >> 5)) * NPAD + OFF_BZ + h * 64 + (e & 31) * 2); }
        __syncthreads();
#pragma unroll 2
        for (int t = 0; t < 32; ++t) {
            const float dA = DA[t], xdt = X[t * 64 + lane] * DT[t]; float py = 0.f;
#pragma unroll
            for (int n4 = 0; n4 < 4; ++n4) { const f32x4 b4 = *(const LAS f32x4*)(Bs + t * 128 + 16 * wave + 4 * n4), c4 = *(const LAS f32x4*)(Cs + t * 128 + 16 * wave + 4 * n4);
#pragma unroll
                for (int j = 0; j < 4; ++j) { const int nn = 4 * n4 + j; hst[nn] = fmaf(xdt, b4[j], dA * hst[nn]); py = fmaf(hst[nn], c4[j], py); } }
            PY[(t * 8 + wave) * 64 + lane] = py;
        }
        __syncthreads();
#pragma unroll
        for (int j = 0; j < 2; ++j) { const int e = tid + 512 * j, t = e >> 5, p2 = (e & 31) * 2; float y0 = 0.f, y1 = 0.f;
#pragma unroll
            for (int w = 0; w < 8; ++w) { const f32x2 p = *(const LAS f32x2*)(PY + (t * 8 + w) * 64 + p2); y0 += p.x; y1 += p.y; }
            const f32x2 xv = *(const LAS f32x2*)(X + t * 64 + p2); y0 += Dh * xv.x; y1 += Dh * xv.y;
            const size_t row = rbase + t; const unsigned z = zg[j];
            *(unsigned*)(YB + row * 1024 + h * 64 + p2) = pk2(y0 * siluf_(bflo(z)), y1 * siluf_(bfhi(z))); }
        __syncthreads();
    }
#pragma unroll
    for (int j = 0; j < 4; ++j) *(f32x4*)(sout + lane * 128 + 16 * wave + 4 * j) = (f32x4){hst[4 * j], hst[4 * j + 1], hst[4 * j + 2], hst[4 * j + 3]};
    __syncthreads();
}

__device__ __forceinline__ bf16 v4u_el(const v4u& d, int e) { const unsigned w = d[e >> 1]; return (bf16)((e & 1) ? (w >> 16) : (w & 0xffffu)); }
__device__ __forceinline__ void ssd_mfma_pair(LAS unsigned char* lds, int tid, int lane, int wave, const bf16* P, const bf16* XC, const float* DTb, const float* ACUM, bf16* YB, int row0, int h0, float Dh0, float Dh1, float* sout0) {
    constexpr int PC = 136, PS = 72;
    LAS bf16* Cm0 = (LAS bf16*)lds;
    LAS bf16* Bm = Cm0 + 2 * 64 * PC;
    LAS bf16* BmT = Bm + 64 * PC;
    LAS bf16* XT0 = BmT + 128 * PS;
    LAS bf16* Mm0 = XT0 + 4 * 64 * PS;
    LAS float* AC0 = (LAS float*)(Mm0 + 2 * 64 * PS);
    static_assert((2 * 64 * PC + 64 * PC + 128 * PS + 4 * 64 * PS + 2 * 64 * PS) * 2 + 4 * 192 * 4 <= RING_BYTES, "ssd pair LDS");
    const int fr = lane & 15, fq = lane >> 4, g = h0 >> 3;
    const int hw = wave >> 2, pt = wave & 3;
    __syncthreads();
    f32x4 hacc[8];
#pragma unroll
    for (int j = 0; j < 8; ++j) hacc[j] = (f32x4){0.f, 0.f, 0.f, 0.f};
    int pf_s[6], pf_c[6]; v4u pf[6];
#pragma unroll
    for (int j = 0; j < 6; ++j) { const int q = tid + 512 * j; pf_s[j] = q / 48; const int c16 = q - 48 * pf_s[j];
        const int col = c16 < 16 ? (h0 + (c16 >> 3)) * 64 + 8 * (c16 & 7) : (c16 < 32 ? 1024 + g * 128 + 8 * (c16 - 16) : 1280 + g * 128 + 8 * (c16 - 32));
        pf_c[j] = (c16 << 16) | col; pf[j] = *(const v4u*)((const char*)XC + (unsigned)(((unsigned)row0 + pf_s[j]) * 1536u + col) * 2u); }
    float pf_ac = 0.f, pf_dt = 0.f, pf_acl = 0.f; const int sh = tid >> 6, ssx = tid & 63;
    if (tid < 128) { pf_ac = *(const float*)((const char*)ACUM + (unsigned)(((unsigned)row0 + ssx) * 16u + h0 + sh) * 4u); pf_dt = *(const float*)((const char*)DTb + (unsigned)(((unsigned)row0 + ssx) * 16u + h0 + sh) * 4u); pf_acl = *(const float*)((const char*)ACUM + (unsigned)(((unsigned)row0 + 63u) * 16u + h0 + sh) * 4u); }
    for (int c = 0; c < 32; ++c) {
        const unsigned rbase = (unsigned)row0 + 64u * c;
        bf16 zr[4][4];
#pragma unroll
        for (int li = 0; li < 4; ++li)
#pragma unroll
            for (int r = 0; r < 4; ++r) zr[li][r] = *(const bf16*)((const char*)P + (unsigned)((rbase + 16 * li + 4 * fq + r) * (unsigned)NPAD + OFF_BZ + (h0 + hw) * 64 + 16 * pt + fr) * 2u);
        const int cb = c & 1;
        LAS bf16* Cm = Cm0 + cb * 64 * PC; LAS bf16* XTb = XT0 + cb * 2 * 64 * PS; LAS float* ACb = AC0 + cb * 2 * 192;
        if (tid < 128) { LAS float* A = ACb + sh * 192; A[ssx] = pf_ac; A[128 + ssx] = pf_dt; A[64 + ssx] = __expf(pf_acl - pf_ac) * pf_dt; }
#pragma unroll
        for (int j = 0; j < 6; ++j) { const int s = pf_s[j], c16 = pf_c[j] >> 16; const v4u d = pf[j];
            if (c16 < 16) { LAS bf16* XT = XTb + (c16 >> 3) * 64 * PS; const int cc = c16 & 7;
#pragma unroll
                for (int e = 0; e < 8; ++e) XT[(8 * cc + e) * PS + (s ^ (cc << 3))] = v4u_el(d, e); }
            else if (c16 < 32) { const int n0 = 8 * (c16 - 16); *(LAS v4u*)(Bm + s * PC + n0) = d;
#pragma unroll
                for (int e = 0; e < 8; ++e) BmT[(n0 + e) * PS + (s ^ (((c16 - 16) & 7) << 3))] = v4u_el(d, e); }
            else { *(LAS v4u*)(Cm + s * PC + 8 * (c16 - 32)) = d; } }
        if (c + 1 < 32) {
#pragma unroll
            for (int j = 0; j < 6; ++j) pf[j] = *(const v4u*)((const char*)XC + (unsigned)((rbase + 64u + pf_s[j]) * 1536u + (pf_c[j] & 0xffff)) * 2u);
            if (tid < 128) { pf_ac = *(const float*)((const char*)ACUM + (unsigned)((rbase + 64u + ssx) * 16u + h0 + sh) * 4u); pf_dt = *(const float*)((const char*)DTb + (unsigned)((rbase + 64u + ssx) * 16u + h0 + sh) * 4u); pf_acl = *(const float*)((const char*)ACUM + (unsigned)((rbase + 127u) * 16u + h0 + sh) * 4u); } }
        BAR_LDS();
        const LAS float* AC = ACb + hw * 192; const LAS bf16* XT = XTb + hw * 64 * PS;
        f32x4 yo[4];
        { bf16x8_t hb[4];
#pragma unroll
          for (int m = 0; m < 4; ++m) { v4u o; o.x = pk2(hacc[2 * m][0], hacc[2 * m][1]); o.y = pk2(hacc[2 * m][2], hacc[2 * m][3]); o.z = pk2(hacc[2 * m + 1][0], hacc[2 * m + 1][1]); o.w = pk2(hacc[2 * m + 1][2], hacc[2 * m + 1][3]);
              hb[m] = __builtin_bit_cast(bf16x8_t, o); }
#pragma unroll
          for (int li = 0; li < 4; ++li) { yo[li] = (f32x4){0.f, 0.f, 0.f, 0.f};
#pragma unroll
              for (int m = 0; m < 4; ++m) { const LAS bf16* cp = Cm + (16 * li + fr) * PC + 32 * m + 4 * fq; const v2u c0 = *(const LAS v2u*)cp, c1 = *(const LAS v2u*)(cp + 16);
                  v4u xo; xo.x = c0.x; xo.y = c0.y; xo.z = c1.x; xo.w = c1.y; yo[li] = MFMA16(__builtin_bit_cast(bf16x8_t, xo), hb[m], yo[li]); } } }
        { const LAS float* WU = AC + 64; const float dec = __expf(AC[63]);
          bf16x8_t xs[2];
#pragma unroll
          for (int ss = 0; ss < 2; ++ss) { const v4u d = *(const LAS v4u*)(XT + (16 * pt + fr) * PS + ((32 * ss + 8 * fq) ^ (((2 * pt + (fr >> 3)) & 7) << 3)));
              const f32x4 wa = *(const LAS f32x4*)(WU + 32 * ss + 8 * fq), wb = *(const LAS f32x4*)(WU + 32 * ss + 8 * fq + 4);
              v4u o; o.x = pk2(bflo(d.x) * wa.x, bfhi(d.x) * wa.y); o.y = pk2(bflo(d.y) * wa.z, bfhi(d.y) * wa.w); o.z = pk2(bflo(d.z) * wb.x, bfhi(d.z) * wb.y); o.w = pk2(bflo(d.w) * wb.z, bfhi(d.w) * wb.w);
              xs[ss] = __builtin_bit_cast(bf16x8_t, o); }
#pragma unroll
          for (int j = 0; j < 8; ++j) { hacc[j] = hacc[j] * dec;
#pragma unroll
              for (int ss = 0; ss < 2; ++ss) hacc[j] = MFMA16(LDFRAG(BmT, 16 * j + fr, PS, (32 * ss + 8 * fq) ^ (((2 * j + (fr >> 3)) & 7) << 3)), xs[ss], hacc[j]); } }
        {
            const int li = wave >> 1, si0 = 2 * (wave & 1);
#pragma unroll
            for (int tt = 0; tt < 2; ++tt) { const int si = si0 + tt; f32x4 acc = (f32x4){0.f, 0.f, 0.f, 0.f};
                if (si <= li) {
#pragma unroll
                    for (int ks = 0; ks < 4; ++ks) acc = MFMA16(LDFRAG(Cm, 16 * li + fr, PC, 32 * ks + 8 * fq), LDFRAG(Bm, 16 * si + fr, PC, 32 * ks + 8 * fq), acc); }
                const int s = 16 * si + fr;
#pragma unroll
                for (int hh = 0; hh < 2; ++hh) { const LAS float* A2 = ACb + hh * 192; LAS bf16* Mm = Mm0 + hh * 64 * PS; const float acs = A2[s], dts = A2[128 + s];
#pragma unroll
                    for (int r = 0; r < 4; ++r) { const int l = 16 * li + 4 * fq + r; const float m = (s <= l) ? acc[r] * __expf(A2[l] - acs) * dts : 0.f; Mm[l * PS + s] = (bf16)f2bf(m); } } }
        }
        BAR_LDS();
        {
            const LAS bf16* Mm = Mm0 + hw * 64 * PS; const int h = h0 + hw; const float Dh = hw ? Dh1 : Dh0; const int p = 16 * pt + fr;
            bf16x8_t xf[2];
#pragma unroll
            for (int ss = 0; ss < 2; ++ss) xf[ss] = LDFRAG(XT, 16 * pt + fr, PS, (32 * ss + 8 * fq) ^ (((2 * pt + (fr >> 3)) & 7) << 3));
#pragma unroll
            for (int li = 0; li < 4; ++li) { f32x4 yd = (f32x4){0.f, 0.f, 0.f, 0.f};
#pragma unroll
                for (int ss = 0; ss < 2; ++ss) { if (ss == 1 && li < 2) continue;
                    yd = MFMA16(LDFRAG(Mm, 16 * li + fr, PS, 32 * ss + 8 * fq), xf[ss], yd); }
#pragma unroll
                for (int r = 0; r < 4; ++r) { const int l = 16 * li + 4 * fq + r; const float y = yd[r] + __expf(AC[l]) * yo[li][r] + Dh * bf1(XT[p * PS + (l ^ (((p >> 3) & 7) << 3))]);
                    const float z = bf1(zr[li][r]);
                    *(bf16*)((char*)YB + (unsigned)((rbase + l) * 1024u + h * 64 + p) * 2u) = (bf16)f2bf(y * siluf_(z)); } }
        }
    }
#pragma unroll
    for (int j = 0; j < 8; ++j) *(f32x4*)(sout0 + (size_t)hw * 8192 + (16 * pt + fr) * 128 + 16 * j + 4 * fq) = hacc[j];
    __syncthreads();
}

__device__ __forceinline__ unsigned cm_off_b(unsigned row, unsigned ch) { return 256u * row + 16u * (ch ^ (((row & 3u) << 2) | ((row >> 2) & 3u))); }
__device__ __forceinline__ unsigned cm_tr_addr(unsigned lane, unsigned c, unsigned ks, unsigned t) { const unsigned g = lane >> 4, q = (lane & 15) >> 2, p = lane & 3; return cm_off_b(32 * ks + 8 * g + 4 * t + q, 2 * c + (p >> 1)) + 8 * (p & 1); }
__device__ __forceinline__ void cmlp_mfma_item(LAS unsigned char* lds, int tid, int lane, int wave, bf16* P, bf16* YC, int row0, const float* ln_g, const float* ln_b, const float* wsl, const float* bsl) {
    constexpr int PW = 136;
    LAS bf16* Wb = (LAS bf16*)lds;
    LAS unsigned char* Vimg = lds + 34816;
    LAS bf16* OUTb = (LAS bf16*)(lds + 67584);
    LAS float* ST = (LAS float*)(lds + ST_OFF);
    const int fr = lane & 15, fq = lane >> 4;
    __syncthreads();
    v4u sa[4], sb[4];
    const unsigned cvo = (unsigned)(((unsigned)row0 + (unsigned)wave * 16u) * (unsigned)NPAD + OFF_CV + 16u * lane) * 2u;
#pragma unroll
    for (int j = 0; j < 4; ++j) { const v4u* p = (const v4u*)((const char*)P + cvo + (unsigned)j * (unsigned)(NPAD * 2)); sa[j] = p[0]; sb[j] = p[1]; }
#pragma unroll 1
    for (int ib = 0; ib < 4; ++ib) {
        v4u na[4], nb[4];
        if (ib < 3) {
#pragma unroll
            for (int j = 0; j < 4; ++j) { const v4u* p = (const v4u*)((const char*)P + cvo + (unsigned)(4 * ib + 4 + j) * (unsigned)(NPAD * 2)); na[j] = p[0]; nb[j] = p[1]; } }
#pragma unroll
        for (int j = 0; j < 4; ++j) { const int s = wave * 16 + 4 * ib + j; const v4u a = sa[j], b = sb[j];
            float v[16]; v[0] = bflo(a.x); v[1] = bfhi(a.x); v[2] = bflo(a.y); v[3] = bfhi(a.y); v[4] = bflo(a.z); v[5] = bfhi(a.z); v[6] = bflo(a.w); v[7] = bfhi(a.w);
            v[8] = bflo(b.x); v[9] = bfhi(b.x); v[10] = bflo(b.y); v[11] = bfhi(b.y); v[12] = bflo(b.z); v[13] = bfhi(b.z); v[14] = bflo(b.w); v[15] = bfhi(b.w);
            float sm = 0.f;
#pragma unroll
            for (int q = 0; q < 16; ++q) { v[q] = geluf_(v[q]); sm += v[q]; }
            v4u oa, ob; oa.x = pk2(v[0], v[1]); oa.y = pk2(v[2], v[3]); oa.z = pk2(v[4], v[5]); oa.w = pk2(v[6], v[7]); ob.x = pk2(v[8], v[9]); ob.y = pk2(v[10], v[11]); ob.z = pk2(v[12], v[13]); ob.w = pk2(v[14], v[15]);
            v4u* po = (v4u*)((char*)P + cvo + (unsigned)(4 * ib + j) * (unsigned)(NPAD * 2)); po[0] = oa; po[1] = ob;
            const float mean = wave_sum(sm) * (1.0f / 1024.0f); float sq = 0.f;
#pragma unroll
            for (int q = 0; q < 16; ++q) { const float d = v[q] - mean; sq += d * d; }
            const float rstd = rsqrtf_(wave_sum(sq) * (1.0f / 1024.0f) + NORM_EPS);
            if (lane == 0) { ST[2 * s] = mean; ST[2 * s + 1] = rstd; } }
        if (ib < 3) {
#pragma unroll
            for (int j = 0; j < 4; ++j) { sa[j] = na[j]; sb[j] = nb[j]; } }
    }
    __syncthreads();
    f32x4 wreg[8]; v2u vreg[8];
#pragma unroll
    for (int e = 0; e < 8; ++e) { const int q = tid + 512 * e; wreg[e] = *(const f32x4*)(wsl + (size_t)(q >> 5) * 128 + 4 * (q & 31)); vreg[e] = *(const v2u*)(P + (size_t)(row0 + (q >> 5)) * NPAD + OFF_CV + 4 * (q & 31)); }
    for (int gh = 0; gh < 8; ++gh) { const int g = gh >> 1, c0 = gh * 128;
        if ((gh & 1) == 0) {
#pragma unroll
            for (int e = 0; e < 8; ++e) { const int q = tid + 512 * e, t = q >> 5, s4 = 4 * (q & 31); const f32x4 w = wreg[e];
                v2u o; o.x = pk2(s4 + 0 <= t ? w.x : 0.f, s4 + 1 <= t ? w.y : 0.f); o.y = pk2(s4 + 2 <= t ? w.z : 0.f, s4 + 3 <= t ? w.w : 0.f); *(LAS v2u*)(Wb + t * PW + s4) = o; } }
#pragma unroll
        for (int e = 0; e < 8; ++e) { const int q = tid + 512 * e, sr = q >> 5, c4 = 4 * (q & 31); const v2u cv = vreg[e]; const float mean = ST[2 * sr], rstd = ST[2 * sr + 1];
            const f32x4 lg = *(const f32x4*)(ln_g + c0 + c4), lb = *(const f32x4*)(ln_b + c0 + c4);
            v2u o; o.x = pk2((bflo(cv.x) - mean) * rstd * lg.x + lb.x, (bfhi(cv.x) - mean) * rstd * lg.y + lb.y); o.y = pk2((bflo(cv.y) - mean) * rstd * lg.z + lb.z, (bfhi(cv.y) - mean) * rstd * lg.w + lb.w);
            *(LAS v2u*)(Vimg + cm_off_b((unsigned)sr, (unsigned)(c4 >> 3)) + 2 * (c4 & 7)) = o; }
        v4u ureg[4];
#pragma unroll
        for (int e = 0; e < 4; ++e) { const int q = tid + 512 * e; ureg[e] = *(const v4u*)(P + (size_t)(row0 + (q >> 4)) * NPAD + OFF_CU + c0 + 8 * (q & 15)); }
        if (gh + 1 < 8) {
#pragma unroll
            for (int e = 0; e < 8; ++e) { const int q = tid + 512 * e; vreg[e] = *(const v2u*)(P + (size_t)(row0 + (q >> 5)) * NPAD + OFF_CV + c0 + 128 + 4 * (q & 31)); }
            if (gh & 1) {
#pragma unroll
                for (int e = 0; e < 8; ++e) { const int q = tid + 512 * e; wreg[e] = *(const f32x4*)(wsl + ((size_t)(g + 1) * 128 + (q >> 5)) * 128 + 4 * (q & 31)); } } }
        BAR_LDS();
        { f32x4 acc[8];
#pragma unroll
            for (int ti = 0; ti < 8; ++ti) acc[ti] = (f32x4){0.f, 0.f, 0.f, 0.f};
            const unsigned vb = (unsigned)(size_t)Vimg;
#pragma unroll
            for (int ks = 0; ks < 4; ++ks) { v2u y0, y1;
                asm volatile("ds_read_b64_tr_b16 %0, %2\n\tds_read_b64_tr_b16 %1, %3\n\ts_waitcnt lgkmcnt(0)" : "=&v"(y0), "=&v"(y1) : "v"(vb + cm_tr_addr((unsigned)lane, (unsigned)wave, (unsigned)ks, 0u)), "v"(vb + cm_tr_addr((unsigned)lane, (unsigned)wave, (unsigned)ks, 1u)) : "memory");
                v4u yy; yy.x = y0.x; yy.y = y0.y; yy.z = y1.x; yy.w = y1.y; const bf16x8_t yf = __builtin_bit_cast(bf16x8_t, yy);
#pragma unroll
                for (int ti = 2 * ks; ti < 8; ++ti) acc[ti] = MFMA16(LDFRAG(Wb, 16 * ti + fr, PW, 32 * ks + 8 * fq), yf, acc[ti]); }
#pragma unroll
            for (int ti = 0; ti < 8; ++ti)
#pragma unroll
                for (int r = 0; r < 4; ++r) OUTb[(16 * ti + 4 * fq + r) * PW + 16 * wave + fr] = (bf16)f2bf(acc[ti][r]); }
        BAR_LDS();
#pragma unroll
        for (int e = 0; e < 4; ++e) { const int q = tid + 512 * e, t = q >> 4, c8 = 8 * (q & 15); const v4u o = *(const LAS v4u*)(OUTb + t * PW + c8); const v4u u = ureg[e]; const float bsv = bsl[g * 128 + t];
            v4u y; y.x = pk2(geluf_(bflo(u.x)) * (bflo(o.x) + bsv), geluf_(bfhi(u.x)) * (bfhi(o.x) + bsv)); y.y = pk2(geluf_(bflo(u.y)) * (bflo(o.y) + bsv), geluf_(bfhi(u.y)) * (bfhi(o.y) + bsv));
            y.z = pk2(geluf_(bflo(u.z)) * (bflo(o.z) + bsv), geluf_(bfhi(u.z)) * (bfhi(o.z) + bsv)); y.w = pk2(geluf_(bflo(u.w)) * (bflo(o.w) + bsv), geluf_(bfhi(u.w)) * (bfhi(o.w) + bsv));
            *(v4u*)(YC + (size_t)(row0 + t) * 1024 + c0 + c8) = y; }
    }
    __syncthreads();
}

__device__ __forceinline__ void cmlp_item(LAS unsigned char* lds, int tid, int lane, int wave, const bf16* P, bf16* YC, int row0, int Lc,
                                          const float* ln_g, const float* ln_b, const float* wsl, const float* bsl, float* vout) {
    LAS float* WT = (LAS float*)lds;
    LAS float* V = WT + 16384;
    LAS float* ST = (LAS float*)(lds + ST_OFF);
    __syncthreads();
    for (int i = 0; i < 16; ++i) { const int s = wave * 16 + i; if (s < Lc) {
            const v4u* p = (const v4u*)(P + (size_t)(row0 + s) * NPAD + OFF_CV + 16 * lane); const v4u a = p[0], b = p[1];
            float v[16]; v[0] = bflo(a.x); v[1] = bfhi(a.x); v[2] = bflo(a.y); v[3] = bfhi(a.y); v[4] = bflo(a.z); v[5] = bfhi(a.z); v[6] = bflo(a.w); v[7] = bfhi(a.w);
            v[8] = bflo(b.x); v[9] = bfhi(b.x); v[10] = bflo(b.y); v[11] = bfhi(b.y); v[12] = bflo(b.z); v[13] = bfhi(b.z); v[14] = bflo(b.w); v[15] = bfhi(b.w);
            float sm = 0.f;
#pragma unroll
            for (int j = 0; j < 16; ++j) { v[j] = geluf_(v[j]); sm += v[j]; }
            const float mean = wave_sum(sm) * (1.0f / 1024.0f); float sq = 0.f;
#pragma unroll
            for (int j = 0; j < 16; ++j) { const float d = v[j] - mean; sq += d * d; }
            const float rstd = 1.0f / sqrtf(wave_sum(sq) * (1.0f / 1024.0f) + NORM_EPS);
            if (lane == 0) { ST[2 * s] = mean; ST[2 * s + 1] = rstd; } } }
    const int tg = tid >> 4, cg = tid & 15;
    for (int g = 0; g < 4; ++g) {
        __syncthreads();
#pragma unroll 1
        for (int j = 0; j < 8; ++j) { const int e = tid + 512 * j, s4 = (e >> 7) * 4, t = e & 127;
            f32x4 w = (f32x4){0.f, 0.f, 0.f, 0.f}; if (t < Lc && s4 < Lc) w = *(const f32x4*)(wsl + ((size_t)g * 128 + t) * 128 + s4);
#pragma unroll
            for (int jj = 0; jj < 4; ++jj) WT[(s4 + jj) * 128 + t] = (s4 + jj <= t) ? w[jj] : 0.f; }
        for (int half = 0; half < 2; ++half) { const int c0 = g * 256 + half * 128;
            if (half) __syncthreads();
#pragma unroll 2
            for (int j = 0; j < 8; ++j) { const int e = tid + 512 * j, s = e >> 5, c4 = (e & 31) * 4;
                if (s < Lc) { const v2u cv = *(const v2u*)(P + (size_t)(row0 + s) * NPAD + OFF_CV + c0 + c4); const float mean = ST[2 * s], rstd = ST[2 * s + 1];
                    const f32x4 lg = *(const f32x4*)(ln_g + c0 + c4), lb = *(const f32x4*)(ln_b + c0 + c4);
                    f32x4 v; v.x = (geluf_(bflo(cv.x)) - mean) * rstd * lg.x + lb.x; v.y = (geluf_(bfhi(cv.x)) - mean) * rstd * lg.y + lb.y; v.z = (geluf_(bflo(cv.y)) - mean) * rstd * lg.z + lb.z; v.w = (geluf_(bfhi(cv.y)) - mean) * rstd * lg.w + lb.w;
                    *(LAS f32x4*)(V + s * 128 + c4) = v; if (vout) *(f32x4*)(vout + (size_t)s * 1024 + c0 + c4) = v; } }
            __syncthreads();
            float acc[4][8];
#pragma unroll
            for (int i = 0; i < 4; ++i)
#pragma unroll
                for (int j = 0; j < 8; ++j) acc[i][j] = 0.f;
            for (int s = 0; s < Lc; ++s) { const f32x4 w4 = *(const LAS f32x4*)(WT + s * 128 + 4 * tg), va = *(const LAS f32x4*)(V + s * 128 + 4 * cg), vb = *(const LAS f32x4*)(V + s * 128 + 64 + 4 * cg);
#pragma unroll
                for (int i = 0; i < 4; ++i) {
#pragma unroll
                    for (int j = 0; j < 4; ++j) { acc[i][j] = fmaf(w4[i], va[j], acc[i][j]); acc[i][4 + j] = fmaf(w4[i], vb[j], acc[i][4 + j]); } } }
#pragma unroll
            for (int i = 0; i < 4; ++i) { const int t = 4 * tg + i; if (t < Lc) { const size_t row = (size_t)(row0 + t); const float bsv = bsl[g * 128 + t];
                    const v2u ua = *(const v2u*)(P + row * NPAD + OFF_CU + c0 + 4 * cg), ub = *(const v2u*)(P + row * NPAD + OFF_CU + c0 + 64 + 4 * cg);
                    v2u oa, ob; oa.x = pk2(geluf_(bflo(ua.x)) * (acc[i][0] + bsv), geluf_(bfhi(ua.x)) * (acc[i][1] + bsv)); oa.y = pk2(geluf_(bflo(ua.y)) * (acc[i][2] + bsv), geluf_(bfhi(ua.y)) * (acc[i][3] + bsv));
                    ob.x = pk2(geluf_(bflo(ub.x)) * (acc[i][4] + bsv), geluf_(bfhi(ub.x)) * (acc[i][5] + bsv)); ob.y = pk2(geluf_(bflo(ub.y)) * (acc[i][6] + bsv), geluf_(bfhi(ub.y)) * (acc[i][7] + bsv));
                    *(v2u*)(YC + row * 1024 + c0 + 4 * cg) = oa; *(v2u*)(YC + row * 1024 + c0 + 64 + 4 * cg) = ob; } }
        }
    }
    __syncthreads();
}

#ifndef DOWN_REV
#define DOWN_REV 1
#endif
#ifndef EPI_ALIGN_HEAVY
#define EPI_ALIGN_HEAVY true
#endif
#ifndef TAIL_SPLIT
#define TAIL_SPLIT 1
#endif
#ifndef MK_N_LAUNCHES
#define MK_N_LAUNCHES 1
#endif
constexpr int PH_PER_LAYER = 10, N_PHASES = 2 + DEPTH * PH_PER_LAYER;
constexpr int Q_NITEMS = 128 + 128 + 256 + 256 + 512 + 32;
struct Args { const float* in[29]; float* out; unsigned char* ws; int ph_lo, ph_hi; };
static_assert(sizeof(Args) == 29 * 8 + 8 + 8 + 8, "no padding in Args");

typedef const __attribute__((address_space(4))) unsigned long long* karg_t;
__device__ __forceinline__ unsigned long long ldarg(int i) { karg_t p = (karg_t)__builtin_amdgcn_kernarg_segment_ptr(); asm volatile("" : "+s"(p)); return p[i]; }
#define INP(i) ((const float*)(const GAS float*)ldarg(i))
#define OUTP() ((float*)(GAS float*)ldarg(29))
#define WSP() ((unsigned char*)(GAS unsigned char*)ldarg(30))

__device__ __forceinline__ int tid_now(int wave_s) { return (int)__builtin_amdgcn_mbcnt_hi(~0u, __builtin_amdgcn_mbcnt_lo(~0u, 0u)) + 64 * wave_s; }
__global__ void __launch_bounds__(NWAVES * 64, 2) fwd(Args args) {
    extern __shared__ __attribute__((aligned(16))) unsigned char lds_raw[];
    LAS unsigned char* lds = (LAS unsigned char*)lds_raw;
    volatile LAS unsigned* MISC = (volatile LAS unsigned*)(lds + MISC_OFF);
    const int wave_s = __builtin_amdgcn_readfirstlane((int)threadIdx.x >> 6);
    for (int u = threadIdx.x; u < 64; u += NWAVES * 64) MISC[u] = 0u;
    __syncthreads();
    XcdBarrier bar = xcd_barrier_post((unsigned*)WSP() + CW_BAR, MISC + 8, (int)threadIdx.x);
    const int lo = args.ph_lo, hi = args.ph_hi;
#define IN(k) (lo <= (k) && (k) < hi)
#define SEAM(k) do { if (IN((k) + 1)) { XcdBarrier b2_ = bar; b2_.bar = (unsigned*)WSP() + CW_BAR; asm volatile("" : "+s"(b2_.x)); xcd_barrier(b2_, tid_now(wave_s)); } } while (0)
#define GEOM() int tid = tid_now(wave_s); asm volatile("" : "+v"(tid)); int G = gridDim.x, bx = blockIdx.x; asm volatile("" : "+s"(G), "+s"(bx)); \
    const int lane = tid & 63, wave = __builtin_amdgcn_readfirstlane(tid >> 6); \
    const int vcu = (G % 8 == 0) ? (bx % 8) * (G / 8) + bx / 8 : bx; const int gw = vcu * NWAVES + wave, NGW = G * NWAVES; (void)lane; (void)gw; (void)NGW; (void)wave; (void)tid

    if (IN(0)) { GEOM();
        for (int it = bx; it < DEPTH * 96; it += G) mod_item(lds, tid, it, INP(5), INP(6), INP(9), INP(10), (float*)(WSP() + WS_MOD));
        { unsigned char* ws = WSP(); cvt_phase<true>(lds, wave, lane, 0, 0, 0, INP(11), INP(24), INP(25), INP(26), INP(27), ws + wofs(0), (unsigned*)ws + CW_QC); }
        SEAM(0);
    }
    for (int lc = 0; lc < DEPTH; ++lc) {
        const int pb = 1 + PH_PER_LAYER * lc;
        if (IN(pb + 0)) { GEOM(); int l = lc; asm volatile("" : "+s"(l)); unsigned char* ws = WSP(); bf16* X = (bf16*)(ws + WS_X);
            const bool comb = TAIL_SPLIT && l > 0; if (comb) build_tail_map((LAS int*)lds, tid, G, DOWN_REV);
            const float* modl = (const float*)(ws + WS_MOD) + (size_t)l * NSEQ * 12288;
            if (l == 0) norm_mod_phase<true>(lane, gw, NGW, INP(0), INP(1), X, INP(7), modl, 0, 1, (bf16*)(ws + WS_H), false, (const LAS int*)lds, (const float*)(ws + WS_SLAB), false);
            else norm_mod_phase<false>(lane, gw, NGW, nullptr, nullptr, X, INP(7) + l * DM, modl, 0, 1, (bf16*)(ws + WS_H), comb, (const LAS int*)lds, (const float*)(ws + WS_SLAB), false);
            SEAM(pb + 0);
        }
        if (IN(pb + 1)) { unsigned char* ws = WSP(); const int G = gridDim.x, bx = blockIdx.x;
            pg8::Gemm g{(const bf16*)(ws + WS_H), (const bf16*)(ws + wofs(lc) + WS_WIN), MT, NPAD, DM, DM}; pg8::StaticOrder S; S.init(MT, NPAD, G, bx);
            pg8::EpiStore<0> E{(bf16*)(ws + WS_P), NPAD};
#ifndef REP_P1
#define REP_P1 1
#endif
#pragma unroll 1
            for (int rp = 0; rp < REP_P1; ++rp)
#ifndef WIN_B_AUX
#define WIN_B_AUX 0
#endif
#ifdef SPLIT_WIN
            { S.nlim = (S.nwg / (2 * G)) * G; pg8::gemm_phase<pg8::EpiStore<0>, pg8::StaticOrder, true, true, 0, WIN_B_AUX>(lds, g, S, E, tid_now(wave_s));
              { XcdBarrier b2_ = bar; b2_.bar = (unsigned*)WSP() + CW_BAR; asm volatile("" : "+s"(b2_.x)); xcd_barrier(b2_, tid_now(wave_s)); }
              S.off = S.nlim; S.nlim = S.nwg; }
#endif
            pg8::gemm_phase<pg8::EpiStore<0>, pg8::StaticOrder, true, true, 0, WIN_B_AUX>(lds, g, S, E, tid_now(wave_s));
            SEAM(pb + 1);
        }
        if (IN(pb + 2)) { GEOM(); int l = lc; asm volatile("" : "+s"(l)); unsigned char* ws = WSP(); float* out = OUTP();
#ifndef REP_P2
#define REP_P2 1
#endif
#pragma unroll 1
            for (int rp = 0; rp < REP_P2; ++rp)
            ssd_pre_phase(lane, gw, NGW, (const bf16*)(ws + WS_P), (bf16*)(ws + WS_XC), (float*)(ws + WS_DT), (float*)(ws + WS_DT + DT_ARR), (float*)(ws + WS_DT + 2 * DT_ARR),
                          INP(14) + (size_t)l * 4 * 1536, INP(15) + l * 1536, INP(16) + l * 16, INP(17) + l * 16, INP(4) + (size_t)l * 32 * 4608, out + OUT_CONV_P + (size_t)l * 16 * 4608, out + OUT_CONV_S + (size_t)l * 32 * 4608);
            SEAM(pb + 2);
        }
        if (IN(pb + 3)) { GEOM(); int l = lc; asm volatile("" : "+s"(l));
#ifndef MIX_REPS
#define MIX_REPS 1
#endif
#pragma unroll 1
            for (int rep = 0; rep < MIX_REPS; ++rep)
            for (;;) {
                unsigned char* ws = WSP(); float* out = OUTP(); bf16* Pb = (bf16*)(ws + WS_P); bf16* Y3 = (bf16*)(ws + WS_Y3);
                __syncthreads();
                if (tid_now(wave_s) == 0) MISC[0] = __hip_atomic_fetch_add((unsigned*)ws + CW_Q + 64 * (l + 4 * rep), 1u, __ATOMIC_RELAXED, __HIP_MEMORY_SCOPE_AGENT);
                __syncthreads();
                int it = (int)MISC[0];
#ifdef EXTRA_BASE
                if (it >= Q_NITEMS && it < Q_NITEMS + EXTRA_N) it = EXTRA_BASE + (it - Q_NITEMS);
#endif
                if (it >= Q_NITEMS) break;
#define ITEM_GEOM() int tid_i = tid_now(wave_s); asm volatile("" : "+v"(tid_i)); const int lane_i = tid_i & 63, wave_i = __builtin_amdgcn_readfirstlane(tid_i >> 6)
                if (it < 128) {
                    const int b = 15 - (it >> 3), h = it & 7;
                    ITEM_GEOM(); hgrn_mfma_item(lds, tid_i, lane_i, wave_i, Pb, Y3, b * 2048, h, l, out + OUT_HGRN_P + (((size_t)l * 16 + b) * 8 + h) * 16384, INP(12), INP(13) + l * 1024);
                } else if (it < 256) {
                    const int j = it - 128, b = 15 - (j >> 3), h0 = 2 * (j & 7);
                    ITEM_GEOM(); ssd_mfma_pair(lds, tid_i, lane_i, wave_i, Pb, (const bf16*)(ws + WS_XC), (const float*)(ws + WS_DT), (const float*)(ws + WS_DT + 2 * DT_ARR), Y3 + (size_t)MT * 1024, b * 2048, h0, INP(18)[l * 16 + h0], INP(18)[l * 16 + h0 + 1],
                                  out + OUT_SSM_P + (((size_t)l * 16 + b) * 16 + h0) * 8192);
                } else if (it < 512) {
                    ITEM_GEOM(); cmlp_mfma_item(lds, tid_i, lane_i, wave_i, Pb, Y3 + (size_t)2 * MT * 1024, (255 - (it - 256)) * 128, INP(20) + l * 1024, INP(21) + l * 1024, INP(22) + (size_t)l * 4 * 16384, INP(23) + l * 512);
                } else if (it < 768) {
                    const int j = it - 512, b = j >> 3, h = j & 7;
                    ITEM_GEOM(); hgrn_item(lds, tid_i, lane_i, wave_i, Pb, Y3, NTOK_P + b * 32, 32, h, l, INP(2) + (((size_t)l * 32 + b) * 8 + h) * 16384, out + OUT_HGRN_S + (((size_t)l * 32 + b) * 8 + h) * 16384, INP(12), INP(13) + l * 1024);
                } else if (it < 1280) {
                    const int j = it - 768, b = j >> 4, h = j & 15;
                    ITEM_GEOM(); ssd_item(lds, tid_i, lane_i, wave_i, Pb, (const bf16*)(ws + WS_XC), (const float*)(ws + WS_DT), (const float*)(ws + WS_DT + DT_ARR), Y3 + (size_t)MT * 1024, NTOK_P + b * 32, 32, h,
                             INP(3) + (((size_t)l * 32 + b) * 16 + h) * 8192, out + OUT_SSM_S + (((size_t)l * 32 + b) * 16 + h) * 8192, INP(18)[l * 16 + h]);
                } else {
                    const int j = it - 1280;
                    ITEM_GEOM(); cmlp_item(lds, tid_i, lane_i, wave_i, Pb, Y3 + (size_t)2 * MT * 1024, NTOK_P + j * 32, 32, INP(20) + l * 1024, INP(21) + l * 1024, INP(22) + (size_t)l * 4 * 16384, INP(23) + l * 512, out + OUT_V_S + ((size_t)l * 32 + j) * 32 * 1024);
                }
            }
            SEAM(pb + 3);
        }
        if (IN(pb + 4)) { GEOM(); int l = lc; asm volatile("" : "+s"(l)); ssd_norm_phase(lane, gw, NGW, (bf16*)(WSP() + WS_Y3) + (size_t)MT * 1024, INP(19) + l * 1024); SEAM(pb + 4); }
        if (IN(pb + 5)) { unsigned char* ws = WSP(); const int G = gridDim.x, bx = blockIdx.x;
            pg8::Gemm g{(const bf16*)(ws + WS_Y3), (const bf16*)(ws + wofs(lc) + WS_WBR), 3 * MT, 3 * DM, 1024, 1024}; pg8::BranchOrder S; S.init(MT / 256, DM / 256, G, bx);
            pg8::EpiBranch E{(const bf16*)(ws + WS_P), NPAD, OFF_GATE, (bf16*)(ws + WS_H), DM, MT / 256, DM / 256};
#ifndef STAGGER_BR
#define STAGGER_BR 0
#endif
            if (STAGGER_BR && ((bx >> 3) & 1)) { for (int i = 0; i < STAGGER_BR; ++i) __builtin_amdgcn_s_sleep(127); }
#ifndef REP_P5
#define REP_P5 1
#endif
#pragma unroll 1
            for (int rp = 0; rp < REP_P5; ++rp)
            pg8::gemm_phase<pg8::EpiBranch, pg8::BranchOrder, EPI_ALIGN_HEAVY, true>(lds, g, S, E, tid_now(wave_s));
            if (lc + 1 < DEPTH) {
                GEOM(); int l1 = lc + 1; asm volatile("" : "+s"(l1)); unsigned char* ws2 = WSP();
                cvt_phase<true>(lds, wave, lane, 0, 0, l1, INP(11), INP(24), INP(25), INP(26), INP(27), ws2 + wofs(l1), (unsigned*)ws2 + CW_QC + 64 * l1);
#ifdef REP_CVT
                cvt_phase<true>(lds, wave, lane, 0, 0, l1, INP(11), INP(24), INP(25), INP(26), INP(27), ws2 + wofs(l1), (unsigned*)ws2 + CW_QC + 64 * (l1 + 4));
#endif
            }
            SEAM(pb + 5);
        }
        if (IN(pb + 6)) { int l = lc; asm volatile("" : "+s"(l)); unsigned char* ws = WSP(); bf16* X = (bf16*)(ws + WS_X); const int G = gridDim.x, bx = blockIdx.x;
            pg8::StaticOrder S; S.init(MT, DM, G, bx); S.wgm = WGM_N8; const int nfull = TAIL_SPLIT ? tail_nfull(S.nwg, G) : S.nwg; S.nlim = nfull;
            const float* gm = (const float*)(ws + WS_MOD) + (size_t)l * NSEQ * 12288 + 2 * DM;
            { pg8::Gemm g{(const bf16*)(ws + WS_H), (const bf16*)(ws + wofs(lc) + WS_WOUT), MT, DM, DM, DM};
#ifdef REP_P6
              { pg8::EpiRes E0{X, (const float*)(ws + 524288), 0}; pg8::gemm_phase<pg8::EpiRes, pg8::StaticOrder, EPI_ALIGN_HEAVY, true>(lds, g, S, E0, tid_now(wave_s)); }
#endif
              pg8::EpiRes E{X, gm, 12288};
              pg8::gemm_phase<pg8::EpiRes, pg8::StaticOrder, EPI_ALIGN_HEAVY, true>(lds, g, S, E, tid_now(wave_s)); }
            if (TAIL_SPLIT) { pg8::Gemm g{(const bf16*)(ws + WS_H), (const bf16*)(ws + wofs(lc) + WS_WOUT), MT, DM, DM / 8, DM}; pg8::TailOrder T; T.init(S, nfull, 8, DM / 8);
              pg8::EpiSlab E{(float*)(ws + WS_SLAB), gm};
              pg8::gemm_phase<pg8::EpiSlab, pg8::TailOrder, true, true>(lds, g, T, E, tid_now(wave_s)); }
            SEAM(pb + 6);
        }
        if (IN(pb + 7)) { GEOM(); int l = lc; asm volatile("" : "+s"(l)); unsigned char* ws = WSP(); bf16* X = (bf16*)(ws + WS_X);
            if (TAIL_SPLIT) build_tail_map((LAS int*)lds, tid, G, 0);
#ifdef REP_N7
            norm_mod_phase<false>(lane, gw, NGW, nullptr, nullptr, X, INP(8) + l * DM, (const float*)(ws + WS_MOD) + (size_t)l * NSEQ * 12288, 3, 4, (bf16*)(ws + WS_H), false, (const LAS int*)lds, (const float*)(ws + WS_SLAB), true);
#endif
            norm_mod_phase<false>(lane, gw, NGW, nullptr, nullptr, X, INP(8) + l * DM, (const float*)(ws + WS_MOD) + (size_t)l * NSEQ * 12288, 3, 4, (bf16*)(ws + WS_H), TAIL_SPLIT != 0, (const LAS int*)lds, (const float*)(ws + WS_SLAB), true); SEAM(pb + 7); }
        if (IN(pb + 8)) { unsigned char* ws = WSP(); const int G = gridDim.x, bx = blockIdx.x;
            pg8::Gemm g{(const bf16*)(ws + WS_H), (const bf16*)(ws + wofs(lc) + WS_WUP), MT, DFF, DM, DM}; pg8::StaticOrder S; S.init(MT, DFF, G, bx);
            pg8::EpiStore<1> E{(bf16*)(ws + WS_P), DFF};
#ifndef REP_P8
#define REP_P8 1
#endif
#pragma unroll 1
            for (int rp = 0; rp < REP_P8; ++rp)
            pg8::gemm_phase<pg8::EpiStore<1>, pg8::StaticOrder, true, true, 0, WIN_B_AUX>(lds, g, S, E, tid_now(wave_s));
            SEAM(pb + 8);
        }
        if (IN(pb + 9)) { int l = lc; asm volatile("" : "+s"(l)); unsigned char* ws = WSP(); bf16* X = (bf16*)(ws + WS_X); const int G = gridDim.x, bx = blockIdx.x;
            pg8::StaticOrder S; S.init(MT, DM, G, bx); S.wgm = WGM_N8; S.rev = DOWN_REV; const int nfull = TAIL_SPLIT ? tail_nfull(S.nwg, G) : S.nwg; S.nlim = nfull;
            const float* gm = (const float*)(ws + WS_MOD) + (size_t)l * NSEQ * 12288 + 5 * DM;
            { pg8::Gemm g{(const bf16*)(ws + WS_P), (const bf16*)(ws + wofs(lc) + WS_WDN), MT, DM, DFF, DFF};
#ifdef REP_P9
              { pg8::EpiRes E0{X, (const float*)(ws + 524288), 0}; pg8::gemm_phase<pg8::EpiRes, pg8::StaticOrder, EPI_ALIGN_HEAVY, true>(lds, g, S, E0, tid_now(wave_s)); }
#endif
              pg8::EpiRes E{X, gm, 12288};
#ifndef DOWN_A_AUX
#define DOWN_A_AUX 0
#endif
              pg8::gemm_phase<pg8::EpiRes, pg8::StaticOrder, EPI_ALIGN_HEAVY, true, DOWN_A_AUX>(lds, g, S, E, tid_now(wave_s)); }
            if (TAIL_SPLIT) { pg8::Gemm g{(const bf16*)(ws + WS_P), (const bf16*)(ws + wofs(lc) + WS_WDN), MT, DM, DFF / 8, DFF}; pg8::TailOrder T; T.init(S, nfull, 8, DFF / 8);
              pg8::EpiSlab E{(float*)(ws + WS_SLAB), gm};
              pg8::gemm_phase<pg8::EpiSlab, pg8::TailOrder, true, true>(lds, g, T, E, tid_now(wave_s)); }
            SEAM(pb + 9);
        }
    }
    if (IN(N_PHASES - 1)) { GEOM(); unsigned char* ws = WSP(); if (TAIL_SPLIT) build_tail_map((LAS int*)lds, tid, G, DOWN_REV);
        final_norm_phase(lane, gw, NGW, (const bf16*)(ws + WS_X), OUTP(), INP(28), TAIL_SPLIT != 0, (const LAS int*)lds, (const float*)(ws + WS_SLAB)); }
#undef IN
#undef SEAM
#undef GEOM
}

extern "C" void kernel_launch(void* const* d_in, const int* in_sizes, int n_in, void* d_out, int out_size, void* d_ws, size_t ws_size, hipStream_t stream) {
    static int grid = 0;
    if (grid == 0) {
        if (n_in != 29 || (size_t)out_size != OUT_TOTAL || ws_size < WS_END) { fprintf(stderr, "kernel_launch: unexpected shapes: n_in %d out %d ws %zu (need %zu)\n", n_in, out_size, ws_size, (size_t)WS_END); grid = -1; return; }
        int dev = 0, cus = 0, per_cu = 0;
        if (hipGetDevice(&dev) != hipSuccess || hipDeviceGetAttribute(&cus, hipDeviceAttributeMultiprocessorCount, dev) != hipSuccess) { grid = -1; return; }
        if (hipFuncSetAttribute((const void*)fwd, hipFuncAttributeMaxDynamicSharedMemorySize, LDS_BYTES) != hipSuccess) { fprintf(stderr, "kernel_launch: hipFuncSetAttribute failed\n"); grid = -1; return; }
        if (hipOccupancyMaxActiveBlocksPerMultiprocessor(&per_cu, (const void*)fwd, NWAVES * 64, LDS_BYTES) != hipSuccess || per_cu < 1) fprintf(stderr, "kernel_launch: occupancy query says %d\n", per_cu);
        (void)hipGetLastError();
        grid = cus;
    }
    if (grid < 0) return;
    if (hipMemsetAsync((char*)d_ws + WS_CTL, 0, CTL_ZERO_BYTES, stream) != hipSuccess) return;
    Args a{};
    for (int i = 0; i < 29; ++i) a.in[i] = (const float*)d_in[i];
    a.out = (float*)d_out; a.ws = (unsigned char*)d_ws;
#if MK_N_LAUNCHES == 1
    a.ph_lo = 0; a.ph_hi = N_PHASES;
    hipLaunchKernelGGL(fwd, dim3(grid), dim3(NWAVES * 64), LDS_BYTES, stream, a);
#else
    for (int p = 0; p < N_PHASES; ++p) { a.ph_lo = p; a.ph_hi = p + 1; hipLaunchKernelGGL(fwd, dim3(grid), dim3(NWAVES * 64), LDS_BYTES, stream, a); }
#endif
}
```

```cpp
#include <hip/hip_runtime.h>
#include <cstdio>
#include <cstdint>
namespace pg8 {
#define PG8_LAS __attribute__((address_space(3)))
typedef unsigned short bf16_t;
typedef short bf16x8 __attribute__((ext_vector_type(8)));
typedef float f32x4 __attribute__((ext_vector_type(4)));
typedef unsigned u32x4 __attribute__((ext_vector_type(4)));
constexpr int BM = 256, BK = 64, HALF = 128, HTB = HALF * BK * 2  , STAGE_BYTES = 8 * HTB, NXCD = 8, WGM = 4;

__host__ __device__ __forceinline__ int lds_byte(int r, int c) { const int st = (r >> 4) * 2 + (c >> 5), rr = r & 15, cc = c & 31, ob = rr * 64 + cc * 2; return st * 1024 + (ob ^ (((ob >> 9) & 1) << 5)); }
__host__ __device__ __forceinline__ void stage_rc(int b, int& R, int& C) { const int st = b / 1024, sb = b % 1024, swz = sb ^ (((sb >> 9) & 1) << 5); R = (st >> 1) * 16 + swz / 64; C = (st & 1) * 32 + (swz % 64) / 2; }
__host__ __device__ __forceinline__ int perm32(int rho) { const int n = rho >> 4, i = rho & 15; return 8 * (i >> 2) + 4 * n + (i & 3); }

struct Unit { int pm, pn, ko, aux; };
struct Gemm { const bf16_t* A; const bf16_t* Bt; int M, N, K, ld; };

struct StaticOrder {
    int nM, nN, nwg, G, c, nlim, rev, wgm, off;
    __host__ __device__ void init(int M, int N, int G_, int c_) { nM = M / BM; nN = N / BM; nwg = nM * nN; G = G_; c = c_; nlim = nwg; rev = 0; wgm = WGM; off = 0; }
    __host__ __device__ void tile_of(int wgid, Unit& u) const {
        { const int q = nwg / NXCD, r = nwg % NXCD, xcd = wgid % NXCD, off = wgid / NXCD; wgid = (xcd < r ? xcd * (q + 1) : r * (q + 1) + (xcd - r) * q) + off; }
        const int nig = wgm * nN, gid = wgid / nig, fm = gid * wgm, gsz = (nM - fm) < wgm ? (nM - fm) : wgm;
        u.pm = fm + ((wgid % nig) % gsz); u.pn = (wgid % nig) / gsz; u.ko = 0; u.aux = 0; if (rev) u.pm = nM - 1 - u.pm; }
    __host__ __device__ bool next(int i, Unit& u) const {
        const long L = (long)i * G + c + off; if (L >= nlim) return false;
        tile_of((int)L, u); return true;
    }
    __device__ __forceinline__ void a_ready(const Unit&) const {}
    __device__ __forceinline__ void done(const Unit&) const {}
};
typedef float pg8_f32x2 __attribute__((ext_vector_type(2))); typedef __bf16 pg8_bf16x2 __attribute__((ext_vector_type(2)));
__device__ __forceinline__ unsigned cvt_pk_bf16(float lo, float hi) { const pg8_f32x2 v = {lo, hi}; const pg8_bf16x2 b = __builtin_convertvector(v, pg8_bf16x2); return __builtin_bit_cast(unsigned, b); }
typedef unsigned u32x2 __attribute__((ext_vector_type(2)));
__device__ __forceinline__ float bf_lo(unsigned w) { return __uint_as_float(w << 16); }
__device__ __forceinline__ float bf_hi(unsigned w) { return __uint_as_float(w & 0xffff0000u); }
__device__ __forceinline__ float fast_sigmoid(float x) { return __builtin_amdgcn_rcpf(1.0f + __builtin_amdgcn_exp2f(-1.44269504089f * x)); }

#ifndef EPI_NT_STORE
#define EPI_NT_STORE 0
#endif
template <int ACT> struct EpiStore {
    static constexpr bool PERM = true, AFTER_DRAIN = false;
    bf16_t* O; int ldc;
    __device__ __forceinline__ void operator()(const f32x4 (&acc)[2][2][4][2], const Unit& u, int wr, int wc, int fr, int fq) const {
        const int row0 = u.pm * BM + wr * 64 + fr, col0 = u.pn * BM + wc * 32 + 8 * fq;
#pragma unroll
        for (int ai = 0; ai < 2; ++ai)
#pragma unroll
            for (int m = 0; m < 4; ++m) { bf16_t* rowp = O + (size_t)(row0 + ai * HALF + m * 16) * ldc + col0;
#pragma unroll
                for (int bj = 0; bj < 2; ++bj) { f32x4 v0 = acc[ai][bj][m][0], v1 = acc[ai][bj][m][1];
                    if (ACT == 1) {
#pragma unroll
                        for (int j = 0; j < 4; ++j) { const float a = fmaxf(v0[j], 0.f), b = fmaxf(v1[j], 0.f); v0[j] = a * a; v1[j] = b * b; } }
                    u32x4 w; w.x = cvt_pk_bf16(v0[0], v0[1]); w.y = cvt_pk_bf16(v0[2], v0[3]); w.z = cvt_pk_bf16(v1[0], v1[1]); w.w = cvt_pk_bf16(v1[2], v1[3]);
                    if (EPI_NT_STORE) __builtin_nontemporal_store(w, (u32x4*)(rowp + bj * HALF)); else *(u32x4*)(rowp + bj * HALF) = w; } }
    }
};

struct EpiBranch {
    static constexpr bool PERM = true, AFTER_DRAIN = false;
    const bf16_t* P; int ldp; int gate_off; bf16_t* MG; int ldm; int npm, npn;
    __device__ __forceinline__ void operator()(const f32x4 (&acc)[2][2][4][2], const Unit& u, int wr, int wc, int fr, int fq) const {
        const int k = u.pm / npm, pm = u.pm - k * npm, pn = u.pn - k * npn;
        const int row0 = pm * BM + wr * 64 + fr, col0 = pn * BM + wc * 32 + 8 * fq;
#pragma unroll
        for (int ai = 0; ai < 2; ++ai)
#pragma unroll
            for (int m = 0; m < 4; ++m) { const size_t r = (size_t)(row0 + ai * HALF + m * 16);
                const bf16_t* gp = P + r * ldp + gate_off + k * 2048 + col0; bf16_t* mp = MG + r * ldm + col0;
#pragma unroll
                for (int bj = 0; bj < 2; ++bj) { const u32x4 g = *(const u32x4*)(gp + bj * HALF);
                    f32x4 v0 = acc[ai][bj][m][0], v1 = acc[ai][bj][m][1];
                    v0[0] *= fast_sigmoid(bf_lo(g.x)); v0[1] *= fast_sigmoid(bf_hi(g.x)); v0[2] *= fast_sigmoid(bf_lo(g.y)); v0[3] *= fast_sigmoid(bf_hi(g.y));
                    v1[0] *= fast_sigmoid(bf_lo(g.z)); v1[1] *= fast_sigmoid(bf_hi(g.z)); v1[2] *= fast_sigmoid(bf_lo(g.w)); v1[3] *= fast_sigmoid(bf_hi(g.w));
                    if (k > 0) { const u32x4 p = *(const u32x4*)(mp + bj * HALF);
                        v0[0] += bf_lo(p.x); v0[1] += bf_hi(p.x); v0[2] += bf_lo(p.y); v0[3] += bf_hi(p.y);
                        v1[0] += bf_lo(p.z); v1[1] += bf_hi(p.z); v1[2] += bf_lo(p.w); v1[3] += bf_hi(p.w); }
                    u32x4 w; w.x = cvt_pk_bf16(v0[0], v0[1]); w.y = cvt_pk_bf16(v0[2], v0[3]); w.z = cvt_pk_bf16(v1[0], v1[1]); w.w = cvt_pk_bf16(v1[2], v1[3]);
                    *(u32x4*)(mp + bj * HALF) = w; }
                if (m == 3) asm volatile("" ::: "memory"); }
    }
};

struct EpiRes {
    static constexpr bool PERM = true, AFTER_DRAIN = false;
    bf16_t* X; const float* gmod; int gstride;
    __device__ __forceinline__ void operator()(const f32x4 (&acc)[2][2][4][2], const Unit& u, int wr, int wc, int fr, int fq) const {
        const int row0 = u.pm * BM + wr * 64 + fr, col0 = u.pn * BM + wc * 32 + 8 * fq;
#pragma unroll
        for (int ai = 0; ai < 2; ++ai)
#pragma unroll
            for (int m = 0; m < 4; ++m) { const int r = row0 + ai * HALF + m * 16;
                const int seq = r < 32768 ? (r >> 11) : 16 + ((r - 32768) >> 5);
                const float* gp = gmod + (size_t)seq * gstride + col0; bf16_t* xp = X + (size_t)r * 2048 + col0;
#pragma unroll
                for (int bj = 0; bj < 2; ++bj) { const f32x4 g0 = *(const f32x4*)(gp + bj * HALF), g1 = *(const f32x4*)(gp + bj * HALF + 4); const u32x4 b = *(const u32x4*)(xp + bj * HALF);
                    const f32x4 v0 = acc[ai][bj][m][0] * g0, v1 = acc[ai][bj][m][1] * g1;
                    u32x4 w; w.x = cvt_pk_bf16(bf_lo(b.x) + v0[0], bf_hi(b.x) + v0[1]); w.y = cvt_pk_bf16(bf_lo(b.y) + v0[2], bf_hi(b.y) + v0[3]);
                    w.z = cvt_pk_bf16(bf_lo(b.z) + v1[0], bf_hi(b.z) + v1[1]); w.w = cvt_pk_bf16(bf_lo(b.w) + v1[2], bf_hi(b.w) + v1[3]);
                    *(u32x4*)(xp + bj * HALF) = w; }
                if (m == 3) asm volatile("" ::: "memory"); }
    }
};

struct BranchOrder {
    int G, c, npm, npn, ntile;
    __device__ void init(int npm_, int npn_, int G_, int c_) { npm = npm_; npn = npn_; ntile = npm_ * npn_; G = G_; c = c_; }
    __device__ bool next(int i, Unit& u) const {
        const int ti = i / 3, k = i - 3 * ti; const long L = (long)ti * G + c; if (L >= ntile) return false;
        int wgid = (int)L; { const int q = ntile / NXCD, r = ntile % NXCD, xcd = wgid % NXCD, off = wgid / NXCD; wgid = (xcd < r ? xcd * (q + 1) : r * (q + 1) + (xcd - r) * q) + off; }
        const int nig = WGM * npn, gid = wgid / nig, fm = gid * WGM, gsz = (npm - fm) < WGM ? (npm - fm) : WGM;
        u.pm = k * npm + fm + ((wgid % nig) % gsz); u.pn = k * npn + (wgid % nig) / gsz; u.ko = 0; u.aux = 0; return true;
    }
    __device__ __forceinline__ void a_ready(const Unit&) const {}
    __device__ __forceinline__ void done(const Unit&) const {}
};


struct EpiResAtomic {
    static constexpr bool PERM = false, AFTER_DRAIN = false;
    float* out; const float* gmod;
    __device__ __forceinline__ void operator()(const f32x4 (&acc)[2][2][4][2], const Unit& u, int wr, int wc, int fr, int fq) const {
        const int row0 = u.pm * BM + wr * 64 + fr, col0 = u.pn * BM + wc * 32 + 4 * fq;
#pragma unroll
        for (int ai = 0; ai < 2; ++ai)
#pragma unroll
            for (int m = 0; m < 4; ++m) { const int r = row0 + ai * HALF + m * 16;
                const int seq = r < 32768 ? (r >> 11) : 16 + ((r - 32768) >> 5);
                const float* gp = gmod + (size_t)seq * 12288 + col0; float* op = out + (size_t)r * 2048 + col0;
#pragma unroll
                for (int bj = 0; bj < 2; ++bj)
#pragma unroll
                    for (int n = 0; n < 2; ++n) { const f32x4 g = *(const f32x4*)(gp + bj * HALF + n * 16); const f32x4 v = g * acc[ai][bj][m][n]; float* o = op + bj * HALF + n * 16;
                        typedef __attribute__((address_space(1))) float gfloat; gfloat* og = (gfloat*)o;
                        (void)__builtin_amdgcn_global_atomic_fadd_f32(og + 0, v.x); (void)__builtin_amdgcn_global_atomic_fadd_f32(og + 1, v.y); (void)__builtin_amdgcn_global_atomic_fadd_f32(og + 2, v.z); (void)__builtin_amdgcn_global_atomic_fadd_f32(og + 3, v.w); } }
    }
};
struct TailOrder {
    StaticOrder base; int nfull, SL, Ks;
    __device__ void init(const StaticOrder& b, int nfull_, int SL_, int Ks_) { base = b; nfull = nfull_; SL = SL_; Ks = Ks_; }
    __device__ bool next(int i, Unit& u) const { const long L = (long)i * base.G + base.c; if (L >= (long)(base.nwg - nfull) * SL) return false;
        const int t = (int)L / SL, sl = (int)L - t * SL; base.tile_of(nfull + t, u); u.ko = sl * Ks; u.aux = (int)L; return true; }
    __device__ __forceinline__ void a_ready(const Unit&) const {}
    __device__ __forceinline__ void done(const Unit&) const {}
};

struct EpiSlab {
    static constexpr bool PERM = false, AFTER_DRAIN = false;
    float* slab; const float* gmod;
    __device__ __forceinline__ void operator()(const f32x4 (&acc)[2][2][4][2], const Unit& u, int wr, int wc, int fr, int fq) const {
        const int rt0 = wr * 64 + fr, ct0 = wc * 32 + 4 * fq; float* sb = slab + (size_t)u.aux * 65536;
#pragma unroll
        for (int ai = 0; ai < 2; ++ai)
#pragma unroll
            for (int m = 0; m < 4; ++m) { const int rt = rt0 + ai * HALF + m * 16, r = u.pm * BM + rt;
                const int seq = r < 32768 ? (r >> 11) : 16 + ((r - 32768) >> 5);
                const float* gp = gmod + (size_t)seq * 12288 + u.pn * BM + ct0; float* op = sb + rt * 256 + ct0;
#pragma unroll
                for (int bj = 0; bj < 2; ++bj)
#pragma unroll
                    for (int n = 0; n < 2; ++n) { const f32x4 g = *(const f32x4*)(gp + bj * HALF + n * 16); *(f32x4*)(op + bj * HALF + n * 16) = g * acc[ai][bj][m][n]; } }
    }
};
template <class Epi, class Sched, bool ALIGN_EPI = false, bool SP2 = false, int A_AUX = 0, int B_AUX = 0>
__device__ __forceinline__ void gemm_phase(PG8_LAS unsigned char* lds, const Gemm g, const Sched& S, const Epi& E, int tid_in) {
    int tid_ = tid_in; asm volatile("" : "+v"(tid_));
    const int tid = tid_, wid = __builtin_amdgcn_readfirstlane(tid >> 6), lane = tid & 63, wr = wid >> 2, wc = wid & 3, fr = lane & 15, fq = lane >> 4;
    const int K = g.K, ld = g.ld, nt = K / BK;
    unsigned voffA[2], voffB[2];
#pragma unroll
    for (int i = 0; i < 2; ++i) { int R, C; stage_rc(tid * 16 + i * 8192, R, C); const int Rb = Epi::PERM ? ((R & ~31) + perm32(R & 31)) : R;
        voffA[i] = (unsigned)(R * ld + C) * 2u; voffB[i] = (unsigned)(Rb * ld + C) * 2u; }
    const size_t kstep = (size_t)(BK * 2);
    const size_t hstep = (size_t)HALF * ld * 2;
    const size_t tstep = 2 * hstep;
    const unsigned ldsw = (unsigned)wid * 1024u;
    const int aoff = lds_byte(wr * 64 + fr, fq * 8), boff = lds_byte(wc * 32 + fr, fq * 8);
#define PG8_SA(b, h) (((b) * 2 + (h)) * HTB)
#define PG8_SB(b, h) ((4 + (b) * 2 + (h)) * HTB)
#define PG8_STAGE(bufoff, gbase, voff) do { _Pragma("unroll") for (int _i = 0; _i < 2; ++_i) \
        __builtin_amdgcn_global_load_lds((const unsigned*)((const char*)(gbase) + (voff)[_i]), (PG8_LAS unsigned*)(lds + (bufoff) + ldsw + _i * 8192), 16, 0, B_AUX); } while (0)
#define PG8_STAGEA(bufoff, gbase, voff) do { _Pragma("unroll") for (int _i = 0; _i < 2; ++_i) \
        __builtin_amdgcn_global_load_lds((const unsigned*)((const char*)(gbase) + (voff)[_i]), (PG8_LAS unsigned*)(lds + (bufoff) + ldsw + _i * 8192), 16, 0, A_AUX); } while (0)
#define PG8_LDA(dst, b, h) do { _Pragma("unroll") for (int m = 0; m < 4; ++m) _Pragma("unroll") for (int k = 0; k < 2; ++k) dst[m][k] = *(const PG8_LAS bf16x8*)(lds + PG8_SA(b, h) + aoff + m * 2048 + k * 1024); } while (0)
#define PG8_LDB(dst, b, h) do { _Pragma("unroll") for (int n = 0; n < 2; ++n) _Pragma("unroll") for (int k = 0; k < 2; ++k) dst[n][k] = *(const PG8_LAS bf16x8*)(lds + PG8_SB(b, h) + boff + n * 2048 + k * 1024); } while (0)
#define PG8_MMA(ai, bj, At, Bt) do { __builtin_amdgcn_s_setprio(1); _Pragma("unroll") for (int m = 0; m < 4; ++m) _Pragma("unroll") for (int n = 0; n < 2; ++n) _Pragma("unroll") for (int k = 0; k < 2; ++k) \
        acc[ai][bj][m][n] = __builtin_amdgcn_mfma_f32_16x16x32_bf16(Bt[n][k], At[m][k], acc[ai][bj][m][n], 0, 0, 0); __builtin_amdgcn_s_setprio(0); } while (0)
#define PG8_WAIT_V(n) asm volatile("s_waitcnt vmcnt(" #n ")" ::: "memory")
#define PG8_WAIT_L(n) asm volatile("s_waitcnt lgkmcnt(" #n ")" ::: "memory")
#define PG8_BAR __builtin_amdgcn_s_barrier()
#define PG8_SCHED __builtin_amdgcn_sched_barrier(0)
    Unit cur, nxt; int ui = 0;
    if (!S.next(0, cur)) return;
    f32x4 acc[2][2][4][2];
#pragma unroll
    for (int a = 0; a < 2; ++a)
#pragma unroll
        for (int b = 0; b < 2; ++b)
#pragma unroll
            for (int m = 0; m < 4; ++m)
#pragma unroll
                for (int n = 0; n < 2; ++n) acc[a][b][m][n] = (f32x4){0.f, 0.f, 0.f, 0.f};
    bf16x8 At[4][2], B0[2][2], B1[2][2];
    const char* cA = (const char*)g.A + (size_t)cur.pm * tstep + (size_t)cur.ko * 2; const char* cB = (const char*)g.Bt + (size_t)cur.pn * tstep + (size_t)cur.ko * 2;
    S.a_ready(cur);
    if constexpr (SP2) {
        PG8_STAGE(PG8_SB(0, 0), cB, voffB); PG8_STAGE(PG8_SB(0, 1), cB + hstep, voffB); PG8_STAGEA(PG8_SA(0, 0), cA, voffA); PG8_STAGEA(PG8_SA(0, 1), cA + hstep, voffA);
        if (wr == 1) PG8_BAR;
        PG8_WAIT_V(2); PG8_BAR;
        PG8_STAGE(PG8_SB(1, 0), cB + kstep, voffB); PG8_STAGEA(PG8_SA(1, 0), cA + kstep, voffA); PG8_STAGE(PG8_SB(1, 1), cB + hstep + kstep, voffB);
        PG8_WAIT_V(6); PG8_BAR;
    } else {
        PG8_STAGE(PG8_SB(0, 0), cB, voffB); PG8_STAGEA(PG8_SA(0, 0), cA, voffA); PG8_STAGE(PG8_SB(0, 1), cB + hstep, voffB); PG8_STAGEA(PG8_SA(0, 1), cA + hstep, voffA);
        if (wr == 1) PG8_BAR;
        PG8_WAIT_V(4); PG8_BAR;
        PG8_STAGE(PG8_SB(1, 0), cB + kstep, voffB); PG8_STAGEA(PG8_SA(1, 0), cA + kstep, voffA); PG8_STAGE(PG8_SB(1, 1), cB + hstep + kstep, voffB);
        PG8_WAIT_V(6); PG8_BAR;
    }
    for (;;) {
        const bool has_next = S.next(ui + 1, nxt);
        const char* nA = has_next ? (const char*)g.A + (size_t)nxt.pm * tstep + (size_t)nxt.ko * 2 : cA; const char* nB = has_next ? (const char*)g.Bt + (size_t)nxt.pn * tstep + (size_t)nxt.ko * 2 : cB;
        for (int t = 0; t < nt; t += 2) {
            const bool last = (t == nt - 2);
            const char* a1 = cA + (size_t)(t + 1) * kstep;
            const char* a2 = last ? nA : cA + (size_t)(t + 2) * kstep; const char* b2 = last ? nB : cB + (size_t)(t + 2) * kstep;
            const char* a3 = a2 + kstep; const char* b3 = b2 + kstep;
            if (last && has_next) S.a_ready(nxt);
            if constexpr (SP2) {
            PG8_LDB(B0, 0, 0); PG8_LDB(B1, 0, 1); PG8_SCHED; PG8_LDA(At, 0, 0); PG8_STAGEA(PG8_SA(1, 1), a1 + hstep, voffA);
            PG8_WAIT_V(8); PG8_WAIT_L(0); PG8_BAR; PG8_MMA(0, 0, At, B0); PG8_MMA(0, 1, At, B1); PG8_BAR; PG8_SCHED;
            PG8_LDA(At, 0, 1); PG8_STAGE(PG8_SB(0, 0), b2, voffB); PG8_STAGE(PG8_SB(0, 1), b2 + hstep, voffB); PG8_STAGEA(PG8_SA(0, 0), a2, voffA);
            PG8_WAIT_V(8); PG8_WAIT_L(0); PG8_BAR; PG8_MMA(1, 0, At, B0); PG8_MMA(1, 1, At, B1); PG8_BAR; PG8_SCHED;
            PG8_LDB(B0, 1, 0); PG8_LDB(B1, 1, 1); PG8_SCHED; PG8_LDA(At, 1, 0); PG8_STAGEA(PG8_SA(0, 1), a2 + hstep, voffA);
            PG8_WAIT_V(8); PG8_WAIT_L(0); PG8_BAR; PG8_MMA(0, 0, At, B0); PG8_MMA(0, 1, At, B1); PG8_BAR; PG8_SCHED;
            PG8_LDA(At, 1, 1); PG8_STAGE(PG8_SB(1, 0), b3, voffB); PG8_STAGE(PG8_SB(1, 1), b3 + hstep, voffB); PG8_STAGEA(PG8_SA(1, 0), a3, voffA);
            PG8_WAIT_V(8); PG8_WAIT_L(0); PG8_BAR; PG8_MMA(1, 0, At, B0); PG8_MMA(1, 1, At, B1); PG8_BAR; PG8_SCHED;
            } else {
            PG8_LDB(B0, 0, 0); PG8_SCHED; PG8_LDA(At, 0, 0); PG8_STAGEA(PG8_SA(1, 1), a1 + hstep, voffA);
            PG8_WAIT_L(8); PG8_BAR; PG8_WAIT_L(0); PG8_MMA(0, 0, At, B0); PG8_BAR; PG8_SCHED;
            PG8_LDB(B1, 0, 1); PG8_STAGE(PG8_SB(0, 0), b2, voffB);
            PG8_BAR; PG8_WAIT_L(0); PG8_MMA(0, 1, At, B1); PG8_BAR;
            PG8_LDA(At, 0, 1); PG8_STAGEA(PG8_SA(0, 0), a2, voffA);
            PG8_BAR; PG8_WAIT_L(0); PG8_MMA(1, 0, At, B0); PG8_BAR; PG8_SCHED;
            PG8_STAGE(PG8_SB(0, 1), b2 + hstep, voffB);
            PG8_WAIT_V(6); PG8_BAR; PG8_MMA(1, 1, At, B1); PG8_BAR;
            PG8_LDB(B0, 1, 0); PG8_SCHED; PG8_LDA(At, 1, 0); PG8_STAGEA(PG8_SA(0, 1), a2 + hstep, voffA);
            PG8_WAIT_L(8); PG8_BAR; PG8_WAIT_L(0); PG8_MMA(0, 0, At, B0); PG8_BAR; PG8_SCHED;
            PG8_LDB(B1, 1, 1); PG8_STAGE(PG8_SB(1, 0), b3, voffB);
            PG8_BAR; PG8_WAIT_L(0); PG8_MMA(0, 1, At, B1); PG8_BAR;
            PG8_LDA(At, 1, 1); PG8_STAGEA(PG8_SA(1, 0), a3, voffA);
            PG8_BAR; PG8_WAIT_L(0); PG8_MMA(1, 0, At, B0); PG8_BAR; PG8_SCHED;
            PG8_STAGE(PG8_SB(1, 1), b3 + hstep, voffB);
            PG8_WAIT_V(6); PG8_BAR; PG8_MMA(1, 1, At, B1); PG8_BAR;
            }
        }
        if constexpr (ALIGN_EPI) { if (wr == 0) PG8_BAR; }
        if constexpr (!Epi::AFTER_DRAIN) { E(acc, cur, wr, wc, fr, fq); S.done(cur); }
        if (!has_next) break;
#pragma unroll
        for (int a = 0; a < 2; ++a)
#pragma unroll
            for (int b = 0; b < 2; ++b)
#pragma unroll
                for (int m = 0; m < 4; ++m)
#pragma unroll
                    for (int n = 0; n < 2; ++n) acc[a][b][m][n] = (f32x4){0.f, 0.f, 0.f, 0.f};
        cur = nxt; cA = nA; cB = nB; ++ui;
        if constexpr (ALIGN_EPI) { if (wr == 1) PG8_BAR; }
    }
    PG8_WAIT_V(0);
    if constexpr (!ALIGN_EPI) { if (wr == 0) PG8_BAR; }
    PG8_BAR;
    if constexpr (Epi::AFTER_DRAIN) { E.fused(acc, cur, wr, wc, fr, fq, lds, wid, lane); S.done(cur); }
#undef PG8_SA
#undef PG8_SB
#undef PG8_STAGE
#undef PG8_STAGEA
#undef PG8_LDA
#undef PG8_LDB
#undef PG8_MMA
#undef PG8_WAIT_V
#undef PG8_WAIT_L
#undef PG8_BAR
#undef PG8_SCHED
}
}

constexpr int NWAVES = 8;
constexpr int DM = 2048, NTOK_P = 32768, NTOK_S = 1024, MT = NTOK_P + NTOK_S  , NSEQ = 48, DEPTH = 4, DFF = 8192;
constexpr int IN_TOTAL = 14864, NPAD = 15104;
constexpr int OFF_AQ = 0, OFF_AF = 1024, OFF_AI = 2048, OFF_AG = 3072, OFF_BZ = 4096, OFF_XBC = 5120, OFF_CU = 6656, OFF_CV = 7680, OFF_GATE = 8704, OFF_DT = 14848;
constexpr float NORM_EPS = 1e-6f;
constexpr size_t OUT_X = 0, OUT_HGRN_P = 69206016, OUT_SSM_P = 77594624, OUT_CONV_P = 85983232, OUT_HGRN_S = 86278144, OUT_SSM_S = 103055360, OUT_CONV_S = 119832576, OUT_V_S = 120422400, OUT_TOTAL = 124616704;
constexpr size_t MiB = 1u << 20;
constexpr size_t WS_CTL = 0, CTL_ZERO_BYTES = 1 * MiB;
constexpr size_t WS_MOD = 1 * MiB;
constexpr size_t WS_WIN = 16 * MiB;
constexpr size_t WS_WBR = 76 * MiB;
constexpr size_t WS_WOUT = 88 * MiB;
constexpr size_t WS_WUP = 96 * MiB;
constexpr size_t WS_WDN = 128 * MiB;
constexpr size_t WS_H = 160 * MiB;
constexpr size_t WS_Y3 = 292 * MiB;
constexpr size_t WS_P = 490 * MiB;
constexpr size_t WS_XC = 1464 * MiB;
constexpr size_t WS_DT = 1564 * MiB;
constexpr size_t DT_ARR = (size_t)MT * 16 * 4;
constexpr size_t WS_WSET2 = 1576 * MiB;
constexpr size_t WSET_BYTES = WS_H - WS_WIN;
constexpr size_t WS_SLAB = WS_Y3;
constexpr size_t WS_X = WS_WSET2 + WSET_BYTES;
constexpr size_t WS_END = WS_X + (size_t)MT * DM * 2;
static_assert((size_t)32 * 8 * 65536 * 4 <= (size_t)3 * MT * 1024 * 2, "slabs fit the y_a|y_b|y_c region");
static_assert(WS_DT + 3 * DT_ARR <= WS_WSET2, "d_ws map 3");
__host__ __device__ constexpr size_t wofs(int l) { return (l & 1) ? (WS_WSET2 - WS_WIN) : 0; }
static_assert(WS_P + (size_t)MT * NPAD * 2 <= WS_XC && WS_XC + (size_t)MT * 1536 * 2 <= WS_DT, "d_ws map 2");
static_assert(WS_MOD + (size_t)DEPTH * NSEQ * 12288 * 4 <= WS_WIN && WS_WIN + (size_t)NPAD * DM * 2 <= WS_WBR && WS_H + (size_t)MT * DM * 2 <= WS_Y3 && WS_Y3 + (size_t)3 * MT * 1024 * 2 <= WS_P, "d_ws map");
constexpr int CW_BAR = 4096;
constexpr int CW_Q = 8192;
constexpr int CW_QC = 12288;
constexpr int RING_BYTES = 131072, ST_OFF = RING_BYTES  , MISC_OFF = RING_BYTES + 1024, LDS_BYTES = 147456;

#define GAS __attribute__((address_space(1)))
#define LAS __attribute__((address_space(3)))
typedef unsigned short bf16;
typedef unsigned v4u __attribute__((ext_vector_type(4)));
typedef unsigned v2u __attribute__((ext_vector_type(2)));
typedef float f32x4 __attribute__((ext_vector_type(4)));
typedef float f32x2 __attribute__((ext_vector_type(2)));
#define LDS_WAIT() asm volatile("s_waitcnt lgkmcnt(0)" ::: "memory")
#define VM_WAIT() asm volatile("s_waitcnt vmcnt(0)" ::: "memory")
typedef float cv_f32x2 __attribute__((ext_vector_type(2))); typedef __bf16 cv_bf16x2 __attribute__((ext_vector_type(2)));
__device__ __forceinline__ unsigned pk2(float lo, float hi) { const cv_f32x2 v = {lo, hi}; const cv_bf16x2 b = __builtin_convertvector(v, cv_bf16x2); return __builtin_bit_cast(unsigned, b); }
__device__ __forceinline__ unsigned f2bf(float f) { const __bf16 b = (__bf16)f; return (unsigned)__builtin_bit_cast(unsigned short, b); }
__device__ __forceinline__ float bflo(unsigned w) { return __uint_as_float(w << 16); }
__device__ __forceinline__ float bfhi(unsigned w) { return __uint_as_float(w & 0xffff0000u); }
__device__ __forceinline__ float bf1(bf16 v) { return __uint_as_float(((unsigned)v) << 16); }
__device__ __forceinline__ float sigmoidf_(float x) { return __builtin_amdgcn_rcpf(1.0f + __expf(-x)); }
__device__ __forceinline__ float siluf_(float x) { return x * __builtin_amdgcn_rcpf(1.0f + __expf(-x)); }
__device__ __forceinline__ float rsqrtf_(float x) { return __builtin_amdgcn_rsqf(x); }
__device__ __forceinline__ float geluf_(float v) {
    const float av = fabsf(v), t = __builtin_amdgcn_rcpf(1.0f + 0.2316418882f * av);
    float q = t * 0.5307027145f + (-0.7265760135f); q = q * t + 0.7107068705f; q = q * t + (-0.142248368f); q = q * t + 0.127414796f; q = q * t;
    const float e = __expf(-0.5f * v * v), m = v * (q * e);
    return v < 0.f ? m : v - m;
}
__device__ __forceinline__ float wave_sum(float v) {
#pragma unroll
    for (int o = 1; o < 64; o <<= 1) v += __shfl_xor(v, o);
    return v;
}
__device__ __forceinline__ float half_sum(float v) {
#pragma unroll
    for (int o = 1; o < 32; o <<= 1) v += __shfl_xor(v, o);
    return v;
}

#define XB_TMO      128
#define XB_XCNT(j)  (256  + 64 * (j))
#define XB_XSUB(j)  (1280 + 64 * (j))
#define XB_XGEN(j)  (2304 + 64 * (j))
#define XB_TOP      3328
#define XB_TOPGEN   3392
#define XCD_BAR_WORDS 3456
#define XB_SPIN_CAP (1u << 18)

__device__ __forceinline__ unsigned xb_ld(unsigned* p)              { return __hip_atomic_load(p, __ATOMIC_RELAXED, __HIP_MEMORY_SCOPE_AGENT); }
__device__ __forceinline__ unsigned xb_add(unsigned* p, unsigned v) { return __hip_atomic_fetch_add(p, v, __ATOMIC_RELAXED, __HIP_MEMORY_SCOPE_AGENT); }
__device__ __forceinline__ unsigned xb_xcc_id() { return (unsigned)__builtin_amdgcn_s_getreg((3 << 11) | 20) & 0xFu; }
#define XB_SPIN(cond, bar) do { unsigned _sp = 0; while (cond) { __builtin_amdgcn_s_sleep(1); \
    if ((++_sp & 255u) == 0u) { if (xb_ld(&(bar)[XB_TMO])) break; if (_sp > XB_SPIN_CAP) { atomicAdd(&(bar)[XB_TMO], 1u); break; } } } } while (0)

struct XcdBarrier {
    unsigned* bar; unsigned x;
    volatile LAS unsigned* st;
};

__device__ __forceinline__ XcdBarrier xcd_barrier_post(unsigned* bar, volatile LAS unsigned* st, int tid) {
    XcdBarrier b; b.bar = bar; b.x = xb_xcc_id(); b.st = st;
    if (tid == 0) (void)xb_add(&bar[XB_XCNT(b.x)], 1u);
    return b;
}
__device__ __forceinline__ void xcd_barrier_complete(unsigned* bar, unsigned x, unsigned& nloc, unsigned& nx) {
    const unsigned G = gridDim.x * gridDim.y * gridDim.z;
    unsigned sum, cnt, mine, sp = 0u;
    for (;;) {
        sum = 0u; cnt = 0u; mine = 0u;
#pragma unroll
        for (unsigned j = 0; j < 16; ++j) { const unsigned c = xb_ld(&bar[XB_XCNT(j)]); sum += c; cnt += (c > 0u) ? 1u : 0u; mine = (j == x) ? c : mine; }
        if (sum == G) break;
        __builtin_amdgcn_s_sleep(1);
        if ((++sp & 255u) == 0u) { if (xb_ld(&bar[XB_TMO])) break; if (sp > XB_SPIN_CAP) { atomicAdd(&bar[XB_TMO], 1u); break; } }
    }
    nloc = mine > 0u ? mine : 1u; nx = cnt > 0u ? cnt : 1u;
}

__device__ __forceinline__ void xcd_barrier(const XcdBarrier& b, int tid) {
    asm volatile("s_waitcnt vmcnt(0)" ::: "memory");
    __syncthreads();
    if (tid == 0) {
        unsigned* bar = b.bar;
        __builtin_amdgcn_s_waitcnt(0);
        unsigned nloc = b.st[0], nx = b.st[1];
        if (nloc == 0u) { xcd_barrier_complete(bar, b.x, nloc, nx); b.st[0] = nloc; b.st[1] = nx; }
        const unsigned old = xb_add(&bar[XB_XSUB(b.x)], 1u);
        const unsigned gen = old / nloc;
        if (old + 1u == (gen + 1u) * nloc) {
            __builtin_amdgcn_fence(__ATOMIC_RELEASE, "agent");
            asm volatile("s_waitcnt vmcnt(0)" ::: "memory");
            const unsigned og = xb_add(&bar[XB_TOP], 1u);
            const unsigned tg = og / nx;
            if (og + 1u == (tg + 1u) * nx) xb_add(&bar[XB_TOPGEN], 1u);
            else XB_SPIN(xb_ld(&bar[XB_TOPGEN]) == tg, bar);
            __builtin_amdgcn_fence(__ATOMIC_ACQUIRE, "agent");
            xb_add(&bar[XB_XGEN(b.x)], 1u);
            asm volatile("s_waitcnt vmcnt(0)" ::: "memory");
        } else {
            XB_SPIN(xb_ld(&bar[XB_XGEN(b.x)]) == gen, bar);
            __builtin_amdgcn_fence(__ATOMIC_ACQUIRE, "agent");
            asm volatile("s_waitcnt vmcnt(0)" ::: "memory");
        }
    }
    __syncthreads();
}


__device__ __forceinline__ void mod_item(LAS unsigned char* lds, int tid_in, int it, const float* c_prompt, const float* c_sample, const float* w_mod, const float* b_mod, float* MOD) {
    int tid = tid_in;
    const int l = it / 96, cb = it - l * 96, j0 = cb * 128;
    const int cq = tid & 31, sh = (tid >> 5) & 1, kq = tid >> 6;
    LAS float* CS = (LAS float*)lds;
    f32x2 acc[24][2];
#pragma unroll
    for (int s = 0; s < 24; ++s) { acc[s][0] = (f32x2){0.f, 0.f}; acc[s][1] = (f32x2){0.f, 0.f}; }
    const float* wbase = w_mod + (size_t)l * DM * 12288 + j0 + 4 * cq;
    for (int kt = 0; kt < 8; ++kt) {
        __syncthreads();
#pragma unroll 8
        for (int j = 0; j < 24; ++j) { const int e = tid + 512 * j, s = e >> 8, kidx = e & 255, kq2 = kidx >> 5, kk = kidx & 31, k = kq2 * 256 + kt * 32 + kk;
            const float cv = s < 16 ? c_prompt[s * DM + k] : c_sample[(s - 16) * DM + k];
            CS[(kq2 * 32 + kk) * 48 + s] = siluf_(cv); }
        __syncthreads();
        { const float* wr = wbase + (size_t)(kq * 256 + kt * 32) * 12288;
          f32x4 wn[4];
#pragma unroll
          for (int i = 0; i < 4; ++i) wn[i] = *(const f32x4*)(wr + (size_t)i * 12288);
#pragma unroll 1
          for (int kk = 0; kk < 32; kk += 4) { f32x4 wc[4];
#pragma unroll
              for (int i = 0; i < 4; ++i) wc[i] = wn[i];
              if (kk + 4 < 32) {
#pragma unroll
                  for (int i = 0; i < 4; ++i) wn[i] = *(const f32x4*)(wr + (size_t)(kk + 4 + i) * 12288); }
#pragma unroll
              for (int i = 0; i < 4; ++i) { const f32x2 w01 = (f32x2){wc[i].x, wc[i].y}, w23 = (f32x2){wc[i].z, wc[i].w}; const LAS f32x4* cr = (const LAS f32x4*)(CS + (kq * 32 + kk + i) * 48 + 24 * sh);
#pragma unroll
                  for (int s4 = 0; s4 < 6; ++s4) { const f32x4 c4 = cr[s4];
#pragma unroll
                      for (int q = 0; q < 4; ++q) { const f32x2 cc = (f32x2){c4[q], c4[q]};
                          acc[4 * s4 + q][0] = __builtin_elementwise_fma(w01, cc, acc[4 * s4 + q][0]); acc[4 * s4 + q][1] = __builtin_elementwise_fma(w23, cc, acc[4 * s4 + q][1]); } } } } }
    }
    LAS float* RED = (LAS float*)lds;
    asm volatile("" : "+v"(tid));
    const int cq2 = tid & 31, sh2 = (tid >> 5) & 1, kq2_ = tid >> 6;
#pragma unroll
    for (int sb = 0; sb < 4; ++sb) {
        __syncthreads();
        if (sh2 == (sb >> 1)) {
#pragma unroll
            for (int i = 0; i < 12; ++i) { const f32x2 a = acc[12 * (sb & 1) + i][0], b = acc[12 * (sb & 1) + i][1]; *(LAS f32x4*)(RED + (kq2_ * 12 + i) * 128 + 4 * cq2) = (f32x4){a.x, a.y, b.x, b.y}; } }
        __syncthreads();
#pragma unroll
        for (int j = 0; j < 3; ++j) { const int e = tid + 512 * j, s = e >> 7, col = e & 127; float v = 0.f;
#pragma unroll
            for (int q = 0; q < 8; ++q) v += RED[(q * 12 + s) * 128 + col];
            MOD[((size_t)l * NSEQ + 12 * sb + s) * 12288 + j0 + col] = v + b_mod[l * 12288 + j0 + col]; }
    }
    __syncthreads();
}

struct CvItem { const float* src; bf16* dst; int N, K, nv; };
constexpr int CV_A = 472 * 32, CV_B = 3 * 16 * 64, CV_C = 32 * 64, CV_D = 32 * 256, CV_E = 128 * 64, CV_ALL = CV_A + CV_B + CV_C + CV_D + CV_E;
__device__ __forceinline__ CvItem cvt_decode(int it, int l, const float* w_in, const float* w_branch, const float* w_out, const float* w_up, const float* w_down, unsigned char* ws) {
    CvItem c; int r = it;
    if (r < CV_A) { const int nb = r % 472, kb = r / 472; int n0s, nv;
        if (nb < 208) { n0s = 32 * nb; nv = 32; } else if (nb < 464) { n0s = 32 * nb + 16; nv = 32; } else if (nb == 464) { n0s = 6656; nv = 16; } else { n0s = 0; nv = 0; }
        c.N = IN_TOTAL; c.K = DM; c.nv = nv; c.src = w_in + (size_t)l * DM * IN_TOTAL + (size_t)(64 * kb) * IN_TOTAL + n0s; c.dst = (bf16*)(ws + WS_WIN) + (size_t)(32 * nb) * DM + 64 * kb; return c; }
    r -= CV_A;
    if (r < CV_B) { const int br = r / 1024, r2 = r % 1024, kb = r2 / 64, nb = r2 % 64;
        c.N = DM; c.K = 1024; c.nv = 32; c.src = w_branch + ((size_t)l * 3072 + br * 1024 + 64 * kb) * DM + 32 * nb; c.dst = (bf16*)(ws + WS_WBR) + (size_t)br * 2048 * 1024 + (size_t)(32 * nb) * 1024 + 64 * kb; return c; }
    r -= CV_B;
    if (r < CV_C) { const int kb = r / 64, nb = r % 64;
        c.N = DM; c.K = DM; c.nv = 32; c.src = w_out + (size_t)l * DM * DM + (size_t)(64 * kb) * DM + 32 * nb; c.dst = (bf16*)(ws + WS_WOUT) + (size_t)(32 * nb) * DM + 64 * kb; return c; }
    r -= CV_C;
    if (r < CV_D) { const int kb = r / 256, nb = r % 256;
        c.N = DFF; c.K = DM; c.nv = 32; c.src = w_up + (size_t)l * DM * DFF + (size_t)(64 * kb) * DFF + 32 * nb; c.dst = (bf16*)(ws + WS_WUP) + (size_t)(32 * nb) * DM + 64 * kb; return c; }
    r -= CV_D;
    { const int kb = r / 64, nb = r % 64;
        c.N = DM; c.K = DFF; c.nv = 32; c.src = w_down + (size_t)l * DFF * DM + (size_t)(64 * kb) * DM + 32 * nb; c.dst = (bf16*)(ws + WS_WDN) + (size_t)(32 * nb) * DFF + 64 * kb; return c; }
}
__device__ __forceinline__ void cvt_load(const CvItem& c, int lane, f32x4 (&v)[8]) {
    const int kk = lane >> 3, n4 = (lane & 7) * 4;
#pragma unroll
    for (int i = 0; i < 8; ++i) v[i] = (n4 < c.nv) ? *(const f32x4*)(c.src + (size_t)(8 * i + kk) * c.N + n4) : (f32x4){0.f, 0.f, 0.f, 0.f};
}
__device__ __forceinline__ void cvt_store(const CvItem& c, int lane, const f32x4 (&v)[8], LAS float* scr) {
    { const int kk = lane >> 3, n4 = (lane & 7) * 4;
#pragma unroll
        for (int i = 0; i < 8; ++i) { LAS float* d = scr + (8 * i + kk) * 33 + n4; d[0] = v[i].x; d[1] = v[i].y; d[2] = v[i].z; d[3] = v[i].w; } }
    LDS_WAIT(); asm volatile("" ::: "memory");
    const int cc = lane & 7;
#pragma unroll
    for (int j = 0; j < 4; ++j) { const int n = (lane >> 3) + 8 * j; const LAS float* s = scr + (8 * cc) * 33 + n;
        v4u o; o.x = pk2(s[0 * 33], s[1 * 33]); o.y = pk2(s[2 * 33], s[3 * 33]); o.z = pk2(s[4 * 33], s[5 * 33]); o.w = pk2(s[6 * 33], s[7 * 33]);
        *(v4u*)(c.dst + (size_t)n * c.K + 8 * cc) = o; }
    LDS_WAIT(); asm volatile("" ::: "memory");
}
template <bool QUEUE>
__device__ __forceinline__ void cvt_phase(LAS unsigned char* lds, int wave, int lane, int gw, int NGW, int l, const float* w_in, const float* w_branch, const float* w_out, const float* w_up, const float* w_down, unsigned char* ws, unsigned* qhead) {
    LAS float* scr = (LAS float*)(lds + wave * 16384);
    int it = gw, left = 0;
#define CV_NEXT() do { if (QUEUE) { if (left == 0) { unsigned t0 = 0; if (lane == 0) t0 = __hip_atomic_fetch_add(qhead, 4u, __ATOMIC_RELAXED, __HIP_MEMORY_SCOPE_AGENT); it = __builtin_amdgcn_readfirstlane((int)t0); left = 4; } else ++it; --left; } else it += NGW; } while (0)
    if (QUEUE) { it = 0; CV_NEXT(); }
    if (it >= CV_ALL) return;
    CvItem ca = cvt_decode(it, l, w_in, w_branch, w_out, w_up, w_down, ws), cb = ca; f32x4 va[8], vb[8];
    cvt_load(ca, lane, va);
    for (;;) {
        CV_NEXT(); const bool hb = it < CV_ALL;
        if (hb) { cb = cvt_decode(it, l, w_in, w_branch, w_out, w_up, w_down, ws); cvt_load(cb, lane, vb); }
        cvt_store(ca, lane, va, scr);
        if (!hb) break;
        CV_NEXT(); const bool ha = it < CV_ALL;
        if (ha) { ca = cvt_decode(it, l, w_in, w_branch, w_out, w_up, w_down, ws); cvt_load(ca, lane, va); }
        cvt_store(cb, lane, vb, scr);
        if (!ha) break;
    }
#undef CV_NEXT
}

#ifndef WGM_N8
#define WGM_N8 4
#endif
__device__ __forceinline__ int tail_nfull(int nwg, int G) { const int nf = (nwg / G) * G; return (nwg - nf) <= 32 ? nf : nwg; }
__device__ __forceinline__ void build_tail_map(LAS int* tmap, int tid, int G, int rev) {
    pg8::StaticOrder S; S.init(MT, DM, G, 0); S.rev = rev; S.wgm = WGM_N8; const int nfull = tail_nfull(S.nwg, G);
    for (int i = tid; i < S.nwg; i += NWAVES * 64) tmap[i] = -1;
    __syncthreads();
    for (int i = tid; i < S.nwg - nfull; i += NWAVES * 64) { pg8::Unit u; S.tile_of(nfull + i, u); tmap[u.pm * 8 + u.pn] = i; }
    __syncthreads();
}
template <bool SRC_F32>
__device__ __forceinline__ void norm_mod_phase(int lane, int gw, int NGW, const float* xP, const float* xS, bf16* X, const float* ng, const float* modl  , int part_sh, int part_sc, bf16* H,
                                               bool comb, const LAS int* tmap, const float* slab, bool desc) {
    const int g2 = desc ? NGW - 1 - gw : gw;
    const int ra = (int)(((unsigned)g2 * (unsigned)MT) / (unsigned)NGW), rb = (int)(((unsigned)(g2 + 1) * (unsigned)MT) / (unsigned)NGW);
    const int nr = rb - ra, rfirst = desc ? rb - 1 : ra, step = desc ? -1 : 1;
    if (nr <= 0) return;
    f32x4 ca[8], cb[8]; int cur_seq = -1;
    v2u xn[8];
    v2u xm[8];
    f32x4 xf[8];
    if (SRC_F32) { const float* xr = (rfirst < NTOK_P ? xP + (size_t)rfirst * DM : xS + (size_t)(rfirst - NTOK_P) * DM) + 4 * lane;
#pragma unroll
        for (int j = 0; j < 8; ++j) xf[j] = *(const f32x4*)(xr + 256 * j); }
    if (!SRC_F32) { const v2u* xb0 = (const v2u*)(X + (size_t)rfirst * DM) + lane;
#pragma unroll
        for (int j = 0; j < 8; ++j) xn[j] = xb0[64 * j];
        if (nr > 1) { const v2u* xb1 = (const v2u*)(X + (size_t)(rfirst + step) * DM) + lane;
#pragma unroll
            for (int j = 0; j < 8; ++j) xm[j] = xb1[64 * j]; } }
    for (int i = 0; i < nr; ++i) { const int r = rfirst + step * i;
        const int seq = r < NTOK_P ? (r >> 11) : 16 + ((r - NTOK_P) >> 5);
        if (seq != cur_seq) { cur_seq = seq; const float* mp = modl + (size_t)seq * 12288;
#pragma unroll
            for (int j = 0; j < 8; ++j) { const int c = 4 * lane + 256 * j; const f32x4 g = *(const f32x4*)(ng + c), sc = *(const f32x4*)(mp + part_sc * DM + c); ca[j] = g * (sc + 1.0f); cb[j] = *(const f32x4*)(mp + part_sh * DM + c); } }
        f32x4 v[8]; float ss = 0.f; v2u* xb = (v2u*)(X + (size_t)r * DM) + lane;
        if (SRC_F32) {
#pragma unroll
            for (int j = 0; j < 8; ++j) { v[j] = xf[j]; v2u o; o.x = pk2(v[j].x, v[j].y); o.y = pk2(v[j].z, v[j].w); xb[64 * j] = o; }
            if (i + 1 < nr) { const int r1 = r + step; const float* xr = (r1 < NTOK_P ? xP + (size_t)r1 * DM : xS + (size_t)(r1 - NTOK_P) * DM) + 4 * lane;
#pragma unroll
                for (int j = 0; j < 8; ++j) xf[j] = *(const f32x4*)(xr + 256 * j); } }
        else {
#pragma unroll
            for (int j = 0; j < 8; ++j) { const v2u o = xn[j]; v[j] = (f32x4){bflo(o.x), bfhi(o.x), bflo(o.y), bfhi(o.y)}; xn[j] = xm[j]; }
            if (i + 2 < nr) { const v2u* xb2 = (const v2u*)(X + (size_t)(r + 2 * step) * DM) + lane;
#pragma unroll
                for (int j = 0; j < 8; ++j) xm[j] = xb2[64 * j]; } }
        if (comb) {
#pragma unroll
            for (int j = 0; j < 8; ++j) { const int ti = tmap[(r >> 8) * 8 + j]; if (ti >= 0) { const float* sp = slab + (size_t)ti * 8 * 65536 + (r & 255) * 256 + 4 * lane;
#pragma unroll
                    for (int q = 0; q < 8; ++q) v[j] = v[j] + *(const f32x4*)(sp + (size_t)q * 65536);
                    v2u o; o.x = pk2(v[j].x, v[j].y); o.y = pk2(v[j].z, v[j].w); xb[64 * j] = o; } } }
#pragma unroll
        for (int j = 0; j < 8; ++j) ss += (v[j].x * v[j].x + v[j].y * v[j].y) + (v[j].z * v[j].z + v[j].w * v[j].w);
        const float rstd = 1.0f / sqrtf(wave_sum(ss) * (1.0f / DM) + NORM_EPS);
        unsigned long long* o8 = (unsigned long long*)(H + (size_t)r * DM) + lane;
#pragma unroll
        for (int j = 0; j < 8; ++j) { const f32x4 y = v[j] * rstd * ca[j] + cb[j]; o8[64 * j] = (unsigned long long)pk2(y.x, y.y) | ((unsigned long long)pk2(y.z, y.w) << 32); }
    }
}
__device__ __forceinline__ void final_norm_phase(int lane, int gw, int NGW, const bf16* X, float* Y, const float* fg, bool comb, const LAS int* tmap, const float* slab) {
    f32x4 g[8];
#pragma unroll
    for (int j = 0; j < 8; ++j) g[j] = *(const f32x4*)(fg + 4 * lane + 256 * j);
    v2u xn[8], xm[8];
    if (gw < MT) { const v2u* xb0 = (const v2u*)(X + (size_t)gw * DM) + lane;
#pragma unroll
        for (int j = 0; j < 8; ++j) xn[j] = xb0[64 * j]; }
    if (gw + NGW < MT) { const v2u* xb0 = (const v2u*)(X + (size_t)(gw + NGW) * DM) + lane;
#pragma unroll
        for (int j = 0; j < 8; ++j) xm[j] = xb0[64 * j]; }
    for (int r = gw; r < MT; r += NGW) {
        float* yr = Y + (size_t)r * DM + 4 * lane; f32x4 v[8]; float ss = 0.f;
#pragma unroll
        for (int j = 0; j < 8; ++j) { const v2u o = xn[j]; v[j] = (f32x4){bflo(o.x), bfhi(o.x), bflo(o.y), bfhi(o.y)}; xn[j] = xm[j]; }
        if (r + 2 * NGW < MT) { const v2u* xb1 = (const v2u*)(X + (size_t)(r + 2 * NGW) * DM) + lane;
#pragma unroll
            for (int j = 0; j < 8; ++j) xm[j] = xb1[64 * j]; }
        if (comb) {
#pragma unroll
            for (int j = 0; j < 8; ++j) { const int ti = tmap[(r >> 8) * 8 + j]; if (ti >= 0) { const float* sp = slab + (size_t)ti * 8 * 65536 + (r & 255) * 256 + 4 * lane;
#pragma unroll
                    for (int q = 0; q < 8; ++q) v[j] = v[j] + *(const f32x4*)(sp + (size_t)q * 65536); } } }
#pragma unroll
        for (int j = 0; j < 8; ++j) ss += (v[j].x * v[j].x + v[j].y * v[j].y) + (v[j].z * v[j].z + v[j].w * v[j].w);
        const float rstd = 1.0f / sqrtf(wave_sum(ss) * (1.0f / DM) + NORM_EPS);
#pragma unroll
        for (int j = 0; j < 8; ++j) *(f32x4*)(yr + 256 * j) = v[j] * rstd * g[j];
    }
}
__device__ __forceinline__ void ssd_norm_phase(int lane, int gw, int NGW, bf16* YB, const float* g) {
    float gv[16];
#pragma unroll
    for (int j = 0; j < 4; ++j) { const f32x4 t = *(const f32x4*)(g + 16 * lane + 4 * j); gv[4 * j] = t.x; gv[4 * j + 1] = t.y; gv[4 * j + 2] = t.z; gv[4 * j + 3] = t.w; }
    v4u na = (v4u){0u, 0u, 0u, 0u}, nb = na, ma = na, mb = na;
    if (gw < MT) { const v4u* p0 = (const v4u*)(YB + (size_t)gw * 1024 + 16 * lane); na = p0[0]; nb = p0[1]; }
    if (gw + NGW < MT) { const v4u* p0 = (const v4u*)(YB + (size_t)(gw + NGW) * 1024 + 16 * lane); ma = p0[0]; mb = p0[1]; }
    for (int r = gw; r < MT; r += NGW) {
        v4u* p = (v4u*)(YB + (size_t)r * 1024 + 16 * lane); const v4u a = na, b = nb; na = ma; nb = mb;
        if (r + 2 * NGW < MT) { const v4u* p1 = (const v4u*)(YB + (size_t)(r + 2 * NGW) * 1024 + 16 * lane); ma = p1[0]; mb = p1[1]; }
        float v[16]; v[0] = bflo(a.x); v[1] = bfhi(a.x); v[2] = bflo(a.y); v[3] = bfhi(a.y); v[4] = bflo(a.z); v[5] = bfhi(a.z); v[6] = bflo(a.w); v[7] = bfhi(a.w);
        v[8] = bflo(b.x); v[9] = bfhi(b.x); v[10] = bflo(b.y); v[11] = bfhi(b.y); v[12] = bflo(b.z); v[13] = bfhi(b.z); v[14] = bflo(b.w); v[15] = bfhi(b.w);
        float ss = 0.f;
#pragma unroll
        for (int j = 0; j < 16; ++j) ss += v[j] * v[j];
        const float rstd = 1.0f / sqrtf(half_sum(ss) * (1.0f / 512.0f) + NORM_EPS);
#pragma unroll
        for (int j = 0; j < 16; ++j) v[j] = v[j] * rstd * gv[j];
        v4u oa, ob; oa.x = pk2(v[0], v[1]); oa.y = pk2(v[2], v[3]); oa.z = pk2(v[4], v[5]); oa.w = pk2(v[6], v[7]); ob.x = pk2(v[8], v[9]); ob.y = pk2(v[10], v[11]); ob.z = pk2(v[12], v[13]); ob.w = pk2(v[14], v[15]);
        p[0] = oa; p[1] = ob;
    }
}

__device__ __forceinline__ void hgrn_item(LAS unsigned char* lds, int tid, int lane, int wave, const bf16* P, bf16* YA, int row0, int T, int h, int l,
                                          const float* s0, float* sout, const float* lb_raw, const float* onorm_g) {
    LAS float* LBV = (LAS float*)lds;
    LAS float* GV = LBV + 128;
    LAS float* Q = GV + 128;
    LAS float* F = Q + 2048; LAS float* KN = F + 2048; LAS float* IV = KN + 2048;
    LAS float* PO = IV + 2048;
    __syncthreads();
    if (tid < 128) { const int ch = h * 128 + tid; const float a0 = lb_raw[ch], a1 = lb_raw[1024 + ch], a2 = lb_raw[2048 + ch], a3 = lb_raw[3072 + ch];
        const float mx = fmaxf(fmaxf(a0, a1), fmaxf(a2, a3)); const float e0 = __expf(a0 - mx), e1 = __expf(a1 - mx), e2 = __expf(a2 - mx), e3 = __expf(a3 - mx); const float inv = 1.0f / (e0 + e1 + e2 + e3);
        float lb = 0.f; if (l >= 1) lb += e1; if (l >= 2) lb += e2; if (l >= 3) lb += e3; LBV[tid] = lb * inv; GV[tid] = onorm_g[ch]; }
    v2u nq2, nf2, ni2;
    { const bf16* pr = P + (size_t)(row0 + (tid >> 5)) * NPAD + h * 128 + (tid & 31) * 4; nq2 = *(const v2u*)(pr + OFF_AQ); nf2 = *(const v2u*)(pr + OFF_AF); ni2 = *(const v2u*)(pr + OFF_AI); }
    float S0[16], S1[16];
#pragma unroll
    for (int kk = 0; kk < 16; ++kk) { if (s0) { const f32x2 v = *(const f32x2*)(s0 + (16 * wave + kk) * 128 + 2 * lane); S0[kk] = v.x; S1[kk] = v.y; } else { S0[kk] = 0.f; S1[kk] = 0.f; } }
    __syncthreads();
    const int nch = T / 16;
    for (int c = 0; c < nch; ++c) {
        unsigned agv[2];
#pragma unroll
        for (int tt = 0; tt < 2; ++tt) agv[tt] = *(const unsigned*)(P + (size_t)(row0 + c * 16 + 2 * wave + tt) * NPAD + OFF_AG + h * 128 + 2 * lane);
        { const int t = tid >> 5, k4 = (tid & 31) * 4;
            const v2u q2 = nq2, f2 = nf2, i2 = ni2;
            if (c + 1 < nch) { const bf16* pr = P + (size_t)(row0 + (c + 1) * 16 + t) * NPAD + h * 128 + k4; nq2 = *(const v2u*)(pr + OFF_AQ); nf2 = *(const v2u*)(pr + OFF_AF); ni2 = *(const v2u*)(pr + OFF_AI); }
            const f32x4 lb = *(const LAS f32x4*)(LBV + k4);
            const float aq[4] = {bflo(q2.x), bfhi(q2.x), bflo(q2.y), bfhi(q2.y)}, az[4] = {bflo(f2.x), bfhi(f2.x), bflo(f2.y), bfhi(f2.y)};
            f32x4 qv, fv, kv;
#pragma unroll
            for (int j = 0; j < 4; ++j) { qv[j] = siluf_(aq[j]); const float sg = sigmoidf_(az[j]); fv[j] = lb[j] + (1.0f - lb[j]) * sg; kv[j] = (1.0f - lb[j]) * (1.0f - sg); }
            *(LAS f32x4*)(Q + t * 128 + k4) = qv; *(LAS f32x4*)(F + t * 128 + k4) = fv; *(LAS f32x4*)(KN + t * 128 + k4) = kv;
            *(LAS f32x4*)(IV + t * 128 + k4) = (f32x4){bflo(i2.x), bfhi(i2.x), bflo(i2.y), bfhi(i2.y)}; }
        __syncthreads();
#pragma unroll 2
        for (int t = 0; t < 16; ++t) {
            const f32x2 iv = *(const LAS f32x2*)(IV + t * 128 + 2 * lane); float po0 = 0.f, po1 = 0.f;
#pragma unroll
            for (int k4 = 0; k4 < 4; ++k4) { const f32x4 f4 = *(const LAS f32x4*)(F + t * 128 + 16 * wave + 4 * k4), n4 = *(const LAS f32x4*)(KN + t * 128 + 16 * wave + 4 * k4), q4 = *(const LAS f32x4*)(Q + t * 128 + 16 * wave + 4 * k4);
#pragma unroll
                for (int j = 0; j < 4; ++j) { const int kk = 4 * k4 + j; S0[kk] = fmaf(f4[j], S0[kk], n4[j] * iv.x); S1[kk] = fmaf(f4[j], S1[kk], n4[j] * iv.y); po0 = fmaf(q4[j], S0[kk], po0); po1 = fmaf(q4[j], S1[kk], po1); } }
            *(LAS f32x2*)(PO + (t * 8 + wave) * 128 + 2 * lane) = (f32x2){po0, po1};
        }
        __syncthreads();
#pragma unroll
        for (int tt = 0; tt < 2; ++tt) { const int t = 2 * wave + tt; float o0 = 0.f, o1 = 0.f;
#pragma unroll
            for (int w = 0; w < 8; ++w) { const f32x2 p = *(const LAS f32x2*)(PO + (t * 8 + w) * 128 + 2 * lane); o0 += p.x; o1 += p.y; }
            const float rstd = 1.0f / sqrtf(wave_sum(o0 * o0 + o1 * o1) * (1.0f / 128.0f) + NORM_EPS);
            const size_t row = (size_t)(row0 + c * 16 + t);
            const unsigned ag = agv[tt];
            const f32x2 gg = *(const LAS f32x2*)(GV + 2 * lane);
            *(unsigned*)(YA + row * 1024 + h * 128 + 2 * lane) = pk2(o0 * rstd * gg.x * siluf_(bflo(ag)), o1 * rstd * gg.y * siluf_(bfhi(ag))); }
    }
#pragma unroll
    for (int kk = 0; kk < 16; ++kk) *(f32x2*)(sout + (16 * wave + kk) * 128 + 2 * lane) = (f32x2){S0[kk], S1[kk]};
    __syncthreads();
}

typedef short bf16x8_t __attribute__((ext_vector_type(8)));
#define BAR_LDS() do { asm volatile("s_waitcnt lgkmcnt(0)" ::: "memory"); __builtin_amdgcn_s_barrier(); asm volatile("" ::: "memory"); } while (0)
#define MFMA16(x, y, acc) __builtin_amdgcn_mfma_f32_16x16x32_bf16((x), (y), (acc), 0, 0, 0)
#define LDFRAG(base, row, pitch, koff) (*(const LAS bf16x8_t*)((base) + (row) * (pitch) + (koff)))
__device__ __forceinline__ void hgrn_mfma_item(LAS unsigned char* lds, int tid, int lane, int wave, const bf16* P, bf16* YA, int row0, int h, int l, float* sout, const float* lb_raw, const float* onorm_g) {
    constexpr int PQ = 136, PT = 40;
    LAS float* LBV = (LAS float*)lds;
    LAS float* GV = LBV + 128;
    LAS float* DEC = GV + 128;
    LAS float* SS = DEC + 128;
    LAS float* LF = SS + 256;
    LAS bf16* QB = (LAS bf16*)(LF + 4096);
    LAS bf16* KB = QB + 32 * PQ;
    LAS bf16* Qt = KB + 32 * PQ;
    LAS bf16* Qm = Qt + 32 * PQ;
    LAS bf16* Km = Qm + 32 * PQ;
    LAS bf16* Qr = Km + 32 * PQ;
    LAS bf16* Kr = Qr + 16 * PQ;
    LAS bf16* KtT = Kr + 16 * PQ;
    LAS bf16* VT = KtT + 128 * PT;
    LAS bf16* IVr = VT + 128 * PT;
    LAS float* RSW = (LAS float*)(IVr + 32 * 128);
    const int fr = lane & 15, fq = lane >> 4;
    __syncthreads();
    if (tid < 128) { const int ch = h * 128 + tid; const float a0 = lb_raw[ch], a1 = lb_raw[1024 + ch], a2 = lb_raw[2048 + ch], a3 = lb_raw[3072 + ch];
        const float mx = fmaxf(fmaxf(a0, a1), fmaxf(a2, a3)); const float e0 = __expf(a0 - mx), e1 = __expf(a1 - mx), e2 = __expf(a2 - mx), e3 = __expf(a3 - mx); const float inv = 1.0f / (e0 + e1 + e2 + e3);
        float lb = 0.f; if (l >= 1) lb += e1; if (l >= 2) lb += e2; if (l >= 3) lb += e3; LBV[tid] = lb * inv; GV[tid] = onorm_g[ch]; }
    for (int i = tid; i < (128 * PT * 2) / 2; i += 512) ((LAS unsigned*)KtT)[i] = 0u;
    f32x4 sacc[8];
#pragma unroll
    for (int j = 0; j < 8; ++j) sacc[j] = (f32x4){0.f, 0.f, 0.f, 0.f};
    const int st = tid >> 4, sk8 = (tid & 15) * 8;
    const unsigned pst = (unsigned)((unsigned)(row0 + st) * (unsigned)NPAD + h * 128 + sk8) * 2u;
#define HG_LD16(off_) (*(const v4u*)((const char*)P + (unsigned)(off_)))
    v4u nq = HG_LD16(pst + 2u * OFF_AQ), nf = HG_LD16(pst + 2u * OFF_AF), ni = HG_LD16(pst + 2u * OFF_AI);
    f32x4 po0 = (f32x4){0.f, 0.f, 0.f, 0.f}, po1 = po0; bf16 pag[2][4];
#pragma unroll
    for (int hh = 0; hh < 2; ++hh)
#pragma unroll
        for (int r = 0; r < 4; ++r) pag[hh][r] = 0;
    const float gvv = onorm_g[h * 128 + 16 * wave + fr];
    __syncthreads();
#define HG_OUT(rb_) do { { const int t_ = lane & 31; const f32x4 p0 = *(const LAS f32x4*)(SS + t_ * 8), p1 = *(const LAS f32x4*)(SS + t_ * 8 + 4); \
            RSW[wave * 32 + t_] = rsqrtf_(((p0.x + p0.y) + (p0.z + p0.w) + (p1.x + p1.y) + (p1.z + p1.w)) * (1.0f / 128.0f) + NORM_EPS); } \
        LDS_WAIT(); asm volatile("" ::: "memory"); \
        _Pragma("unroll") for (int hh = 0; hh < 2; ++hh) { const f32x4 rs4 = *(const LAS f32x4*)(RSW + wave * 32 + 16 * hh + 4 * fq); \
            _Pragma("unroll") for (int r = 0; r < 4; ++r) { const int t = 16 * hh + 4 * fq + r; const float ov = hh ? po1[r] : po0[r]; \
            *(bf16*)((char*)YA + (unsigned)(((unsigned)(rb_) + t) * 1024u + h * 128 + 16 * wave + fr) * 2u) = (bf16)f2bf(ov * rs4[r] * gvv * siluf_(bf1(pag[hh][r]))); } } } while (0)
    for (int c = 0; c < 64; ++c) {
        const unsigned rbase = (unsigned)row0 + 32u * c;
        bf16 ag[2][4];
        { const f32x4 lb0 = *(const LAS f32x4*)(LBV + sk8), lb1 = *(const LAS f32x4*)(LBV + sk8 + 4); const float lb[8] = {lb0.x, lb0.y, lb0.z, lb0.w, lb1.x, lb1.y, lb1.z, lb1.w};
            const float aq[8] = {bflo(nq.x), bfhi(nq.x), bflo(nq.y), bfhi(nq.y), bflo(nq.z), bfhi(nq.z), bflo(nq.w), bfhi(nq.w)}, az[8] = {bflo(nf.x), bfhi(nf.x), bflo(nf.y), bfhi(nf.y), bflo(nf.z), bfhi(nf.z), bflo(nf.w), bfhi(nf.w)};
            float qv[8], kv[8], lf[8];
#pragma unroll
            for (int j = 0; j < 8; ++j) { qv[j] = siluf_(aq[j]); const float sg = sigmoidf_(az[j]); const float f = fmaxf(lb[j] + (1.0f - lb[j]) * sg, 1e-30f); kv[j] = (1.0f - lb[j]) * (1.0f - sg); lf[j] = __log2f(f); }
            *(LAS f32x4*)(LF + st * 128 + sk8) = (f32x4){lf[0], lf[1], lf[2], lf[3]}; *(LAS f32x4*)(LF + st * 128 + sk8 + 4) = (f32x4){lf[4], lf[5], lf[6], lf[7]};
            v4u qo, ko; qo.x = pk2(qv[0], qv[1]); qo.y = pk2(qv[2], qv[3]); qo.z = pk2(qv[4], qv[5]); qo.w = pk2(qv[6], qv[7]); ko.x = pk2(kv[0], kv[1]); ko.y = pk2(kv[2], kv[3]); ko.z = pk2(kv[4], kv[5]); ko.w = pk2(kv[6], kv[7]);
            *(LAS v4u*)(QB + st * PQ + sk8) = qo; *(LAS v4u*)(KB + st * PQ + sk8) = ko; *(LAS v4u*)(IVr + st * 128 + sk8) = ni;
#pragma unroll
            for (int hh = 0; hh < 2; ++hh)
#pragma unroll
                for (int r = 0; r < 4; ++r) ag[hh][r] = *(const bf16*)((const char*)P + (unsigned)((rbase + 16 * hh + 4 * fq + r) * (unsigned)NPAD + OFF_AG + h * 128 + 16 * wave + fr) * 2u);
            if (c + 1 < 64) { const unsigned pn = pst + (unsigned)(c + 1) * 32u * (unsigned)NPAD * 2u; nq = HG_LD16(pn + 2u * OFF_AQ); nf = HG_LD16(pn + 2u * OFF_AF); ni = HG_LD16(pn + 2u * OFF_AI); } }
        BAR_LDS();
        { const int k = tid & 127, tq = tid >> 7; float b[32]; float run = 0.f;
#pragma unroll
            for (int t = 0; t < 32; ++t) { run += LF[t * 128 + k]; b[t] = run; }
#pragma unroll
            for (int tq2 = 0; tq2 < 4; ++tq2) if (tq2 == tq) { const float mh = (tq2 < 2) ? b[7] : b[23]; float kt[8]; bf16 iv[8];
#pragma unroll
                for (int i = 0; i < 8; ++i) { const int t = 8 * tq2 + i; const float qv = bf1(QB[t * PQ + k]), kv = bf1(KB[t * PQ + k]); iv[i] = IVr[t * 128 + k];
                    Qt[t * PQ + k] = (bf16)f2bf(qv * __builtin_amdgcn_exp2f(b[t])); kt[i] = kv * __builtin_amdgcn_exp2f(b[31] - b[t]);
                    Qm[t * PQ + k] = (bf16)f2bf(qv * __builtin_amdgcn_exp2f(fminf(b[t] - mh, 115.f))); Km[t * PQ + k] = (bf16)f2bf(kv * __builtin_amdgcn_exp2f(fminf(mh - b[t], 115.f)));
                    if (tq2 < 2) Kr[t * PQ + k] = (bf16)f2bf(kv * __builtin_amdgcn_exp2f(b[15] - b[t])); else Qr[(t - 16) * PQ + k] = (bf16)f2bf(qv * __builtin_amdgcn_exp2f(b[t] - b[15])); }
                v4u ko; ko.x = pk2(kt[0], kt[1]); ko.y = pk2(kt[2], kt[3]); ko.z = pk2(kt[4], kt[5]); ko.w = pk2(kt[6], kt[7]); *(LAS v4u*)(KtT + k * PT + 8 * tq2) = ko;
                v4u vo; vo.x = (unsigned)iv[0] | ((unsigned)iv[1] << 16); vo.y = (unsigned)iv[2] | ((unsigned)iv[3] << 16); vo.z = (unsigned)iv[4] | ((unsigned)iv[5] << 16); vo.w = (unsigned)iv[6] | ((unsigned)iv[7] << 16); *(LAS v4u*)(VT + k * PT + 8 * tq2) = vo; }
            if (tq == 0) DEC[k] = __builtin_amdgcn_exp2f(b[31]); }
        if (c > 0) HG_OUT(rbase - 32);
        BAR_LDS();
        f32x4 at0 = (f32x4){0.f, 0.f, 0.f, 0.f}, at1 = at0, at2 = at0, o0 = at0, o1 = at0;
#pragma unroll
        for (int ks = 0; ks < 4; ++ks) { const int ko = 32 * ks + 8 * fq;
            at0 = MFMA16(LDFRAG(Km, fr, PQ, ko), LDFRAG(Qm, fr, PQ, ko), at0);
            at1 = MFMA16(LDFRAG(Km, 16 + fr, PQ, ko), LDFRAG(Qm, 16 + fr, PQ, ko), at1);
            at2 = MFMA16(LDFRAG(Kr, fr, PQ, ko), LDFRAG(Qr, fr, PQ, ko), at2);
            v4u sy; sy.x = pk2(sacc[2 * ks][0], sacc[2 * ks][1]); sy.y = pk2(sacc[2 * ks][2], sacc[2 * ks][3]); sy.z = pk2(sacc[2 * ks + 1][0], sacc[2 * ks + 1][1]); sy.w = pk2(sacc[2 * ks + 1][2], sacc[2 * ks + 1][3]);
            const v2u xa0 = *(const LAS v2u*)(Qt + fr * PQ + 32 * ks + 4 * fq), xb0 = *(const LAS v2u*)(Qt + fr * PQ + 32 * ks + 16 + 4 * fq);
            const v2u xa1 = *(const LAS v2u*)(Qt + (16 + fr) * PQ + 32 * ks + 4 * fq), xb1 = *(const LAS v2u*)(Qt + (16 + fr) * PQ + 32 * ks + 16 + 4 * fq);
            v4u x0; x0.x = xa0.x; x0.y = xa0.y; x0.z = xb0.x; x0.w = xb0.y; v4u x1; x1.x = xa1.x; x1.y = xa1.y; x1.z = xb1.x; x1.w = xb1.y;
            o0 = MFMA16(__builtin_bit_cast(bf16x8_t, x0), __builtin_bit_cast(bf16x8_t, sy), o0); o1 = MFMA16(__builtin_bit_cast(bf16x8_t, x1), __builtin_bit_cast(bf16x8_t, sy), o1); }
        {
            v4u a0, a1, a2; a0.z = 0u; a0.w = 0u; a1.z = 0u; a1.w = 0u; a2.z = 0u; a2.w = 0u;
            a0.x = pk2(4 * fq + 0 <= fr ? at0[0] : 0.f, 4 * fq + 1 <= fr ? at0[1] : 0.f); a0.y = pk2(4 * fq + 2 <= fr ? at0[2] : 0.f, 4 * fq + 3 <= fr ? at0[3] : 0.f);
            a1.x = pk2(4 * fq + 0 <= fr ? at1[0] : 0.f, 4 * fq + 1 <= fr ? at1[1] : 0.f); a1.y = pk2(4 * fq + 2 <= fr ? at1[2] : 0.f, 4 * fq + 3 <= fr ? at1[3] : 0.f);
            a2.x = pk2(at2[0], at2[1]); a2.y = pk2(at2[2], at2[3]);
            const v2u y0 = *(const LAS v2u*)(VT + (16 * wave + fr) * PT + 4 * fq), y1 = *(const LAS v2u*)(VT + (16 * wave + fr) * PT + 16 + 4 * fq);
            v4u v0; v0.x = y0.x; v0.y = y0.y; v0.z = 0u; v0.w = 0u; v4u v1; v1.x = y1.x; v1.y = y1.y; v1.z = 0u; v1.w = 0u;
            o0 = MFMA16(__builtin_bit_cast(bf16x8_t, a0), __builtin_bit_cast(bf16x8_t, v0), o0);
            o1 = MFMA16(__builtin_bit_cast(bf16x8_t, a1), __builtin_bit_cast(bf16x8_t, v1), o1);
            o1 = MFMA16(__builtin_bit_cast(bf16x8_t, a2), __builtin_bit_cast(bf16x8_t, v0), o1); }
#pragma unroll
        for (int r = 0; r < 4; ++r) { float q0 = o0[r] * o0[r], q1 = o1[r] * o1[r];
            q0 += __shfl_xor(q0, 1); q1 += __shfl_xor(q1, 1); q0 += __shfl_xor(q0, 2); q1 += __shfl_xor(q1, 2); q0 += __shfl_xor(q0, 4); q1 += __shfl_xor(q1, 4); q0 += __shfl_xor(q0, 8); q1 += __shfl_xor(q1, 8);
            if (fr == 0) { SS[(4 * fq + r) * 8 + wave] = q0; SS[(16 + 4 * fq + r) * 8 + wave] = q1; } }
        {
            const bf16x8_t vy = LDFRAG(VT, 16 * wave + fr, PT, 8 * fq);
#pragma unroll
            for (int kt = 0; kt < 8; ++kt) { const f32x4 d4 = *(const LAS f32x4*)(DEC + 16 * kt + 4 * fq); sacc[kt] = sacc[kt] * d4; sacc[kt] = MFMA16(LDFRAG(KtT, 16 * kt + fr, PT, 8 * fq), vy, sacc[kt]); } }
        po0 = o0; po1 = o1;
#pragma unroll
        for (int hh = 0; hh < 2; ++hh)
#pragma unroll
            for (int r = 0; r < 4; ++r) pag[hh][r] = ag[hh][r];
    }
    BAR_LDS();
    HG_OUT((unsigned)row0 + 2048u - 32u);
#undef HG_OUT
#undef HG_LD16
#pragma unroll
    for (int kt = 0; kt < 8; ++kt)
#pragma unroll
        for (int r = 0; r < 4; ++r) sout[(16 * kt + 4 * fq + r) * 128 + 16 * wave + fr] = sacc[kt][r];
    __syncthreads();
}

__device__ __forceinline__ void ssd_pre_phase(int lane, int gw, int NGW, const bf16* P, bf16* XC, float* DTb, float* ADT, float* ACUM,
                                              const float* conv_w, const float* conv_b, const float* dt_bias, const float* a_log, const float* state_conv, float* conv_out_p, float* conv_out_s) {
    unsigned ua = (unsigned)(((unsigned long long)(unsigned)gw * (3u * MT)) / (unsigned)NGW); const unsigned ub = (unsigned)(((unsigned long long)((unsigned)gw + 1u) * (3u * MT)) / (unsigned)NGW);
#define PRE_UNPK(dst, u) do { dst[0] = bflo(u.x); dst[1] = bfhi(u.x); dst[2] = bflo(u.y); dst[3] = bfhi(u.y); dst[4] = bflo(u.z); dst[5] = bfhi(u.z); dst[6] = bflo(u.w); dst[7] = bfhi(u.w); } while (0)
    while (ua < ub) {
        const int cg = (int)(ua / (unsigned)MT); const unsigned ue = ub < (unsigned)(cg + 1) * MT ? ub : (unsigned)(cg + 1) * MT;
        const int t0 = (int)(ua - (unsigned)cg * MT), t1 = (int)(ue - (unsigned)cg * MT), cc = cg * 512 + 8 * lane; ua = ue;
        float w[4][8], cb[8], a0[8], a1[8], a2[8];
#pragma unroll
        for (int j = 0; j < 4; ++j) { const f32x4 u0 = *(const f32x4*)(conv_w + j * 1536 + cc), u1 = *(const f32x4*)(conv_w + j * 1536 + cc + 4);
            w[j][0] = u0.x; w[j][1] = u0.y; w[j][2] = u0.z; w[j][3] = u0.w; w[j][4] = u1.x; w[j][5] = u1.y; w[j][6] = u1.z; w[j][7] = u1.w; }
        { const f32x4 u0 = *(const f32x4*)(conv_b + cc), u1 = *(const f32x4*)(conv_b + cc + 4); cb[0] = u0.x; cb[1] = u0.y; cb[2] = u0.z; cb[3] = u0.w; cb[4] = u1.x; cb[5] = u1.y; cb[6] = u1.z; cb[7] = u1.w; }
#pragma unroll
        for (int e = 0; e < 8; ++e) { a0[e] = 0.f; a1[e] = 0.f; a2[e] = 0.f; }
        const int ts = t0 >= 3 ? t0 - 3 : 0;
        const bf16* pc = P + OFF_XBC + cc; bf16* xo = XC + cc;
        v4u un[4];
#pragma unroll
        for (int k = 0; k < 4; ++k) { const int tt = ts + k < t1 ? ts + k : t1 - 1; un[k] = *(const v4u*)(pc + (size_t)tt * NPAD); }
        for (int tb = ts; tb < t1; tb += 4) { v4u uc[4];
#pragma unroll
            for (int k = 0; k < 4; ++k) uc[k] = un[k];
            if (tb + 4 < t1) {
#pragma unroll
                for (int k = 0; k < 4; ++k) { const int tt = tb + 4 + k < t1 ? tb + 4 + k : t1 - 1; un[k] = *(const v4u*)(pc + (size_t)tt * NPAD); } }
#pragma unroll
            for (int k = 0; k < 4; ++k) { const int t = tb + k; if (t < t1) {
                const bool smp = t >= NTOK_P; const bool st = smp ? (((t - NTOK_P) & 31) == 0) : ((t & 2047) == 0);
                if (st) {
                    if (smp) { const float* cbuf = state_conv + (size_t)((t - NTOK_P) >> 5) * 4608 + cc;
#pragma unroll
                        for (int e = 0; e < 8; ++e) { a0[e] = cbuf[e]; a1[e] = cbuf[1536 + e]; a2[e] = cbuf[3072 + e]; } }
                    else {
#pragma unroll
                        for (int e = 0; e < 8; ++e) { a0[e] = 0.f; a1[e] = 0.f; a2[e] = 0.f; } } }
                float cur[8]; PRE_UNPK(cur, uc[k]);
                if (t >= t0) { float o[8];
#pragma unroll
                    for (int e = 0; e < 8; ++e) o[e] = siluf_(cb[e] + w[0][e] * a0[e] + w[1][e] * a1[e] + w[2][e] * a2[e] + w[3][e] * cur[e]);
                    v4u ov; ov.x = pk2(o[0], o[1]); ov.y = pk2(o[2], o[3]); ov.z = pk2(o[4], o[5]); ov.w = pk2(o[6], o[7]);
                    *(v4u*)(xo + (size_t)t * 1536) = ov; }
#pragma unroll
                for (int e = 0; e < 8; ++e) { a0[e] = a1[e]; a1[e] = a2[e]; a2[e] = cur[e]; } } }
        }
    }
#undef PRE_UNPK
    const int dsp = NGW >= 528 * 2 ? NGW / (528 * 2) : 1;
    for (int it = (gw % dsp == 0) ? gw / dsp : 1056; it < 1056; it += NGW / dsp) {
        const int rb = it >> 1, h0 = (it & 1) * 8; const size_t row = (size_t)rb * 64 + lane;
        const v4u d0 = *(const v4u*)(P + row * NPAD + OFF_DT + h0);
        const float xr[8] = {bflo(d0.x), bfhi(d0.x), bflo(d0.y), bfhi(d0.y), bflo(d0.z), bfhi(d0.z), bflo(d0.w), bfhi(d0.w)};
        float dtv[8], av[8], csv[8];
#pragma unroll
        for (int h = 0; h < 8; ++h) { const float xv = xr[h] + dt_bias[h0 + h]; const float eu = __expf(-fabsf(xv)), ew = 1.0f + eu;
            const float l1p = (ew == 1.0f) ? eu : __logf(ew) * (eu * __builtin_amdgcn_rcpf(ew - 1.0f)); const float dt = fmaxf(xv, 0.f) + l1p; const float a = -dt * __expf(a_log[h0 + h]); dtv[h] = dt; av[h] = a; csv[h] = a; }
#pragma unroll
        for (int o = 1; o < 64; o <<= 1) {
#pragma unroll
            for (int h = 0; h < 8; ++h) { const float t = __shfl_up(csv[h], o); if (lane >= o) csv[h] += t; } }
#pragma unroll
        for (int q = 0; q < 2; ++q) { *(f32x4*)(DTb + row * 16 + h0 + 4 * q) = (f32x4){dtv[4 * q], dtv[4 * q + 1], dtv[4 * q + 2], dtv[4 * q + 3]};
            *(f32x4*)(ADT + row * 16 + h0 + 4 * q) = (f32x4){av[4 * q], av[4 * q + 1], av[4 * q + 2], av[4 * q + 3]};
            *(f32x4*)(ACUM + row * 16 + h0 + 4 * q) = (f32x4){csv[4 * q], csv[4 * q + 1], csv[4 * q + 2], csv[4 * q + 3]}; }
    }
    for (int e = gw * 64 + lane; e < 48 * 4608; e += NGW * 64) {
        const int sq = e / 4608, r = e - sq * 4608, j = r / 1536, cc = r - j * 1536;
        const size_t row = sq < 16 ? (size_t)sq * 2048 + 2045 + j : (size_t)NTOK_P + (sq - 16) * 32 + 29 + j;
        const float v = bf1(P[row * NPAD + OFF_XBC + cc]);
        if (sq < 16) conv_out_p[sq * 4608 + r] = v; else conv_out_s[(sq - 16) * 4608 + r] = v;
    }
}

__device__ __forceinline__ void ssd_item(LAS unsigned char* lds, int tid, int lane, int wave, const bf16* P, const bf16* XC, const float* DTb, const float* ADT, bf16* YB, int row0, int T, int h,
                                         const float* s0, float* sout, float Dh) {
    LAS float* X = (LAS float*)lds;
    LAS float* Bs = X + 2048;
    LAS float* Cs = Bs + 4096;
    LAS float* DT = Cs + 4096;
    LAS float* DA = DT + 32;
    LAS float* PY = DA + 32;
    const int g = h >> 3, ci = tid;
    int cc = 0; LAS float* dst = X; int dstride = 64;
    if (ci < 64) { cc = h * 64 + ci; dst = X + ci; dstride = 64; } else if (ci < 192) { cc = 1024 + g * 128 + (ci - 64); dst = Bs + (ci - 64); dstride = 128; } else if (ci < 320) { cc = 1280 + g * 128 + (ci - 192); dst = Cs + (ci - 192); dstride = 128; }
    float hst[16];
#pragma unroll
    for (int j = 0; j < 4; ++j) { f32x4 v = (f32x4){0.f, 0.f, 0.f, 0.f}; if (s0) v = *(const f32x4*)(s0 + lane * 128 + 16 * wave + 4 * j); hst[4 * j] = v.x; hst[4 * j + 1] = v.y; hst[4 * j + 2] = v.z; hst[4 * j + 3] = v.w; }
    __syncthreads();
    const int nch = T / 32;
    for (int c = 0; c < nch; ++c) {
        const size_t rbase = (size_t)(row0 + c * 32);
        if (ci < 320) { const bf16* pc = XC + rbase * 1536 + cc;
            bf16 sv[32];
#pragma unroll
            for (int t = 0; t < 32; ++t) sv[t] = pc[(size_t)t * 1536];
#pragma unroll
            for (int t = 0; t < 32; ++t) dst[t * dstride] = bf1(sv[t]); }
        else if (ci < 352) { const int t = ci - 320; DT[t] = DTb[(rbase + t) * 16 + h]; DA[t] = __expf(ADT[(rbase + t) * 16 + h]); }
        unsigned zg[2];
#pragma unroll
        for (int j = 0; j < 2; ++j) { const int e = tid + 512 * j; zg[j] = *(const unsigned*)(P + (rbase + (e >> 5)) * NPAD + OFF_BZ + h * 64 + (e & 31) * 2); }
        __syncthreads();
#pragma unroll 2
        for (int t = 0; t < 32; ++t) {
            const float dA = DA[t], xdt = X[t * 64 + lane] * DT[t]; float py = 0.f;
#pragma unroll
            for (int n4 = 0; n4 < 4; ++n4) { const f32x4 b4 = *(const LAS f32x4*)(Bs + t * 128 + 16 * wave + 4 * n4), c4 = *(const LAS f32x4*)(Cs + t * 128 + 16 * wave + 4 * n4);
#pragma unroll
                for (int j = 0; j < 4; ++j) { const int nn = 4 * n4 + j; hst[nn] = fmaf(xdt, b4[j], dA * hst[nn]); py = fmaf(hst[nn], c4[j], py); } }
            PY[(t * 8 + wave) * 64 + lane] = py;
        }
        __syncthreads();
#pragma unroll
        for (int j = 0; j < 2; ++j) { const int e = tid + 512 * j, t = e >> 5, p2 = (e & 31) * 2; float y0 = 0.f, y1 = 0.f;
#pragma unroll
            for (int w = 0; w < 8; ++w) { const f32x2 p = *(const LAS f32x2*)(PY + (t * 8 + w) * 64 + p2); y0 += p.x; y1 += p.y; }
            const f32x2 xv = *(const LAS f32x2*)(X + t * 64 + p2); y0 += Dh * xv.x; y1 += Dh * xv.y;
            const size_t row = rbase + t; const unsigned z = zg[j];
            *(unsigned*)(YB + row * 1024 + h * 64 + p2) = pk2(y0 * siluf_(bflo(z)), y1 * siluf_(bfhi(z))); }
        __syncthreads();
    }
#pragma unroll
    for (int j = 0; j < 4; ++j) *(f32x4*)(sout + lane * 128 + 16 * wave + 4 * j) = (f32x4){hst[4 * j], hst[4 * j + 1], hst[4 * j + 2], hst[4 * j + 3]};
    __syncthreads();
}

__device__ __forceinline__ bf16 v4u_el(const v4u& d, int e) { const unsigned w = d[e >> 1]; return (bf16)((e & 1) ? (w >> 16) : (w & 0xffffu)); }
__device__ __forceinline__ void ssd_mfma_pair(LAS unsigned char* lds, int tid, int lane, int wave, const bf16* P, const bf16* XC, const float* DTb, const float* ACUM, bf16* YB, int row0, int h0, float Dh0, float Dh1, float* sout0) {
    constexpr int PC = 136, PS = 72;
    LAS bf16* Cm0 = (LAS bf16*)lds;
    LAS bf16* Bm = Cm0 + 2 * 64 * PC;
    LAS bf16* BmT = Bm + 64 * PC;
    LAS bf16* XT0 = BmT + 128 * PS;
    LAS bf16* Mm0 = XT0 + 4 * 64 * PS;
    LAS float* AC0 = (LAS float*)(Mm0 + 2 * 64 * PS);
    static_assert((2 * 64 * PC + 64 * PC + 128 * PS + 4 * 64 * PS + 2 * 64 * PS) * 2 + 4 * 192 * 4 <= RING_BYTES, "ssd pair LDS");
    const int fr = lane & 15, fq = lane >> 4, g = h0 >> 3;
    const int hw = wave >> 2, pt = wave & 3;
    __syncthreads();
    f32x4 hacc[8];
#pragma unroll
    for (int j = 0; j < 8; ++j) hacc[j] = (f32x4){0.f, 0.f, 0.f, 0.f};
    int pf_s[6], pf_c[6]; v4u pf[6];
#pragma unroll
    for (int j = 0; j < 6; ++j) { const int q = tid + 512 * j; pf_s[j] = q / 48; const int c16 = q - 48 * pf_s[j];
        const int col = c16 < 16 ? (h0 + (c16 >> 3)) * 64 + 8 * (c16 & 7) : (c16 < 32 ? 1024 + g * 128 + 8 * (c16 - 16) : 1280 + g * 128 + 8 * (c16 - 32));
        pf_c[j] = (c16 << 16) | col; pf[j] = *(const v4u*)((const char*)XC + (unsigned)(((unsigned)row0 + pf_s[j]) * 1536u + col) * 2u); }
    float pf_ac = 0.f, pf_dt = 0.f, pf_acl = 0.f; const int sh = tid >> 6, ssx = tid & 63;
    if (tid < 128) { pf_ac = *(const float*)((const char*)ACUM + (unsigned)(((unsigned)row0 + ssx) * 16u + h0 + sh) * 4u); pf_dt = *(const float*)((const char*)DTb + (unsigned)(((unsigned)row0 + ssx) * 16u + h0 + sh) * 4u); pf_acl = *(const float*)((const char*)ACUM + (unsigned)(((unsigned)row0 + 63u) * 16u + h0 + sh) * 4u); }
    for (int c = 0; c < 32; ++c) {
        const unsigned rbase = (unsigned)row0 + 64u * c;
        bf16 zr[4][4];
#pragma unroll
        for (int li = 0; li < 4; ++li)
#pragma unroll
            for (int r = 0; r < 4; ++r) zr[li][r] = *(const bf16*)((const char*)P + (unsigned)((rbase + 16 * li + 4 * fq + r) * (unsigned)NPAD + OFF_BZ + (h0 + hw) * 64 + 16 * pt + fr) * 2u);
        const int cb = c & 1;
        LAS bf16* Cm = Cm0 + cb * 64 * PC; LAS bf16* XTb = XT0 + cb * 2 * 64 * PS; LAS float* ACb = AC0 + cb * 2 * 192;
        if (tid < 128) { LAS float* A = ACb + sh * 192; A[ssx] = pf_ac; A[128 + ssx] = pf_dt; A[64 + ssx] = __expf(pf_acl - pf_ac) * pf_dt; }
#pragma unroll
        for (int j = 0; j < 6; ++j) { const int s = pf_s[j], c16 = pf_c[j] >> 16; const v4u d = pf[j];
            if (c16 < 16) { LAS bf16* XT = XTb + (c16 >> 3) * 64 * PS; const int cc = c16 & 7;
#pragma unroll
                for (int e = 0; e < 8; ++e) XT[(8 * cc + e) * PS + (s ^ (cc << 3))] = v4u_el(d, e); }
            else if (c16 < 32) { const int n0 = 8 * (c16 - 16); *(LAS v4u*)(Bm + s * PC + n0) = d;
#pragma unroll
                for (int e = 0; e < 8; ++e) BmT[(n0 + e) * PS + (s ^ (((c16 - 16) & 7) << 3))] = v4u_el(d, e); }
            else { *(LAS v4u*)(Cm + s * PC + 8 * (c16 - 32)) = d; } }
        if (c + 1 < 32) {
#pragma unroll
            for (int j = 0; j < 6; ++j) pf[j] = *(const v4u*)((const char*)XC + (unsigned)((rbase + 64u + pf_s[j]) * 1536u + (pf_c[j] & 0xffff)) * 2u);
            if (tid < 128) { pf_ac = *(const float*)((const char*)ACUM + (unsigned)((rbase + 64u + ssx) * 16u + h0 + sh) * 4u); pf_dt = *(const float*)((const char*)DTb + (unsigned)((rbase + 64u + ssx) * 16u + h0 + sh) * 4u); pf_acl = *(const float*)((const char*)ACUM + (unsigned)((rbase + 127u) * 16u + h0 + sh) * 4u); } }
        BAR_LDS();
        const LAS float* AC = ACb + hw * 192; const LAS bf16* XT = XTb + hw * 64 * PS;
        f32x4 yo[4];
        { bf16x8_t hb[4];
#pragma unroll
          for (int m = 0; m < 4; ++m) { v4u o; o.x = pk2(hacc[2 * m][0], hacc[2 * m][1]); o.y = pk2(hacc[2 * m][2], hacc[2 * m][3]); o.z = pk2(hacc[2 * m + 1][0], hacc[2 * m + 1][1]); o.w = pk2(hacc[2 * m + 1][2], hacc[2 * m + 1][3]);
              hb[m] = __builtin_bit_cast(bf16x8_t, o); }
#pragma unroll
          for (int li = 0; li < 4; ++li) { yo[li] = (f32x4){0.f, 0.f, 0.f, 0.f};
#pragma unroll
              for (int m = 0; m < 4; ++m) { const LAS bf16* cp = Cm + (16 * li + fr) * PC + 32 * m + 4 * fq; const v2u c0 = *(const LAS v2u*)cp, c1 = *(const LAS v2u*)(cp + 16);
                  v4u xo; xo.x = c0.x; xo.y = c0.y; xo.z = c1.x; xo.w = c1.y; yo[li] = MFMA16(__builtin_bit_cast(bf16x8_t, xo), hb[m], yo[li]); } } }
        { const LAS float* WU = AC + 64; const float dec = __expf(AC[63]);
          bf16x8_t xs[2];
#pragma unroll
          for (int ss = 0; ss < 2; ++ss) { const v4u d = *(const LAS v4u*)(XT + (16 * pt + fr) * PS + ((32 * ss + 8 * fq) ^ (((2 * pt + (fr >> 3)) & 7) << 3)));
              const f32x4 wa = *(const LAS f32x4*)(WU + 32 * ss + 8 * fq), wb = *(const LAS f32x4*)(WU + 32 * ss + 8 * fq + 4);
              v4u o; o.x = pk2(bflo(d.x) * wa.x, bfhi(d.x) * wa.y); o.y = pk2(bflo(d.y) * wa.z, bfhi(d.y) * wa.w); o.z = pk2(bflo(d.z) * wb.x, bfhi(d.z) * wb.y); o.w = pk2(bflo(d.w) * wb.z, bfhi(d.w) * wb.w);
              xs[ss] = __builtin_bit_cast(bf16x8_t, o); }
#pragma unroll
          for (int j = 0; j < 8; ++j) { hacc[j] = hacc[j] * dec;
#pragma unroll
              for (int ss = 0; ss < 2; ++ss) hacc[j] = MFMA16(LDFRAG(BmT, 16 * j + fr, PS, (32 * ss + 8 * fq) ^ (((2 * j + (fr >> 3)) & 7) << 3)), xs[ss], hacc[j]); } }
        {
            const int li = wave >> 1, si0 = 2 * (wave & 1);
#pragma unroll
            for (int tt = 0; tt < 2; ++tt) { const int si = si0 + tt; f32x4 acc = (f32x4){0.f, 0.f, 0.f, 0.f};
                if (si <= li) {
#pragma unroll
                    for (int ks = 0; ks < 4; ++ks) acc = MFMA16(LDFRAG(Cm, 16 * li + fr, PC, 32 * ks + 8 * fq), LDFRAG(Bm, 16 * si + fr, PC, 32 * ks + 8 * fq), acc); }
                const int s = 16 * si + fr;
#pragma unroll
                for (int hh = 0; hh < 2; ++hh) { const LAS float* A2 = ACb + hh * 192; LAS bf16* Mm = Mm0 + hh * 64 * PS; const float acs = A2[s], dts = A2[128 + s];
#pragma unroll
                    for (int r = 0; r < 4; ++r) { const int l = 16 * li + 4 * fq + r; const float m = (s <= l) ? acc[r] * __expf(A2[l] - acs) * dts : 0.f; Mm[l * PS + s] = (bf16)f2bf(m); } } }
        }
        BAR_LDS();
        {
            const LAS bf16* Mm = Mm0 + hw * 64 * PS; const int h = h0 + hw; const float Dh = hw ? Dh1 : Dh0; const int p = 16 * pt + fr;
            bf16x8_t xf[2];
#pragma unroll
            for (int ss = 0; ss < 2; ++ss) xf[ss] = LDFRAG(XT, 16 * pt + fr, PS, (32 * ss + 8 * fq) ^ (((2 * pt + (fr >> 3)) & 7) << 3));
#pragma unroll
            for (int li = 0; li < 4; ++li) { f32x4 yd = (f32x4){0.f, 0.f, 0.f, 0.f};
#pragma unroll
                for (int ss = 0; ss < 2; ++ss) { if (ss == 1 && li < 2) continue;
                    yd = MFMA16(LDFRAG(Mm, 16 * li + fr, PS, 32 * ss + 8 * fq), xf[ss], yd); }
#pragma unroll
                for (int r = 0; r < 4; ++r) { const int l = 16 * li + 4 * fq + r; const float y = yd[r] + __expf(AC[l]) * yo[li][r] + Dh * bf1(XT[p * PS + (l ^ (((p >> 3) & 7) << 3))]);
                    const float z = bf1(zr[li][r]);
                    *(bf16*)((char*)YB + (unsigned)((rbase + l) * 1024u + h * 64 + p) * 2u) = (bf16)f2bf(y * siluf_(z)); } }
        }
    }
#pragma unroll
    for (int j = 0; j < 8; ++j) *(f32x4*)(sout0 + (size_t)hw * 8192 + (16 * pt + fr) * 128 + 16 * j + 4 * fq) = hacc[j];
    __syncthreads();
}

__device__ __forceinline__ unsigned cm_off_b(unsigned row, unsigned ch) { return 256u * row + 16u * (ch ^ (((row & 3u) << 2) | ((row >> 2) & 3u))); }
__device__ __forceinline__ unsigned cm_tr_addr(unsigned lane, unsigned c, unsigned ks, unsigned t) { const unsigned g = lane >> 4, q = (lane & 15) >> 2, p = lane & 3; return cm_off_b(32 * ks + 8 * g + 4 * t + q, 2 * c + (p >> 1)) + 8 * (p & 1); }
__device__ __forceinline__ void cmlp_mfma_item(LAS unsigned char* lds, int tid, int lane, int wave, bf16* P, bf16* YC, int row0, const float* ln_g, const float* ln_b, const float* wsl, const float* bsl) {
    constexpr int PW = 136;
    LAS bf16* Wb = (LAS bf16*)lds;
    LAS unsigned char* Vimg = lds + 34816;
    LAS bf16* OUTb = (LAS bf16*)(lds + 67584);
    LAS float* ST = (LAS float*)(lds + ST_OFF);
    const int fr = lane & 15, fq = lane >> 4;
    __syncthreads();
    v4u sa[4], sb[4];
    const unsigned cvo = (unsigned)(((unsigned)row0 + (unsigned)wave * 16u) * (unsigned)NPAD + OFF_CV + 16u * lane) * 2u;
#pragma unroll
    for (int j = 0; j < 4; ++j) { const v4u* p = (const v4u*)((const char*)P + cvo + (unsigned)j * (unsigned)(NPAD * 2)); sa[j] = p[0]; sb[j] = p[1]; }
#pragma unroll 1
    for (int ib = 0; ib < 4; ++ib) {
        v4u na[4], nb[4];
        if (ib < 3) {
#pragma unroll
            for (int j = 0; j < 4; ++j) { const v4u* p = (const v4u*)((const char*)P + cvo + (unsigned)(4 * ib + 4 + j) * (unsigned)(NPAD * 2)); na[j] = p[0]; nb[j] = p[1]; } }
#pragma unroll
        for (int j = 0; j < 4; ++j) { const int s = wave * 16 + 4 * ib + j; const v4u a = sa[j], b = sb[j];
            float v[16]; v[0] = bflo(a.x); v[1] = bfhi(a.x); v[2] = bflo(a.y); v[3] = bfhi(a.y); v[4] = bflo(a.z); v[5] = bfhi(a.z); v[6] = bflo(a.w); v[7] = bfhi(a.w);
            v[8] = bflo(b.x); v[9] = bfhi(b.x); v[10] = bflo(b.y); v[11] = bfhi(b.y); v[12] = bflo(b.z); v[13] = bfhi(b.z); v[14] = bflo(b.w); v[15] = bfhi(b.w);
            float sm = 0.f;
#pragma unroll
            for (int q = 0; q < 16; ++q) { v[q] = geluf_(v[q]); sm += v[q]; }
            v4u oa, ob; oa.x = pk2(v[0], v[1]); oa.y = pk2(v[2], v[3]); oa.z = pk2(v[4], v[5]); oa.w = pk2(v[6], v[7]); ob.x = pk2(v[8], v[9]); ob.y = pk2(v[10], v[11]); ob.z = pk2(v[12], v[13]); ob.w = pk2(v[14], v[15]);
            v4u* po = (v4u*)((char*)P + cvo + (unsigned)(4 * ib + j) * (unsigned)(NPAD * 2)); po[0] = oa; po[1] = ob;
            const float mean = wave_sum(sm) * (1.0f / 1024.0f); float sq = 0.f;
#pragma unroll
            for (int q = 0; q < 16; ++q) { const float d = v[q] - mean; sq += d * d; }
            const float rstd = rsqrtf_(wave_sum(sq) * (1.0f / 1024.0f) + NORM_EPS);
            if (lane == 0) { ST[2 * s] = mean; ST[2 * s + 1] = rstd; } }
        if (ib < 3) {
#pragma unroll
            for (int j = 0; j < 4; ++j) { sa[j] = na[j]; sb[j] = nb[j]; } }
    }
    __syncthreads();
    f32x4 wreg[8]; v2u vreg[8];
#pragma unroll
    for (int e = 0; e < 8; ++e) { const int q = tid + 512 * e; wreg[e] = *(const f32x4*)(wsl + (size_t)(q >> 5) * 128 + 4 * (q & 31)); vreg[e] = *(const v2u*)(P + (size_t)(row0 + (q >> 5)) * NPAD + OFF_CV + 4 * (q & 31)); }
    for (int gh = 0; gh < 8; ++gh) { const int g = gh >> 1, c0 = gh * 128;
        if ((gh & 1) == 0) {
#pragma unroll
            for (int e = 0; e < 8; ++e) { const int q = tid + 512 * e, t = q >> 5, s4 = 4 * (q & 31); const f32x4 w = wreg[e];
                v2u o; o.x = pk2(s4 + 0 <= t ? w.x : 0.f, s4 + 1 <= t ? w.y : 0.f); o.y = pk2(s4 + 2 <= t ? w.z : 0.f, s4 + 3 <= t ? w.w : 0.f); *(LAS v2u*)(Wb + t * PW + s4) = o; } }
#pragma unroll
        for (int e = 0; e < 8; ++e) { const int q = tid + 512 * e, sr = q >> 5, c4 = 4 * (q & 31); const v2u cv = vreg[e]; const float mean = ST[2 * sr], rstd = ST[2 * sr + 1];
            const f32x4 lg = *(const f32x4*)(ln_g + c0 + c4), lb = *(const f32x4*)(ln_b + c0 + c4);
            v2u o; o.x = pk2((bflo(cv.x) - mean) * rstd * lg.x + lb.x, (bfhi(cv.x) - mean) * rstd * lg.y + lb.y); o.y = pk2((bflo(cv.y) - mean) * rstd * lg.z + lb.z, (bfhi(cv.y) - mean) * rstd * lg.w + lb.w);
            *(LAS v2u*)(Vimg + cm_off_b((unsigned)sr, (unsigned)(c4 >> 3)) + 2 * (c4 & 7)) = o; }
        v4u ureg[4];
#pragma unroll
        for (int e = 0; e < 4; ++e) { const int q = tid + 512 * e; ureg[e] = *(const v4u*)(P + (size_t)(row0 + (q >> 4)) * NPAD + OFF_CU + c0 + 8 * (q & 15)); }
        if (gh + 1 < 8) {
#pragma unroll
            for (int e = 0; e < 8; ++e) { const int q = tid + 512 * e; vreg[e] = *(const v2u*)(P + (size_t)(row0 + (q >> 5)) * NPAD + OFF_CV + c0 + 128 + 4 * (q & 31)); }
            if (gh & 1) {
#pragma unroll
                for (int e = 0; e < 8; ++e) { const int q = tid + 512 * e; wreg[e] = *(const f32x4*)(wsl + ((size_t)(g + 1) * 128 + (q >> 5)) * 128 + 4 * (q & 31)); } } }
        BAR_LDS();
        { f32x4 acc[8];
#pragma unroll
            for (int ti = 0; ti < 8; ++ti) acc[ti] = (f32x4){0.f, 0.f, 0.f, 0.f};
            const unsigned vb = (unsigned)(size_t)Vimg;
#pragma unroll
            for (int ks = 0; ks < 4; ++ks) { v2u y0, y1;
                asm volatile("ds_read_b64_tr_b16 %0, %2\n\tds_read_b64_tr_b16 %1, %3\n\ts_waitcnt lgkmcnt(0)" : "=&v"(y0), "=&v"(y1) : "v"(vb + cm_tr_addr((unsigned)lane, (unsigned)wave, (unsigned)ks, 0u)), "v"(vb + cm_tr_addr((unsigned)lane, (unsigned)wave, (unsigned)ks, 1u)) : "memory");
                v4u yy; yy.x = y0.x; yy.y = y0.y; yy.z = y1.x; yy.w = y1.y; const bf16x8_t yf = __builtin_bit_cast(bf16x8_t, yy);
#pragma unroll
                for (int ti = 2 * ks; ti < 8; ++ti) acc[ti] = MFMA16(LDFRAG(Wb, 16 * ti + fr, PW, 32 * ks + 8 * fq), yf, acc[ti]); }
#pragma unroll
            for (int ti = 0; ti < 8; ++ti)
#pragma unroll
                for (int r = 0; r < 4; ++r) OUTb[(16 * ti + 4 * fq + r) * PW + 16 * wave + fr] = (bf16)f2bf(acc[ti][r]); }
        BAR_LDS();
#pragma unroll
        for (int e = 0; e < 4; ++e) { const int q = tid + 512 * e, t = q >> 4, c8 = 8 * (q & 15); const v4u o = *(const LAS v4u*)(OUTb + t * PW + c8); const v4u u = ureg[e]; const float bsv = bsl[g * 128 + t];
            v4u y; y.x = pk2(geluf_(bflo(u.x)) * (bflo(o.x) + bsv), geluf_(bfhi(u.x)) * (bfhi(o.x) + bsv)); y.y = pk2(geluf_(bflo(u.y)) * (bflo(o.y) + bsv), geluf_(bfhi(u.y)) * (bfhi(o.y) + bsv));
            y.z = pk2(geluf_(bflo(u.z)) * (bflo(o.z) + bsv), geluf_(bfhi(u.z)) * (bfhi(o.z) + bsv)); y.w = pk2(geluf_(bflo(u.w)) * (bflo(o.w) + bsv), geluf_(bfhi(u.w)) * (bfhi(o.w) + bsv));
            *(v4u*)(YC + (size_t)(row0 + t) * 1024 + c0 + c8) = y; }
    }
    __syncthreads();
}

__device__ __forceinline__ void cmlp_item(LAS unsigned char* lds, int tid, int lane, int wave, const bf16* P, bf16* YC, int row0, int Lc,
                                          const float* ln_g, const float* ln_b, const float* wsl, const float* bsl, float* vout) {
    LAS float* WT = (LAS float*)lds;
    LAS float* V = WT + 16384;
    LAS float* ST = (LAS float*)(lds + ST_OFF);
    __syncthreads();
    for (int i = 0; i < 16; ++i) { const int s = wave * 16 + i; if (s < Lc) {
            const v4u* p = (const v4u*)(P + (size_t)(row0 + s) * NPAD + OFF_CV + 16 * lane); const v4u a = p[0], b = p[1];
            float v[16]; v[0] = bflo(a.x); v[1] = bfhi(a.x); v[2] = bflo(a.y); v[3] = bfhi(a.y); v[4] = bflo(a.z); v[5] = bfhi(a.z); v[6] = bflo(a.w); v[7] = bfhi(a.w);
            v[8] = bflo(b.x); v[9] = bfhi(b.x); v[10] = bflo(b.y); v[11] = bfhi(b.y); v[12] = bflo(b.z); v[13] = bfhi(b.z); v[14] = bflo(b.w); v[15] = bfhi(b.w);
            float sm = 0.f;
#pragma unroll
            for (int j = 0; j < 16; ++j) { v[j] = geluf_(v[j]); sm += v[j]; }
            const float mean = wave_sum(sm) * (1.0f / 1024.0f); float sq = 0.f;
#pragma unroll
            for (int j = 0; j < 16; ++j) { const float d = v[j] - mean; sq += d * d; }
            const float rstd = 1.0f / sqrtf(wave_sum(sq) * (1.0f / 1024.0f) + NORM_EPS);
            if (lane == 0) { ST[2 * s] = mean; ST[2 * s + 1] = rstd; } } }
    const int tg = tid >> 4, cg = tid & 15;
    for (int g = 0; g < 4; ++g) {
        __syncthreads();
#pragma unroll 1
        for (int j = 0; j < 8; ++j) { const int e = tid + 512 * j, s4 = (e >> 7) * 4, t = e & 127;
            f32x4 w = (f32x4){0.f, 0.f, 0.f, 0.f}; if (t < Lc && s4 < Lc) w = *(const f32x4*)(wsl + ((size_t)g * 128 + t) * 128 + s4);
#pragma unroll
            for (int jj = 0; jj < 4; ++jj) WT[(s4 + jj) * 128 + t] = (s4 + jj <= t) ? w[jj] : 0.f; }
        for (int half = 0; half < 2; ++half) { const int c0 = g * 256 + half * 128;
            if (half) __syncthreads();
#pragma unroll 2
            for (int j = 0; j < 8; ++j) { const int e = tid + 512 * j, s = e >> 5, c4 = (e & 31) * 4;
                if (s < Lc) { const v2u cv = *(const v2u*)(P + (size_t)(row0 + s) * NPAD + OFF_CV + c0 + c4); const float mean = ST[2 * s], rstd = ST[2 * s + 1];
                    const f32x4 lg = *(const f32x4*)(ln_g + c0 + c4), lb = *(const f32x4*)(ln_b + c0 + c4);
                    f32x4 v; v.x = (geluf_(bflo(cv.x)) - mean) * rstd * lg.x + lb.x; v.y = (geluf_(bfhi(cv.x)) - mean) * rstd * lg.y + lb.y; v.z = (geluf_(bflo(cv.y)) - mean) * rstd * lg.z + lb.z; v.w = (geluf_(bfhi(cv.y)) - mean) * rstd * lg.w + lb.w;
                    *(LAS f32x4*)(V + s * 128 + c4) = v; if (vout) *(f32x4*)(vout + (size_t)s * 1024 + c0 + c4) = v; } }
            __syncthreads();
            float acc[4][8];
#pragma unroll
            for (int i = 0; i < 4; ++i)
#pragma unroll
                for (int j = 0; j < 8; ++j) acc[i][j] = 0.f;
            for (int s = 0; s < Lc; ++s) { const f32x4 w4 = *(const LAS f32x4*)(WT + s * 128 + 4 * tg), va = *(const LAS f32x4*)(V + s * 128 + 4 * cg), vb = *(const LAS f32x4*)(V + s * 128 + 64 + 4 * cg);
#pragma unroll
                for (int i = 0; i < 4; ++i) {
#pragma unroll
                    for (int j = 0; j < 4; ++j) { acc[i][j] = fmaf(w4[i], va[j], acc[i][j]); acc[i][4 + j] = fmaf(w4[i], vb[j], acc[i][4 + j]); } } }
#pragma unroll
            for (int i = 0; i < 4; ++i) { const int t = 4 * tg + i; if (t < Lc) { const size_t row = (size_t)(row0 + t); const float bsv = bsl[g * 128 + t];
                    const v2u ua = *(const v2u*)(P + row * NPAD + OFF_CU + c0 + 4 * cg), ub = *(const v2u*)(P + row * NPAD + OFF_CU + c0 + 64 + 4 * cg);
                    v2u oa, ob; oa.x = pk2(geluf_(bflo(ua.x)) * (acc[i][0] + bsv), geluf_(bfhi(ua.x)) * (acc[i][1] + bsv)); oa.y = pk2(geluf_(bflo(ua.y)) * (acc[i][2] + bsv), geluf_(bfhi(ua.y)) * (acc[i][3] + bsv));
                    ob.x = pk2(geluf_(bflo(ub.x)) * (acc[i][4] + bsv), geluf_(bfhi(ub.x)) * (acc[i][5] + bsv)); ob.y = pk2(geluf_(bflo(ub.y)) * (acc[i][6] + bsv), geluf_(bfhi(ub.y)) * (acc[i][7] + bsv));
                    *(v2u*)(YC + row * 1024 + c0 + 4 * cg) = oa; *(v2u*)(YC + row * 1024 + c0 + 64 + 4 * cg) = ob; } }
        }
    }
    __syncthreads();
}

#ifndef DOWN_REV
#define DOWN_REV 1
#endif
#ifndef EPI_ALIGN_HEAVY
#define EPI_ALIGN_HEAVY true
#endif
#ifndef TAIL_SPLIT
#define TAIL_SPLIT 1
#endif
#ifndef MK_N_LAUNCHES
#define MK_N_LAUNCHES 1
#endif
constexpr int PH_PER_LAYER = 10, N_PHASES = 2 + DEPTH * PH_PER_LAYER;
constexpr int Q_NITEMS = 128 + 128 + 256 + 256 + 512 + 32;
struct Args { const float* in[29]; float* out; unsigned char* ws; int ph_lo, ph_hi; };
static_assert(sizeof(Args) == 29 * 8 + 8 + 8 + 8, "no padding in Args");

typedef const __attribute__((address_space(4))) unsigned long long* karg_t;
__device__ __forceinline__ unsigned long long ldarg(int i) { karg_t p = (karg_t)__builtin_amdgcn_kernarg_segment_ptr(); asm volatile("" : "+s"(p)); return p[i]; }
#define INP(i) ((const float*)(const GAS float*)ldarg(i))
#define OUTP() ((float*)(GAS float*)ldarg(29))
#define WSP() ((unsigned char*)(GAS unsigned char*)ldarg(30))

__device__ __forceinline__ int tid_now(int wave_s) { return (int)__builtin_amdgcn_mbcnt_hi(~0u, __builtin_amdgcn_mbcnt_lo(~0u, 0u)) + 64 * wave_s; }
__global__ void __launch_bounds__(NWAVES * 64, 2) fwd(Args args) {
    extern __shared__ __attribute__((aligned(16))) unsigned char lds_raw[];
    LAS unsigned char* lds = (LAS unsigned char*)lds_raw;
    volatile LAS unsigned* MISC = (volatile LAS unsigned*)(lds + MISC_OFF);
    const int wave_s = __builtin_amdgcn_readfirstlane((int)threadIdx.x >> 6);
    for (int u = threadIdx.x; u < 64; u += NWAVES * 64) MISC[u] = 0u;
    __syncthreads();
    XcdBarrier bar = xcd_barrier_post((unsigned*)WSP() + CW_BAR, MISC + 8, (int)threadIdx.x);
    const int lo = args.ph_lo, hi = args.ph_hi;
#define IN(k) (lo <= (k) && (k) < hi)
#define SEAM(k) do { if (IN((k) + 1)) { XcdBarrier b2_ = bar; b2_.bar = (unsigned*)WSP() + CW_BAR; asm volatile("" : "+s"(b2_.x)); xcd_barrier(b2_, tid_now(wave_s)); } } while (0)
#define GEOM() int tid = tid_now(wave_s); asm volatile("" : "+v"(tid)); int G = gridDim.x, bx = blockIdx.x; asm volatile("" : "+s"(G), "+s"(bx)); \
    const int lane = tid & 63, wave = __builtin_amdgcn_readfirstlane(tid >> 6); \
    const int vcu = (G % 8 == 0) ? (bx % 8) * (G / 8) + bx / 8 : bx; const int gw = vcu * NWAVES + wave, NGW = G * NWAVES; (void)lane; (void)gw; (void)NGW; (void)wave; (void)tid

    if (IN(0)) { GEOM();
        for (int it = bx; it < DEPTH * 96; it += G) mod_item(lds, tid, it, INP(5), INP(6), INP(9), INP(10), (float*)(WSP() + WS_MOD));
        { unsigned char* ws = WSP(); cvt_phase<true>(lds, wave, lane, 0, 0, 0, INP(11), INP(24), INP(25), INP(26), INP(27), ws + wofs(0), (unsigned*)ws + CW_QC); }
        SEAM(0);
    }
    for (int lc = 0; lc < DEPTH; ++lc) {
        const int pb = 1 + PH_PER_LAYER * lc;
        if (IN(pb + 0)) { GEOM(); int l = lc; asm volatile("" : "+s"(l)); unsigned char* ws = WSP(); bf16* X = (bf16*)(ws + WS_X);
            const bool comb = TAIL_SPLIT && l > 0; if (comb) build_tail_map((LAS int*)lds, tid, G, DOWN_REV);
            const float* modl = (const float*)(ws + WS_MOD) + (size_t)l * NSEQ * 12288;
            if (l == 0) norm_mod_phase<true>(lane, gw, NGW, INP(0), INP(1), X, INP(7), modl, 0, 1, (bf16*)(ws + WS_H), false, (const LAS int*)lds, (const float*)(ws + WS_SLAB), false);
            else norm_mod_phase<false>(lane, gw, NGW, nullptr, nullptr, X, INP(7) + l * DM, modl, 0, 1, (bf16*)(ws + WS_H), comb, (const LAS int*)lds, (const float*)(ws + WS_SLAB), false);
            SEAM(pb + 0);
        }
        if (IN(pb + 1)) { unsigned char* ws = WSP(); const int G = gridDim.x, bx = blockIdx.x;
            pg8::Gemm g{(const bf16*)(ws + WS_H), (const bf16*)(ws + wofs(lc) + WS_WIN), MT, NPAD, DM, DM}; pg8::StaticOrder S; S.init(MT, NPAD, G, bx);
            pg8::EpiStore<0> E{(bf16*)(ws + WS_P), NPAD};
#ifndef REP_P1
#define REP_P1 1
#endif
#pragma unroll 1
            for (int rp = 0; rp < REP_P1; ++rp)
#ifndef WIN_B_AUX
#define WIN_B_AUX 0
#endif
#ifdef SPLIT_WIN
            { S.nlim = (S.nwg / (2 * G)) * G; pg8::gemm_phase<pg8::EpiStore<0>, pg8::StaticOrder, true, true, 0, WIN_B_AUX>(lds, g, S, E, tid_now(wave_s));
              { XcdBarrier b2_ = bar; b2_.bar = (unsigned*)WSP() + CW_BAR; asm volatile("" : "+s"(b2_.x)); xcd_barrier(b2_, tid_now(wave_s)); }
              S.off = S.nlim; S.nlim = S.nwg; }
#endif
            pg8::gemm_phase<pg8::EpiStore<0>, pg8::StaticOrder, true, true, 0, WIN_B_AUX>(lds, g, S, E, tid_now(wave_s));
            SEAM(pb + 1);
        }
        if (IN(pb + 2)) { GEOM(); int l = lc; asm volatile("" : "+s"(l)); unsigned char* ws = WSP(); float* out = OUTP();
#ifndef REP_P2
#define REP_P2 1
#endif
#pragma unroll 1
            for (int rp = 0; rp < REP_P2; ++rp)
            ssd_pre_phase(lane, gw, NGW, (const bf16*)(ws + WS_P), (bf16*)(ws + WS_XC), (float*)(ws + WS_DT), (float*)(ws + WS_DT + DT_ARR), (float*)(ws + WS_DT + 2 * DT_ARR),
                          INP(14) + (size_t)l * 4 * 1536, INP(15) + l * 1536, INP(16) + l * 16, INP(17) + l * 16, INP(4) + (size_t)l * 32 * 4608, out + OUT_CONV_P + (size_t)l * 16 * 4608, out + OUT_CONV_S + (size_t)l * 32 * 4608);
            SEAM(pb + 2);
        }
        if (IN(pb + 3)) { GEOM(); int l = lc; asm volatile("" : "+s"(l));
#ifndef MIX_REPS
#define MIX_REPS 1
#endif
#pragma unroll 1
            for (int rep = 0; rep < MIX_REPS; ++rep)
            for (;;) {
                unsigned char* ws = WSP(); float* out = OUTP(); bf16* Pb = (bf16*)(ws + WS_P); bf16* Y3 = (bf16*)(ws + WS_Y3);
                __syncthreads();
                if (tid_now(wave_s) == 0) MISC[0] = __hip_atomic_fetch_add((unsigned*)ws + CW_Q + 64 * (l + 4 * rep), 1u, __ATOMIC_RELAXED, __HIP_MEMORY_SCOPE_AGENT);
                __syncthreads();
                int it = (int)MISC[0];
#ifdef EXTRA_BASE
                if (it >= Q_NITEMS && it < Q_NITEMS + EXTRA_N) it = EXTRA_BASE + (it - Q_NITEMS);
#endif
                if (it >= Q_NITEMS) break;
                it = it < 256 ? it : (it < 288 ? it + 1024 : it - 32);
#define ITEM_GEOM() int tid_i = tid_now(wave_s); asm volatile("" : "+v"(tid_i)); const int lane_i = tid_i & 63, wave_i = __builtin_amdgcn_readfirstlane(tid_i >> 6)
                if (it < 128) {
                    const int b = 15 - (it >> 3), h = it & 7;
                    ITEM_GEOM(); hgrn_mfma_item(lds, tid_i, lane_i, wave_i, Pb, Y3, b * 2048, h, l, out + OUT_HGRN_P + (((size_t)l * 16 + b) * 8 + h) * 16384, INP(12), INP(13) + l * 1024);
                } else if (it < 256) {
                    const int j = it - 128, b = 15 - (j >> 3), h0 = 2 * (j & 7);
                    ITEM_GEOM(); ssd_mfma_pair(lds, tid_i, lane_i, wave_i, Pb, (const bf16*)(ws + WS_XC), (const float*)(ws + WS_DT), (const float*)(ws + WS_DT + 2 * DT_ARR), Y3 + (size_t)MT * 1024, b * 2048, h0, INP(18)[l * 16 + h0], INP(18)[l * 16 + h0 + 1],
                                  out + OUT_SSM_P + (((size_t)l * 16 + b) * 16 + h0) * 8192);
                } else if (it < 512) {
                    ITEM_GEOM(); cmlp_mfma_item(lds, tid_i, lane_i, wave_i, Pb, Y3 + (size_t)2 * MT * 1024, (255 - (it - 256)) * 128, INP(20) + l * 1024, INP(21) + l * 1024, INP(22) + (size_t)l * 4 * 16384, INP(23) + l * 512);
                } else if (it < 768) {
                    const int j = it - 512, b = j >> 3, h = j & 7;
                    ITEM_GEOM(); hgrn_item(lds, tid_i, lane_i, wave_i, Pb, Y3, NTOK_P + b * 32, 32, h, l, INP(2) + (((size_t)l * 32 + b) * 8 + h) * 16384, out + OUT_HGRN_S + (((size_t)l * 32 + b) * 8 + h) * 16384, INP(12), INP(13) + l * 1024);
                } else if (it < 1280) {
                    const int j = it - 768, b = j >> 4, h = j & 15;
                    ITEM_GEOM(); ssd_item(lds, tid_i, lane_i, wave_i, Pb, (const bf16*)(ws + WS_XC), (const float*)(ws + WS_DT), (const float*)(ws + WS_DT + DT_ARR), Y3 + (size_t)MT * 1024, NTOK_P + b * 32, 32, h,
                             INP(3) + (((size_t)l * 32 + b) * 16 + h) * 8192, out + OUT_SSM_S + (((size_t)l * 32 + b) * 16 + h) * 8192, INP(18)[l * 16 + h]);
                } else {
                    const int j = it - 1280;
                    ITEM_GEOM(); cmlp_item(lds, tid_i, lane_i, wave_i, Pb, Y3 + (size_t)2 * MT * 1024, NTOK_P + j * 32, 32, INP(20) + l * 1024, INP(21) + l * 1024, INP(22) + (size_t)l * 4 * 16384, INP(23) + l * 512, out + OUT_V_S + ((size_t)l * 32 + j) * 32 * 1024);
                }
            }
            SEAM(pb + 3);
        }
        if (IN(pb + 4)) { GEOM(); int l = lc; asm volatile("" : "+s"(l)); ssd_norm_phase(lane, gw, NGW, (bf16*)(WSP() + WS_Y3) + (size_t)MT * 1024, INP(19) + l * 1024); SEAM(pb + 4); }
        if (IN(pb + 5)) { unsigned char* ws = WSP(); const int G = gridDim.x, bx = blockIdx.x;
            pg8::Gemm g{(const bf16*)(ws + WS_Y3), (const bf16*)(ws + wofs(lc) + WS_WBR), 3 * MT, 3 * DM, 1024, 1024}; pg8::BranchOrder S; S.init(MT / 256, DM / 256, G, bx);
            pg8::EpiBranch E{(const bf16*)(ws + WS_P), NPAD, OFF_GATE, (bf16*)(ws + WS_H), DM, MT / 256, DM / 256};
#ifndef STAGGER_BR
#define STAGGER_BR 0
#endif
            if (STAGGER_BR && ((bx >> 3) & 1)) { for (int i = 0; i < STAGGER_BR; ++i) __builtin_amdgcn_s_sleep(127); }
#ifndef REP_P5
#define REP_P5 1
#endif
#pragma unroll 1
            for (int rp = 0; rp < REP_P5; ++rp)
            pg8::gemm_phase<pg8::EpiBranch, pg8::BranchOrder, EPI_ALIGN_HEAVY, true>(lds, g, S, E, tid_now(wave_s));
            if (lc + 1 < DEPTH) {
                GEOM(); int l1 = lc + 1; asm volatile("" : "+s"(l1)); unsigned char* ws2 = WSP();
                cvt_phase<true>(lds, wave, lane, 0, 0, l1, INP(11), INP(24), INP(25), INP(26), INP(27), ws2 + wofs(l1), (unsigned*)ws2 + CW_QC + 64 * l1);
#ifdef REP_CVT
                cvt_phase<true>(lds, wave, lane, 0, 0, l1, INP(11), INP(24), INP(25), INP(26), INP(27), ws2 + wofs(l1), (unsigned*)ws2 + CW_QC + 64 * (l1 + 4));
#endif
            }
            SEAM(pb + 5);
        }
        if (IN(pb + 6)) { int l = lc; asm volatile("" : "+s"(l)); unsigned char* ws = WSP(); bf16* X = (bf16*)(ws + WS_X); const int G = gridDim.x, bx = blockIdx.x;
            pg8::StaticOrder S; S.init(MT, DM, G, bx); S.wgm = WGM_N8; const int nfull = TAIL_SPLIT ? tail_nfull(S.nwg, G) : S.nwg; S.nlim = nfull;
            const float* gm = (const float*)(ws + WS_MOD) + (size_t)l * NSEQ * 12288 + 2 * DM;
            { pg8::Gemm g{(const bf16*)(ws + WS_H), (const bf16*)(ws + wofs(lc) + WS_WOUT), MT, DM, DM, DM};
#ifdef REP_P6
              { pg8::EpiRes E0{X, (const float*)(ws + 524288), 0}; pg8::gemm_phase<pg8::EpiRes, pg8::StaticOrder, EPI_ALIGN_HEAVY, true>(lds, g, S, E0, tid_now(wave_s)); }
#endif
              pg8::EpiRes E{X, gm, 12288};
              pg8::gemm_phase<pg8::EpiRes, pg8::StaticOrder, EPI_ALIGN_HEAVY, true>(lds, g, S, E, tid_now(wave_s)); }
            if (TAIL_SPLIT) { pg8::Gemm g{(const bf16*)(ws + WS_H), (const bf16*)(ws + wofs(lc) + WS_WOUT), MT, DM, DM / 8, DM}; pg8::TailOrder T; T.init(S, nfull, 8, DM / 8);
              pg8::EpiSlab E{(float*)(ws + WS_SLAB), gm};
              pg8::gemm_phase<pg8::EpiSlab, pg8::TailOrder, true, true>(lds, g, T, E, tid_now(wave_s)); }
            SEAM(pb + 6);
        }
        if (IN(pb + 7)) { GEOM(); int l = lc; asm volatile("" : "+s"(l)); unsigned char* ws = WSP(); bf16* X = (bf16*)(ws + WS_X);
            if (TAIL_SPLIT) build_tail_map((LAS int*)lds, tid, G, 0);
#ifdef REP_N7
            norm_mod_phase<false>(lane, gw, NGW, nullptr, nullptr, X, INP(8) + l * DM, (const float*)(ws + WS_MOD) + (size_t)l * NSEQ * 12288, 3, 4, (bf16*)(ws + WS_H), false, (const LAS int*)lds, (const float*)(ws + WS_SLAB), true);
#endif
            norm_mod_phase<false>(lane, gw, NGW, nullptr, nullptr, X, INP(8) + l * DM, (const float*)(ws + WS_MOD) + (size_t)l * NSEQ * 12288, 3, 4, (bf16*)(ws + WS_H), TAIL_SPLIT != 0, (const LAS int*)lds, (const float*)(ws + WS_SLAB), true); SEAM(pb + 7); }
        if (IN(pb + 8)) { unsigned char* ws = WSP(); const int G = gridDim.x, bx = blockIdx.x;
            pg8::Gemm g{(const bf16*)(ws + WS_H), (const bf16*)(ws + wofs(lc) + WS_WUP), MT, DFF, DM, DM}; pg8::StaticOrder S; S.init(MT, DFF, G, bx);
            pg8::EpiStore<1> E{(bf16*)(ws + WS_P), DFF};
#ifndef REP_P8
#define REP_P8 1
#endif
#pragma unroll 1
            for (int rp = 0; rp < REP_P8; ++rp)
            pg8::gemm_phase<pg8::EpiStore<1>, pg8::StaticOrder, true, true, 0, WIN_B_AUX>(lds, g, S, E, tid_now(wave_s));
            SEAM(pb + 8);
        }
        if (IN(pb + 9)) { int l = lc; asm volatile("" : "+s"(l)); unsigned char* ws = WSP(); bf16* X = (bf16*)(ws + WS_X); const int G = gridDim.x, bx = blockIdx.x;
            pg8::StaticOrder S; S.init(MT, DM, G, bx); S.wgm = WGM_N8; S.rev = DOWN_REV; const int nfull = TAIL_SPLIT ? tail_nfull(S.nwg, G) : S.nwg; S.nlim = nfull;
            const float* gm = (const float*)(ws + WS_MOD) + (size_t)l * NSEQ * 12288 + 5 * DM;
            { pg8::Gemm g{(const bf16*)(ws + WS_P), (const bf16*)(ws + wofs(lc) + WS_WDN), MT, DM, DFF, DFF};
#ifdef REP_P9
              { pg8::EpiRes E0{X, (const float*)(ws + 524288), 0}; pg8::gemm_phase<pg8::EpiRes, pg8::StaticOrder, EPI_ALIGN_HEAVY, true>(lds, g, S, E0, tid_now(wave_s)); }
#endif
              pg8::EpiRes E{X, gm, 12288};
#ifndef DOWN_A_AUX
#define DOWN_A_AUX 0
#endif
              pg8::gemm_phase<pg8::EpiRes, pg8::StaticOrder, EPI_ALIGN_HEAVY, true, DOWN_A_AUX>(lds, g, S, E, tid_now(wave_s)); }
            if (TAIL_SPLIT) { pg8::Gemm g{(const bf16*)(ws + WS_P), (const bf16*)(ws + wofs(lc) + WS_WDN), MT, DM, DFF / 8, DFF}; pg8::TailOrder T; T.init(S, nfull, 8, DFF / 8);
              pg8::EpiSlab E{(float*)(ws + WS_SLAB), gm};
              pg8::gemm_phase<pg8::EpiSlab, pg8::TailOrder, true, true>(lds, g, T, E, tid_now(wave_s)); }
            SEAM(pb + 9);
        }
    }
    if (IN(N_PHASES - 1)) { GEOM(); unsigned char* ws = WSP(); if (TAIL_SPLIT) build_tail_map((LAS int*)lds, tid, G, DOWN_REV);
        final_norm_phase(lane, gw, NGW, (const bf16*)(ws + WS_X), OUTP(), INP(28), TAIL_SPLIT != 0, (const LAS int*)lds, (const float*)(ws + WS_SLAB)); }
#undef IN
#undef SEAM
#undef GEOM
}

extern "C" void kernel_launch(void* const* d_in, const int* in_sizes, int n_in, void* d_out, int out_size, void* d_ws, size_t ws_size, hipStream_t stream) {
    static int grid = 0;
    if (grid == 0) {
        if (n_in != 29 || (size_t)out_size != OUT_TOTAL || ws_size < WS_END) { fprintf(stderr, "kernel_launch: unexpected shapes: n_in %d out %d ws %zu (need %zu)\n", n_in, out_size, ws_size, (size_t)WS_END); grid = -1; return; }
        int dev = 0, cus = 0, per_cu = 0;
        if (hipGetDevice(&dev) != hipSuccess || hipDeviceGetAttribute(&cus, hipDeviceAttributeMultiprocessorCount, dev) != hipSuccess) { grid = -1; return; }
        if (hipFuncSetAttribute((const void*)fwd, hipFuncAttributeMaxDynamicSharedMemorySize, LDS_BYTES) != hipSuccess) { fprintf(stderr, "kernel_launch: hipFuncSetAttribute failed\n"); grid = -1; return; }
        if (hipOccupancyMaxActiveBlocksPerMultiprocessor(&per_cu, (const void*)fwd, NWAVES * 64, LDS_BYTES) != hipSuccess || per_cu < 1) fprintf(stderr, "kernel_launch: occupancy query says %d\n", per_cu);
        (void)hipGetLastError();
        grid = cus;
    }
    if (grid < 0) return;
    if (hipMemsetAsync((char*)d_ws + WS_CTL, 0, CTL_ZERO_BYTES, stream) != hipSuccess) return;
    Args a{};
    for (int i = 0; i < 29; ++i) a.in[i] = (const float*)d_in[i];
    a.out = (float*)d_out; a.ws = (unsigned char*)d_ws;
#if MK_N_LAUNCHES == 1
    a.ph_lo = 0; a.ph_hi = N_PHASES;
    hipLaunchKernelGGL(fwd, dim3(grid), dim3(NWAVES * 64), LDS_BYTES, stream, a);
#else
    for (int p = 0; p < N_PHASES; ++p) { a.ph_lo = p; a.ph_hi = p + 1; hipLaunchKernelGGL(fwd, dim3(grid), dim3(NWAVES * 64), LDS_BYTES, stream, a); }
#endif
}
```

```cpp
#include <hip/hip_runtime.h>
#include <cstdio>
#include <cstdint>
namespace pg8 {
#define PG8_LAS __attribute__((address_space(3)))
typedef unsigned short bf16_t;
typedef short bf16x8 __attribute__((ext_vector_type(8)));
typedef float f32x4 __attribute__((ext_vector_type(4)));
typedef unsigned u32x4 __attribute__((ext_vector_type(4)));
constexpr int BM = 256, BK = 64, HALF = 128, HTB = HALF * BK * 2  , STAGE_BYTES = 8 * HTB, NXCD = 8, WGM = 4;

__host__ __device__ __forceinline__ int lds_byte(int r, int c) { const int st = (r >> 4) * 2 + (c >> 5), rr = r & 15, cc = c & 31, ob = rr * 64 + cc * 2; return st * 1024 + (ob ^ (((ob >> 9) & 1) << 5)); }
__host__ __device__ __forceinline__ void stage_rc(int b, int& R, int& C) { const int st = b / 1024, sb = b % 1024, swz = sb ^ (((sb >> 9) & 1) << 5); R = (st >> 1) * 16 + swz / 64; C = (st & 1) * 32 + (swz % 64) / 2; }
__host__ __device__ __forceinline__ int perm32(int rho) { const int n = rho >> 4, i = rho & 15; return 8 * (i >> 2) + 4 * n + (i & 3); }

struct Unit { int pm, pn, ko, aux; };
struct Gemm { const bf16_t* A; const bf16_t* Bt; int M, N, K, ld; };

struct StaticOrder {
    int nM, nN, nwg, G, c, nlim, rev, wgm, off;
    __host__ __device__ void init(int M, int N, int G_, int c_) { nM = M / BM; nN = N / BM; nwg = nM * nN; G = G_; c = c_; nlim = nwg; rev = 0; wgm = WGM; off = 0; }
    __host__ __device__ void tile_of(int wgid, Unit& u) const {
        { const int q = nwg / NXCD, r = nwg % NXCD, xcd = wgid % NXCD, off = wgid / NXCD; wgid = (xcd < r ? xcd * (q + 1) : r * (q + 1) + (xcd - r) * q) + off; }
        const int nig = wgm * nN, gid = wgid / nig, fm = gid * wgm, gsz = (nM - fm) < wgm ? (nM - fm) : wgm;
        u.pm = fm + ((wgid % nig) % gsz); u.pn = (wgid % nig) / gsz; u.ko = 0; u.aux = 0; if (rev) u.pm = nM - 1 - u.pm; }
    __host__ __device__ bool next(int i, Unit& u) const {
        const long L = (long)i * G + c + off; if (L >= nlim) return false;
        tile_of((int)L, u); return true;
    }
    __device__ __forceinline__ void a_ready(const Unit&) const {}
    __device__ __forceinline__ void done(const Unit&) const {}
};
typedef float pg8_f32x2 __attribute__((ext_vector_type(2))); typedef __bf16 pg8_bf16x2 __attribute__((ext_vector_type(2)));
__device__ __forceinline__ unsigned cvt_pk_bf16(float lo, float hi) { const pg8_f32x2 v = {lo, hi}; const pg8_bf16x2 b = __builtin_convertvector(v, pg8_bf16x2); return __builtin_bit_cast(unsigned, b); }
typedef unsigned u32x2 __attribute__((ext_vector_type(2)));
__device__ __forceinline__ float bf_lo(unsigned w) { return __uint_as_float(w << 16); }
__device__ __forceinline__ float bf_hi(unsigned w) { return __uint_as_float(w & 0xffff0000u); }
__device__ __forceinline__ float fast_sigmoid(float x) { return __builtin_amdgcn_rcpf(1.0f + __builtin_amdgcn_exp2f(-1.44269504089f * x)); }

#ifndef EPI_BATCH_BARRIER
#define EPI_BATCH_BARRIER 0
#endif
#ifndef EPI_NT_GATE
#define EPI_NT_GATE 1
#endif
#ifndef EPI_NT_STORE
#define EPI_NT_STORE 0
#endif
template <int ACT> struct EpiStore {
    static constexpr bool PERM = true, AFTER_DRAIN = false;
    bf16_t* O; int ldc;
    __device__ __forceinline__ void operator()(const f32x4 (&acc)[2][2][4][2], const Unit& u, int wr, int wc, int fr, int fq) const {
        const int row0 = u.pm * BM + wr * 64 + fr, col0 = u.pn * BM + wc * 32 + 8 * fq;
#pragma unroll
        for (int ai = 0; ai < 2; ++ai)
#pragma unroll
            for (int m = 0; m < 4; ++m) { bf16_t* rowp = O + (size_t)(row0 + ai * HALF + m * 16) * ldc + col0;
#pragma unroll
                for (int bj = 0; bj < 2; ++bj) { f32x4 v0 = acc[ai][bj][m][0], v1 = acc[ai][bj][m][1];
                    if (ACT == 1) {
#pragma unroll
                        for (int j = 0; j < 4; ++j) { const float a = fmaxf(v0[j], 0.f), b = fmaxf(v1[j], 0.f); v0[j] = a * a; v1[j] = b * b; } }
                    u32x4 w; w.x = cvt_pk_bf16(v0[0], v0[1]); w.y = cvt_pk_bf16(v0[2], v0[3]); w.z = cvt_pk_bf16(v1[0], v1[1]); w.w = cvt_pk_bf16(v1[2], v1[3]);
                    if (EPI_NT_STORE) __builtin_nontemporal_store(w, (u32x4*)(rowp + bj * HALF)); else *(u32x4*)(rowp + bj * HALF) = w; } }
    }
};

struct EpiBranch {
    static constexpr bool PERM = true, AFTER_DRAIN = false;
    const bf16_t* P; int ldp; int gate_off; bf16_t* MG; int ldm; int npm, npn;
    __device__ __forceinline__ void operator()(const f32x4 (&acc)[2][2][4][2], const Unit& u, int wr, int wc, int fr, int fq) const {
        const int k = u.pm / npm, pm = u.pm - k * npm, pn = u.pn - k * npn;
        const int row0 = pm * BM + wr * 64 + fr, col0 = pn * BM + wc * 32 + 8 * fq;
#pragma unroll
        for (int ai = 0; ai < 2; ++ai)
#pragma unroll
            for (int m = 0; m < 4; ++m) { const size_t r = (size_t)(row0 + ai * HALF + m * 16);
                const bf16_t* gp = P + r * ldp + gate_off + k * 2048 + col0; bf16_t* mp = MG + r * ldm + col0;
#pragma unroll
                for (int bj = 0; bj < 2; ++bj) { const u32x4 g = EPI_NT_GATE ? __builtin_nontemporal_load((const u32x4*)(gp + bj * HALF)) : *(const u32x4*)(gp + bj * HALF);
                    f32x4 v0 = acc[ai][bj][m][0], v1 = acc[ai][bj][m][1];
                    v0[0] *= fast_sigmoid(bf_lo(g.x)); v0[1] *= fast_sigmoid(bf_hi(g.x)); v0[2] *= fast_sigmoid(bf_lo(g.y)); v0[3] *= fast_sigmoid(bf_hi(g.y));
                    v1[0] *= fast_sigmoid(bf_lo(g.z)); v1[1] *= fast_sigmoid(bf_hi(g.z)); v1[2] *= fast_sigmoid(bf_lo(g.w)); v1[3] *= fast_sigmoid(bf_hi(g.w));
                    if (k > 0) { const u32x4 p = *(const u32x4*)(mp + bj * HALF);
                        v0[0] += bf_lo(p.x); v0[1] += bf_hi(p.x); v0[2] += bf_lo(p.y); v0[3] += bf_hi(p.y);
                        v1[0] += bf_lo(p.z); v1[1] += bf_hi(p.z); v1[2] += bf_lo(p.w); v1[3] += bf_hi(p.w); }
                    u32x4 w; w.x = cvt_pk_bf16(v0[0], v0[1]); w.y = cvt_pk_bf16(v0[2], v0[3]); w.z = cvt_pk_bf16(v1[0], v1[1]); w.w = cvt_pk_bf16(v1[2], v1[3]);
                    *(u32x4*)(mp + bj * HALF) = w; }
                if (EPI_BATCH_BARRIER && m == 3) asm volatile("" ::: "memory"); }
    }
};

struct EpiRes {
    static constexpr bool PERM = true, AFTER_DRAIN = false;
    bf16_t* X; const float* gmod; int gstride;
    __device__ __forceinline__ void operator()(const f32x4 (&acc)[2][2][4][2], const Unit& u, int wr, int wc, int fr, int fq) const {
        const int row0 = u.pm * BM + wr * 64 + fr, col0 = u.pn * BM + wc * 32 + 8 * fq;
#pragma unroll
        for (int ai = 0; ai < 2; ++ai)
#pragma unroll
            for (int m = 0; m < 4; ++m) { const int r = row0 + ai * HALF + m * 16;
                const int seq = r < 32768 ? (r >> 11) : 16 + ((r - 32768) >> 5);
                const float* gp = gmod + (size_t)seq * gstride + col0; bf16_t* xp = X + (size_t)r * 2048 + col0;
#pragma unroll
                for (int bj = 0; bj < 2; ++bj) { const f32x4 g0 = *(const f32x4*)(gp + bj * HALF), g1 = *(const f32x4*)(gp + bj * HALF + 4); const u32x4 b = *(const u32x4*)(xp + bj * HALF);
                    const f32x4 v0 = acc[ai][bj][m][0] * g0, v1 = acc[ai][bj][m][1] * g1;
                    u32x4 w; w.x = cvt_pk_bf16(bf_lo(b.x) + v0[0], bf_hi(b.x) + v0[1]); w.y = cvt_pk_bf16(bf_lo(b.y) + v0[2], bf_hi(b.y) + v0[3]);
                    w.z = cvt_pk_bf16(bf_lo(b.z) + v1[0], bf_hi(b.z) + v1[1]); w.w = cvt_pk_bf16(bf_lo(b.w) + v1[2], bf_hi(b.w) + v1[3]);
                    *(u32x4*)(xp + bj * HALF) = w; }
                if (EPI_BATCH_BARRIER && m == 3) asm volatile("" ::: "memory"); }
    }
};

struct BranchOrder {
    int G, c, npm, npn, ntile;
    __device__ void init(int npm_, int npn_, int G_, int c_) { npm = npm_; npn = npn_; ntile = npm_ * npn_; G = G_; c = c_; }
    __device__ bool next(int i, Unit& u) const {
        const int ti = i / 3, k = i - 3 * ti; const long L = (long)ti * G + c; if (L >= ntile) return false;
        int wgid = (int)L; { const int q = ntile / NXCD, r = ntile % NXCD, xcd = wgid % NXCD, off = wgid / NXCD; wgid = (xcd < r ? xcd * (q + 1) : r * (q + 1) + (xcd - r) * q) + off; }
        const int nig = WGM * npn, gid = wgid / nig, fm = gid * WGM, gsz = (npm - fm) < WGM ? (npm - fm) : WGM;
        u.pm = k * npm + fm + ((wgid % nig) % gsz); u.pn = k * npn + (wgid % nig) / gsz; u.ko = 0; u.aux = 0; return true;
    }
    __device__ __forceinline__ void a_ready(const Unit&) const {}
    __device__ __forceinline__ void done(const Unit&) const {}
};


struct EpiResAtomic {
    static constexpr bool PERM = false, AFTER_DRAIN = false;
    float* out; const float* gmod;
    __device__ __forceinline__ void operator()(const f32x4 (&acc)[2][2][4][2], const Unit& u, int wr, int wc, int fr, int fq) const {
        const int row0 = u.pm * BM + wr * 64 + fr, col0 = u.pn * BM + wc * 32 + 4 * fq;
#pragma unroll
        for (int ai = 0; ai < 2; ++ai)
#pragma unroll
            for (int m = 0; m < 4; ++m) { const int r = row0 + ai * HALF + m * 16;
                const int seq = r < 32768 ? (r >> 11) : 16 + ((r - 32768) >> 5);
                const float* gp = gmod + (size_t)seq * 12288 + col0; float* op = out + (size_t)r * 2048 + col0;
#pragma unroll
                for (int bj = 0; bj < 2; ++bj)
#pragma unroll
                    for (int n = 0; n < 2; ++n) { const f32x4 g = *(const f32x4*)(gp + bj * HALF + n * 16); const f32x4 v = g * acc[ai][bj][m][n]; float* o = op + bj * HALF + n * 16;
                        typedef __attribute__((address_space(1))) float gfloat; gfloat* og = (gfloat*)o;
                        (void)__builtin_amdgcn_global_atomic_fadd_f32(og + 0, v.x); (void)__builtin_amdgcn_global_atomic_fadd_f32(og + 1, v.y); (void)__builtin_amdgcn_global_atomic_fadd_f32(og + 2, v.z); (void)__builtin_amdgcn_global_atomic_fadd_f32(og + 3, v.w); } }
    }
};
struct TailOrder {
    StaticOrder base; int nfull, SL, Ks;
    __device__ void init(const StaticOrder& b, int nfull_, int SL_, int Ks_) { base = b; nfull = nfull_; SL = SL_; Ks = Ks_; }
    __device__ bool next(int i, Unit& u) const { const long L = (long)i * base.G + base.c; if (L >= (long)(base.nwg - nfull) * SL) return false;
        const int t = (int)L / SL, sl = (int)L - t * SL; base.tile_of(nfull + t, u); u.ko = sl * Ks; u.aux = (int)L; return true; }
    __device__ __forceinline__ void a_ready(const Unit&) const {}
    __device__ __forceinline__ void done(const Unit&) const {}
};

struct EpiSlab {
    static constexpr bool PERM = false, AFTER_DRAIN = false;
    float* slab; const float* gmod;
    __device__ __forceinline__ void operator()(const f32x4 (&acc)[2][2][4][2], const Unit& u, int wr, int wc, int fr, int fq) const {
        const int rt0 = wr * 64 + fr, ct0 = wc * 32 + 4 * fq; float* sb = slab + (size_t)u.aux * 65536;
#pragma unroll
        for (int ai = 0; ai < 2; ++ai)
#pragma unroll
            for (int m = 0; m < 4; ++m) { const int rt = rt0 + ai * HALF + m * 16, r = u.pm * BM + rt;
                const int seq = r < 32768 ? (r >> 11) : 16 + ((r - 32768) >> 5);
                const float* gp = gmod + (size_t)seq * 12288 + u.pn * BM + ct0; float* op = sb + rt * 256 + ct0;
#pragma unroll
                for (int bj = 0; bj < 2; ++bj)
#pragma unroll
                    for (int n = 0; n < 2; ++n) { const f32x4 g = *(const f32x4*)(gp + bj * HALF + n * 16); *(f32x4*)(op + bj * HALF + n * 16) = g * acc[ai][bj][m][n]; } }
    }
};
template <class Epi, class Sched, bool ALIGN_EPI = false, bool SP2 = false, int A_AUX = 0, int B_AUX = 0>
__device__ __forceinline__ void gemm_phase(PG8_LAS unsigned char* lds, const Gemm g, const Sched& S, const Epi& E, int tid_in) {
    int tid_ = tid_in; asm volatile("" : "+v"(tid_));
    const int tid = tid_, wid = __builtin_amdgcn_readfirstlane(tid >> 6), lane = tid & 63, wr = wid >> 2, wc = wid & 3, fr = lane & 15, fq = lane >> 4;
    const int K = g.K, ld = g.ld, nt = K / BK;
    unsigned voffA[2], voffB[2];
#pragma unroll
    for (int i = 0; i < 2; ++i) { int R, C; stage_rc(tid * 16 + i * 8192, R, C); const int Rb = Epi::PERM ? ((R & ~31) + perm32(R & 31)) : R;
        voffA[i] = (unsigned)(R * ld + C) * 2u; voffB[i] = (unsigned)(Rb * ld + C) * 2u; }
    const size_t kstep = (size_t)(BK * 2);
    const size_t hstep = (size_t)HALF * ld * 2;
    const size_t tstep = 2 * hstep;
    const unsigned ldsw = (unsigned)wid * 1024u;
    const int aoff = lds_byte(wr * 64 + fr, fq * 8), boff = lds_byte(wc * 32 + fr, fq * 8);
#define PG8_SA(b, h) (((b) * 2 + (h)) * HTB)
#define PG8_SB(b, h) ((4 + (b) * 2 + (h)) * HTB)
#define PG8_STAGE(bufoff, gbase, voff) do { _Pragma("unroll") for (int _i = 0; _i < 2; ++_i) \
        __builtin_amdgcn_global_load_lds((const unsigned*)((const char*)(gbase) + (voff)[_i]), (PG8_LAS unsigned*)(lds + (bufoff) + ldsw + _i * 8192), 16, 0, B_AUX); } while (0)
#define PG8_STAGEA(bufoff, gbase, voff) do { _Pragma("unroll") for (int _i = 0; _i < 2; ++_i) \
        __builtin_amdgcn_global_load_lds((const unsigned*)((const char*)(gbase) + (voff)[_i]), (PG8_LAS unsigned*)(lds + (bufoff) + ldsw + _i * 8192), 16, 0, A_AUX); } while (0)
#define PG8_LDA(dst, b, h) do { _Pragma("unroll") for (int m = 0; m < 4; ++m) _Pragma("unroll") for (int k = 0; k < 2; ++k) dst[m][k] = *(const PG8_LAS bf16x8*)(lds + PG8_SA(b, h) + aoff + m * 2048 + k * 1024); } while (0)
#define PG8_LDB(dst, b, h) do { _Pragma("unroll") for (int n = 0; n < 2; ++n) _Pragma("unroll") for (int k = 0; k < 2; ++k) dst[n][k] = *(const PG8_LAS bf16x8*)(lds + PG8_SB(b, h) + boff + n * 2048 + k * 1024); } while (0)
#define PG8_MMA(ai, bj, At, Bt) do { __builtin_amdgcn_s_setprio(1); _Pragma("unroll") for (int m = 0; m < 4; ++m) _Pragma("unroll") for (int n = 0; n < 2; ++n) _Pragma("unroll") for (int k = 0; k < 2; ++k) \
        acc[ai][bj][m][n] = __builtin_amdgcn_mfma_f32_16x16x32_bf16(Bt[n][k], At[m][k], acc[ai][bj][m][n], 0, 0, 0); __builtin_amdgcn_s_setprio(0); } while (0)
#define PG8_WAIT_V(n) asm volatile("s_waitcnt vmcnt(" #n ")" ::: "memory")
#define PG8_WAIT_L(n) asm volatile("s_waitcnt lgkmcnt(" #n ")" ::: "memory")
#define PG8_BAR __builtin_amdgcn_s_barrier()
#define PG8_SCHED __builtin_amdgcn_sched_barrier(0)
    Unit cur, nxt; int ui = 0;
    if (!S.next(0, cur)) return;
    f32x4 acc[2][2][4][2];
#pragma unroll
    for (int a = 0; a < 2; ++a)
#pragma unroll
        for (int b = 0; b < 2; ++b)
#pragma unroll
            for (int m = 0; m < 4; ++m)
#pragma unroll
                for (int n = 0; n < 2; ++n) acc[a][b][m][n] = (f32x4){0.f, 0.f, 0.f, 0.f};
    bf16x8 At[4][2], B0[2][2], B1[2][2];
    const char* cA = (const char*)g.A + (size_t)cur.pm * tstep + (size_t)cur.ko * 2; const char* cB = (const char*)g.Bt + (size_t)cur.pn * tstep + (size_t)cur.ko * 2;
    S.a_ready(cur);
    if constexpr (SP2) {
        PG8_STAGE(PG8_SB(0, 0), cB, voffB); PG8_STAGE(PG8_SB(0, 1), cB + hstep, voffB); PG8_STAGEA(PG8_SA(0, 0), cA, voffA); PG8_STAGEA(PG8_SA(0, 1), cA + hstep, voffA);
        if (wr == 1) PG8_BAR;
        PG8_WAIT_V(2); PG8_BAR;
        PG8_STAGE(PG8_SB(1, 0), cB + kstep, voffB); PG8_STAGEA(PG8_SA(1, 0), cA + kstep, voffA); PG8_STAGE(PG8_SB(1, 1), cB + hstep + kstep, voffB);
        PG8_WAIT_V(6); PG8_BAR;
    } else {
        PG8_STAGE(PG8_SB(0, 0), cB, voffB); PG8_STAGEA(PG8_SA(0, 0), cA, voffA); PG8_STAGE(PG8_SB(0, 1), cB + hstep, voffB); PG8_STAGEA(PG8_SA(0, 1), cA + hstep, voffA);
        if (wr == 1) PG8_BAR;
        PG8_WAIT_V(4); PG8_BAR;
        PG8_STAGE(PG8_SB(1, 0), cB + kstep, voffB); PG8_STAGEA(PG8_SA(1, 0), cA + kstep, voffA); PG8_STAGE(PG8_SB(1, 1), cB + hstep + kstep, voffB);
        PG8_WAIT_V(6); PG8_BAR;
    }
    for (;;) {
        const bool has_next = S.next(ui + 1, nxt);
        const char* nA = has_next ? (const char*)g.A + (size_t)nxt.pm * tstep + (size_t)nxt.ko * 2 : cA; const char* nB = has_next ? (const char*)g.Bt + (size_t)nxt.pn * tstep + (size_t)nxt.ko * 2 : cB;
        for (int t = 0; t < nt; t += 2) {
            const bool last = (t == nt - 2);
            const char* a1 = cA + (size_t)(t + 1) * kstep;
            const char* a2 = last ? nA : cA + (size_t)(t + 2) * kstep; const char* b2 = last ? nB : cB + (size_t)(t + 2) * kstep;
            const char* a3 = a2 + kstep; const char* b3 = b2 + kstep;
            if (last && has_next) S.a_ready(nxt);
            if constexpr (SP2) {
            PG8_LDB(B0, 0, 0); PG8_LDB(B1, 0, 1); PG8_SCHED; PG8_LDA(At, 0, 0); PG8_STAGEA(PG8_SA(1, 1), a1 + hstep, voffA);
            PG8_WAIT_V(8); PG8_WAIT_L(0); PG8_BAR; PG8_MMA(0, 0, At, B0); PG8_MMA(0, 1, At, B1); PG8_BAR; PG8_SCHED;
            PG8_LDA(At, 0, 1); PG8_STAGE(PG8_SB(0, 0), b2, voffB); PG8_STAGE(PG8_SB(0, 1), b2 + hstep, voffB); PG8_STAGEA(PG8_SA(0, 0), a2, voffA);
            PG8_WAIT_V(8); PG8_WAIT_L(0); PG8_BAR; PG8_MMA(1, 0, At, B0); PG8_MMA(1, 1, At, B1); PG8_BAR; PG8_SCHED;
            PG8_LDB(B0, 1, 0); PG8_LDB(B1, 1, 1); PG8_SCHED; PG8_LDA(At, 1, 0); PG8_STAGEA(PG8_SA(0, 1), a2 + hstep, voffA);
            PG8_WAIT_V(8); PG8_WAIT_L(0); PG8_BAR; PG8_MMA(0, 0, At, B0); PG8_MMA(0, 1, At, B1); PG8_BAR; PG8_SCHED;
            PG8_LDA(At, 1, 1); PG8_STAGE(PG8_SB(1, 0), b3, voffB); PG8_STAGE(PG8_SB(1, 1), b3 + hstep, voffB); PG8_STAGEA(PG8_SA(1, 0), a3, voffA);
            PG8_WAIT_V(8); PG8_WAIT_L(0); PG8_BAR; PG8_MMA(1, 0, At, B0); PG8_MMA(1, 1, At, B1); PG8_BAR; PG8_SCHED;
            } else {
            PG8_LDB(B0, 0, 0); PG8_SCHED; PG8_LDA(At, 0, 0); PG8_STAGEA(PG8_SA(1, 1), a1 + hstep, voffA);
            PG8_WAIT_L(8); PG8_BAR; PG8_WAIT_L(0); PG8_MMA(0, 0, At, B0); PG8_BAR; PG8_SCHED;
            PG8_LDB(B1, 0, 1); PG8_STAGE(PG8_SB(0, 0), b2, voffB);
            PG8_BAR; PG8_WAIT_L(0); PG8_MMA(0, 1, At, B1); PG8_BAR;
            PG8_LDA(At, 0, 1); PG8_STAGEA(PG8_SA(0, 0), a2, voffA);
            PG8_BAR; PG8_WAIT_L(0); PG8_MMA(1, 0, At, B0); PG8_BAR; PG8_SCHED;
            PG8_STAGE(PG8_SB(0, 1), b2 + hstep, voffB);
            PG8_WAIT_V(6); PG8_BAR; PG8_MMA(1, 1, At, B1); PG8_BAR;
            PG8_LDB(B0, 1, 0); PG8_SCHED; PG8_LDA(At, 1, 0); PG8_STAGEA(PG8_SA(0, 1), a2 + hstep, voffA);
            PG8_WAIT_L(8); PG8_BAR; PG8_WAIT_L(0); PG8_MMA(0, 0, At, B0); PG8_BAR; PG8_SCHED;
            PG8_LDB(B1, 1, 1); PG8_STAGE(PG8_SB(1, 0), b3, voffB);
            PG8_BAR; PG8_WAIT_L(0); PG8_MMA(0, 1, At, B1); PG8_BAR;
            PG8_LDA(At, 1, 1); PG8_STAGEA(PG8_SA(1, 0), a3, voffA);
            PG8_BAR; PG8_WAIT_L(0); PG8_MMA(1, 0, At, B0); PG8_BAR; PG8_SCHED;
            PG8_STAGE(PG8_SB(1, 1), b3 + hstep, voffB);
            PG8_WAIT_V(6); PG8_BAR; PG8_MMA(1, 1, At, B1); PG8_BAR;
            }
        }
        if constexpr (ALIGN_EPI) { if (wr == 0) PG8_BAR; }
        if constexpr (!Epi::AFTER_DRAIN) { E(acc, cur, wr, wc, fr, fq); S.done(cur); }
        if (!has_next) break;
#pragma unroll
        for (int a = 0; a < 2; ++a)
#pragma unroll
            for (int b = 0; b < 2; ++b)
#pragma unroll
                for (int m = 0; m < 4; ++m)
#pragma unroll
                    for (int n = 0; n < 2; ++n) acc[a][b][m][n] = (f32x4){0.f, 0.f, 0.f, 0.f};
        cur = nxt; cA = nA; cB = nB; ++ui;
        if constexpr (ALIGN_EPI) { if (wr == 1) PG8_BAR; }
    }
    PG8_WAIT_V(0);
    if constexpr (!ALIGN_EPI) { if (wr == 0) PG8_BAR; }
    PG8_BAR;
    if constexpr (Epi::AFTER_DRAIN) { E.fused(acc, cur, wr, wc, fr, fq, lds, wid, lane); S.done(cur); }
#undef PG8_SA
#undef PG8_SB
#undef PG8_STAGE
#undef PG8_STAGEA
#undef PG8_LDA
#undef PG8_LDB
#undef PG8_MMA
#undef PG8_WAIT_V
#undef PG8_WAIT_L
#undef PG8_BAR
#undef PG8_SCHED
}
}

constexpr int NWAVES = 8;
constexpr int DM = 2048, NTOK_P = 32768, NTOK_S = 1024, MT = NTOK_P + NTOK_S  , NSEQ = 48, DEPTH = 4, DFF = 8192;
constexpr int IN_TOTAL = 14864, NPAD = 15104;
constexpr int OFF_AQ = 0, OFF_AF = 1024, OFF_AI = 2048, OFF_AG = 3072, OFF_BZ = 4096, OFF_XBC = 5120, OFF_CU = 6656, OFF_CV = 7680, OFF_GATE = 8704, OFF_DT = 14848;
constexpr float NORM_EPS = 1e-6f;
constexpr size_t OUT_X = 0, OUT_HGRN_P = 69206016, OUT_SSM_P = 77594624, OUT_CONV_P = 85983232, OUT_HGRN_S = 86278144, OUT_SSM_S = 103055360, OUT_CONV_S = 119832576, OUT_V_S = 120422400, OUT_TOTAL = 124616704;
constexpr size_t MiB = 1u << 20;
constexpr size_t WS_CTL = 0, CTL_ZERO_BYTES = 1 * MiB;
constexpr size_t WS_MOD = 1 * MiB;
constexpr size_t WS_WIN = 16 * MiB;
constexpr size_t WS_WBR = 76 * MiB;
constexpr size_t WS_WOUT = 88 * MiB;
constexpr size_t WS_WUP = 96 * MiB;
constexpr size_t WS_WDN = 128 * MiB;
constexpr size_t WS_H = 160 * MiB;
constexpr size_t WS_Y3 = 292 * MiB;
constexpr size_t WS_P = 490 * MiB;
constexpr size_t WS_XC = 1464 * MiB;
constexpr size_t WS_DT = 1564 * MiB;
constexpr size_t DT_ARR = (size_t)MT * 16 * 4;
constexpr size_t WS_WSET2 = 1576 * MiB;
constexpr size_t WSET_BYTES = WS_H - WS_WIN;
constexpr size_t WS_SLAB = WS_Y3;
constexpr size_t WS_X = WS_WSET2 + WSET_BYTES;
constexpr size_t WS_END = WS_X + (size_t)MT * DM * 2;
static_assert((size_t)32 * 8 * 65536 * 4 <= (size_t)3 * MT * 1024 * 2, "slabs fit the y_a|y_b|y_c region");
static_assert(WS_DT + 3 * DT_ARR <= WS_WSET2, "d_ws map 3");
__host__ __device__ constexpr size_t wofs(int l) { return (l & 1) ? (WS_WSET2 - WS_WIN) : 0; }
static_assert(WS_P + (size_t)MT * NPAD * 2 <= WS_XC && WS_XC + (size_t)MT * 1536 * 2 <= WS_DT, "d_ws map 2");
static_assert(WS_MOD + (size_t)DEPTH * NSEQ * 12288 * 4 <= WS_WIN && WS_WIN + (size_t)NPAD * DM * 2 <= WS_WBR && WS_H + (size_t)MT * DM * 2 <= WS_Y3 && WS_Y3 + (size_t)3 * MT * 1024 * 2 <= WS_P, "d_ws map");
constexpr int CW_BAR = 4096;
constexpr int CW_Q = 8192;
constexpr int CW_QC = 12288;
constexpr int RING_BYTES = 131072, ST_OFF = RING_BYTES  , MISC_OFF = RING_BYTES + 1024, LDS_BYTES = 147456;

#define GAS __attribute__((address_space(1)))
#define LAS __attribute__((address_space(3)))
typedef unsigned short bf16;
typedef unsigned v4u __attribute__((ext_vector_type(4)));
typedef unsigned v2u __attribute__((ext_vector_type(2)));
typedef float f32x4 __attribute__((ext_vector_type(4)));
typedef float f32x2 __attribute__((ext_vector_type(2)));
#define LDS_WAIT() asm volatile("s_waitcnt lgkmcnt(0)" ::: "memory")
#define VM_WAIT() asm volatile("s_waitcnt vmcnt(0)" ::: "memory")
typedef float cv_f32x2 __attribute__((ext_vector_type(2))); typedef __bf16 cv_bf16x2 __attribute__((ext_vector_type(2)));
__device__ __forceinline__ unsigned pk2(float lo, float hi) { const cv_f32x2 v = {lo, hi}; const cv_bf16x2 b = __builtin_convertvector(v, cv_bf16x2); return __builtin_bit_cast(unsigned, b); }
__device__ __forceinline__ unsigned f2bf(float f) { const __bf16 b = (__bf16)f; return (unsigned)__builtin_bit_cast(unsigned short, b); }
__device__ __forceinline__ float bflo(unsigned w) { return __uint_as_float(w << 16); }
__device__ __forceinline__ float bfhi(unsigned w) { return __uint_as_float(w & 0xffff0000u); }
__device__ __forceinline__ float bf1(bf16 v) { return __uint_as_float(((unsigned)v) << 16); }
__device__ __forceinline__ float sigmoidf_(float x) { return __builtin_amdgcn_rcpf(1.0f + __expf(-x)); }
__device__ __forceinline__ float siluf_(float x) { return x * __builtin_amdgcn_rcpf(1.0f + __expf(-x)); }
__device__ __forceinline__ float rsqrtf_(float x) { return __builtin_amdgcn_rsqf(x); }
__device__ __forceinline__ float geluf_(float v) {
    const float av = fabsf(v), t = __builtin_amdgcn_rcpf(1.0f + 0.2316418882f * av);
    float q = t * 0.5307027145f + (-0.7265760135f); q = q * t + 0.7107068705f; q = q * t + (-0.142248368f); q = q * t + 0.127414796f; q = q * t;
    const float e = __expf(-0.5f * v * v), m = v * (q * e);
    return v < 0.f ? m : v - m;
}
__device__ __forceinline__ float wave_sum(float v) {
#pragma unroll
    for (int o = 1; o < 64; o <<= 1) v += __shfl_xor(v, o);
    return v;
}
__device__ __forceinline__ float half_sum(float v) {
#pragma unroll
    for (int o = 1; o < 32; o <<= 1) v += __shfl_xor(v, o);
    return v;
}

#define XB_TMO      128
#define XB_XCNT(j)  (256  + 64 * (j))
#define XB_XSUB(j)  (1280 + 64 * (j))
#define XB_XGEN(j)  (2304 + 64 * (j))
#define XB_TOP      3328
#define XB_TOPGEN   3392
#define XCD_BAR_WORDS 3456
#define XB_SPIN_CAP (1u << 18)

__device__ __forceinline__ unsigned xb_ld(unsigned* p)              { return __hip_atomic_load(p, __ATOMIC_RELAXED, __HIP_MEMORY_SCOPE_AGENT); }
__device__ __forceinline__ unsigned xb_add(unsigned* p, unsigned v) { return __hip_atomic_fetch_add(p, v, __ATOMIC_RELAXED, __HIP_MEMORY_SCOPE_AGENT); }
__device__ __forceinline__ unsigned xb_xcc_id() { return (unsigned)__builtin_amdgcn_s_getreg((3 << 11) | 20) & 0xFu; }
#define XB_SPIN(cond, bar) do { unsigned _sp = 0; while (cond) { __builtin_amdgcn_s_sleep(1); \
    if ((++_sp & 255u) == 0u) { if (xb_ld(&(bar)[XB_TMO])) break; if (_sp > XB_SPIN_CAP) { atomicAdd(&(bar)[XB_TMO], 1u); break; } } } } while (0)

struct XcdBarrier {
    unsigned* bar; unsigned x;
    volatile LAS unsigned* st;
};

__device__ __forceinline__ XcdBarrier xcd_barrier_post(unsigned* bar, volatile LAS unsigned* st, int tid) {
    XcdBarrier b; b.bar = bar; b.x = xb_xcc_id(); b.st = st;
    if (tid == 0) (void)xb_add(&bar[XB_XCNT(b.x)], 1u);
    return b;
}
__device__ __forceinline__ void xcd_barrier_complete(unsigned* bar, unsigned x, unsigned& nloc, unsigned& nx) {
    const unsigned G = gridDim.x * gridDim.y * gridDim.z;
    unsigned sum, cnt, mine, sp = 0u;
    for (;;) {
        sum = 0u; cnt = 0u; mine = 0u;
#pragma unroll
        for (unsigned j = 0; j < 16; ++j) { const unsigned c = xb_ld(&bar[XB_XCNT(j)]); sum += c; cnt += (c > 0u) ? 1u : 0u; mine = (j == x) ? c : mine; }
        if (sum == G) break;
        __builtin_amdgcn_s_sleep(1);
        if ((++sp & 255u) == 0u) { if (xb_ld(&bar[XB_TMO])) break; if (sp > XB_SPIN_CAP) { atomicAdd(&bar[XB_TMO], 1u); break; } }
    }
    nloc = mine > 0u ? mine : 1u; nx = cnt > 0u ? cnt : 1u;
}

__device__ __forceinline__ void xcd_barrier(const XcdBarrier& b, int tid) {
    asm volatile("s_waitcnt vmcnt(0)" ::: "memory");
    __syncthreads();
    if (tid == 0) {
        unsigned* bar = b.bar;
        __builtin_amdgcn_s_waitcnt(0);
        unsigned nloc = b.st[0], nx = b.st[1];
        if (nloc == 0u) { xcd_barrier_complete(bar, b.x, nloc, nx); b.st[0] = nloc; b.st[1] = nx; }
        const unsigned old = xb_add(&bar[XB_XSUB(b.x)], 1u);
        const unsigned gen = old / nloc;
        if (old + 1u == (gen + 1u) * nloc) {
            __builtin_amdgcn_fence(__ATOMIC_RELEASE, "agent");
            asm volatile("s_waitcnt vmcnt(0)" ::: "memory");
            const unsigned og = xb_add(&bar[XB_TOP], 1u);
            const unsigned tg = og / nx;
            if (og + 1u == (tg + 1u) * nx) xb_add(&bar[XB_TOPGEN], 1u);
            else XB_SPIN(xb_ld(&bar[XB_TOPGEN]) == tg, bar);
            __builtin_amdgcn_fence(__ATOMIC_ACQUIRE, "agent");
            xb_add(&bar[XB_XGEN(b.x)], 1u);
            asm volatile("s_waitcnt vmcnt(0)" ::: "memory");
        } else {
            XB_SPIN(xb_ld(&bar[XB_XGEN(b.x)]) == gen, bar);
            __builtin_amdgcn_fence(__ATOMIC_ACQUIRE, "agent");
            asm volatile("s_waitcnt vmcnt(0)" ::: "memory");
        }
    }
    __syncthreads();
}


__device__ __forceinline__ void mod_item(LAS unsigned char* lds, int tid_in, int it, const float* c_prompt, const float* c_sample, const float* w_mod, const float* b_mod, float* MOD) {
    int tid = tid_in;
    const int l = it / 96, cb = it - l * 96, j0 = cb * 128;
    const int cq = tid & 31, sh = (tid >> 5) & 1, kq = tid >> 6;
    LAS float* CS = (LAS float*)lds;
    f32x2 acc[24][2];
#pragma unroll
    for (int s = 0; s < 24; ++s) { acc[s][0] = (f32x2){0.f, 0.f}; acc[s][1] = (f32x2){0.f, 0.f}; }
    const float* wbase = w_mod + (size_t)l * DM * 12288 + j0 + 4 * cq;
    for (int kt = 0; kt < 8; ++kt) {
        __syncthreads();
#pragma unroll 8
        for (int j = 0; j < 24; ++j) { const int e = tid + 512 * j, s = e >> 8, kidx = e & 255, kq2 = kidx >> 5, kk = kidx & 31, k = kq2 * 256 + kt * 32 + kk;
            const float cv = s < 16 ? c_prompt[s * DM + k] : c_sample[(s - 16) * DM + k];
            CS[(kq2 * 32 + kk) * 48 + s] = siluf_(cv); }
        __syncthreads();
        { const float* wr = wbase + (size_t)(kq * 256 + kt * 32) * 12288;
          f32x4 wn[4];
#pragma unroll
          for (int i = 0; i < 4; ++i) wn[i] = *(const f32x4*)(wr + (size_t)i * 12288);
#pragma unroll 1
          for (int kk = 0; kk < 32; kk += 4) { f32x4 wc[4];
#pragma unroll
              for (int i = 0; i < 4; ++i) wc[i] = wn[i];
              if (kk + 4 < 32) {
#pragma unroll
                  for (int i = 0; i < 4; ++i) wn[i] = *(const f32x4*)(wr + (size_t)(kk + 4 + i) * 12288); }
#pragma unroll
              for (int i = 0; i < 4; ++i) { const f32x2 w01 = (f32x2){wc[i].x, wc[i].y}, w23 = (f32x2){wc[i].z, wc[i].w}; const LAS f32x4* cr = (const LAS f32x4*)(CS + (kq * 32 + kk + i) * 48 + 24 * sh);
#pragma unroll
                  for (int s4 = 0; s4 < 6; ++s4) { const f32x4 c4 = cr[s4];
#pragma unroll
                      for (int q = 0; q < 4; ++q) { const f32x2 cc = (f32x2){c4[q], c4[q]};
                          acc[4 * s4 + q][0] = __builtin_elementwise_fma(w01, cc, acc[4 * s4 + q][0]); acc[4 * s4 + q][1] = __builtin_elementwise_fma(w23, cc, acc[4 * s4 + q][1]); } } } } }
    }
    LAS float* RED = (LAS float*)lds;
    asm volatile("" : "+v"(tid));
    const int cq2 = tid & 31, sh2 = (tid >> 5) & 1, kq2_ = tid >> 6;
#pragma unroll
    for (int sb = 0; sb < 4; ++sb) {
        __syncthreads();
        if (sh2 == (sb >> 1)) {
#pragma unroll
            for (int i = 0; i < 12; ++i) { const f32x2 a = acc[12 * (sb & 1) + i][0], b = acc[12 * (sb & 1) + i][1]; *(LAS f32x4*)(RED + (kq2_ * 12 + i) * 128 + 4 * cq2) = (f32x4){a.x, a.y, b.x, b.y}; } }
        __syncthreads();
#pragma unroll
        for (int j = 0; j < 3; ++j) { const int e = tid + 512 * j, s = e >> 7, col = e & 127; float v = 0.f;
#pragma unroll
            for (int q = 0; q < 8; ++q) v += RED[(q * 12 + s) * 128 + col];
            MOD[((size_t)l * NSEQ + 12 * sb + s) * 12288 + j0 + col] = v + b_mod[l * 12288 + j0 + col]; }
    }
    __syncthreads();
}

struct CvItem { const float* src; bf16* dst; int N, K, nv; };
constexpr int CV_A = 472 * 32, CV_B = 3 * 16 * 64, CV_C = 32 * 64, CV_D = 32 * 256, CV_E = 128 * 64, CV_ALL = CV_A + CV_B + CV_C + CV_D + CV_E;
__device__ __forceinline__ CvItem cvt_decode(int it, int l, const float* w_in, const float* w_branch, const float* w_out, const float* w_up, const float* w_down, unsigned char* ws) {
    CvItem c; int r = it;
    if (r < CV_A) { const int nb = r % 472, kb = r / 472; int n0s, nv;
        if (nb < 208) { n0s = 32 * nb; nv = 32; } else if (nb < 464) { n0s = 32 * nb + 16; nv = 32; } else if (nb == 464) { n0s = 6656; nv = 16; } else { n0s = 0; nv = 0; }
        c.N = IN_TOTAL; c.K = DM; c.nv = nv; c.src = w_in + (size_t)l * DM * IN_TOTAL + (size_t)(64 * kb) * IN_TOTAL + n0s; c.dst = (bf16*)(ws + WS_WIN) + (size_t)(32 * nb) * DM + 64 * kb; return c; }
    r -= CV_A;
    if (r < CV_B) { const int br = r / 1024, r2 = r % 1024, kb = r2 / 64, nb = r2 % 64;
        c.N = DM; c.K = 1024; c.nv = 32; c.src = w_branch + ((size_t)l * 3072 + br * 1024 + 64 * kb) * DM + 32 * nb; c.dst = (bf16*)(ws + WS_WBR) + (size_t)br * 2048 * 1024 + (size_t)(32 * nb) * 1024 + 64 * kb; return c; }
    r -= CV_B;
    if (r < CV_C) { const int kb = r / 64, nb = r % 64;
        c.N = DM; c.K = DM; c.nv = 32; c.src = w_out + (size_t)l * DM * DM + (size_t)(64 * kb) * DM + 32 * nb; c.dst = (bf16*)(ws + WS_WOUT) + (size_t)(32 * nb) * DM + 64 * kb; return c; }
    r -= CV_C;
    if (r < CV_D) { const int kb = r / 256, nb = r % 256;
        c.N = DFF; c.K = DM; c.nv = 32; c.src = w_up + (size_t)l * DM * DFF + (size_t)(64 * kb) * DFF + 32 * nb; c.dst = (bf16*)(ws + WS_WUP) + (size_t)(32 * nb) * DM + 64 * kb; return c; }
    r -= CV_D;
    { const int kb = r / 64, nb = r % 64;
        c.N = DM; c.K = DFF; c.nv = 32; c.src = w_down + (size_t)l * DFF * DM + (size_t)(64 * kb) * DM + 32 * nb; c.dst = (bf16*)(ws + WS_WDN) + (size_t)(32 * nb) * DFF + 64 * kb; return c; }
}
__device__ __forceinline__ void cvt_load(const CvItem& c, int lane, f32x4 (&v)[8]) {
    const int kk = lane >> 3, n4 = (lane & 7) * 4;
#pragma unroll
    for (int i = 0; i < 8; ++i) v[i] = (n4 < c.nv) ? *(const f32x4*)(c.src + (size_t)(8 * i + kk) * c.N + n4) : (f32x4){0.f, 0.f, 0.f, 0.f};
}
__device__ __forceinline__ void cvt_store(const CvItem& c, int lane, const f32x4 (&v)[8], LAS float* scr) {
    { const int kk = lane >> 3, n4 = (lane & 7) * 4;
#pragma unroll
        for (int i = 0; i < 8; ++i) { LAS float* d = scr + (8 * i + kk) * 33 + n4; d[0] = v[i].x; d[1] = v[i].y; d[2] = v[i].z; d[3] = v[i].w; } }
    LDS_WAIT(); asm volatile("" ::: "memory");
    const int cc = lane & 7;
#pragma unroll
    for (int j = 0; j < 4; ++j) { const int n = (lane >> 3) + 8 * j; const LAS float* s = scr + (8 * cc) * 33 + n;
        v4u o; o.x = pk2(s[0 * 33], s[1 * 33]); o.y = pk2(s[2 * 33], s[3 * 33]); o.z = pk2(s[4 * 33], s[5 * 33]); o.w = pk2(s[6 * 33], s[7 * 33]);
        *(v4u*)(c.dst + (size_t)n * c.K + 8 * cc) = o; }
    LDS_WAIT(); asm volatile("" ::: "memory");
}
template <bool QUEUE>
__device__ __forceinline__ void cvt_phase(LAS unsigned char* lds, int wave, int lane, int gw, int NGW, int l, const float* w_in, const float* w_branch, const float* w_out, const float* w_up, const float* w_down, unsigned char* ws, unsigned* qhead) {
    LAS float* scr = (LAS float*)(lds + wave * 16384);
    int it = gw, left = 0;
#define CV_NEXT() do { if (QUEUE) { if (left == 0) { unsigned t0 = 0; if (lane == 0) t0 = __hip_atomic_fetch_add(qhead, 4u, __ATOMIC_RELAXED, __HIP_MEMORY_SCOPE_AGENT); it = __builtin_amdgcn_readfirstlane((int)t0); left = 4; } else ++it; --left; } else it += NGW; } while (0)
    if (QUEUE) { it = 0; CV_NEXT(); }
    if (it >= CV_ALL) return;
    CvItem ca = cvt_decode(it, l, w_in, w_branch, w_out, w_up, w_down, ws), cb = ca; f32x4 va[8], vb[8];
    cvt_load(ca, lane, va);
    for (;;) {
        CV_NEXT(); const bool hb = it < CV_ALL;
        if (hb) { cb = cvt_decode(it, l, w_in, w_branch, w_out, w_up, w_down, ws); cvt_load(cb, lane, vb); }
        cvt_store(ca, lane, va, scr);
        if (!hb) break;
        CV_NEXT(); const bool ha = it < CV_ALL;
        if (ha) { ca = cvt_decode(it, l, w_in, w_branch, w_out, w_up, w_down, ws); cvt_load(ca, lane, va); }
        cvt_store(cb, lane, vb, scr);
        if (!ha) break;
    }
#undef CV_NEXT
}

#ifndef WGM_N8
#define WGM_N8 4
#endif
__device__ __forceinline__ int tail_nfull(int nwg, int G) { const int nf = (nwg / G) * G; return (nwg - nf) <= 32 ? nf : nwg; }
__device__ __forceinline__ void build_tail_map(LAS int* tmap, int tid, int G, int rev) {
    pg8::StaticOrder S; S.init(MT, DM, G, 0); S.rev = rev; S.wgm = WGM_N8; const int nfull = tail_nfull(S.nwg, G);
    for (int i = tid; i < S.nwg; i += NWAVES * 64) tmap[i] = -1;
    __syncthreads();
    for (int i = tid; i < S.nwg - nfull; i += NWAVES * 64) { pg8::Unit u; S.tile_of(nfull + i, u); tmap[u.pm * 8 + u.pn] = i; }
    __syncthreads();
}
template <bool SRC_F32>
__device__ __forceinline__ void norm_mod_phase(int lane, int gw, int NGW, const float* xP, const float* xS, bf16* X, const float* ng, const float* modl  , int part_sh, int part_sc, bf16* H,
                                               bool comb, const LAS int* tmap, const float* slab, bool desc) {
    const int g2 = desc ? NGW - 1 - gw : gw;
    const int ra = (int)(((unsigned)g2 * (unsigned)MT) / (unsigned)NGW), rb = (int)(((unsigned)(g2 + 1) * (unsigned)MT) / (unsigned)NGW);
    const int nr = rb - ra, rfirst = desc ? rb - 1 : ra, step = desc ? -1 : 1;
    if (nr <= 0) return;
    f32x4 ca[8], cb[8]; int cur_seq = -1;
    v2u xn[8];
    v2u xm[8];
    f32x4 xf[8];
    if (SRC_F32) { const float* xr = (rfirst < NTOK_P ? xP + (size_t)rfirst * DM : xS + (size_t)(rfirst - NTOK_P) * DM) + 4 * lane;
#pragma unroll
        for (int j = 0; j < 8; ++j) xf[j] = *(const f32x4*)(xr + 256 * j); }
    if (!SRC_F32) { const v2u* xb0 = (const v2u*)(X + (size_t)rfirst * DM) + lane;
#pragma unroll
        for (int j = 0; j < 8; ++j) xn[j] = xb0[64 * j];
        if (nr > 1) { const v2u* xb1 = (const v2u*)(X + (size_t)(rfirst + step) * DM) + lane;
#pragma unroll
            for (int j = 0; j < 8; ++j) xm[j] = xb1[64 * j]; } }
    for (int i = 0; i < nr; ++i) { const int r = rfirst + step * i;
        const int seq = r < NTOK_P ? (r >> 11) : 16 + ((r - NTOK_P) >> 5);
        if (seq != cur_seq) { cur_seq = seq; const float* mp = modl + (size_t)seq * 12288;
#pragma unroll
            for (int j = 0; j < 8; ++j) { const int c = 4 * lane + 256 * j; const f32x4 g = *(const f32x4*)(ng + c), sc = *(const f32x4*)(mp + part_sc * DM + c); ca[j] = g * (sc + 1.0f); cb[j] = *(const f32x4*)(mp + part_sh * DM + c); } }
        f32x4 v[8]; float ss = 0.f; v2u* xb = (v2u*)(X + (size_t)r * DM) + lane;
        if (SRC_F32) {
#pragma unroll
            for (int j = 0; j < 8; ++j) { v[j] = xf[j]; v2u o; o.x = pk2(v[j].x, v[j].y); o.y = pk2(v[j].z, v[j].w); xb[64 * j] = o; }
            if (i + 1 < nr) { const int r1 = r + step; const float* xr = (r1 < NTOK_P ? xP + (size_t)r1 * DM : xS + (size_t)(r1 - NTOK_P) * DM) + 4 * lane;
#pragma unroll
                for (int j = 0; j < 8; ++j) xf[j] = *(const f32x4*)(xr + 256 * j); } }
        else {
#pragma unroll
            for (int j = 0; j < 8; ++j) { const v2u o = xn[j]; v[j] = (f32x4){bflo(o.x), bfhi(o.x), bflo(o.y), bfhi(o.y)}; xn[j] = xm[j]; }
            if (i + 2 < nr) { const v2u* xb2 = (const v2u*)(X + (size_t)(r + 2 * step) * DM) + lane;
#pragma unroll
                for (int j = 0; j < 8; ++j) xm[j] = xb2[64 * j]; } }
        if (comb) {
#pragma unroll
            for (int j = 0; j < 8; ++j) { const int ti = tmap[(r >> 8) * 8 + j]; if (ti >= 0) { const float* sp = slab + (size_t)ti * 8 * 65536 + (r & 255) * 256 + 4 * lane;
#pragma unroll
                    for (int q = 0; q < 8; ++q) v[j] = v[j] + *(const f32x4*)(sp + (size_t)q * 65536);
                    v2u o; o.x = pk2(v[j].x, v[j].y); o.y = pk2(v[j].z, v[j].w); xb[64 * j] = o; } } }
#pragma unroll
        for (int j = 0; j < 8; ++j) ss += (v[j].x * v[j].x + v[j].y * v[j].y) + (v[j].z * v[j].z + v[j].w * v[j].w);
        const float rstd = 1.0f / sqrtf(wave_sum(ss) * (1.0f / DM) + NORM_EPS);
        unsigned long long* o8 = (unsigned long long*)(H + (size_t)r * DM) + lane;
#pragma unroll
        for (int j = 0; j < 8; ++j) { const f32x4 y = v[j] * rstd * ca[j] + cb[j]; o8[64 * j] = (unsigned long long)pk2(y.x, y.y) | ((unsigned long long)pk2(y.z, y.w) << 32); }
    }
}
__device__ __forceinline__ void final_norm_phase(int lane, int gw, int NGW, const bf16* X, float* Y, const float* fg, bool comb, const LAS int* tmap, const float* slab) {
    f32x4 g[8];
#pragma unroll
    for (int j = 0; j < 8; ++j) g[j] = *(const f32x4*)(fg + 4 * lane + 256 * j);
    v2u xn[8], xm[8];
    if (gw < MT) { const v2u* xb0 = (const v2u*)(X + (size_t)gw * DM) + lane;
#pragma unroll
        for (int j = 0; j < 8; ++j) xn[j] = xb0[64 * j]; }
    if (gw + NGW < MT) { const v2u* xb0 = (const v2u*)(X + (size_t)(gw + NGW) * DM) + lane;
#pragma unroll
        for (int j = 0; j < 8; ++j) xm[j] = xb0[64 * j]; }
    for (int r = gw; r < MT; r += NGW) {
        float* yr = Y + (size_t)r * DM + 4 * lane; f32x4 v[8]; float ss = 0.f;
#pragma unroll
        for (int j = 0; j < 8; ++j) { const v2u o = xn[j]; v[j] = (f32x4){bflo(o.x), bfhi(o.x), bflo(o.y), bfhi(o.y)}; xn[j] = xm[j]; }
        if (r + 2 * NGW < MT) { const v2u* xb1 = (const v2u*)(X + (size_t)(r + 2 * NGW) * DM) + lane;
#pragma unroll
            for (int j = 0; j < 8; ++j) xm[j] = xb1[64 * j]; }
        if (comb) {
#pragma unroll
            for (int j = 0; j < 8; ++j) { const int ti = tmap[(r >> 8) * 8 + j]; if (ti >= 0) { const float* sp = slab + (size_t)ti * 8 * 65536 + (r & 255) * 256 + 4 * lane;
#pragma unroll
                    for (int q = 0; q < 8; ++q) v[j] = v[j] + *(const f32x4*)(sp + (size_t)q * 65536); } } }
#pragma unroll
        for (int j = 0; j < 8; ++j) ss += (v[j].x * v[j].x + v[j].y * v[j].y) + (v[j].z * v[j].z + v[j].w * v[j].w);
        const float rstd = 1.0f / sqrtf(wave_sum(ss) * (1.0f / DM) + NORM_EPS);
#pragma unroll
        for (int j = 0; j < 8; ++j) *(f32x4*)(yr + 256 * j) = v[j] * rstd * g[j];
    }
}
__device__ __forceinline__ void ssd_norm_phase(int lane, int gw, int NGW, bf16* YB, const float* g) {
    float gv[16];
#pragma unroll
    for (int j = 0; j < 4; ++j) { const f32x4 t = *(const f32x4*)(g + 16 * lane + 4 * j); gv[4 * j] = t.x; gv[4 * j + 1] = t.y; gv[4 * j + 2] = t.z; gv[4 * j + 3] = t.w; }
    v4u na = (v4u){0u, 0u, 0u, 0u}, nb = na, ma = na, mb = na;
    if (gw < MT) { const v4u* p0 = (const v4u*)(YB + (size_t)gw * 1024 + 16 * lane); na = p0[0]; nb = p0[1]; }
    if (gw + NGW < MT) { const v4u* p0 = (const v4u*)(YB + (size_t)(gw + NGW) * 1024 + 16 * lane); ma = p0[0]; mb = p0[1]; }
    for (int r = gw; r < MT; r += NGW) {
        v4u* p = (v4u*)(YB + (size_t)r * 1024 + 16 * lane); const v4u a = na, b = nb; na = ma; nb = mb;
        if (r + 2 * NGW < MT) { const v4u* p1 = (const v4u*)(YB + (size_t)(r + 2 * NGW) * 1024 + 16 * lane); ma = p1[0]; mb = p1[1]; }
        float v[16]; v[0] = bflo(a.x); v[1] = bfhi(a.x); v[2] = bflo(a.y); v[3] = bfhi(a.y); v[4] = bflo(a.z); v[5] = bfhi(a.z); v[6] = bflo(a.w); v[7] = bfhi(a.w);
        v[8] = bflo(b.x); v[9] = bfhi(b.x); v[10] = bflo(b.y); v[11] = bfhi(b.y); v[12] = bflo(b.z); v[13] = bfhi(b.z); v[14] = bflo(b.w); v[15] = bfhi(b.w);
        float ss = 0.f;
#pragma unroll
        for (int j = 0; j < 16; ++j) ss += v[j] * v[j];
        const float rstd = 1.0f / sqrtf(half_sum(ss) * (1.0f / 512.0f) + NORM_EPS);
#pragma unroll
        for (int j = 0; j < 16; ++j) v[j] = v[j] * rstd * gv[j];
        v4u oa, ob; oa.x = pk2(v[0], v[1]); oa.y = pk2(v[2], v[3]); oa.z = pk2(v[4], v[5]); oa.w = pk2(v[6], v[7]); ob.x = pk2(v[8], v[9]); ob.y = pk2(v[10], v[11]); ob.z = pk2(v[12], v[13]); ob.w = pk2(v[14], v[15]);
        p[0] = oa; p[1] = ob;
    }
}

__device__ __forceinline__ void hgrn_item(LAS unsigned char* lds, int tid, int lane, int wave, const bf16* P, bf16* YA, int row0, int T, int h, int l,
                                          const float* s0, float* sout, const float* lb_raw, const float* onorm_g) {
    LAS float* LBV = (LAS float*)lds;
    LAS float* GV = LBV + 128;
    LAS float* Q = GV + 128;
    LAS float* F = Q + 2048; LAS float* KN = F + 2048; LAS float* IV = KN + 2048;
    LAS float* PO = IV + 2048;
    __syncthreads();
    if (tid < 128) { const int ch = h * 128 + tid; const float a0 = lb_raw[ch], a1 = lb_raw[1024 + ch], a2 = lb_raw[2048 + ch], a3 = lb_raw[3072 + ch];
        const float mx = fmaxf(fmaxf(a0, a1), fmaxf(a2, a3)); const float e0 = __expf(a0 - mx), e1 = __expf(a1 - mx), e2 = __expf(a2 - mx), e3 = __expf(a3 - mx); const float inv = 1.0f / (e0 + e1 + e2 + e3);
        float lb = 0.f; if (l >= 1) lb += e1; if (l >= 2) lb += e2; if (l >= 3) lb += e3; LBV[tid] = lb * inv; GV[tid] = onorm_g[ch]; }
    v2u nq2, nf2, ni2;
    { const bf16* pr = P + (size_t)(row0 + (tid >> 5)) * NPAD + h * 128 + (tid & 31) * 4; nq2 = *(const v2u*)(pr + OFF_AQ); nf2 = *(const v2u*)(pr + OFF_AF); ni2 = *(const v2u*)(pr + OFF_AI); }
    float S0[16], S1[16];
#pragma unroll
    for (int kk = 0; kk < 16; ++kk) { if (s0) { const f32x2 v = *(const f32x2*)(s0 + (16 * wave + kk) * 128 + 2 * lane); S0[kk] = v.x; S1[kk] = v.y; } else { S0[kk] = 0.f; S1[kk] = 0.f; } }
    __syncthreads();
    const int nch = T / 16;
    for (int c = 0; c < nch; ++c) {
        unsigned agv[2];
#pragma unroll
        for (int tt = 0; tt < 2; ++tt) agv[tt] = *(const unsigned*)(P + (size_t)(row0 + c * 16 + 2 * wave + tt) * NPAD + OFF_AG + h * 128 + 2 * lane);
        { const int t = tid >> 5, k4 = (tid & 31) * 4;
            const v2u q2 = nq2, f2 = nf2, i2 = ni2;
            if (c + 1 < nch) { const bf16* pr = P + (size_t)(row0 + (c + 1) * 16 + t) * NPAD + h * 128 + k4; nq2 = *(const v2u*)(pr + OFF_AQ); nf2 = *(const v2u*)(pr + OFF_AF); ni2 = *(const v2u*)(pr + OFF_AI); }
            const f32x4 lb = *(const LAS f32x4*)(LBV + k4);
            const float aq[4] = {bflo(q2.x), bfhi(q2.x), bflo(q2.y), bfhi(q2.y)}, az[4] = {bflo(f2.x), bfhi(f2.x), bflo(f2.y), bfhi(f2.y)};
            f32x4 qv, fv, kv;
#pragma unroll
            for (int j = 0; j < 4; ++j) { qv[j] = siluf_(aq[j]); const float sg = sigmoidf_(az[j]); fv[j] = lb[j] + (1.0f - lb[j]) * sg; kv[j] = (1.0f - lb[j]) * (1.0f - sg); }
            *(LAS f32x4*)(Q + t * 128 + k4) = qv; *(LAS f32x4*)(F + t * 128 + k4) = fv; *(LAS f32x4*)(KN + t * 128 + k4) = kv;
            *(LAS f32x4*)(IV + t * 128 + k4) = (f32x4){bflo(i2.x), bfhi(i2.x), bflo(i2.y), bfhi(i2.y)}; }
        __syncthreads();
#pragma unroll 2
        for (int t = 0; t < 16; ++t) {
            const f32x2 iv = *(const LAS f32x2*)(IV + t * 128 + 2 * lane); float po0 = 0.f, po1 = 0.f;
#pragma unroll
            for (int k4 = 0; k4 < 4; ++k4) { const f32x4 f4 = *(const LAS f32x4*)(F + t * 128 + 16 * wave + 4 * k4), n4 = *(const LAS f32x4*)(KN + t * 128 + 16 * wave + 4 * k4), q4 = *(const LAS f32x4*)(Q + t * 128 + 16 * wave + 4 * k4);
#pragma unroll
                for (int j = 0; j < 4; ++j) { const int kk = 4 * k4 + j; S0[kk] = fmaf(f4[j], S0[kk], n4[j] * iv.x); S1[kk] = fmaf(f4[j], S1[kk], n4[j] * iv.y); po0 = fmaf(q4[j], S0[kk], po0); po1 = fmaf(q4[j], S1[kk], po1); } }
            *(LAS f32x2*)(PO + (t * 8 + wave) * 128 + 2 * lane) = (f32x2){po0, po1};
        }
        __syncthreads();
#pragma unroll
        for (int tt = 0; tt < 2; ++tt) { const int t = 2 * wave + tt; float o0 = 0.f, o1 = 0.f;
#pragma unroll
            for (int w = 0; w < 8; ++w) { const f32x2 p = *(const LAS f32x2*)(PO + (t * 8 + w) * 128 + 2 * lane); o0 += p.x; o1 += p.y; }
            const float rstd = 1.0f / sqrtf(wave_sum(o0 * o0 + o1 * o1) * (1.0f / 128.0f) + NORM_EPS);
            const size_t row = (size_t)(row0 + c * 16 + t);
            const unsigned ag = agv[tt];
            const f32x2 gg = *(const LAS f32x2*)(GV + 2 * lane);
            *(unsigned*)(YA + row * 1024 + h * 128 + 2 * lane) = pk2(o0 * rstd * gg.x * siluf_(bflo(ag)), o1 * rstd * gg.y * siluf_(bfhi(ag))); }
    }
#pragma unroll
    for (int kk = 0; kk < 16; ++kk) *(f32x2*)(sout + (16 * wave + kk) * 128 + 2 * lane) = (f32x2){S0[kk], S1[kk]};
    __syncthreads();
}

typedef short bf16x8_t __attribute__((ext_vector_type(8)));
#define BAR_LDS() do { asm volatile("s_waitcnt lgkmcnt(0)" ::: "memory"); __builtin_amdgcn_s_barrier(); asm volatile("" ::: "memory"); } while (0)
#define MFMA16(x, y, acc) __builtin_amdgcn_mfma_f32_16x16x32_bf16((x), (y), (acc), 0, 0, 0)
#define LDFRAG(base, row, pitch, koff) (*(const LAS bf16x8_t*)((base) + (row) * (pitch) + (koff)))
__device__ __forceinline__ void hgrn_mfma_item(LAS unsigned char* lds, int tid, int lane, int wave, const bf16* P, bf16* YA, int row0, int h, int l, float* sout, const float* lb_raw, const float* onorm_g) {
    constexpr int PQ = 136, PT = 40;
    LAS float* LBV = (LAS float*)lds;
    LAS float* GV = LBV + 128;
    LAS float* DEC = GV + 128;
    LAS float* SS = DEC + 128;
    LAS float* LF = SS + 256;
    LAS bf16* QB = (LAS bf16*)(LF + 4096);
    LAS bf16* KB = QB + 32 * PQ;
    LAS bf16* Qt = KB + 32 * PQ;
    LAS bf16* Qm = Qt + 32 * PQ;
    LAS bf16* Km = Qm + 32 * PQ;
    LAS bf16* Qr = Km + 32 * PQ;
    LAS bf16* Kr = Qr + 16 * PQ;
    LAS bf16* KtT = Kr + 16 * PQ;
    LAS bf16* VT = KtT + 128 * PT;
    LAS bf16* IVr = VT + 128 * PT;
    LAS float* RSW = (LAS float*)(IVr + 32 * 128);
    const int fr = lane & 15, fq = lane >> 4;
    __syncthreads();
    if (tid < 128) { const int ch = h * 128 + tid; const float a0 = lb_raw[ch], a1 = lb_raw[1024 + ch], a2 = lb_raw[2048 + ch], a3 = lb_raw[3072 + ch];
        const float mx = fmaxf(fmaxf(a0, a1), fmaxf(a2, a3)); const float e0 = __expf(a0 - mx), e1 = __expf(a1 - mx), e2 = __expf(a2 - mx), e3 = __expf(a3 - mx); const float inv = 1.0f / (e0 + e1 + e2 + e3);
        float lb = 0.f; if (l >= 1) lb += e1; if (l >= 2) lb += e2; if (l >= 3) lb += e3; LBV[tid] = lb * inv; GV[tid] = onorm_g[ch]; }
    for (int i = tid; i < (128 * PT * 2) / 2; i += 512) ((LAS unsigned*)KtT)[i] = 0u;
    f32x4 sacc[8];
#pragma unroll
    for (int j = 0; j < 8; ++j) sacc[j] = (f32x4){0.f, 0.f, 0.f, 0.f};
    const int st = tid >> 4, sk8 = (tid & 15) * 8;
    const unsigned pst = (unsigned)((unsigned)(row0 + st) * (unsigned)NPAD + h * 128 + sk8) * 2u;
#define HG_LD16(off_) (*(const v4u*)((const char*)P + (unsigned)(off_)))
    v4u nq = HG_LD16(pst + 2u * OFF_AQ), nf = HG_LD16(pst + 2u * OFF_AF), ni = HG_LD16(pst + 2u * OFF_AI);
    f32x4 po0 = (f32x4){0.f, 0.f, 0.f, 0.f}, po1 = po0; bf16 pag[2][4];
#pragma unroll
    for (int hh = 0; hh < 2; ++hh)
#pragma unroll
        for (int r = 0; r < 4; ++r) pag[hh][r] = 0;
    const float gvv = onorm_g[h * 128 + 16 * wave + fr];
    __syncthreads();
#define HG_OUT(rb_) do { { const int t_ = lane & 31; const f32x4 p0 = *(const LAS f32x4*)(SS + t_ * 8), p1 = *(const LAS f32x4*)(SS + t_ * 8 + 4); \
            RSW[wave * 32 + t_] = rsqrtf_(((p0.x + p0.y) + (p0.z + p0.w) + (p1.x + p1.y) + (p1.z + p1.w)) * (1.0f / 128.0f) + NORM_EPS); } \
        LDS_WAIT(); asm volatile("" ::: "memory"); \
        _Pragma("unroll") for (int hh = 0; hh < 2; ++hh) { const f32x4 rs4 = *(const LAS f32x4*)(RSW + wave * 32 + 16 * hh + 4 * fq); \
            _Pragma("unroll") for (int r = 0; r < 4; ++r) { const int t = 16 * hh + 4 * fq + r; const float ov = hh ? po1[r] : po0[r]; \
            *(bf16*)((char*)YA + (unsigned)(((unsigned)(rb_) + t) * 1024u + h * 128 + 16 * wave + fr) * 2u) = (bf16)f2bf(ov * rs4[r] * gvv * siluf_(bf1(pag[hh][r]))); } } } while (0)
    for (int c = 0; c < 64; ++c) {
        const unsigned rbase = (unsigned)row0 + 32u * c;
        bf16 ag[2][4];
        { const f32x4 lb0 = *(const LAS f32x4*)(LBV + sk8), lb1 = *(const LAS f32x4*)(LBV + sk8 + 4); const float lb[8] = {lb0.x, lb0.y, lb0.z, lb0.w, lb1.x, lb1.y, lb1.z, lb1.w};
            const float aq[8] = {bflo(nq.x), bfhi(nq.x), bflo(nq.y), bfhi(nq.y), bflo(nq.z), bfhi(nq.z), bflo(nq.w), bfhi(nq.w)}, az[8] = {bflo(nf.x), bfhi(nf.x), bflo(nf.y), bfhi(nf.y), bflo(nf.z), bfhi(nf.z), bflo(nf.w), bfhi(nf.w)};
            float qv[8], kv[8], lf[8];
#pragma unroll
            for (int j = 0; j < 8; ++j) { qv[j] = siluf_(aq[j]); const float sg = sigmoidf_(az[j]); const float f = fmaxf(lb[j] + (1.0f - lb[j]) * sg, 1e-30f); kv[j] = (1.0f - lb[j]) * (1.0f - sg); lf[j] = __log2f(f); }
            *(LAS f32x4*)(LF + st * 128 + sk8) = (f32x4){lf[0], lf[1], lf[2], lf[3]}; *(LAS f32x4*)(LF + st * 128 + sk8 + 4) = (f32x4){lf[4], lf[5], lf[6], lf[7]};
            v4u qo, ko; qo.x = pk2(qv[0], qv[1]); qo.y = pk2(qv[2], qv[3]); qo.z = pk2(qv[4], qv[5]); qo.w = pk2(qv[6], qv[7]); ko.x = pk2(kv[0], kv[1]); ko.y = pk2(kv[2], kv[3]); ko.z = pk2(kv[4], kv[5]); ko.w = pk2(kv[6], kv[7]);
            *(LAS v4u*)(QB + st * PQ + sk8) = qo; *(LAS v4u*)(KB + st * PQ + sk8) = ko; *(LAS v4u*)(IVr + st * 128 + sk8) = ni;
#pragma unroll
            for (int hh = 0; hh < 2; ++hh)
#pragma unroll
                for (int r = 0; r < 4; ++r) ag[hh][r] = *(const bf16*)((const char*)P + (unsigned)((rbase + 16 * hh + 4 * fq + r) * (unsigned)NPAD + OFF_AG + h * 128 + 16 * wave + fr) * 2u);
            if (c + 1 < 64) { const unsigned pn = pst + (unsigned)(c + 1) * 32u * (unsigned)NPAD * 2u; nq = HG_LD16(pn + 2u * OFF_AQ); nf = HG_LD16(pn + 2u * OFF_AF); ni = HG_LD16(pn + 2u * OFF_AI); } }
        BAR_LDS();
        { const int k = tid & 127, tq = tid >> 7; float b[32]; float run = 0.f;
#pragma unroll
            for (int t = 0; t < 32; ++t) { run += LF[t * 128 + k]; b[t] = run; }
#pragma unroll
            for (int tq2 = 0; tq2 < 4; ++tq2) if (tq2 == tq) { const float mh = (tq2 < 2) ? b[7] : b[23]; float kt[8]; bf16 iv[8];
#pragma unroll
                for (int i = 0; i < 8; ++i) { const int t = 8 * tq2 + i; const float qv = bf1(QB[t * PQ + k]), kv = bf1(KB[t * PQ + k]); iv[i] = IVr[t * 128 + k];
                    Qt[t * PQ + k] = (bf16)f2bf(qv * __builtin_amdgcn_exp2f(b[t])); kt[i] = kv * __builtin_amdgcn_exp2f(b[31] - b[t]);
                    Qm[t * PQ + k] = (bf16)f2bf(qv * __builtin_amdgcn_exp2f(fminf(b[t] - mh, 115.f))); Km[t * PQ + k] = (bf16)f2bf(kv * __builtin_amdgcn_exp2f(fminf(mh - b[t], 115.f)));
                    if (tq2 < 2) Kr[t * PQ + k] = (bf16)f2bf(kv * __builtin_amdgcn_exp2f(b[15] - b[t])); else Qr[(t - 16) * PQ + k] = (bf16)f2bf(qv * __builtin_amdgcn_exp2f(b[t] - b[15])); }
                v4u ko; ko.x = pk2(kt[0], kt[1]); ko.y = pk2(kt[2], kt[3]); ko.z = pk2(kt[4], kt[5]); ko.w = pk2(kt[6], kt[7]); *(LAS v4u*)(KtT + k * PT + 8 * tq2) = ko;
                v4u vo; vo.x = (unsigned)iv[0] | ((unsigned)iv[1] << 16); vo.y = (unsigned)iv[2] | ((unsigned)iv[3] << 16); vo.z = (unsigned)iv[4] | ((unsigned)iv[5] << 16); vo.w = (unsigned)iv[6] | ((unsigned)iv[7] << 16); *(LAS v4u*)(VT + k * PT + 8 * tq2) = vo; }
            if (tq == 0) DEC[k] = __builtin_amdgcn_exp2f(b[31]); }
        if (c > 0) HG_OUT(rbase - 32);
        BAR_LDS();
        f32x4 at0 = (f32x4){0.f, 0.f, 0.f, 0.f}, at1 = at0, at2 = at0, o0 = at0, o1 = at0;
#pragma unroll
        for (int ks = 0; ks < 4; ++ks) { const int ko = 32 * ks + 8 * fq;
            at0 = MFMA16(LDFRAG(Km, fr, PQ, ko), LDFRAG(Qm, fr, PQ, ko), at0);
            at1 = MFMA16(LDFRAG(Km, 16 + fr, PQ, ko), LDFRAG(Qm, 16 + fr, PQ, ko), at1);
            at2 = MFMA16(LDFRAG(Kr, fr, PQ, ko), LDFRAG(Qr, fr, PQ, ko), at2);
            v4u sy; sy.x = pk2(sacc[2 * ks][0], sacc[2 * ks][1]); sy.y = pk2(sacc[2 * ks][2], sacc[2 * ks][3]); sy.z = pk2(sacc[2 * ks + 1][0], sacc[2 * ks + 1][1]); sy.w = pk2(sacc[2 * ks + 1][2], sacc[2 * ks + 1][3]);
            const v2u xa0 = *(const LAS v2u*)(Qt + fr * PQ + 32 * ks + 4 * fq), xb0 = *(const LAS v2u*)(Qt + fr * PQ + 32 * ks + 16 + 4 * fq);
            const v2u xa1 = *(const LAS v2u*)(Qt + (16 + fr) * PQ + 32 * ks + 4 * fq), xb1 = *(const LAS v2u*)(Qt + (16 + fr) * PQ + 32 * ks + 16 + 4 * fq);
            v4u x0; x0.x = xa0.x; x0.y = xa0.y; x0.z = xb0.x; x0.w = xb0.y; v4u x1; x1.x = xa1.x; x1.y = xa1.y; x1.z = xb1.x; x1.w = xb1.y;
            o0 = MFMA16(__builtin_bit_cast(bf16x8_t, x0), __builtin_bit_cast(bf16x8_t, sy), o0); o1 = MFMA16(__builtin_bit_cast(bf16x8_t, x1), __builtin_bit_cast(bf16x8_t, sy), o1); }
        {
            v4u a0, a1, a2; a0.z = 0u; a0.w = 0u; a1.z = 0u; a1.w = 0u; a2.z = 0u; a2.w = 0u;
            a0.x = pk2(4 * fq + 0 <= fr ? at0[0] : 0.f, 4 * fq + 1 <= fr ? at0[1] : 0.f); a0.y = pk2(4 * fq + 2 <= fr ? at0[2] : 0.f, 4 * fq + 3 <= fr ? at0[3] : 0.f);
            a1.x = pk2(4 * fq + 0 <= fr ? at1[0] : 0.f, 4 * fq + 1 <= fr ? at1[1] : 0.f); a1.y = pk2(4 * fq + 2 <= fr ? at1[2] : 0.f, 4 * fq + 3 <= fr ? at1[3] : 0.f);
            a2.x = pk2(at2[0], at2[1]); a2.y = pk2(at2[2], at2[3]);
            const v2u y0 = *(const LAS v2u*)(VT + (16 * wave + fr) * PT + 4 * fq), y1 = *(const LAS v2u*)(VT + (16 * wave + fr) * PT + 16 + 4 * fq);
            v4u v0; v0.x = y0.x; v0.y = y0.y; v0.z = 0u; v0.w = 0u; v4u v1; v1.x = y1.x; v1.y = y1.y; v1.z = 0u; v1.w = 0u;
            o0 = MFMA16(__builtin_bit_cast(bf16x8_t, a0), __builtin_bit_cast(bf16x8_t, v0), o0);
            o1 = MFMA16(__builtin_bit_cast(bf16x8_t, a1), __builtin_bit_cast(bf16x8_t, v1), o1);
            o1 = MFMA16(__builtin_bit_cast(bf16x8_t, a2), __builtin_bit_cast(bf16x8_t, v0), o1); }
#pragma unroll
        for (int r = 0; r < 4; ++r) { float q0 = o0[r] * o0[r], q1 = o1[r] * o1[r];
            q0 += __shfl_xor(q0, 1); q1 += __shfl_xor(q1, 1); q0 += __shfl_xor(q0, 2); q1 += __shfl_xor(q1, 2); q0 += __shfl_xor(q0, 4); q1 += __shfl_xor(q1, 4); q0 += __shfl_xor(q0, 8); q1 += __shfl_xor(q1, 8);
            if (fr == 0) { SS[(4 * fq + r) * 8 + wave] = q0; SS[(16 + 4 * fq + r) * 8 + wave] = q1; } }
        {
            const bf16x8_t vy = LDFRAG(VT, 16 * wave + fr, PT, 8 * fq);
#pragma unroll
            for (int kt = 0; kt < 8; ++kt) { const f32x4 d4 = *(const LAS f32x4*)(DEC + 16 * kt + 4 * fq); sacc[kt] = sacc[kt] * d4; sacc[kt] = MFMA16(LDFRAG(KtT, 16 * kt + fr, PT, 8 * fq), vy, sacc[kt]); } }
        po0 = o0; po1 = o1;
#pragma unroll
        for (int hh = 0; hh < 2; ++hh)
#pragma unroll
            for (int r = 0; r < 4; ++r) pag[hh][r] = ag[hh][r];
    }
    BAR_LDS();
    HG_OUT((unsigned)row0 + 2048u - 32u);
#undef HG_OUT
#undef HG_LD16
#pragma unroll
    for (int kt = 0; kt < 8; ++kt)
#pragma unroll
        for (int r = 0; r < 4; ++r) sout[(16 * kt + 4 * fq + r) * 128 + 16 * wave + fr] = sacc[kt][r];
    __syncthreads();
}

__device__ __forceinline__ void ssd_pre_phase(int lane, int gw, int NGW, const bf16* P, bf16* XC, float* DTb, float* ADT, float* ACUM,
                                              const float* conv_w, const float* conv_b, const float* dt_bias, const float* a_log, const float* state_conv, float* conv_out_p, float* conv_out_s) {
    unsigned ua = (unsigned)(((unsigned long long)(unsigned)gw * (3u * MT)) / (unsigned)NGW); const unsigned ub = (unsigned)(((unsigned long long)((unsigned)gw + 1u) * (3u * MT)) / (unsigned)NGW);
#define PRE_UNPK(dst, u) do { dst[0] = bflo(u.x); dst[1] = bfhi(u.x); dst[2] = bflo(u.y); dst[3] = bfhi(u.y); dst[4] = bflo(u.z); dst[5] = bfhi(u.z); dst[6] = bflo(u.w); dst[7] = bfhi(u.w); } while (0)
    while (ua < ub) {
        const int cg = (int)(ua / (unsigned)MT); const unsigned ue = ub < (unsigned)(cg + 1) * MT ? ub : (unsigned)(cg + 1) * MT;
        const int t0 = (int)(ua - (unsigned)cg * MT), t1 = (int)(ue - (unsigned)cg * MT), cc = cg * 512 + 8 * lane; ua = ue;
        float w[4][8], cb[8], a0[8], a1[8], a2[8];
#pragma unroll
        for (int j = 0; j < 4; ++j) { const f32x4 u0 = *(const f32x4*)(conv_w + j * 1536 + cc), u1 = *(const f32x4*)(conv_w + j * 1536 + cc + 4);
            w[j][0] = u0.x; w[j][1] = u0.y; w[j][2] = u0.z; w[j][3] = u0.w; w[j][4] = u1.x; w[j][5] = u1.y; w[j][6] = u1.z; w[j][7] = u1.w; }
        { const f32x4 u0 = *(const f32x4*)(conv_b + cc), u1 = *(const f32x4*)(conv_b + cc + 4); cb[0] = u0.x; cb[1] = u0.y; cb[2] = u0.z; cb[3] = u0.w; cb[4] = u1.x; cb[5] = u1.y; cb[6] = u1.z; cb[7] = u1.w; }
#pragma unroll
        for (int e = 0; e < 8; ++e) { a0[e] = 0.f; a1[e] = 0.f; a2[e] = 0.f; }
        const int ts = t0 >= 3 ? t0 - 3 : 0;
        const bf16* pc = P + OFF_XBC + cc; bf16* xo = XC + cc;
        v4u un[4];
#pragma unroll
        for (int k = 0; k < 4; ++k) { const int tt = ts + k < t1 ? ts + k : t1 - 1; un[k] = *(const v4u*)(pc + (size_t)tt * NPAD); }
        for (int tb = ts; tb < t1; tb += 4) { v4u uc[4];
#pragma unroll
            for (int k = 0; k < 4; ++k) uc[k] = un[k];
            if (tb + 4 < t1) {
#pragma unroll
                for (int k = 0; k < 4; ++k) { const int tt = tb + 4 + k < t1 ? tb + 4 + k : t1 - 1; un[k] = *(const v4u*)(pc + (size_t)tt * NPAD); } }
#pragma unroll
            for (int k = 0; k < 4; ++k) { const int t = tb + k; if (t < t1) {
                const bool smp = t >= NTOK_P; const bool st = smp ? (((t - NTOK_P) & 31) == 0) : ((t & 2047) == 0);
                if (st) {
                    if (smp) { const float* cbuf = state_conv + (size_t)((t - NTOK_P) >> 5) * 4608 + cc;
#pragma unroll
                        for (int e = 0; e < 8; ++e) { a0[e] = cbuf[e]; a1[e] = cbuf[1536 + e]; a2[e] = cbuf[3072 + e]; } }
                    else {
#pragma unroll
                        for (int e = 0; e < 8; ++e) { a0[e] = 0.f; a1[e] = 0.f; a2[e] = 0.f; } } }
                float cur[8]; PRE_UNPK(cur, uc[k]);
                if (t >= t0) { float o[8];
#pragma unroll
                    for (int e = 0; e < 8; ++e) o[e] = siluf_(cb[e] + w[0][e] * a0[e] + w[1][e] * a1[e] + w[2][e] * a2[e] + w[3][e] * cur[e]);
                    v4u ov; ov.x = pk2(o[0], o[1]); ov.y = pk2(o[2], o[3]); ov.z = pk2(o[4], o[5]); ov.w = pk2(o[6], o[7]);
                    *(v4u*)(xo + (size_t)t * 1536) = ov; }
#pragma unroll
                for (int e = 0; e < 8; ++e) { a0[e] = a1[e]; a1[e] = a2[e]; a2[e] = cur[e]; } } }
        }
    }
#undef PRE_UNPK
    const int dsp = NGW >= 528 * 2 ? NGW / (528 * 2) : 1;
    for (int it = (gw % dsp == 0) ? gw / dsp : 1056; it < 1056; it += NGW / dsp) {
        const int rb = it >> 1, h0 = (it & 1) * 8; const size_t row = (size_t)rb * 64 + lane;
        const v4u d0 = *(const v4u*)(P + row * NPAD + OFF_DT + h0);
        const float xr[8] = {bflo(d0.x), bfhi(d0.x), bflo(d0.y), bfhi(d0.y), bflo(d0.z), bfhi(d0.z), bflo(d0.w), bfhi(d0.w)};
        float dtv[8], av[8], csv[8];
#pragma unroll
        for (int h = 0; h < 8; ++h) { const float xv = xr[h] + dt_bias[h0 + h]; const float eu = __expf(-fabsf(xv)), ew = 1.0f + eu;
            const float l1p = (ew == 1.0f) ? eu : __logf(ew) * (eu * __builtin_amdgcn_rcpf(ew - 1.0f)); const float dt = fmaxf(xv, 0.f) + l1p; const float a = -dt * __expf(a_log[h0 + h]); dtv[h] = dt; av[h] = a; csv[h] = a; }
#pragma unroll
        for (int o = 1; o < 64; o <<= 1) {
#pragma unroll
            for (int h = 0; h < 8; ++h) { const float t = __shfl_up(csv[h], o); if (lane >= o) csv[h] += t; } }
#pragma unroll
        for (int q = 0; q < 2; ++q) { *(f32x4*)(DTb + row * 16 + h0 + 4 * q) = (f32x4){dtv[4 * q], dtv[4 * q + 1], dtv[4 * q + 2], dtv[4 * q + 3]};
            *(f32x4*)(ADT + row * 16 + h0 + 4 * q) = (f32x4){av[4 * q], av[4 * q + 1], av[4 * q + 2], av[4 * q + 3]};
            *(f32x4*)(ACUM + row * 16 + h0 + 4 * q) = (f32x4){csv[4 * q], csv[4 * q + 1], csv[4 * q + 2], csv[4 * q + 3]}; }
    }
    for (int e = gw * 64 + lane; e < 48 * 4608; e += NGW * 64) {
        const int sq = e / 4608, r = e - sq * 4608, j = r / 1536, cc = r - j * 1536;
        const size_t row = sq < 16 ? (size_t)sq * 2048 + 2045 + j : (size_t)NTOK_P + (sq - 16) * 32 + 29 + j;
        const float v = bf1(P[row * NPAD + OFF_XBC + cc]);
        if (sq < 16) conv_out_p[sq * 4608 + r] = v; else conv_out_s[(sq - 16) * 4608 + r] = v;
    }
}

__device__ __forceinline__ void ssd_item(LAS unsigned char* lds, int tid, int lane, int wave, const bf16* P, const bf16* XC, const float* DTb, const float* ADT, bf16* YB, int row0, int T, int h,
                                         const float* s0, float* sout, float Dh) {
    LAS float* X = (LAS float*)lds;
    LAS float* Bs = X + 2048;
    LAS float* Cs = Bs + 4096;
    LAS float* DT = Cs + 4096;
    LAS float* DA = DT + 32;
    LAS float* PY = DA + 32;
    const int g = h >> 3, ci = tid;
    int cc = 0; LAS float* dst = X; int dstride = 64;
    if (ci < 64) { cc = h * 64 + ci; dst = X + ci; dstride = 64; } else if (ci < 192) { cc = 1024 + g * 128 + (ci - 64); dst = Bs + (ci - 64); dstride = 128; } else if (ci < 320) { cc = 1280 + g * 128 + (ci - 192); dst = Cs + (ci - 192); dstride = 128; }
    float hst[16];
#pragma unroll
    for (int j = 0; j < 4; ++j) { f32x4 v = (f32x4){0.f, 0.f, 0.f, 0.f}; if (s0) v = *(const f32x4*)(s0 + lane * 128 + 16 * wave + 4 * j); hst[4 * j] = v.x; hst[4 * j + 1] = v.y; hst[4 * j + 2] = v.z; hst[4 * j + 3] = v.w; }
    __syncthreads();
    const int nch = T / 32;
    for (int c = 0; c < nch; ++c) {
        const size_t rbase = (size_t)(row0 + c * 32);
        if (ci < 320) { const bf16* pc = XC + rbase * 1536 + cc;
            bf16 sv[32];
#pragma unroll
            for (int t = 0; t < 32; ++t) sv[t] = pc[(size_t)t * 1536];
#pragma unroll
            for (int t = 0; t < 32; ++t) dst[t * dstride] = bf1(sv[t]); }
        else if (ci < 352) { const int t = ci - 320; DT[t] = DTb[(rbase + t) * 16 + h]; DA[t] = __expf(ADT[(rbase + t) * 16 + h]); }
        unsigned zg[2];
#pragma unroll
        for (int j = 0; j < 2; ++j) { const int e = tid + 512 * j; zg[j] = *(const unsigned*)(P + (rbase + (e >> 5)) * NPAD + OFF_BZ + h * 64 + (e & 31) * 2); }
        __syncthreads();
#pragma unroll 2
        for (int t = 0; t < 32; ++t) {
            const float dA = DA[t], xdt = X[t * 64 + lane] * DT[t]; float py = 0.f;
#pragma unroll
            for (int n4 = 0; n4 < 4; ++n4) { const f32x4 b4 = *(const LAS f32x4*)(Bs + t * 128 + 16 * wave + 4 * n4), c4 = *(const LAS f32x4*)(Cs + t * 128 + 16 * wave + 4 * n4);
#pragma unroll
                for (int j = 0; j < 4; ++j) { const int nn = 4 * n4 + j; hst[nn] = fmaf(xdt, b4[j], dA * hst[nn]); py = fmaf(hst[nn], c4[j], py); } }
            PY[(t * 8 + wave) * 64 + lane] = py;
        }
        __syncthreads();
#pragma unroll
        for (int j = 0; j < 2; ++j) { const int e = tid + 512 * j, t = e >> 5, p2 = (e & 31) * 2; float y0 = 0.f, y1 = 0.f;
#pragma unroll
            for (int w = 0; w < 8; ++w) { const f32x2 p = *(const LAS f32x2*)(PY + (t * 8 + w) * 64 + p2); y0 += p.x; y1 += p.y; }
            const f32x2 xv = *(const LAS f32x2*)(X + t * 64 + p2); y0 += Dh * xv.x; y1 += Dh * xv.y;
            const size_t row = rbase + t; const unsigned z = zg[j];
            *(unsigned*)(YB + row * 1024 + h * 64 + p2) = pk2(y0 * siluf_(bflo(z)), y1 * siluf_(bfhi(z))); }
        __syncthreads();
    }
#pragma unroll
    for (int j = 0; j < 4; ++j) *(f32x4*)(sout + lane * 128 + 16 * wave + 4 * j) = (f32x4){hst[4 * j], hst[4 * j + 1], hst[4 * j + 2], hst[4 * j + 3]};
    __syncthreads();
}

__device__ __forceinline__ bf16 v4u_el(const v4u& d, int e) { const unsigned w = d[e >> 1]; return (bf16)((e & 1) ? (w >> 16) : (w & 0xffffu)); }
__device__ __forceinline__ void ssd_mfma_pair(LAS unsigned char* lds, int tid, int lane, int wave, const bf16* P, const bf16* XC, const float* DTb, const float* ACUM, bf16* YB, int row0, int h0, float Dh0, float Dh1, float* sout0) {
    constexpr int PC = 136, PS = 72;
    LAS bf16* Cm0 = (LAS bf16*)lds;
    LAS bf16* Bm = Cm0 + 2 * 64 * PC;
    LAS bf16* BmT = Bm + 64 * PC;
    LAS bf16* XT0 = BmT + 128 * PS;
    LAS bf16* Mm0 = XT0 + 4 * 64 * PS;
    LAS float* AC0 = (LAS float*)(Mm0 + 2 * 64 * PS);
    static_assert((2 * 64 * PC + 64 * PC + 128 * PS + 4 * 64 * PS + 2 * 64 * PS) * 2 + 4 * 192 * 4 <= RING_BYTES, "ssd pair LDS");
    const int fr = lane & 15, fq = lane >> 4, g = h0 >> 3;
    const int hw = wave >> 2, pt = wave & 3;
    __syncthreads();
    f32x4 hacc[8];
#pragma unroll
    for (int j = 0; j < 8; ++j) hacc[j] = (f32x4){0.f, 0.f, 0.f, 0.f};
    int pf_s[6], pf_c[6]; v4u pf[6];
#pragma unroll
    for (int j = 0; j < 6; ++j) { const int q = tid + 512 * j; pf_s[j] = q / 48; const int c16 = q - 48 * pf_s[j];
        const int col = c16 < 16 ? (h0 + (c16 >> 3)) * 64 + 8 * (c16 & 7) : (c16 < 32 ? 1024 + g * 128 + 8 * (c16 - 16) : 1280 + g * 128 + 8 * (c16 - 32));
        pf_c[j] = (c16 << 16) | col; pf[j] = *(const v4u*)((const char*)XC + (unsigned)(((unsigned)row0 + pf_s[j]) * 1536u + col) * 2u); }
    float pf_ac = 0.f, pf_dt = 0.f, pf_acl = 0.f; const int sh = tid >> 6, ssx = tid & 63;
    if (tid < 128) { pf_ac = *(const float*)((const char*)ACUM + (unsigned)(((unsigned)row0 + ssx) * 16u + h0 + sh) * 4u); pf_dt = *(const float*)((const char*)DTb + (unsigned)(((unsigned)row0 + ssx) * 16u + h0 + sh) * 4u); pf_acl = *(const float*)((const char*)ACUM + (unsigned)(((unsigned)row0 + 63u) * 16u + h0 + sh) * 4u); }
    for (int c = 0; c < 32; ++c) {
        const unsigned rbase = (unsigned)row0 + 64u * c;
        bf16 zr[4][4];
#pragma unroll
        for (int li = 0; li < 4; ++li)
#pragma unroll
            for (int r = 0; r < 4; ++r) zr[li][r] = *(const bf16*)((const char*)P + (unsigned)((rbase + 16 * li + 4 * fq + r) * (unsigned)NPAD + OFF_BZ + (h0 + hw) * 64 + 16 * pt + fr) * 2u);
        const int cb = c & 1;
        LAS bf16* Cm = Cm0 + cb * 64 * PC; LAS bf16* XTb = XT0 + cb * 2 * 64 * PS; LAS float* ACb = AC0 + cb * 2 * 192;
        if (tid < 128) { LAS float* A = ACb + sh * 192; A[ssx] = pf_ac; A[128 + ssx] = pf_dt; A[64 + ssx] = __expf(pf_acl - pf_ac) * pf_dt; }
#pragma unroll
        for (int j = 0; j < 6; ++j) { const int s = pf_s[j], c16 = pf_c[j] >> 16; const v4u d = pf[j];
            if (c16 < 16) { LAS bf16* XT = XTb + (c16 >> 3) * 64 * PS; const int cc = c16 & 7;
#pragma unroll
                for (int e = 0; e < 8; ++e) XT[(8 * cc + e) * PS + (s ^ (cc << 3))] = v4u_el(d, e); }
            else if (c16 < 32) { const int n0 = 8 * (c16 - 16); *(LAS v4u*)(Bm + s * PC + n0) = d;
#pragma unroll
                for (int e = 0; e < 8; ++e) BmT[(n0 + e) * PS + (s ^ (((c16 - 16) & 7) << 3))] = v4u_el(d, e); }
            else { *(LAS v4u*)(Cm + s * PC + 8 * (c16 - 32)) = d; } }
        if (c + 1 < 32) {
#pragma unroll
            for (int j = 0; j < 6; ++j) pf[j] = *(const v4u*)((const char*)XC + (unsigned)((rbase + 64u + pf_s[j]) * 1536u + (pf_c[j] & 0xffff)) * 2u);
            if (tid < 128) { pf_ac = *(const float*)((const char*)ACUM + (unsigned)((rbase + 64u + ssx) * 16u + h0 + sh) * 4u); pf_dt = *(const float*)((const char*)DTb + (unsigned)((rbase + 64u + ssx) * 16u + h0 + sh) * 4u); pf_acl = *(const float*)((const char*)ACUM + (unsigned)((rbase + 127u) * 16u + h0 + sh) * 4u); } }
        BAR_LDS();
        const LAS float* AC = ACb + hw * 192; const LAS bf16* XT = XTb + hw * 64 * PS;
        f32x4 yo[4];
        { bf16x8_t hb[4];
#pragma unroll
          for (int m = 0; m < 4; ++m) { v4u o; o.x = pk2(hacc[2 * m][0], hacc[2 * m][1]); o.y = pk2(hacc[2 * m][2], hacc[2 * m][3]); o.z = pk2(hacc[2 * m + 1][0], hacc[2 * m + 1][1]); o.w = pk2(hacc[2 * m + 1][2], hacc[2 * m + 1][3]);
              hb[m] = __builtin_bit_cast(bf16x8_t, o); }
#pragma unroll
          for (int li = 0; li < 4; ++li) { yo[li] = (f32x4){0.f, 0.f, 0.f, 0.f};
#pragma unroll
              for (int m = 0; m < 4; ++m) { const LAS bf16* cp = Cm + (16 * li + fr) * PC + 32 * m + 4 * fq; const v2u c0 = *(const LAS v2u*)cp, c1 = *(const LAS v2u*)(cp + 16);
                  v4u xo; xo.x = c0.x; xo.y = c0.y; xo.z = c1.x; xo.w = c1.y; yo[li] = MFMA16(__builtin_bit_cast(bf16x8_t, xo), hb[m], yo[li]); } } }
        { const LAS float* WU = AC + 64; const float dec = __expf(AC[63]);
          bf16x8_t xs[2];
#pragma unroll
          for (int ss = 0; ss < 2; ++ss) { const v4u d = *(const LAS v4u*)(XT + (16 * pt + fr) * PS + ((32 * ss + 8 * fq) ^ (((2 * pt + (fr >> 3)) & 7) << 3)));
              const f32x4 wa = *(const LAS f32x4*)(WU + 32 * ss + 8 * fq), wb = *(const LAS f32x4*)(WU + 32 * ss + 8 * fq + 4);
              v4u o; o.x = pk2(bflo(d.x) * wa.x, bfhi(d.x) * wa.y); o.y = pk2(bflo(d.y) * wa.z, bfhi(d.y) * wa.w); o.z = pk2(bflo(d.z) * wb.x, bfhi(d.z) * wb.y); o.w = pk2(bflo(d.w) * wb.z, bfhi(d.w) * wb.w);
              xs[ss] = __builtin_bit_cast(bf16x8_t, o); }
#pragma unroll
          for (int j = 0; j < 8; ++j) { hacc[j] = hacc[j] * dec;
#pragma unroll
              for (int ss = 0; ss < 2; ++ss) hacc[j] = MFMA16(LDFRAG(BmT, 16 * j + fr, PS, (32 * ss + 8 * fq) ^ (((2 * j + (fr >> 3)) & 7) << 3)), xs[ss], hacc[j]); } }
        {
            const int li = wave >> 1, si0 = 2 * (wave & 1);
#pragma unroll
            for (int tt = 0; tt < 2; ++tt) { const int si = si0 + tt; f32x4 acc = (f32x4){0.f, 0.f, 0.f, 0.f};
                if (si <= li) {
#pragma unroll
                    for (int ks = 0; ks < 4; ++ks) acc = MFMA16(LDFRAG(Cm, 16 * li + fr, PC, 32 * ks + 8 * fq), LDFRAG(Bm, 16 * si + fr, PC, 32 * ks + 8 * fq), acc); }
                const int s = 16 * si + fr;
#pragma unroll
                for (int hh = 0; hh < 2; ++hh) { const LAS float* A2 = ACb + hh * 192; LAS bf16* Mm = Mm0 + hh * 64 * PS; const float acs = A2[s], dts = A2[128 + s];
#pragma unroll
                    for (int r = 0; r < 4; ++r) { const int l = 16 * li + 4 * fq + r; const float m = (s <= l) ? acc[r] * __expf(A2[l] - acs) * dts : 0.f; Mm[l * PS + s] = (bf16)f2bf(m); } } }
        }
        BAR_LDS();
        {
            const LAS bf16* Mm = Mm0 + hw * 64 * PS; const int h = h0 + hw; const float Dh = hw ? Dh1 : Dh0; const int p = 16 * pt + fr;
            bf16x8_t xf[2];
#pragma unroll
            for (int ss = 0; ss < 2; ++ss) xf[ss] = LDFRAG(XT, 16 * pt + fr, PS, (32 * ss + 8 * fq) ^ (((2 * pt + (fr >> 3)) & 7) << 3));
#pragma unroll
            for (int li = 0; li < 4; ++li) { f32x4 yd = (f32x4){0.f, 0.f, 0.f, 0.f};
#pragma unroll
                for (int ss = 0; ss < 2; ++ss) { if (ss == 1 && li < 2) continue;
                    yd = MFMA16(LDFRAG(Mm, 16 * li + fr, PS, 32 * ss + 8 * fq), xf[ss], yd); }
#pragma unroll
                for (int r = 0; r < 4; ++r) { const int l = 16 * li + 4 * fq + r; const float y = yd[r] + __expf(AC[l]) * yo[li][r] + Dh * bf1(XT[p * PS + (l ^ (((p >> 3) & 7) << 3))]);
                    const float z = bf1(zr[li][r]);
                    *(bf16*)((char*)YB + (unsigned)((rbase + l) * 1024u + h * 64 + p) * 2u) = (bf16)f2bf(y * siluf_(z)); } }
        }
    }
#pragma unroll
    for (int j = 0; j < 8; ++j) *(f32x4*)(sout0 + (size_t)hw * 8192 + (16 * pt + fr) * 128 + 16 * j + 4 * fq) = hacc[j];
    __syncthreads();
}

__device__ __forceinline__ unsigned cm_off_b(unsigned row, unsigned ch) { return 256u * row + 16u * (ch ^ (((row & 3u) << 2) | ((row >> 2) & 3u))); }
__device__ __forceinline__ unsigned cm_tr_addr(unsigned lane, unsigned c, unsigned ks, unsigned t) { const unsigned g = lane >> 4, q = (lane & 15) >> 2, p = lane & 3; return cm_off_b(32 * ks + 8 * g + 4 * t + q, 2 * c + (p >> 1)) + 8 * (p & 1); }
__device__ __forceinline__ void cmlp_mfma_item(LAS unsigned char* lds, int tid, int lane, int wave, bf16* P, bf16* YC, int row0, const float* ln_g, const float* ln_b, const float* wsl, const float* bsl) {
    constexpr int PW = 136;
    LAS bf16* Wb = (LAS bf16*)lds;
    LAS unsigned char* Vimg = lds + 34816;
    LAS bf16* OUTb = (LAS bf16*)(lds + 67584);
    LAS float* ST = (LAS float*)(lds + ST_OFF);
    const int fr = lane & 15, fq = lane >> 4;
    __syncthreads();
    v4u sa[4], sb[4];
    const unsigned cvo = (unsigned)(((unsigned)row0 + (unsigned)wave * 16u) * (unsigned)NPAD + OFF_CV + 16u * lane) * 2u;
#pragma unroll
    for (int j = 0; j < 4; ++j) { const v4u* p = (const v4u*)((const char*)P + cvo + (unsigned)j * (unsigned)(NPAD * 2)); sa[j] = p[0]; sb[j] = p[1]; }
#pragma unroll 1
    for (int ib = 0; ib < 4; ++ib) {
        v4u na[4], nb[4];
        if (ib < 3) {
#pragma unroll
            for (int j = 0; j < 4; ++j) { const v4u* p = (const v4u*)((const char*)P + cvo + (unsigned)(4 * ib + 4 + j) * (unsigned)(NPAD * 2)); na[j] = p[0]; nb[j] = p[1]; } }
#pragma unroll
        for (int j = 0; j < 4; ++j) { const int s = wave * 16 + 4 * ib + j; const v4u a = sa[j], b = sb[j];
            float v[16]; v[0] = bflo(a.x); v[1] = bfhi(a.x); v[2] = bflo(a.y); v[3] = bfhi(a.y); v[4] = bflo(a.z); v[5] = bfhi(a.z); v[6] = bflo(a.w); v[7] = bfhi(a.w);
            v[8] = bflo(b.x); v[9] = bfhi(b.x); v[10] = bflo(b.y); v[11] = bfhi(b.y); v[12] = bflo(b.z); v[13] = bfhi(b.z); v[14] = bflo(b.w); v[15] = bfhi(b.w);
            float sm = 0.f;
#pragma unroll
            for (int q = 0; q < 16; ++q) { v[q] = geluf_(v[q]); sm += v[q]; }
            v4u oa, ob; oa.x = pk2(v[0], v[1]); oa.y = pk2(v[2], v[3]); oa.z = pk2(v[4], v[5]); oa.w = pk2(v[6], v[7]); ob.x = pk2(v[8], v[9]); ob.y = pk2(v[10], v[11]); ob.z = pk2(v[12], v[13]); ob.w = pk2(v[14], v[15]);
            v4u* po = (v4u*)((char*)P + cvo + (unsigned)(4 * ib + j) * (unsigned)(NPAD * 2)); po[0] = oa; po[1] = ob;
            const float mean = wave_sum(sm) * (1.0f / 1024.0f); float sq = 0.f;
#pragma unroll
            for (int q = 0; q < 16; ++q) { const float d = v[q] - mean; sq += d * d; }
            const float rstd = rsqrtf_(wave_sum(sq) * (1.0f / 1024.0f) + NORM_EPS);
            if (lane == 0) { ST[2 * s] = mean; ST[2 * s + 1] = rstd; } }
        if (ib < 3) {
#pragma unroll
            for (int j = 0; j < 4; ++j) { sa[j] = na[j]; sb[j] = nb[j]; } }
    }
    __syncthreads();
    f32x4 wreg[8]; v2u vreg[8];
#pragma unroll
    for (int e = 0; e < 8; ++e) { const int q = tid + 512 * e; wreg[e] = *(const f32x4*)(wsl + (size_t)(q >> 5) * 128 + 4 * (q & 31)); vreg[e] = *(const v2u*)(P + (size_t)(row0 + (q >> 5)) * NPAD + OFF_CV + 4 * (q & 31)); }
    for (int gh = 0; gh < 8; ++gh) { const int g = gh >> 1, c0 = gh * 128;
        if ((gh & 1) == 0) {
#pragma unroll
            for (int e = 0; e < 8; ++e) { const int q = tid + 512 * e, t = q >> 5, s4 = 4 * (q & 31); const f32x4 w = wreg[e];
                v2u o; o.x = pk2(s4 + 0 <= t ? w.x : 0.f, s4 + 1 <= t ? w.y : 0.f); o.y = pk2(s4 + 2 <= t ? w.z : 0.f, s4 + 3 <= t ? w.w : 0.f); *(LAS v2u*)(Wb + t * PW + s4) = o; } }
#pragma unroll
        for (int e = 0; e < 8; ++e) { const int q = tid + 512 * e, sr = q >> 5, c4 = 4 * (q & 31); const v2u cv = vreg[e]; const float mean = ST[2 * sr], rstd = ST[2 * sr + 1];
            const f32x4 lg = *(const f32x4*)(ln_g + c0 + c4), lb = *(const f32x4*)(ln_b + c0 + c4);
            v2u o; o.x = pk2((bflo(cv.x) - mean) * rstd * lg.x + lb.x, (bfhi(cv.x) - mean) * rstd * lg.y + lb.y); o.y = pk2((bflo(cv.y) - mean) * rstd * lg.z + lb.z, (bfhi(cv.y) - mean) * rstd * lg.w + lb.w);
            *(LAS v2u*)(Vimg + cm_off_b((unsigned)sr, (unsigned)(c4 >> 3)) + 2 * (c4 & 7)) = o; }
        v4u ureg[4];
#pragma unroll
        for (int e = 0; e < 4; ++e) { const int q = tid + 512 * e; ureg[e] = *(const v4u*)(P + (size_t)(row0 + (q >> 4)) * NPAD + OFF_CU + c0 + 8 * (q & 15)); }
        if (gh + 1 < 8) {
#pragma unroll
            for (int e = 0; e < 8; ++e) { const int q = tid + 512 * e; vreg[e] = *(const v2u*)(P + (size_t)(row0 + (q >> 5)) * NPAD + OFF_CV + c0 + 128 + 4 * (q & 31)); }
            if (gh & 1) {
#pragma unroll
                for (int e = 0; e < 8; ++e) { const int q = tid + 512 * e; wreg[e] = *(const f32x4*)(wsl + ((size_t)(g + 1) * 128 + (q >> 5)) * 128 + 4 * (q & 31)); } } }
        BAR_LDS();
        { f32x4 acc[8];
#pragma unroll
            for (int ti = 0; ti < 8; ++ti) acc[ti] = (f32x4){0.f, 0.f, 0.f, 0.f};
            const unsigned vb = (unsigned)(size_t)Vimg;
#pragma unroll
            for (int ks = 0; ks < 4; ++ks) { v2u y0, y1;
                asm volatile("ds_read_b64_tr_b16 %0, %2\n\tds_read_b64_tr_b16 %1, %3\n\ts_waitcnt lgkmcnt(0)" : "=&v"(y0), "=&v"(y1) : "v"(vb + cm_tr_addr((unsigned)lane, (unsigned)wave, (unsigned)ks, 0u)), "v"(vb + cm_tr_addr((unsigned)lane, (unsigned)wave, (unsigned)ks, 1u)) : "memory");
                v4u yy; yy.x = y0.x; yy.y = y0.y; yy.z = y1.x; yy.w = y1.y; const bf16x8_t yf = __builtin_bit_cast(bf16x8_t, yy);
#pragma unroll
                for (int ti = 2 * ks; ti < 8; ++ti) acc[ti] = MFMA16(LDFRAG(Wb, 16 * ti + fr, PW, 32 * ks + 8 * fq), yf, acc[ti]); }
#pragma unroll
            for (int ti = 0; ti < 8; ++ti)
#pragma unroll
                for (int r = 0; r < 4; ++r) OUTb[(16 * ti + 4 * fq + r) * PW + 16 * wave + fr] = (bf16)f2bf(acc[ti][r]); }
        BAR_LDS();
#pragma unroll
        for (int e = 0; e < 4; ++e) { const int q = tid + 512 * e, t = q >> 4, c8 = 8 * (q & 15); const v4u o = *(const LAS v4u*)(OUTb + t * PW + c8); const v4u u = ureg[e]; const float bsv = bsl[g * 128 + t];
            v4u y; y.x = pk2(geluf_(bflo(u.x)) * (bflo(o.x) + bsv), geluf_(bfhi(u.x)) * (bfhi(o.x) + bsv)); y.y = pk2(geluf_(bflo(u.y)) * (bflo(o.y) + bsv), geluf_(bfhi(u.y)) * (bfhi(o.y) + bsv));
            y.z = pk2(geluf_(bflo(u.z)) * (bflo(o.z) + bsv), geluf_(bfhi(u.z)) * (bfhi(o.z) + bsv)); y.w = pk2(geluf_(bflo(u.w)) * (bflo(o.w) + bsv), geluf_(bfhi(u.w)) * (bfhi(o.w) + bsv));
            *(v4u*)(YC + (size_t)(row0 + t) * 1024 + c0 + c8) = y; }
    }
    __syncthreads();
}

__device__ __forceinline__ void cmlp_item(LAS unsigned char* lds, int tid, int lane, int wave, const bf16* P, bf16* YC, int row0, int Lc,
                                          const float* ln_g, const float* ln_b, const float* wsl, const float* bsl, float* vout) {
    LAS float* WT = (LAS float*)lds;
    LAS float* V = WT + 16384;
    LAS float* ST = (LAS float*)(lds + ST_OFF);
    __syncthreads();
    for (int i = 0; i < 16; ++i) { const int s = wave * 16 + i; if (s < Lc) {
            const v4u* p = (const v4u*)(P + (size_t)(row0 + s) * NPAD + OFF_CV + 16 * lane); const v4u a = p[0], b = p[1];
            float v[16]; v[0] = bflo(a.x); v[1] = bfhi(a.x); v[2] = bflo(a.y); v[3] = bfhi(a.y); v[4] = bflo(a.z); v[5] = bfhi(a.z); v[6] = bflo(a.w); v[7] = bfhi(a.w);
            v[8] = bflo(b.x); v[9] = bfhi(b.x); v[10] = bflo(b.y); v[11] = bfhi(b.y); v[12] = bflo(b.z); v[13] = bfhi(b.z); v[14] = bflo(b.w); v[15] = bfhi(b.w);
            float sm = 0.f;
#pragma unroll
            for (int j = 0; j < 16; ++j) { v[j] = geluf_(v[j]); sm += v[j]; }
            const float mean = wave_sum(sm) * (1.0f / 1024.0f); float sq = 0.f;
#pragma unroll
            for (int j = 0; j < 16; ++j) { const float d = v[j] - mean; sq += d * d; }
            const float rstd = 1.0f / sqrtf(wave_sum(sq) * (1.0f / 1024.0f) + NORM_EPS);
            if (lane == 0) { ST[2 * s] = mean; ST[2 * s + 1] = rstd; } } }
    const int tg = tid >> 4, cg = tid & 15;
    for (int g = 0; g < 4; ++g) {
        __syncthreads();
#pragma unroll 1
        for (int j = 0; j < 8; ++j) { const int e = tid + 512 * j, s4 = (e >> 7) * 4, t = e & 127;
            f32x4 w = (f32x4){0.f, 0.f, 0.f, 0.f}; if (t < Lc && s4 < Lc) w = *(const f32x4*)(wsl + ((size_t)g * 128 + t) * 128 + s4);
#pragma unroll
            for (int jj = 0; jj < 4; ++jj) WT[(s4 + jj) * 128 + t] = (s4 + jj <= t) ? w[jj] : 0.f; }
        for (int half = 0; half < 2; ++half) { const int c0 = g * 256 + half * 128;
            if (half) __syncthreads();
#pragma unroll 2
            for (int j = 0; j < 8; ++j) { const int e = tid + 512 * j, s = e >> 5, c4 = (e & 31) * 4;
                if (s < Lc) { const v2u cv = *(const v2u*)(P + (size_t)(row0 + s) * NPAD + OFF_CV + c0 + c4); const float mean = ST[2 * s], rstd = ST[2 * s + 1];
                    const f32x4 lg = *(const f32x4*)(ln_g + c0 + c4), lb = *(const f32x4*)(ln_b + c0 + c4);
                    f32x4 v; v.x = (geluf_(bflo(cv.x)) - mean) * rstd * lg.x + lb.x; v.y = (geluf_(bfhi(cv.x)) - mean) * rstd * lg.y + lb.y; v.z = (geluf_(bflo(cv.y)) - mean) * rstd * lg.z + lb.z; v.w = (geluf_(bfhi(cv.y)) - mean) * rstd * lg.w + lb.w;
                    *(LAS f32x4*)(V + s * 128 + c4) = v; if (vout) *(f32x4*)(vout + (size_t)s * 1024 + c0 + c4) = v; } }
            __syncthreads();
            float acc[4][8];
#pragma unroll
            for (int i = 0; i < 4; ++i)
#pragma unroll
                for (int j = 0; j < 8; ++j) acc[i][j] = 0.f;
            for (int s = 0; s < Lc; ++s) { const f32x4 w4 = *(const LAS f32x4*)(WT + s * 128 + 4 * tg), va = *(const LAS f32x4*)(V + s * 128 + 4 * cg), vb = *(const LAS f32x4*)(V + s * 128 + 64 + 4 * cg);
#pragma unroll
                for (int i = 0; i < 4; ++i) {
#pragma unroll
                    for (int j = 0; j < 4; ++j) { acc[i][j] = fmaf(w4[i], va[j], acc[i][j]); acc[i][4 + j] = fmaf(w4[i], vb[j], acc[i][4 + j]); } } }
#pragma unroll
            for (int i = 0; i < 4; ++i) { const int t = 4 * tg + i; if (t < Lc) { const size_t row = (size_t)(row0 + t); const float bsv = bsl[g * 128 + t];
                    const v2u ua = *(const v2u*)(P + row * NPAD + OFF_CU + c0 + 4 * cg), ub = *(const v2u*)(P + row * NPAD + OFF_CU + c0 + 64 + 4 * cg);
                    v2u oa, ob; oa.x = pk2(geluf_(bflo(ua.x)) * (acc[i][0] + bsv), geluf_(bfhi(ua.x)) * (acc[i][1] + bsv)); oa.y = pk2(geluf_(bflo(ua.y)) * (acc[i][2] + bsv), geluf_(bfhi(ua.y)) * (acc[i][3] + bsv));
                    ob.x = pk2(geluf_(bflo(ub.x)) * (acc[i][4] + bsv), geluf_(bfhi(ub.x)) * (acc[i][5] + bsv)); ob.y = pk2(geluf_(bflo(ub.y)) * (acc[i][6] + bsv), geluf_(bfhi(ub.y)) * (acc[i][7] + bsv));
                    *(v2u*)(YC + row * 1024 + c0 + 4 * cg) = oa; *(v2u*)(YC + row * 1024 + c0 + 64 + 4 * cg) = ob; } }
        }
    }
    __syncthreads();
}

#ifndef DOWN_REV
#define DOWN_REV 1
#endif
#ifndef EPI_ALIGN_HEAVY
#define EPI_ALIGN_HEAVY true
#endif
#ifndef TAIL_SPLIT
#define TAIL_SPLIT 1
#endif
#ifndef MK_N_LAUNCHES
#define MK_N_LAUNCHES 1
#endif
constexpr int PH_PER_LAYER = 10, N_PHASES = 2 + DEPTH * PH_PER_LAYER;
constexpr int Q_NITEMS = 128 + 128 + 256 + 256 + 512 + 32;
struct Args { const float* in[29]; float* out; unsigned char* ws; int ph_lo, ph_hi; };
static_assert(sizeof(Args) == 29 * 8 + 8 + 8 + 8, "no padding in Args");

typedef const __attribute__((address_space(4))) unsigned long long* karg_t;
__device__ __forceinline__ unsigned long long ldarg(int i) { karg_t p = (karg_t)__builtin_amdgcn_kernarg_segment_ptr(); asm volatile("" : "+s"(p)); return p[i]; }
#define INP(i) ((const float*)(const GAS float*)ldarg(i))
#define OUTP() ((float*)(GAS float*)ldarg(29))
#define WSP() ((unsigned char*)(GAS unsigned char*)ldarg(30))

__device__ __forceinline__ int tid_now(int wave_s) { return (int)__builtin_amdgcn_mbcnt_hi(~0u, __builtin_amdgcn_mbcnt_lo(~0u, 0u)) + 64 * wave_s; }
__global__ void __launch_bounds__(NWAVES * 64, 2) fwd(Args args) {
    extern __shared__ __attribute__((aligned(16))) unsigned char lds_raw[];
    LAS unsigned char* lds = (LAS unsigned char*)lds_raw;
    volatile LAS unsigned* MISC = (volatile LAS unsigned*)(lds + MISC_OFF);
    const int wave_s = __builtin_amdgcn_readfirstlane((int)threadIdx.x >> 6);
    for (int u = threadIdx.x; u < 64; u += NWAVES * 64) MISC[u] = 0u;
    __syncthreads();
    XcdBarrier bar = xcd_barrier_post((unsigned*)WSP() + CW_BAR, MISC + 8, (int)threadIdx.x);
    const int lo = args.ph_lo, hi = args.ph_hi;
#define IN(k) (lo <= (k) && (k) < hi)
#define SEAM(k) do { if (IN((k) + 1)) { XcdBarrier b2_ = bar; b2_.bar = (unsigned*)WSP() + CW_BAR; asm volatile("" : "+s"(b2_.x)); xcd_barrier(b2_, tid_now(wave_s)); } } while (0)
#define GEOM() int tid = tid_now(wave_s); asm volatile("" : "+v"(tid)); int G = gridDim.x, bx = blockIdx.x; asm volatile("" : "+s"(G), "+s"(bx)); \
    const int lane = tid & 63, wave = __builtin_amdgcn_readfirstlane(tid >> 6); \
    const int vcu = (G % 8 == 0) ? (bx % 8) * (G / 8) + bx / 8 : bx; const int gw = vcu * NWAVES + wave, NGW = G * NWAVES; (void)lane; (void)gw; (void)NGW; (void)wave; (void)tid

    if (IN(0)) { GEOM();
        for (int it = bx; it < DEPTH * 96; it += G) mod_item(lds, tid, it, INP(5), INP(6), INP(9), INP(10), (float*)(WSP() + WS_MOD));
        { unsigned char* ws = WSP(); cvt_phase<true>(lds, wave, lane, 0, 0, 0, INP(11), INP(24), INP(25), INP(26), INP(27), ws + wofs(0), (unsigned*)ws + CW_QC); }
        SEAM(0);
    }
    for (int lc = 0; lc < DEPTH; ++lc) {
        const int pb = 1 + PH_PER_LAYER * lc;
        if (IN(pb + 0)) { GEOM(); int l = lc; asm volatile("" : "+s"(l)); unsigned char* ws = WSP(); bf16* X = (bf16*)(ws + WS_X);
            const bool comb = TAIL_SPLIT && l > 0; if (comb) build_tail_map((LAS int*)lds, tid, G, DOWN_REV);
            const float* modl = (const float*)(ws + WS_MOD) + (size_t)l * NSEQ * 12288;
            if (l == 0) norm_mod_phase<true>(lane, gw, NGW, INP(0), INP(1), X, INP(7), modl, 0, 1, (bf16*)(ws + WS_H), false, (const LAS int*)lds, (const float*)(ws + WS_SLAB), false);
            else norm_mod_phase<false>(lane, gw, NGW, nullptr, nullptr, X, INP(7) + l * DM, modl, 0, 1, (bf16*)(ws + WS_H), comb, (const LAS int*)lds, (const float*)(ws + WS_SLAB), false);
            SEAM(pb + 0);
        }
        if (IN(pb + 1)) { unsigned char* ws = WSP(); const int G = gridDim.x, bx = blockIdx.x;
            pg8::Gemm g{(const bf16*)(ws + WS_H), (const bf16*)(ws + wofs(lc) + WS_WIN), MT, NPAD, DM, DM}; pg8::StaticOrder S; S.init(MT, NPAD, G, bx);
            pg8::EpiStore<0> E{(bf16*)(ws + WS_P), NPAD};
#ifndef REP_P1
#define REP_P1 1
#endif
#pragma unroll 1
            for (int rp = 0; rp < REP_P1; ++rp)
#ifndef WIN_B_AUX
#define WIN_B_AUX 0
#endif
#ifdef SPLIT_WIN
            { S.nlim = (S.nwg / (2 * G)) * G; pg8::gemm_phase<pg8::EpiStore<0>, pg8::StaticOrder, true, true, 0, WIN_B_AUX>(lds, g, S, E, tid_now(wave_s));
              { XcdBarrier b2_ = bar; b2_.bar = (unsigned*)WSP() + CW_BAR; asm volatile("" : "+s"(b2_.x)); xcd_barrier(b2_, tid_now(wave_s)); }
              S.off = S.nlim; S.nlim = S.nwg; }
#endif
            pg8::gemm_phase<pg8::EpiStore<0>, pg8::StaticOrder, true, true, 0, WIN_B_AUX>(lds, g, S, E, tid_now(wave_s));
            SEAM(pb + 1);
        }
        if (IN(pb + 2)) { GEOM(); int l = lc; asm volatile("" : "+s"(l)); unsigned char* ws = WSP(); float* out = OUTP();
#ifndef REP_P2
#define REP_P2 1
#endif
#pragma unroll 1
            for (int rp = 0; rp < REP_P2; ++rp)
            ssd_pre_phase(lane, gw, NGW, (const bf16*)(ws + WS_P), (bf16*)(ws + WS_XC), (float*)(ws + WS_DT), (float*)(ws + WS_DT + DT_ARR), (float*)(ws + WS_DT + 2 * DT_ARR),
                          INP(14) + (size_t)l * 4 * 1536, INP(15) + l * 1536, INP(16) + l * 16, INP(17) + l * 16, INP(4) + (size_t)l * 32 * 4608, out + OUT_CONV_P + (size_t)l * 16 * 4608, out + OUT_CONV_S + (size_t)l * 32 * 4608);
            SEAM(pb + 2);
        }
        if (IN(pb + 3)) { GEOM(); int l = lc; asm volatile("" : "+s"(l));
#ifndef MIX_REPS
#define MIX_REPS 1
#endif
#pragma unroll 1
            for (int rep = 0; rep < MIX_REPS; ++rep)
            for (;;) {
                unsigned char* ws = WSP(); float* out = OUTP(); bf16* Pb = (bf16*)(ws + WS_P); bf16* Y3 = (bf16*)(ws + WS_Y3);
                __syncthreads();
                if (tid_now(wave_s) == 0) MISC[0] = __hip_atomic_fetch_add((unsigned*)ws + CW_Q + 64 * (l + 4 * rep), 1u, __ATOMIC_RELAXED, __HIP_MEMORY_SCOPE_AGENT);
                __syncthreads();
                int it = (int)MISC[0];
#ifdef EXTRA_BASE
                if (it >= Q_NITEMS && it < Q_NITEMS + EXTRA_N) it = EXTRA_BASE + (it - Q_NITEMS);
#endif
                if (it >= Q_NITEMS) break;
                it = it < 256 ? it : (it < 288 ? it + 1024 : it - 32);
#define ITEM_GEOM() int tid_i = tid_now(wave_s); asm volatile("" : "+v"(tid_i)); const int lane_i = tid_i & 63, wave_i = __builtin_amdgcn_readfirstlane(tid_i >> 6)
                if (it < 128) {
                    const int b = 15 - (it >> 3), h = it & 7;
                    ITEM_GEOM(); hgrn_mfma_item(lds, tid_i, lane_i, wave_i, Pb, Y3, b * 2048, h, l, out + OUT_HGRN_P + (((size_t)l * 16 + b) * 8 + h) * 16384, INP(12), INP(13) + l * 1024);
                } else if (it < 256) {
                    const int j = it - 128, b = 15 - (j >> 3), h0 = 2 * (j & 7);
                    ITEM_GEOM(); ssd_mfma_pair(lds, tid_i, lane_i, wave_i, Pb, (const bf16*)(ws + WS_XC), (const float*)(ws + WS_DT), (const float*)(ws + WS_DT + 2 * DT_ARR), Y3 + (size_t)MT * 1024, b * 2048, h0, INP(18)[l * 16 + h0], INP(18)[l * 16 + h0 + 1],
                                  out + OUT_SSM_P + (((size_t)l * 16 + b) * 16 + h0) * 8192);
                } else if (it < 512) {
                    ITEM_GEOM(); cmlp_mfma_item(lds, tid_i, lane_i, wave_i, Pb, Y3 + (size_t)2 * MT * 1024, (255 - (it - 256)) * 128, INP(20) + l * 1024, INP(21) + l * 1024, INP(22) + (size_t)l * 4 * 16384, INP(23) + l * 512);
                } else if (it < 768) {
                    const int j = it - 512, b = j >> 3, h = j & 7;
                    ITEM_GEOM(); hgrn_item(lds, tid_i, lane_i, wave_i, Pb, Y3, NTOK_P + b * 32, 32, h, l, INP(2) + (((size_t)l * 32 + b) * 8 + h) * 16384, out + OUT_HGRN_S + (((size_t)l * 32 + b) * 8 + h) * 16384, INP(12), INP(13) + l * 1024);
                } else if (it < 1280) {
                    const int j = it - 768, b = j >> 4, h = j & 15;
                    ITEM_GEOM(); ssd_item(lds, tid_i, lane_i, wave_i, Pb, (const bf16*)(ws + WS_XC), (const float*)(ws + WS_DT), (const float*)(ws + WS_DT + DT_ARR), Y3 + (size_t)MT * 1024, NTOK_P + b * 32, 32, h,
                             INP(3) + (((size_t)l * 32 + b) * 16 + h) * 8192, out + OUT_SSM_S + (((size_t)l * 32 + b) * 16 + h) * 8192, INP(18)[l * 16 + h]);
                } else {
                    const int j = it - 1280;
                    ITEM_GEOM(); cmlp_item(lds, tid_i, lane_i, wave_i, Pb, Y3 + (size_t)2 * MT * 1024, NTOK_P + j * 32, 32, INP(20) + l * 1024, INP(21) + l * 1024, INP(22) + (size_t)l * 4 * 16384, INP(23) + l * 512, out + OUT_V_S + ((size_t)l * 32 + j) * 32 * 1024);
                }
            }
            SEAM(pb + 3);
        }
        if (IN(pb + 4)) { GEOM(); int l = lc; asm volatile("" : "+s"(l)); ssd_norm_phase(lane, gw, NGW, (bf16*)(WSP() + WS_Y3) + (size_t)MT * 1024, INP(19) + l * 1024); SEAM(pb + 4); }
        if (IN(pb + 5)) { unsigned char* ws = WSP(); const int G = gridDim.x, bx = blockIdx.x;
            pg8::Gemm g{(const bf16*)(ws + WS_Y3), (const bf16*)(ws + wofs(lc) + WS_WBR), 3 * MT, 3 * DM, 1024, 1024}; pg8::BranchOrder S; S.init(MT / 256, DM / 256, G, bx);
            pg8::EpiBranch E{(const bf16*)(ws + WS_P), NPAD, OFF_GATE, (bf16*)(ws + WS_H), DM, MT / 256, DM / 256};
#ifndef STAGGER_BR
#define STAGGER_BR 0
#endif
            if (STAGGER_BR && ((bx >> 3) & 1)) { for (int i = 0; i < STAGGER_BR; ++i) __builtin_amdgcn_s_sleep(127); }
#ifndef REP_P5
#define REP_P5 1
#endif
#pragma unroll 1
            for (int rp = 0; rp < REP_P5; ++rp)
            pg8::gemm_phase<pg8::EpiBranch, pg8::BranchOrder, EPI_ALIGN_HEAVY, true>(lds, g, S, E, tid_now(wave_s));
            if (lc + 1 < DEPTH) {
                GEOM(); int l1 = lc + 1; asm volatile("" : "+s"(l1)); unsigned char* ws2 = WSP();
                cvt_phase<true>(lds, wave, lane, 0, 0, l1, INP(11), INP(24), INP(25), INP(26), INP(27), ws2 + wofs(l1), (unsigned*)ws2 + CW_QC + 64 * l1);
#ifdef REP_CVT
                cvt_phase<true>(lds, wave, lane, 0, 0, l1, INP(11), INP(24), INP(25), INP(26), INP(27), ws2 + wofs(l1), (unsigned*)ws2 + CW_QC + 64 * (l1 + 4));
#endif
            }
            SEAM(pb + 5);
        }
        if (IN(pb + 6)) { int l = lc; asm volatile("" : "+s"(l)); unsigned char* ws = WSP(); bf16* X = (bf16*)(ws + WS_X); const int G = gridDim.x, bx = blockIdx.x;
            pg8::StaticOrder S; S.init(MT, DM, G, bx); S.wgm = WGM_N8; const int nfull = TAIL_SPLIT ? tail_nfull(S.nwg, G) : S.nwg; S.nlim = nfull;
            const float* gm = (const float*)(ws + WS_MOD) + (size_t)l * NSEQ * 12288 + 2 * DM;
            { pg8::Gemm g{(const bf16*)(ws + WS_H), (const bf16*)(ws + wofs(lc) + WS_WOUT), MT, DM, DM, DM};
#ifdef REP_P6
              { pg8::EpiRes E0{X, (const float*)(ws + 524288), 0}; pg8::gemm_phase<pg8::EpiRes, pg8::StaticOrder, EPI_ALIGN_HEAVY, true>(lds, g, S, E0, tid_now(wave_s)); }
#endif
              pg8::EpiRes E{X, gm, 12288};
              pg8::gemm_phase<pg8::EpiRes, pg8::StaticOrder, EPI_ALIGN_HEAVY, true>(lds, g, S, E, tid_now(wave_s)); }
            if (TAIL_SPLIT) { pg8::Gemm g{(const bf16*)(ws + WS_H), (const bf16*)(ws + wofs(lc) + WS_WOUT), MT, DM, DM / 8, DM}; pg8::TailOrder T; T.init(S, nfull, 8, DM / 8);
              pg8::EpiSlab E{(float*)(ws + WS_SLAB), gm};
              pg8::gemm_phase<pg8::EpiSlab, pg8::TailOrder, true, true>(lds, g, T, E, tid_now(wave_s)); }
            SEAM(pb + 6);
        }
        if (IN(pb + 7)) { GEOM(); int l = lc; asm volatile("" : "+s"(l)); unsigned char* ws = WSP(); bf16* X = (bf16*)(ws + WS_X);
            if (TAIL_SPLIT) build_tail_map((LAS int*)lds, tid, G, 0);
#ifdef REP_N7
            norm_mod_phase<false>(lane, gw, NGW, nullptr, nullptr, X, INP(8) + l * DM, (const float*)(ws + WS_MOD) + (size_t)l * NSEQ * 12288, 3, 4, (bf16*)(ws + WS_H), false, (const LAS int*)lds, (const float*)(ws + WS_SLAB), true);
#endif
            norm_mod_phase<false>(lane, gw, NGW, nullptr, nullptr, X, INP(8) + l * DM, (const float*)(ws + WS_MOD) + (size_t)l * NSEQ * 12288, 3, 4, (bf16*)(ws + WS_H), TAIL_SPLIT != 0, (const LAS int*)lds, (const float*)(ws + WS_SLAB), true); SEAM(pb + 7); }
        if (IN(pb + 8)) { unsigned char* ws = WSP(); const int G = gridDim.x, bx = blockIdx.x;
            pg8::Gemm g{(const bf16*)(ws + WS_H), (const bf16*)(ws + wofs(lc) + WS_WUP), MT, DFF, DM, DM}; pg8::StaticOrder S; S.init(MT, DFF, G, bx);
            pg8::EpiStore<1> E{(bf16*)(ws + WS_P), DFF};
#ifndef REP_P8
#define REP_P8 1
#endif
#pragma unroll 1
            for (int rp = 0; rp < REP_P8; ++rp)
            pg8::gemm_phase<pg8::EpiStore<1>, pg8::StaticOrder, true, true, 0, WIN_B_AUX>(lds, g, S, E, tid_now(wave_s));
            SEAM(pb + 8);
        }
        if (IN(pb + 9)) { int l = lc; asm volatile("" : "+s"(l)); unsigned char* ws = WSP(); bf16* X = (bf16*)(ws + WS_X); const int G = gridDim.x, bx = blockIdx.x;
            pg8::StaticOrder S; S.init(MT, DM, G, bx); S.wgm = WGM_N8; S.rev = DOWN_REV; const int nfull = TAIL_SPLIT ? tail_nfull(S.nwg, G) : S.nwg; S.nlim = nfull;
            const float* gm = (const float*)(ws + WS_MOD) + (size_t)l * NSEQ * 12288 + 5 * DM;
            { pg8::Gemm g{(const bf16*)(ws + WS_P), (const bf16*)(ws + wofs(lc) + WS_WDN), MT, DM, DFF, DFF};
#ifdef REP_P9
              { pg8::EpiRes E0{X, (const float*)(ws + 524288), 0}; pg8::gemm_phase<pg8::EpiRes, pg8::StaticOrder, EPI_ALIGN_HEAVY, true>(lds, g, S, E0, tid_now(wave_s)); }
#endif
              pg8::EpiRes E{X, gm, 12288};
#ifndef DOWN_A_AUX
#define DOWN_A_AUX 0
#endif
              pg8::gemm_phase<pg8::EpiRes, pg8::StaticOrder, EPI_ALIGN_HEAVY, true, DOWN_A_AUX>(lds, g, S, E, tid_now(wave_s)); }
            if (TAIL_SPLIT) { pg8::Gemm g{(const bf16*)(ws + WS_P), (const bf16*)(ws + wofs(lc) + WS_WDN), MT, DM, DFF / 8, DFF}; pg8::TailOrder T; T.init(S, nfull, 8, DFF / 8);
              pg8::EpiSlab E{(float*)(ws + WS_SLAB), gm};
              pg8::gemm_phase<pg8::EpiSlab, pg8::TailOrder, true, true>(lds, g, T, E, tid_now(wave_s)); }
            SEAM(pb + 9);
        }
    }
    if (IN(N_PHASES - 1)) { GEOM(); unsigned char* ws = WSP(); if (TAIL_SPLIT) build_tail_map((LAS int*)lds, tid, G, DOWN_REV);
        final_norm_phase(lane, gw, NGW, (const bf16*)(ws + WS_X), OUTP(), INP(28), TAIL_SPLIT != 0, (const LAS int*)lds, (const float*)(ws + WS_SLAB)); }
#undef IN
#undef SEAM
#undef GEOM
}

extern "C" void kernel_launch(void* const* d_in, const int* in_sizes, int n_in, void* d_out, int out_size, void* d_ws, size_t ws_size, hipStream_t stream) {
    static int grid = 0;
    if (grid == 0) {
        if (n_in != 29 || (size_t)out_size != OUT_TOTAL || ws_size < WS_END) { fprintf(stderr, "kernel_launch: unexpected shapes: n_in %d out %d ws %zu (need %zu)\n", n_in, out_size, ws_size, (size_t)WS_END); grid = -1; return; }
        int dev = 0, cus = 0, per_cu = 0;
        if (hipGetDevice(&dev) != hipSuccess || hipDeviceGetAttribute(&cus, hipDeviceAttributeMultiprocessorCount, dev) != hipSuccess) { grid = -1; return; }
        if (hipFuncSetAttribute((const void*)fwd, hipFuncAttributeMaxDynamicSharedMemorySize, LDS_BYTES) != hipSuccess) { fprintf(stderr, "kernel_launch: hipFuncSetAttribute failed\n"); grid = -1; return; }
        if (hipOccupancyMaxActiveBlocksPerMultiprocessor(&per_cu, (const void*)fwd, NWAVES * 64, LDS_BYTES) != hipSuccess || per_cu < 1) fprintf(stderr, "kernel_launch: occupancy query says %d\n", per_cu);
        (void)hipGetLastError();
        grid = cus;
    }
    if (grid < 0) return;
    if (hipMemsetAsync((char*)d_ws + WS_CTL, 0, CTL_ZERO_BYTES, stream) != hipSuccess) return;
    Args a{};
    for (int i = 0; i < 29; ++i) a.in[i] = (const float*)d_in[i];
    a.out = (float*)d_out; a.ws = (unsigned char*)d_ws;
#if MK_N_LAUNCHES == 1
    a.ph_lo = 0; a.ph_hi = N_PHASES;
    hipLaunchKernelGGL(fwd, dim3(grid), dim3(NWAVES * 64), LDS_BYTES, stream, a);
#else
    for (int p = 0; p < N_PHASES; ++p) { a.ph_lo = p; a.ph_hi = p + 1; hipLaunchKernelGGL(fwd, dim3(grid), dim3(NWAVES * 64), LDS_BYTES, stream, a); }
#endif
}
```

```cpp
#include <hip/hip_runtime.h>
#include <cstdio>
#include <cstdint>
namespace pg8 {
#define PG8_LAS __attribute__((address_space(3)))
typedef unsigned short bf16_t;
typedef short bf16x8 __attribute__((ext_vector_type(8)));
typedef float f32x4 __attribute__((ext_vector_type(4)));
typedef unsigned u32x4 __attribute__((ext_vector_type(4)));
constexpr int BM = 256, BK = 64, HALF = 128, HTB = HALF * BK * 2  , STAGE_BYTES = 8 * HTB, NXCD = 8, WGM = 4;

__host__ __device__ __forceinline__ int lds_byte(int r, int c) { const int st = (r >> 4) * 2 + (c >> 5), rr = r & 15, cc = c & 31, ob = rr * 64 + cc * 2; return st * 1024 + (ob ^ (((ob >> 9) & 1) << 5)); }
__host__ __device__ __forceinline__ void stage_rc(int b, int& R, int& C) { const int st = b / 1024, sb = b % 1024, swz = sb ^ (((sb >> 9) & 1) << 5); R = (st >> 1) * 16 + swz / 64; C = (st & 1) * 32 + (swz % 64) / 2; }
__host__ __device__ __forceinline__ int perm32(int rho) { const int n = rho >> 4, i = rho & 15; return 8 * (i >> 2) + 4 * n + (i & 3); }

struct Unit { int pm, pn, ko, aux; };
struct Gemm { const bf16_t* A; const bf16_t* Bt; int M, N, K, ld; };

struct StaticOrder {
    int nM, nN, nwg, G, c, nlim, rev, wgm, off;
    __host__ __device__ void init(int M, int N, int G_, int c_) { nM = M / BM; nN = N / BM; nwg = nM * nN; G = G_; c = c_; nlim = nwg; rev = 0; wgm = WGM; off = 0; }
    __host__ __device__ void tile_of(int wgid, Unit& u) const {
        { const int q = nwg / NXCD, r = nwg % NXCD, xcd = wgid % NXCD, off = wgid / NXCD; wgid = (xcd < r ? xcd * (q + 1) : r * (q + 1) + (xcd - r) * q) + off; }
        const int nig = wgm * nN, gid = wgid / nig, fm = gid * wgm, gsz = (nM - fm) < wgm ? (nM - fm) : wgm;
        u.pm = fm + ((wgid % nig) % gsz); u.pn = (wgid % nig) / gsz; u.ko = 0; u.aux = 0; if (rev) u.pm = nM - 1 - u.pm; }
    __host__ __device__ bool next(int i, Unit& u) const {
        const long L = (long)i * G + c + off; if (L >= nlim) return false;
        tile_of((int)L, u); return true;
    }
    __device__ __forceinline__ void a_ready(const Unit&) const {}
    __device__ __forceinline__ void done(const Unit&) const {}
};
typedef float pg8_f32x2 __attribute__((ext_vector_type(2))); typedef __bf16 pg8_bf16x2 __attribute__((ext_vector_type(2)));
__device__ __forceinline__ unsigned cvt_pk_bf16(float lo, float hi) { const pg8_f32x2 v = {lo, hi}; const pg8_bf16x2 b = __builtin_convertvector(v, pg8_bf16x2); return __builtin_bit_cast(unsigned, b); }
typedef unsigned u32x2 __attribute__((ext_vector_type(2)));
__device__ __forceinline__ float bf_lo(unsigned w) { return __uint_as_float(w << 16); }
__device__ __forceinline__ float bf_hi(unsigned w) { return __uint_as_float(w & 0xffff0000u); }
__device__ __forceinline__ float fast_sigmoid(float x) { return __builtin_amdgcn_rcpf(1.0f + __builtin_amdgcn_exp2f(-1.44269504089f * x)); }

#ifndef EPI_BATCH_BARRIER
#define EPI_BATCH_BARRIER 0
#endif
#ifndef EPI_NT_GATE
#define EPI_NT_GATE 1
#endif
#ifndef EPI_NT_STORE
#define EPI_NT_STORE 0
#endif
template <int ACT> struct EpiStore {
    static constexpr bool PERM = true, AFTER_DRAIN = false;
    bf16_t* O; int ldc;
    __device__ __forceinline__ void operator()(const f32x4 (&acc)[2][2][4][2], const Unit& u, int wr, int wc, int fr, int fq) const {
        const int row0 = u.pm * BM + wr * 64 + fr, col0 = u.pn * BM + wc * 32 + 8 * fq;
#pragma unroll
        for (int ai = 0; ai < 2; ++ai)
#pragma unroll
            for (int m = 0; m < 4; ++m) { bf16_t* rowp = O + (size_t)(row0 + ai * HALF + m * 16) * ldc + col0;
#pragma unroll
                for (int bj = 0; bj < 2; ++bj) { f32x4 v0 = acc[ai][bj][m][0], v1 = acc[ai][bj][m][1];
                    if (ACT == 1) {
#pragma unroll
                        for (int j = 0; j < 4; ++j) { const float a = fmaxf(v0[j], 0.f), b = fmaxf(v1[j], 0.f); v0[j] = a * a; v1[j] = b * b; } }
                    u32x4 w; w.x = cvt_pk_bf16(v0[0], v0[1]); w.y = cvt_pk_bf16(v0[2], v0[3]); w.z = cvt_pk_bf16(v1[0], v1[1]); w.w = cvt_pk_bf16(v1[2], v1[3]);
                    if (EPI_NT_STORE) __builtin_nontemporal_store(w, (u32x4*)(rowp + bj * HALF)); else *(u32x4*)(rowp + bj * HALF) = w; } }
    }
};

struct EpiBranch {
    static constexpr bool PERM = true, AFTER_DRAIN = false;
    const bf16_t* P; int ldp; int gate_off; bf16_t* MG; int ldm; int npm, npn;
    __device__ __forceinline__ void operator()(const f32x4 (&acc)[2][2][4][2], const Unit& u, int wr, int wc, int fr, int fq) const {
        const int k = u.pm / npm, pm = u.pm - k * npm, pn = u.pn - k * npn;
        const int row0 = pm * BM + wr * 64 + fr, col0 = pn * BM + wc * 32 + 8 * fq;
#pragma unroll
        for (int ai = 0; ai < 2; ++ai)
#pragma unroll
            for (int m = 0; m < 4; ++m) { const size_t r = (size_t)(row0 + ai * HALF + m * 16);
                const bf16_t* gp = P + r * ldp + gate_off + k * 2048 + col0; bf16_t* mp = MG + r * ldm + col0;
#pragma unroll
                for (int bj = 0; bj < 2; ++bj) { const u32x4 g = EPI_NT_GATE ? __builtin_nontemporal_load((const u32x4*)(gp + bj * HALF)) : *(const u32x4*)(gp + bj * HALF);
                    f32x4 v0 = acc[ai][bj][m][0], v1 = acc[ai][bj][m][1];
                    v0[0] *= fast_sigmoid(bf_lo(g.x)); v0[1] *= fast_sigmoid(bf_hi(g.x)); v0[2] *= fast_sigmoid(bf_lo(g.y)); v0[3] *= fast_sigmoid(bf_hi(g.y));
                    v1[0] *= fast_sigmoid(bf_lo(g.z)); v1[1] *= fast_sigmoid(bf_hi(g.z)); v1[2] *= fast_sigmoid(bf_lo(g.w)); v1[3] *= fast_sigmoid(bf_hi(g.w));
                    if (k > 0) { const u32x4 p = *(const u32x4*)(mp + bj * HALF);
                        v0[0] += bf_lo(p.x); v0[1] += bf_hi(p.x); v0[2] += bf_lo(p.y); v0[3] += bf_hi(p.y);
                        v1[0] += bf_lo(p.z); v1[1] += bf_hi(p.z); v1[2] += bf_lo(p.w); v1[3] += bf_hi(p.w); }
                    u32x4 w; w.x = cvt_pk_bf16(v0[0], v0[1]); w.y = cvt_pk_bf16(v0[2], v0[3]); w.z = cvt_pk_bf16(v1[0], v1[1]); w.w = cvt_pk_bf16(v1[2], v1[3]);
                    *(u32x4*)(mp + bj * HALF) = w; }
                if (EPI_BATCH_BARRIER && m == 3) asm volatile("" ::: "memory"); }
    }
};

struct EpiRes {
    static constexpr bool PERM = true, AFTER_DRAIN = false;
    bf16_t* X; const float* gmod; int gstride;
    __device__ __forceinline__ void operator()(const f32x4 (&acc)[2][2][4][2], const Unit& u, int wr, int wc, int fr, int fq) const {
        const int row0 = u.pm * BM + wr * 64 + fr, col0 = u.pn * BM + wc * 32 + 8 * fq;
#pragma unroll
        for (int ai = 0; ai < 2; ++ai)
#pragma unroll
            for (int m = 0; m < 4; ++m) { const int r = row0 + ai * HALF + m * 16;
                const int seq = r < 32768 ? (r >> 11) : 16 + ((r - 32768) >> 5);
                const float* gp = gmod + (size_t)seq * gstride + col0; bf16_t* xp = X + (size_t)r * 2048 + col0;
#pragma unroll
                for (int bj = 0; bj < 2; ++bj) { const f32x4 g0 = *(const f32x4*)(gp + bj * HALF), g1 = *(const f32x4*)(gp + bj * HALF + 4); const u32x4 b = *(const u32x4*)(xp + bj * HALF);
                    const f32x4 v0 = acc[ai][bj][m][0] * g0, v1 = acc[ai][bj][m][1] * g1;
                    u32x4 w; w.x = cvt_pk_bf16(bf_lo(b.x) + v0[0], bf_hi(b.x) + v0[1]); w.y = cvt_pk_bf16(bf_lo(b.y) + v0[2], bf_hi(b.y) + v0[3]);
                    w.z = cvt_pk_bf16(bf_lo(b.z) + v1[0], bf_hi(b.z) + v1[1]); w.w = cvt_pk_bf16(bf_lo(b.w) + v1[2], bf_hi(b.w) + v1[3]);
                    *(u32x4*)(xp + bj * HALF) = w; }
                if (EPI_BATCH_BARRIER && m == 3) asm volatile("" ::: "memory"); }
    }
};

struct BranchOrder {
    int G, c, npm, npn, ntile;
    __device__ void init(int npm_, int npn_, int G_, int c_) { npm = npm_; npn = npn_; ntile = npm_ * npn_; G = G_; c = c_; }
    __device__ bool next(int i, Unit& u) const {
        const int ti = i / 3, k = i - 3 * ti; const long L = (long)ti * G + c; if (L >= ntile) return false;
        int wgid = (int)L; { const int q = ntile / NXCD, r = ntile % NXCD, xcd = wgid % NXCD, off = wgid / NXCD; wgid = (xcd < r ? xcd * (q + 1) : r * (q + 1) + (xcd - r) * q) + off; }
        const int nig = WGM * npn, gid = wgid / nig, fm = gid * WGM, gsz = (npm - fm) < WGM ? (npm - fm) : WGM;
        u.pm = k * npm + fm + ((wgid % nig) % gsz); u.pn = k * npn + (wgid % nig) / gsz; u.ko = 0; u.aux = 0; return true;
    }
    __device__ __forceinline__ void a_ready(const Unit&) const {}
    __device__ __forceinline__ void done(const Unit&) const {}
};


struct EpiResAtomic {
    static constexpr bool PERM = false, AFTER_DRAIN = false;
    float* out; const float* gmod;
    __device__ __forceinline__ void operator()(const f32x4 (&acc)[2][2][4][2], const Unit& u, int wr, int wc, int fr, int fq) const {
        const int row0 = u.pm * BM + wr * 64 + fr, col0 = u.pn * BM + wc * 32 + 4 * fq;
#pragma unroll
        for (int ai = 0; ai < 2; ++ai)
#pragma unroll
            for (int m = 0; m < 4; ++m) { const int r = row0 + ai * HALF + m * 16;
                const int seq = r < 32768 ? (r >> 11) : 16 + ((r - 32768) >> 5);
                const float* gp = gmod + (size_t)seq * 12288 + col0; float* op = out + (size_t)r * 2048 + col0;
#pragma unroll
                for (int bj = 0; bj < 2; ++bj)
#pragma unroll
                    for (int n = 0; n < 2; ++n) { const f32x4 g = *(const f32x4*)(gp + bj * HALF + n * 16); const f32x4 v = g * acc[ai][bj][m][n]; float* o = op + bj * HALF + n * 16;
                        typedef __attribute__((address_space(1))) float gfloat; gfloat* og = (gfloat*)o;
                        (void)__builtin_amdgcn_global_atomic_fadd_f32(og + 0, v.x); (void)__builtin_amdgcn_global_atomic_fadd_f32(og + 1, v.y); (void)__builtin_amdgcn_global_atomic_fadd_f32(og + 2, v.z); (void)__builtin_amdgcn_global_atomic_fadd_f32(og + 3, v.w); } }
    }
};
struct TailOrder {
    StaticOrder base; int nfull, SL, Ks;
    __device__ void init(const StaticOrder& b, int nfull_, int SL_, int Ks_) { base = b; nfull = nfull_; SL = SL_; Ks = Ks_; }
    __device__ bool next(int i, Unit& u) const { const long L = (long)i * base.G + base.c; if (L >= (long)(base.nwg - nfull) * SL) return false;
        const int t = (int)L / SL, sl = (int)L - t * SL; base.tile_of(nfull + t, u); u.ko = sl * Ks; u.aux = (int)L; return true; }
    __device__ __forceinline__ void a_ready(const Unit&) const {}
    __device__ __forceinline__ void done(const Unit&) const {}
};

struct EpiSlab {
    static constexpr bool PERM = false, AFTER_DRAIN = false;
    float* slab; const float* gmod;
    __device__ __forceinline__ void operator()(const f32x4 (&acc)[2][2][4][2], const Unit& u, int wr, int wc, int fr, int fq) const {
        const int rt0 = wr * 64 + fr, ct0 = wc * 32 + 4 * fq; float* sb = slab + (size_t)u.aux * 65536;
#pragma unroll
        for (int ai = 0; ai < 2; ++ai)
#pragma unroll
            for (int m = 0; m < 4; ++m) { const int rt = rt0 + ai * HALF + m * 16, r = u.pm * BM + rt;
                const int seq = r < 32768 ? (r >> 11) : 16 + ((r - 32768) >> 5);
                const float* gp = gmod + (size_t)seq * 12288 + u.pn * BM + ct0; float* op = sb + rt * 256 + ct0;
#pragma unroll
                for (int bj = 0; bj < 2; ++bj)
#pragma unroll
                    for (int n = 0; n < 2; ++n) { const f32x4 g = *(const f32x4*)(gp + bj * HALF + n * 16); *(f32x4*)(op + bj * HALF + n * 16) = g * acc[ai][bj][m][n]; } }
    }
};
template <class Epi, class Sched, bool ALIGN_EPI = false, bool SP2 = false, int A_AUX = 0, int B_AUX = 0>
__device__ __forceinline__ void gemm_phase(PG8_LAS unsigned char* lds, const Gemm g, const Sched& S, const Epi& E, int tid_in) {
    int tid_ = tid_in; asm volatile("" : "+v"(tid_));
    const int tid = tid_, wid = __builtin_amdgcn_readfirstlane(tid >> 6), lane = tid & 63, wr = wid >> 2, wc = wid & 3, fr = lane & 15, fq = lane >> 4;
    const int K = g.K, ld = g.ld, nt = K / BK;
    unsigned voffA[2], voffB[2];
#pragma unroll
    for (int i = 0; i < 2; ++i) { int R, C; stage_rc(tid * 16 + i * 8192, R, C); const int Rb = Epi::PERM ? ((R & ~31) + perm32(R & 31)) : R;
        voffA[i] = (unsigned)(R * ld + C) * 2u; voffB[i] = (unsigned)(Rb * ld + C) * 2u; }
    const size_t kstep = (size_t)(BK * 2);
    const size_t hstep = (size_t)HALF * ld * 2;
    const size_t tstep = 2 * hstep;
    const unsigned ldsw = (unsigned)wid * 1024u;
    const int aoff = lds_byte(wr * 64 + fr, fq * 8), boff = lds_byte(wc * 32 + fr, fq * 8);
#define PG8_SA(b, h) (((b) * 2 + (h)) * HTB)
#define PG8_SB(b, h) ((4 + (b) * 2 + (h)) * HTB)
#define PG8_STAGE(bufoff, gbase, voff) do { _Pragma("unroll") for (int _i = 0; _i < 2; ++_i) \
        __builtin_amdgcn_global_load_lds((const unsigned*)((const char*)(gbase) + (voff)[_i]), (PG8_LAS unsigned*)(lds + (bufoff) + ldsw + _i * 8192), 16, 0, B_AUX); } while (0)
#define PG8_STAGEA(bufoff, gbase, voff) do { _Pragma("unroll") for (int _i = 0; _i < 2; ++_i) \
        __builtin_amdgcn_global_load_lds((const unsigned*)((const char*)(gbase) + (voff)[_i]), (PG8_LAS unsigned*)(lds + (bufoff) + ldsw + _i * 8192), 16, 0, A_AUX); } while (0)
#define PG8_LDA(dst, b, h) do { _Pragma("unroll") for (int m = 0; m < 4; ++m) _Pragma("unroll") for (int k = 0; k < 2; ++k) dst[m][k] = *(const PG8_LAS bf16x8*)(lds + PG8_SA(b, h) + aoff + m * 2048 + k * 1024); } while (0)
#define PG8_LDB(dst, b, h) do { _Pragma("unroll") for (int n = 0; n < 2; ++n) _Pragma("unroll") for (int k = 0; k < 2; ++k) dst[n][k] = *(const PG8_LAS bf16x8*)(lds + PG8_SB(b, h) + boff + n * 2048 + k * 1024); } while (0)
#define PG8_MMA(ai, bj, At, Bt) do { __builtin_amdgcn_s_setprio(1); _Pragma("unroll") for (int m = 0; m < 4; ++m) _Pragma("unroll") for (int n = 0; n < 2; ++n) _Pragma("unroll") for (int k = 0; k < 2; ++k) \
        acc[ai][bj][m][n] = __builtin_amdgcn_mfma_f32_16x16x32_bf16(Bt[n][k], At[m][k], acc[ai][bj][m][n], 0, 0, 0); __builtin_amdgcn_s_setprio(0); } while (0)
#define PG8_WAIT_V(n) asm volatile("s_waitcnt vmcnt(" #n ")" ::: "memory")
#define PG8_WAIT_L(n) asm volatile("s_waitcnt lgkmcnt(" #n ")" ::: "memory")
#define PG8_BAR __builtin_amdgcn_s_barrier()
#define PG8_SCHED __builtin_amdgcn_sched_barrier(0)
    Unit cur, nxt; int ui = 0;
    if (!S.next(0, cur)) return;
    f32x4 acc[2][2][4][2];
#pragma unroll
    for (int a = 0; a < 2; ++a)
#pragma unroll
        for (int b = 0; b < 2; ++b)
#pragma unroll
            for (int m = 0; m < 4; ++m)
#pragma unroll
                for (int n = 0; n < 2; ++n) acc[a][b][m][n] = (f32x4){0.f, 0.f, 0.f, 0.f};
    bf16x8 At[4][2], B0[2][2], B1[2][2];
    const char* cA = (const char*)g.A + (size_t)cur.pm * tstep + (size_t)cur.ko * 2; const char* cB = (const char*)g.Bt + (size_t)cur.pn * tstep + (size_t)cur.ko * 2;
    S.a_ready(cur);
    if constexpr (SP2) {
        PG8_STAGE(PG8_SB(0, 0), cB, voffB); PG8_STAGE(PG8_SB(0, 1), cB + hstep, voffB); PG8_STAGEA(PG8_SA(0, 0), cA, voffA); PG8_STAGEA(PG8_SA(0, 1), cA + hstep, voffA);
        if (wr == 1) PG8_BAR;
        PG8_WAIT_V(2); PG8_BAR;
        PG8_STAGE(PG8_SB(1, 0), cB + kstep, voffB); PG8_STAGEA(PG8_SA(1, 0), cA + kstep, voffA); PG8_STAGE(PG8_SB(1, 1), cB + hstep + kstep, voffB);
        PG8_WAIT_V(6); PG8_BAR;
    } else {
        PG8_STAGE(PG8_SB(0, 0), cB, voffB); PG8_STAGEA(PG8_SA(0, 0), cA, voffA); PG8_STAGE(PG8_SB(0, 1), cB + hstep, voffB); PG8_STAGEA(PG8_SA(0, 1), cA + hstep, voffA);
        if (wr == 1) PG8_BAR;
        PG8_WAIT_V(4); PG8_BAR;
        PG8_STAGE(PG8_SB(1, 0), cB + kstep, voffB); PG8_STAGEA(PG8_SA(1, 0), cA + kstep, voffA); PG8_STAGE(PG8_SB(1, 1), cB + hstep + kstep, voffB);
        PG8_WAIT_V(6); PG8_BAR;
    }
    for (;;) {
        const bool has_next = S.next(ui + 1, nxt);
        const char* nA = has_next ? (const char*)g.A + (size_t)nxt.pm * tstep + (size_t)nxt.ko * 2 : cA; const char* nB = has_next ? (const char*)g.Bt + (size_t)nxt.pn * tstep + (size_t)nxt.ko * 2 : cB;
        for (int t = 0; t < nt; t += 2) {
            const bool last = (t == nt - 2);
            const char* a1 = cA + (size_t)(t + 1) * kstep;
            const char* a2 = last ? nA : cA + (size_t)(t + 2) * kstep; const char* b2 = last ? nB : cB + (size_t)(t + 2) * kstep;
            const char* a3 = a2 + kstep; const char* b3 = b2 + kstep;
            if (last && has_next) S.a_ready(nxt);
            if constexpr (SP2) {
            PG8_LDB(B0, 0, 0); PG8_LDB(B1, 0, 1); PG8_SCHED; PG8_LDA(At, 0, 0); PG8_STAGEA(PG8_SA(1, 1), a1 + hstep, voffA);
            PG8_WAIT_V(8); PG8_WAIT_L(0); PG8_BAR; PG8_MMA(0, 0, At, B0); PG8_MMA(0, 1, At, B1); PG8_BAR; PG8_SCHED;
            PG8_LDA(At, 0, 1); PG8_STAGE(PG8_SB(0, 0), b2, voffB); PG8_STAGE(PG8_SB(0, 1), b2 + hstep, voffB); PG8_STAGEA(PG8_SA(0, 0), a2, voffA);
            PG8_WAIT_V(8); PG8_WAIT_L(0); PG8_BAR; PG8_MMA(1, 0, At, B0); PG8_MMA(1, 1, At, B1); PG8_BAR; PG8_SCHED;
            PG8_LDB(B0, 1, 0); PG8_LDB(B1, 1, 1); PG8_SCHED; PG8_LDA(At, 1, 0); PG8_STAGEA(PG8_SA(0, 1), a2 + hstep, voffA);
            PG8_WAIT_V(8); PG8_WAIT_L(0); PG8_BAR; PG8_MMA(0, 0, At, B0); PG8_MMA(0, 1, At, B1); PG8_BAR; PG8_SCHED;
            PG8_LDA(At, 1, 1); PG8_STAGE(PG8_SB(1, 0), b3, voffB); PG8_STAGE(PG8_SB(1, 1), b3 + hstep, voffB); PG8_STAGEA(PG8_SA(1, 0), a3, voffA);
            PG8_WAIT_V(8); PG8_WAIT_L(0); PG8_BAR; PG8_MMA(1, 0, At, B0); PG8_MMA(1, 1, At, B1); PG8_BAR; PG8_SCHED;
            } else {
            PG8_LDB(B0, 0, 0); PG8_SCHED; PG8_LDA(At, 0, 0); PG8_STAGEA(PG8_SA(1, 1), a1 + hstep, voffA);
            PG8_WAIT_L(8); PG8_BAR; PG8_WAIT_L(0); PG8_MMA(0, 0, At, B0); PG8_BAR; PG8_SCHED;
            PG8_LDB(B1, 0, 1); PG8_STAGE(PG8_SB(0, 0), b2, voffB);
            PG8_BAR; PG8_WAIT_L(0); PG8_MMA(0, 1, At, B1); PG8_BAR;
            PG8_LDA(At, 0, 1); PG8_STAGEA(PG8_SA(0, 0), a2, voffA);
            PG8_BAR; PG8_WAIT_L(0); PG8_MMA(1, 0, At, B0); PG8_BAR; PG8_SCHED;
            PG8_STAGE(PG8_SB(0, 1), b2 + hstep, voffB);
            PG8_WAIT_V(6); PG8_BAR; PG8_MMA(1, 1, At, B1); PG8_BAR;
            PG8_LDB(B0, 1, 0); PG8_SCHED; PG8_LDA(At, 1, 0); PG8_STAGEA(PG8_SA(0, 1), a2 + hstep, voffA);
            PG8_WAIT_L(8); PG8_BAR; PG8_WAIT_L(0); PG8_MMA(0, 0, At, B0); PG8_BAR; PG8_SCHED;
            PG8_LDB(B1, 1, 1); PG8_STAGE(PG8_SB(1, 0), b3, voffB);
            PG8_BAR; PG8_WAIT_L(0); PG8_MMA(0, 1, At, B1); PG8_BAR;
            PG8_LDA(At, 1, 1); PG8_STAGEA(PG8_SA(1, 0), a3, voffA);
            PG8_BAR; PG8_WAIT_L(0); PG8_MMA(1, 0, At, B0); PG8_BAR; PG8_SCHED;
            PG8_STAGE(PG8_SB(1, 1), b3 + hstep, voffB);
            PG8_WAIT_V(6); PG8_BAR; PG8_MMA(1, 1, At, B1); PG8_BAR;
            }
        }
        if constexpr (ALIGN_EPI) { if (wr == 0) PG8_BAR; }
        if constexpr (!Epi::AFTER_DRAIN) { E(acc, cur, wr, wc, fr, fq); S.done(cur); }
        if (!has_next) break;
#pragma unroll
        for (int a = 0; a < 2; ++a)
#pragma unroll
            for (int b = 0; b < 2; ++b)
#pragma unroll
                for (int m = 0; m < 4; ++m)
#pragma unroll
                    for (int n = 0; n < 2; ++n) acc[a][b][m][n] = (f32x4){0.f, 0.f, 0.f, 0.f};
        cur = nxt; cA = nA; cB = nB; ++ui;
        if constexpr (ALIGN_EPI) { if (wr == 1) PG8_BAR; }
    }
    PG8_WAIT_V(0);
    if constexpr (!ALIGN_EPI) { if (wr == 0) PG8_BAR; }
    PG8_BAR;
    if constexpr (Epi::AFTER_DRAIN) { E.fused(acc, cur, wr, wc, fr, fq, lds, wid, lane); S.done(cur); }
#undef PG8_SA
#undef PG8_SB
#undef PG8_STAGE
#undef PG8_STAGEA
#undef PG8_LDA
#undef PG8_LDB
#undef PG8_MMA
#undef PG8_WAIT_V
#undef PG8_WAIT_L
#undef PG8_BAR
#undef PG8_SCHED
}
}

constexpr int NWAVES = 8;
constexpr int DM = 2048, NTOK_P = 32768, NTOK_S = 1024, MT = NTOK_P + NTOK_S  , NSEQ = 48, DEPTH = 4, DFF = 8192;
constexpr int IN_TOTAL = 14864, NPAD = 15104;
constexpr int OFF_AQ = 0, OFF_AF = 1024, OFF_AI = 2048, OFF_AG = 3072, OFF_BZ = 4096, OFF_XBC = 5120, OFF_CU = 6656, OFF_CV = 7680, OFF_GATE = 8704, OFF_DT = 14848;
constexpr float NORM_EPS = 1e-6f;
constexpr size_t OUT_X = 0, OUT_HGRN_P = 69206016, OUT_SSM_P = 77594624, OUT_CONV_P = 85983232, OUT_HGRN_S = 86278144, OUT_SSM_S = 103055360, OUT_CONV_S = 119832576, OUT_V_S = 120422400, OUT_TOTAL = 124616704;
constexpr size_t MiB = 1u << 20;
constexpr size_t WS_CTL = 0, CTL_ZERO_BYTES = 1 * MiB;
constexpr size_t WS_MOD = 1 * MiB;
constexpr size_t WS_WIN = 16 * MiB;
constexpr size_t WS_WBR = 76 * MiB;
constexpr size_t WS_WOUT = 88 * MiB;
constexpr size_t WS_WUP = 96 * MiB;
constexpr size_t WS_WDN = 128 * MiB;
constexpr size_t WS_H = 160 * MiB;
constexpr size_t WS_Y3 = 292 * MiB;
constexpr size_t WS_P = 490 * MiB;
constexpr size_t WS_XC = 1464 * MiB;
constexpr size_t WS_DT = 1564 * MiB;
constexpr size_t DT_ARR = (size_t)MT * 16 * 4;
constexpr size_t WS_WSET2 = 1576 * MiB;
constexpr size_t WSET_BYTES = WS_H - WS_WIN;
constexpr size_t WS_SLAB = WS_Y3;
constexpr size_t WS_X = WS_WSET2 + WSET_BYTES;
constexpr size_t WS_END = WS_X + (size_t)MT * DM * 2;
static_assert((size_t)32 * 8 * 65536 * 4 <= (size_t)3 * MT * 1024 * 2, "slabs fit the y_a|y_b|y_c region");
static_assert(WS_DT + 3 * DT_ARR <= WS_WSET2, "d_ws map 3");
__host__ __device__ constexpr size_t wofs(int l) { return (l & 1) ? (WS_WSET2 - WS_WIN) : 0; }
static_assert(WS_P + (size_t)MT * NPAD * 2 <= WS_XC && WS_XC + (size_t)MT * 1536 * 2 <= WS_DT, "d_ws map 2");
static_assert(WS_MOD + (size_t)DEPTH * NSEQ * 12288 * 4 <= WS_WIN && WS_WIN + (size_t)NPAD * DM * 2 <= WS_WBR && WS_H + (size_t)MT * DM * 2 <= WS_Y3 && WS_Y3 + (size_t)3 * MT * 1024 * 2 <= WS_P, "d_ws map");
constexpr int CW_BAR = 4096;
constexpr int CW_Q = 8192;
constexpr int CW_QC = 12288;
constexpr int RING_BYTES = 131072, ST_OFF = RING_BYTES  , MISC_OFF = RING_BYTES + 1024, LDS_BYTES = 147456;

#define GAS __attribute__((address_space(1)))
#define LAS __attribute__((address_space(3)))
typedef unsigned short bf16;
typedef unsigned v4u __attribute__((ext_vector_type(4)));
typedef unsigned v2u __attribute__((ext_vector_type(2)));
typedef float f32x4 __attribute__((ext_vector_type(4)));
typedef float f32x2 __attribute__((ext_vector_type(2)));
#define LDS_WAIT() asm volatile("s_waitcnt lgkmcnt(0)" ::: "memory")
#define VM_WAIT() asm volatile("s_waitcnt vmcnt(0)" ::: "memory")
typedef float cv_f32x2 __attribute__((ext_vector_type(2))); typedef __bf16 cv_bf16x2 __attribute__((ext_vector_type(2)));
__device__ __forceinline__ unsigned pk2(float lo, float hi) { const cv_f32x2 v = {lo, hi}; const cv_bf16x2 b = __builtin_convertvector(v, cv_bf16x2); return __builtin_bit_cast(unsigned, b); }
__device__ __forceinline__ unsigned f2bf(float f) { const __bf16 b = (__bf16)f; return (unsigned)__builtin_bit_cast(unsigned short, b); }
__device__ __forceinline__ float bflo(unsigned w) { return __uint_as_float(w << 16); }
__device__ __forceinline__ float bfhi(unsigned w) { return __uint_as_float(w & 0xffff0000u); }
__device__ __forceinline__ float bf1(bf16 v) { return __uint_as_float(((unsigned)v) << 16); }
__device__ __forceinline__ float sigmoidf_(float x) { return __builtin_amdgcn_rcpf(1.0f + __expf(-x)); }
__device__ __forceinline__ float siluf_(float x) { return x * __builtin_amdgcn_rcpf(1.0f + __expf(-x)); }
__device__ __forceinline__ float rsqrtf_(float x) { return __builtin_amdgcn_rsqf(x); }
__device__ __forceinline__ float geluf_(float v) {
    const float av = fabsf(v), t = __builtin_amdgcn_rcpf(1.0f + 0.2316418882f * av);
    float q = t * 0.5307027145f + (-0.7265760135f); q = q * t + 0.7107068705f; q = q * t + (-0.142248368f); q = q * t + 0.127414796f; q = q * t;
    const float e = __expf(-0.5f * v * v), m = v * (q * e);
    return v < 0.f ? m : v - m;
}
template <int CTRL> __device__ __forceinline__ float dpp_mov(float v) { return __builtin_bit_cast(float, __builtin_amdgcn_update_dpp(0, __builtin_bit_cast(int, v), CTRL, 0xf, 0xf, true)); }
__device__ __forceinline__ float row16_sum(float v) {
    v += dpp_mov<0xB1>(v);
    v += dpp_mov<0x4E>(v);
    v += dpp_mov<0x141>(v);
    v += dpp_mov<0x140>(v);
    return v;
}
__device__ __forceinline__ float lane_bcast(float v, int l) { return __builtin_bit_cast(float, __builtin_amdgcn_readlane(__builtin_bit_cast(int, v), l)); }
__device__ __forceinline__ float wave_sum(float v) {
    v = row16_sum(v);
    return (lane_bcast(v, 0) + lane_bcast(v, 16)) + (lane_bcast(v, 32) + lane_bcast(v, 48));
}
__device__ __forceinline__ float half_sum(float v, int lane) {
    v = row16_sum(v);
    const float lo = lane_bcast(v, 0) + lane_bcast(v, 16), hi = lane_bcast(v, 32) + lane_bcast(v, 48);
    return lane < 32 ? lo : hi;
}

#define XB_TMO      128
#define XB_XCNT(j)  (256  + 64 * (j))
#define XB_XSUB(j)  (1280 + 64 * (j))
#define XB_XGEN(j)  (2304 + 64 * (j))
#define XB_TOP      3328
#define XB_TOPGEN   3392
#define XCD_BAR_WORDS 3456
#define XB_SPIN_CAP (1u << 18)

__device__ __forceinline__ unsigned xb_ld(unsigned* p)              { return __hip_atomic_load(p, __ATOMIC_RELAXED, __HIP_MEMORY_SCOPE_AGENT); }
__device__ __forceinline__ unsigned xb_add(unsigned* p, unsigned v) { return __hip_atomic_fetch_add(p, v, __ATOMIC_RELAXED, __HIP_MEMORY_SCOPE_AGENT); }
__device__ __forceinline__ unsigned xb_xcc_id() { return (unsigned)__builtin_amdgcn_s_getreg((3 << 11) | 20) & 0xFu; }
#define XB_SPIN(cond, bar) do { unsigned _sp = 0; while (cond) { __builtin_amdgcn_s_sleep(1); \
    if ((++_sp & 255u) == 0u) { if (xb_ld(&(bar)[XB_TMO])) break; if (_sp > XB_SPIN_CAP) { atomicAdd(&(bar)[XB_TMO], 1u); break; } } } } while (0)

struct XcdBarrier {
    unsigned* bar; unsigned x;
    volatile LAS unsigned* st;
};

__device__ __forceinline__ XcdBarrier xcd_barrier_post(unsigned* bar, volatile LAS unsigned* st, int tid) {
    XcdBarrier b; b.bar = bar; b.x = xb_xcc_id(); b.st = st;
    if (tid == 0) (void)xb_add(&bar[XB_XCNT(b.x)], 1u);
    return b;
}
__device__ __forceinline__ void xcd_barrier_complete(unsigned* bar, unsigned x, unsigned& nloc, unsigned& nx) {
    const unsigned G = gridDim.x * gridDim.y * gridDim.z;
    unsigned sum, cnt, mine, sp = 0u;
    for (;;) {
        sum = 0u; cnt = 0u; mine = 0u;
#pragma unroll
        for (unsigned j = 0; j < 16; ++j) { const unsigned c = xb_ld(&bar[XB_XCNT(j)]); sum += c; cnt += (c > 0u) ? 1u : 0u; mine = (j == x) ? c : mine; }
        if (sum == G) break;
        __builtin_amdgcn_s_sleep(1);
        if ((++sp & 255u) == 0u) { if (xb_ld(&bar[XB_TMO])) break; if (sp > XB_SPIN_CAP) { atomicAdd(&bar[XB_TMO], 1u); break; } }
    }
    nloc = mine > 0u ? mine : 1u; nx = cnt > 0u ? cnt : 1u;
}

__device__ __forceinline__ void xcd_barrier(const XcdBarrier& b, int tid) {
    asm volatile("s_waitcnt vmcnt(0)" ::: "memory");
    __syncthreads();
    if (tid == 0) {
        unsigned* bar = b.bar;
        __builtin_amdgcn_s_waitcnt(0);
        unsigned nloc = b.st[0], nx = b.st[1];
        if (nloc == 0u) { xcd_barrier_complete(bar, b.x, nloc, nx); b.st[0] = nloc; b.st[1] = nx; }
        const unsigned old = xb_add(&bar[XB_XSUB(b.x)], 1u);
        const unsigned gen = old / nloc;
        if (old + 1u == (gen + 1u) * nloc) {
            __builtin_amdgcn_fence(__ATOMIC_RELEASE, "agent");
            asm volatile("s_waitcnt vmcnt(0)" ::: "memory");
            const unsigned og = xb_add(&bar[XB_TOP], 1u);
            const unsigned tg = og / nx;
            if (og + 1u == (tg + 1u) * nx) xb_add(&bar[XB_TOPGEN], 1u);
            else XB_SPIN(xb_ld(&bar[XB_TOPGEN]) == tg, bar);
            __builtin_amdgcn_fence(__ATOMIC_ACQUIRE, "agent");
            xb_add(&bar[XB_XGEN(b.x)], 1u);
            asm volatile("s_waitcnt vmcnt(0)" ::: "memory");
        } else {
            XB_SPIN(xb_ld(&bar[XB_XGEN(b.x)]) == gen, bar);
            __builtin_amdgcn_fence(__ATOMIC_ACQUIRE, "agent");
            asm volatile("s_waitcnt vmcnt(0)" ::: "memory");
        }
    }
    __syncthreads();
}


__device__ __forceinline__ void mod_item(LAS unsigned char* lds, int tid_in, int it, const float* c_prompt, const float* c_sample, const float* w_mod, const float* b_mod, float* MOD) {
    int tid = tid_in;
    const int l = it / 96, cb = it - l * 96, j0 = cb * 128;
    const int cq = tid & 31, sh = (tid >> 5) & 1, kq = tid >> 6;
    LAS float* CS = (LAS float*)lds;
    f32x2 acc[24][2];
#pragma unroll
    for (int s = 0; s < 24; ++s) { acc[s][0] = (f32x2){0.f, 0.f}; acc[s][1] = (f32x2){0.f, 0.f}; }
    const float* wbase = w_mod + (size_t)l * DM * 12288 + j0 + 4 * cq;
    for (int kt = 0; kt < 8; ++kt) {
        __syncthreads();
#pragma unroll 8
        for (int j = 0; j < 24; ++j) { const int e = tid + 512 * j, s = e >> 8, kidx = e & 255, kq2 = kidx >> 5, kk = kidx & 31, k = kq2 * 256 + kt * 32 + kk;
            const float cv = s < 16 ? c_prompt[s * DM + k] : c_sample[(s - 16) * DM + k];
            CS[(kq2 * 32 + kk) * 48 + s] = siluf_(cv); }
        __syncthreads();
        { const float* wr = wbase + (size_t)(kq * 256 + kt * 32) * 12288;
          f32x4 wn[4];
#pragma unroll
          for (int i = 0; i < 4; ++i) wn[i] = *(const f32x4*)(wr + (size_t)i * 12288);
#pragma unroll 1
          for (int kk = 0; kk < 32; kk += 4) { f32x4 wc[4];
#pragma unroll
              for (int i = 0; i < 4; ++i) wc[i] = wn[i];
              if (kk + 4 < 32) {
#pragma unroll
                  for (int i = 0; i < 4; ++i) wn[i] = *(const f32x4*)(wr + (size_t)(kk + 4 + i) * 12288); }
#pragma unroll
              for (int i = 0; i < 4; ++i) { const f32x2 w01 = (f32x2){wc[i].x, wc[i].y}, w23 = (f32x2){wc[i].z, wc[i].w}; const LAS f32x4* cr = (const LAS f32x4*)(CS + (kq * 32 + kk + i) * 48 + 24 * sh);
#pragma unroll
                  for (int s4 = 0; s4 < 6; ++s4) { const f32x4 c4 = cr[s4];
#pragma unroll
                      for (int q = 0; q < 4; ++q) { const f32x2 cc = (f32x2){c4[q], c4[q]};
                          acc[4 * s4 + q][0] = __builtin_elementwise_fma(w01, cc, acc[4 * s4 + q][0]); acc[4 * s4 + q][1] = __builtin_elementwise_fma(w23, cc, acc[4 * s4 + q][1]); } } } } }
    }
    LAS float* RED = (LAS float*)lds;
    asm volatile("" : "+v"(tid));
    const int cq2 = tid & 31, sh2 = (tid >> 5) & 1, kq2_ = tid >> 6;
#pragma unroll
    for (int sb = 0; sb < 4; ++sb) {
        __syncthreads();
        if (sh2 == (sb >> 1)) {
#pragma unroll
            for (int i = 0; i < 12; ++i) { const f32x2 a = acc[12 * (sb & 1) + i][0], b = acc[12 * (sb & 1) + i][1]; *(LAS f32x4*)(RED + (kq2_ * 12 + i) * 128 + 4 * cq2) = (f32x4){a.x, a.y, b.x, b.y}; } }
        __syncthreads();
#pragma unroll
        for (int j = 0; j < 3; ++j) { const int e = tid + 512 * j, s = e >> 7, col = e & 127; float v = 0.f;
#pragma unroll
            for (int q = 0; q < 8; ++q) v += RED[(q * 12 + s) * 128 + col];
            MOD[((size_t)l * NSEQ + 12 * sb + s) * 12288 + j0 + col] = v + b_mod[l * 12288 + j0 + col]; }
    }
    __syncthreads();
}

struct CvItem { const float* src; bf16* dst; int N, K, nv; };
constexpr int CV_A = 472 * 32, CV_B = 3 * 16 * 64, CV_C = 32 * 64, CV_D = 32 * 256, CV_E = 128 * 64, CV_ALL = CV_A + CV_B + CV_C + CV_D + CV_E;
__device__ __forceinline__ CvItem cvt_decode(int it, int l, const float* w_in, const float* w_branch, const float* w_out, const float* w_up, const float* w_down, unsigned char* ws) {
    CvItem c; int r = it;
    if (r < CV_A) { const int nb = r % 472, kb = r / 472; int n0s, nv;
        if (nb < 208) { n0s = 32 * nb; nv = 32; } else if (nb < 464) { n0s = 32 * nb + 16; nv = 32; } else if (nb == 464) { n0s = 6656; nv = 16; } else { n0s = 0; nv = 0; }
        c.N = IN_TOTAL; c.K = DM; c.nv = nv; c.src = w_in + (size_t)l * DM * IN_TOTAL + (size_t)(64 * kb) * IN_TOTAL + n0s; c.dst = (bf16*)(ws + WS_WIN) + (size_t)(32 * nb) * DM + 64 * kb; return c; }
    r -= CV_A;
    if (r < CV_B) { const int br = r / 1024, r2 = r % 1024, kb = r2 / 64, nb = r2 % 64;
        c.N = DM; c.K = 1024; c.nv = 32; c.src = w_branch + ((size_t)l * 3072 + br * 1024 + 64 * kb) * DM + 32 * nb; c.dst = (bf16*)(ws + WS_WBR) + (size_t)br * 2048 * 1024 + (size_t)(32 * nb) * 1024 + 64 * kb; return c; }
    r -= CV_B;
    if (r < CV_C) { const int kb = r / 64, nb = r % 64;
        c.N = DM; c.K = DM; c.nv = 32; c.src = w_out + (size_t)l * DM * DM + (size_t)(64 * kb) * DM + 32 * nb; c.dst = (bf16*)(ws + WS_WOUT) + (size_t)(32 * nb) * DM + 64 * kb; return c; }
    r -= CV_C;
    if (r < CV_D) { const int kb = r / 256, nb = r % 256;
        c.N = DFF; c.K = DM; c.nv = 32; c.src = w_up + (size_t)l * DM * DFF + (size_t)(64 * kb) * DFF + 32 * nb; c.dst = (bf16*)(ws + WS_WUP) + (size_t)(32 * nb) * DM + 64 * kb; return c; }
    r -= CV_D;
    { const int kb = r / 64, nb = r % 64;
        c.N = DM; c.K = DFF; c.nv = 32; c.src = w_down + (size_t)l * DFF * DM + (size_t)(64 * kb) * DM + 32 * nb; c.dst = (bf16*)(ws + WS_WDN) + (size_t)(32 * nb) * DFF + 64 * kb; return c; }
}
__device__ __forceinline__ void cvt_load(const CvItem& c, int lane, f32x4 (&v)[8]) {
    const int kk = lane >> 3, n4 = (lane & 7) * 4;
#pragma unroll
    for (int i = 0; i < 8; ++i) v[i] = (n4 < c.nv) ? *(const f32x4*)(c.src + (size_t)(8 * i + kk) * c.N + n4) : (f32x4){0.f, 0.f, 0.f, 0.f};
}
__device__ __forceinline__ void cvt_store(const CvItem& c, int lane, const f32x4 (&v)[8], LAS float* scr) {
    { const int kk = lane >> 3, n4 = (lane & 7) * 4;
#pragma unroll
        for (int i = 0; i < 8; ++i) { LAS float* d = scr + (8 * i + kk) * 33 + n4; d[0] = v[i].x; d[1] = v[i].y; d[2] = v[i].z; d[3] = v[i].w; } }
    LDS_WAIT(); asm volatile("" ::: "memory");
    const int cc = lane & 7;
#pragma unroll
    for (int j = 0; j < 4; ++j) { const int n = (lane >> 3) + 8 * j; const LAS float* s = scr + (8 * cc) * 33 + n;
        v4u o; o.x = pk2(s[0 * 33], s[1 * 33]); o.y = pk2(s[2 * 33], s[3 * 33]); o.z = pk2(s[4 * 33], s[5 * 33]); o.w = pk2(s[6 * 33], s[7 * 33]);
        *(v4u*)(c.dst + (size_t)n * c.K + 8 * cc) = o; }
    LDS_WAIT(); asm volatile("" ::: "memory");
}
template <bool QUEUE>
__device__ __forceinline__ void cvt_phase(LAS unsigned char* lds, int wave, int lane, int gw, int NGW, int l, const float* w_in, const float* w_branch, const float* w_out, const float* w_up, const float* w_down, unsigned char* ws, unsigned* qhead) {
    LAS float* scr = (LAS float*)(lds + wave * 16384);
    int it = gw, left = 0;
#define CV_NEXT() do { if (QUEUE) { if (left == 0) { unsigned t0 = 0; if (lane == 0) t0 = __hip_atomic_fetch_add(qhead, 4u, __ATOMIC_RELAXED, __HIP_MEMORY_SCOPE_AGENT); it = __builtin_amdgcn_readfirstlane((int)t0); left = 4; } else ++it; --left; } else it += NGW; } while (0)
    if (QUEUE) { it = 0; CV_NEXT(); }
    if (it >= CV_ALL) return;
    CvItem ca = cvt_decode(it, l, w_in, w_branch, w_out, w_up, w_down, ws), cb = ca; f32x4 va[8], vb[8];
    cvt_load(ca, lane, va);
    for (;;) {
        CV_NEXT(); const bool hb = it < CV_ALL;
        if (hb) { cb = cvt_decode(it, l, w_in, w_branch, w_out, w_up, w_down, ws); cvt_load(cb, lane, vb); }
        cvt_store(ca, lane, va, scr);
        if (!hb) break;
        CV_NEXT(); const bool ha = it < CV_ALL;
        if (ha) { ca = cvt_decode(it, l, w_in, w_branch, w_out, w_up, w_down, ws); cvt_load(ca, lane, va); }
        cvt_store(cb, lane, vb, scr);
        if (!ha) break;
    }
#undef CV_NEXT
}

#ifndef WGM_N8
#define WGM_N8 4
#endif
__device__ __forceinline__ int tail_nfull(int nwg, int G) { const int nf = (nwg / G) * G; return (nwg - nf) <= 32 ? nf : nwg; }
__device__ __forceinline__ void build_tail_map(LAS int* tmap, int tid, int G, int rev) {
    pg8::StaticOrder S; S.init(MT, DM, G, 0); S.rev = rev; S.wgm = WGM_N8; const int nfull = tail_nfull(S.nwg, G);
    for (int i = tid; i < S.nwg; i += NWAVES * 64) tmap[i] = -1;
    __syncthreads();
    for (int i = tid; i < S.nwg - nfull; i += NWAVES * 64) { pg8::Unit u; S.tile_of(nfull + i, u); tmap[u.pm * 8 + u.pn] = i; }
    __syncthreads();
}
template <bool SRC_F32>
__device__ __forceinline__ void norm_mod_phase(int lane, int gw, int NGW, const float* xP, const float* xS, bf16* X, const float* ng, const float* modl  , int part_sh, int part_sc, bf16* H,
                                               bool comb, const LAS int* tmap, const float* slab, bool desc) {
    const int g2 = desc ? NGW - 1 - gw : gw;
    const int ra = (int)(((unsigned)g2 * (unsigned)MT) / (unsigned)NGW), rb = (int)(((unsigned)(g2 + 1) * (unsigned)MT) / (unsigned)NGW);
    const int nr = rb - ra, rfirst = desc ? rb - 1 : ra, step = desc ? -1 : 1;
    if (nr <= 0) return;
    f32x4 ca[8], cb[8]; int cur_seq = -1;
    v2u xn[8];
    v2u xm[8];
    f32x4 xf[8];
    if (SRC_F32) { const float* xr = (rfirst < NTOK_P ? xP + (size_t)rfirst * DM : xS + (size_t)(rfirst - NTOK_P) * DM) + 4 * lane;
#pragma unroll
        for (int j = 0; j < 8; ++j) xf[j] = *(const f32x4*)(xr + 256 * j); }
    if (!SRC_F32) { const v2u* xb0 = (const v2u*)(X + (size_t)rfirst * DM) + lane;
#pragma unroll
        for (int j = 0; j < 8; ++j) xn[j] = xb0[64 * j];
        if (nr > 1) { const v2u* xb1 = (const v2u*)(X + (size_t)(rfirst + step) * DM) + lane;
#pragma unroll
            for (int j = 0; j < 8; ++j) xm[j] = xb1[64 * j]; } }
    for (int i = 0; i < nr; ++i) { const int r = rfirst + step * i;
        const int seq = r < NTOK_P ? (r >> 11) : 16 + ((r - NTOK_P) >> 5);
        if (seq != cur_seq) { cur_seq = seq; const float* mp = modl + (size_t)seq * 12288;
#pragma unroll
            for (int j = 0; j < 8; ++j) { const int c = 4 * lane + 256 * j; const f32x4 g = *(const f32x4*)(ng + c), sc = *(const f32x4*)(mp + part_sc * DM + c); ca[j] = g * (sc + 1.0f); cb[j] = *(const f32x4*)(mp + part_sh * DM + c); } }
        f32x4 v[8]; float ss = 0.f; v2u* xb = (v2u*)(X + (size_t)r * DM) + lane;
        if (SRC_F32) {
#pragma unroll
            for (int j = 0; j < 8; ++j) { v[j] = xf[j]; v2u o; o.x = pk2(v[j].x, v[j].y); o.y = pk2(v[j].z, v[j].w); xb[64 * j] = o; }
            if (i + 1 < nr) { const int r1 = r + step; const float* xr = (r1 < NTOK_P ? xP + (size_t)r1 * DM : xS + (size_t)(r1 - NTOK_P) * DM) + 4 * lane;
#pragma unroll
                for (int j = 0; j < 8; ++j) xf[j] = *(const f32x4*)(xr + 256 * j); } }
        else {
#pragma unroll
            for (int j = 0; j < 8; ++j) { const v2u o = xn[j]; v[j] = (f32x4){bflo(o.x), bfhi(o.x), bflo(o.y), bfhi(o.y)}; xn[j] = xm[j]; }
            if (i + 2 < nr) { const v2u* xb2 = (const v2u*)(X + (size_t)(r + 2 * step) * DM) + lane;
#pragma unroll
                for (int j = 0; j < 8; ++j) xm[j] = xb2[64 * j]; } }
        if (comb) {
#pragma unroll
            for (int j = 0; j < 8; ++j) { const int ti = tmap[(r >> 8) * 8 + j]; if (ti >= 0) { const float* sp = slab + (size_t)ti * 8 * 65536 + (r & 255) * 256 + 4 * lane;
#pragma unroll
                    for (int q = 0; q < 8; ++q) v[j] = v[j] + *(const f32x4*)(sp + (size_t)q * 65536);
                    v2u o; o.x = pk2(v[j].x, v[j].y); o.y = pk2(v[j].z, v[j].w); xb[64 * j] = o; } } }
#pragma unroll
        for (int j = 0; j < 8; ++j) ss += (v[j].x * v[j].x + v[j].y * v[j].y) + (v[j].z * v[j].z + v[j].w * v[j].w);
        const float rstd = 1.0f / sqrtf(wave_sum(ss) * (1.0f / DM) + NORM_EPS);
        unsigned long long* o8 = (unsigned long long*)(H + (size_t)r * DM) + lane;
#pragma unroll
        for (int j = 0; j < 8; ++j) { const f32x4 y = v[j] * rstd * ca[j] + cb[j]; o8[64 * j] = (unsigned long long)pk2(y.x, y.y) | ((unsigned long long)pk2(y.z, y.w) << 32); }
    }
}
__device__ __forceinline__ void final_norm_phase(int lane, int gw, int NGW, const bf16* X, float* Y, const float* fg, bool comb, const LAS int* tmap, const float* slab) {
    f32x4 g[8];
#pragma unroll
    for (int j = 0; j < 8; ++j) g[j] = *(const f32x4*)(fg + 4 * lane + 256 * j);
    v2u xn[8], xm[8];
    if (gw < MT) { const v2u* xb0 = (const v2u*)(X + (size_t)gw * DM) + lane;
#pragma unroll
        for (int j = 0; j < 8; ++j) xn[j] = xb0[64 * j]; }
    if (gw + NGW < MT) { const v2u* xb0 = (const v2u*)(X + (size_t)(gw + NGW) * DM) + lane;
#pragma unroll
        for (int j = 0; j < 8; ++j) xm[j] = xb0[64 * j]; }
    for (int r = gw; r < MT; r += NGW) {
        float* yr = Y + (size_t)r * DM + 4 * lane; f32x4 v[8]; float ss = 0.f;
#pragma unroll
        for (int j = 0; j < 8; ++j) { const v2u o = xn[j]; v[j] = (f32x4){bflo(o.x), bfhi(o.x), bflo(o.y), bfhi(o.y)}; xn[j] = xm[j]; }
        if (r + 2 * NGW < MT) { const v2u* xb1 = (const v2u*)(X + (size_t)(r + 2 * NGW) * DM) + lane;
#pragma unroll
            for (int j = 0; j < 8; ++j) xm[j] = xb1[64 * j]; }
        if (comb) {
#pragma unroll
            for (int j = 0; j < 8; ++j) { const int ti = tmap[(r >> 8) * 8 + j]; if (ti >= 0) { const float* sp = slab + (size_t)ti * 8 * 65536 + (r & 255) * 256 + 4 * lane;
#pragma unroll
                    for (int q = 0; q < 8; ++q) v[j] = v[j] + *(const f32x4*)(sp + (size_t)q * 65536); } } }
#pragma unroll
        for (int j = 0; j < 8; ++j) ss += (v[j].x * v[j].x + v[j].y * v[j].y) + (v[j].z * v[j].z + v[j].w * v[j].w);
        const float rstd = 1.0f / sqrtf(wave_sum(ss) * (1.0f / DM) + NORM_EPS);
#pragma unroll
        for (int j = 0; j < 8; ++j) *(f32x4*)(yr + 256 * j) = v[j] * rstd * g[j];
    }
}
__device__ __forceinline__ void ssd_norm_phase(int lane, int gw, int NGW, bf16* YB, const float* g) {
    float gv[16];
#pragma unroll
    for (int j = 0; j < 4; ++j) { const f32x4 t = *(const f32x4*)(g + 16 * lane + 4 * j); gv[4 * j] = t.x; gv[4 * j + 1] = t.y; gv[4 * j + 2] = t.z; gv[4 * j + 3] = t.w; }
    v4u na = (v4u){0u, 0u, 0u, 0u}, nb = na, ma = na, mb = na;
    if (gw < MT) { const v4u* p0 = (const v4u*)(YB + (size_t)gw * 1024 + 16 * lane); na = p0[0]; nb = p0[1]; }
    if (gw + NGW < MT) { const v4u* p0 = (const v4u*)(YB + (size_t)(gw + NGW) * 1024 + 16 * lane); ma = p0[0]; mb = p0[1]; }
    for (int r = gw; r < MT; r += NGW) {
        v4u* p = (v4u*)(YB + (size_t)r * 1024 + 16 * lane); const v4u a = na, b = nb; na = ma; nb = mb;
        if (r + 2 * NGW < MT) { const v4u* p1 = (const v4u*)(YB + (size_t)(r + 2 * NGW) * 1024 + 16 * lane); ma = p1[0]; mb = p1[1]; }
        float v[16]; v[0] = bflo(a.x); v[1] = bfhi(a.x); v[2] = bflo(a.y); v[3] = bfhi(a.y); v[4] = bflo(a.z); v[5] = bfhi(a.z); v[6] = bflo(a.w); v[7] = bfhi(a.w);
        v[8] = bflo(b.x); v[9] = bfhi(b.x); v[10] = bflo(b.y); v[11] = bfhi(b.y); v[12] = bflo(b.z); v[13] = bfhi(b.z); v[14] = bflo(b.w); v[15] = bfhi(b.w);
        float ss = 0.f;
#pragma unroll
        for (int j = 0; j < 16; ++j) ss += v[j] * v[j];
        const float rstd = 1.0f / sqrtf(half_sum(ss, lane) * (1.0f / 512.0f) + NORM_EPS);
#pragma unroll
        for (int j = 0; j < 16; ++j) v[j] = v[j] * rstd * gv[j];
        v4u oa, ob; oa.x = pk2(v[0], v[1]); oa.y = pk2(v[2], v[3]); oa.z = pk2(v[4], v[5]); oa.w = pk2(v[6], v[7]); ob.x = pk2(v[8], v[9]); ob.y = pk2(v[10], v[11]); ob.z = pk2(v[12], v[13]); ob.w = pk2(v[14], v[15]);
        p[0] = oa; p[1] = ob;
    }
}

__device__ __forceinline__ void hgrn_item(LAS unsigned char* lds, int tid, int lane, int wave, const bf16* P, bf16* YA, int row0, int T, int h, int l,
                                          const float* s0, float* sout, const float* lb_raw, const float* onorm_g) {
    LAS float* LBV = (LAS float*)lds;
    LAS float* GV = LBV + 128;
    LAS float* Q = GV + 128;
    LAS float* F = Q + 2048; LAS float* KN = F + 2048; LAS float* IV = KN + 2048;
    LAS float* PO = IV + 2048;
    __syncthreads();
    if (tid < 128) { const int ch = h * 128 + tid; const float a0 = lb_raw[ch], a1 = lb_raw[1024 + ch], a2 = lb_raw[2048 + ch], a3 = lb_raw[3072 + ch];
        const float mx = fmaxf(fmaxf(a0, a1), fmaxf(a2, a3)); const float e0 = __expf(a0 - mx), e1 = __expf(a1 - mx), e2 = __expf(a2 - mx), e3 = __expf(a3 - mx); const float inv = 1.0f / (e0 + e1 + e2 + e3);
        float lb = 0.f; if (l >= 1) lb += e1; if (l >= 2) lb += e2; if (l >= 3) lb += e3; LBV[tid] = lb * inv; GV[tid] = onorm_g[ch]; }
    v2u nq2, nf2, ni2;
    { const bf16* pr = P + (size_t)(row0 + (tid >> 5)) * NPAD + h * 128 + (tid & 31) * 4; nq2 = *(const v2u*)(pr + OFF_AQ); nf2 = *(const v2u*)(pr + OFF_AF); ni2 = *(const v2u*)(pr + OFF_AI); }
    float S0[16], S1[16];
#pragma unroll
    for (int kk = 0; kk < 16; ++kk) { if (s0) { const f32x2 v = *(const f32x2*)(s0 + (16 * wave + kk) * 128 + 2 * lane); S0[kk] = v.x; S1[kk] = v.y; } else { S0[kk] = 0.f; S1[kk] = 0.f; } }
    __syncthreads();
    const int nch = T / 16;
    for (int c = 0; c < nch; ++c) {
        unsigned agv[2];
#pragma unroll
        for (int tt = 0; tt < 2; ++tt) agv[tt] = *(const unsigned*)(P + (size_t)(row0 + c * 16 + 2 * wave + tt) * NPAD + OFF_AG + h * 128 + 2 * lane);
        { const int t = tid >> 5, k4 = (tid & 31) * 4;
            const v2u q2 = nq2, f2 = nf2, i2 = ni2;
            if (c + 1 < nch) { const bf16* pr = P + (size_t)(row0 + (c + 1) * 16 + t) * NPAD + h * 128 + k4; nq2 = *(const v2u*)(pr + OFF_AQ); nf2 = *(const v2u*)(pr + OFF_AF); ni2 = *(const v2u*)(pr + OFF_AI); }
            const f32x4 lb = *(const LAS f32x4*)(LBV + k4);
            const float aq[4] = {bflo(q2.x), bfhi(q2.x), bflo(q2.y), bfhi(q2.y)}, az[4] = {bflo(f2.x), bfhi(f2.x), bflo(f2.y), bfhi(f2.y)};
            f32x4 qv, fv, kv;
#pragma unroll
            for (int j = 0; j < 4; ++j) { qv[j] = siluf_(aq[j]); const float sg = sigmoidf_(az[j]); fv[j] = lb[j] + (1.0f - lb[j]) * sg; kv[j] = (1.0f - lb[j]) * (1.0f - sg); }
            *(LAS f32x4*)(Q + t * 128 + k4) = qv; *(LAS f32x4*)(F + t * 128 + k4) = fv; *(LAS f32x4*)(KN + t * 128 + k4) = kv;
            *(LAS f32x4*)(IV + t * 128 + k4) = (f32x4){bflo(i2.x), bfhi(i2.x), bflo(i2.y), bfhi(i2.y)}; }
        __syncthreads();
#pragma unroll 2
        for (int t = 0; t < 16; ++t) {
            const f32x2 iv = *(const LAS f32x2*)(IV + t * 128 + 2 * lane); float po0 = 0.f, po1 = 0.f;
#pragma unroll
            for (int k4 = 0; k4 < 4; ++k4) { const f32x4 f4 = *(const LAS f32x4*)(F + t * 128 + 16 * wave + 4 * k4), n4 = *(const LAS f32x4*)(KN + t * 128 + 16 * wave + 4 * k4), q4 = *(const LAS f32x4*)(Q + t * 128 + 16 * wave + 4 * k4);
#pragma unroll
                for (int j = 0; j < 4; ++j) { const int kk = 4 * k4 + j; S0[kk] = fmaf(f4[j], S0[kk], n4[j] * iv.x); S1[kk] = fmaf(f4[j], S1[kk], n4[j] * iv.y); po0 = fmaf(q4[j], S0[kk], po0); po1 = fmaf(q4[j], S1[kk], po1); } }
            *(LAS f32x2*)(PO + (t * 8 + wave) * 128 + 2 * lane) = (f32x2){po0, po1};
        }
        __syncthreads();
#pragma unroll
        for (int tt = 0; tt < 2; ++tt) { const int t = 2 * wave + tt; float o0 = 0.f, o1 = 0.f;
#pragma unroll
            for (int w = 0; w < 8; ++w) { const f32x2 p = *(const LAS f32x2*)(PO + (t * 8 + w) * 128 + 2 * lane); o0 += p.x; o1 += p.y; }
            const float rstd = 1.0f / sqrtf(wave_sum(o0 * o0 + o1 * o1) * (1.0f / 128.0f) + NORM_EPS);
            const size_t row = (size_t)(row0 + c * 16 + t);
            const unsigned ag = agv[tt];
            const f32x2 gg = *(const LAS f32x2*)(GV + 2 * lane);
            *(unsigned*)(YA + row * 1024 + h * 128 + 2 * lane) = pk2(o0 * rstd * gg.x * siluf_(bflo(ag)), o1 * rstd * gg.y * siluf_(bfhi(ag))); }
    }
#pragma unroll
    for (int kk = 0; kk < 16; ++kk) *(f32x2*)(sout + (16 * wave + kk) * 128 + 2 * lane) = (f32x2){S0[kk], S1[kk]};
    __syncthreads();
}

typedef short bf16x8_t __attribute__((ext_vector_type(8)));
#define BAR_LDS() do { asm volatile("s_waitcnt lgkmcnt(0)" ::: "memory"); __builtin_amdgcn_s_barrier(); asm volatile("" ::: "memory"); } while (0)
#define MFMA16(x, y, acc) __builtin_amdgcn_mfma_f32_16x16x32_bf16((x), (y), (acc), 0, 0, 0)
#define LDFRAG(base, row, pitch, koff) (*(const LAS bf16x8_t*)((base) + (row) * (pitch) + (koff)))
__device__ __forceinline__ void hgrn_mfma_item(LAS unsigned char* lds, int tid, int lane, int wave, const bf16* P, bf16* YA, int row0, int h, int l, float* sout, const float* lb_raw, const float* onorm_g) {
    constexpr int PQ = 136, PT = 40;
    LAS float* LBV = (LAS float*)lds;
    LAS float* GV = LBV + 128;
    LAS float* DEC = GV + 128;
    LAS float* SS = DEC + 128;
    LAS float* LF = SS + 256;
    LAS bf16* QB = (LAS bf16*)(LF + 4096);
    LAS bf16* KB = QB + 32 * PQ;
    LAS bf16* Qt = KB + 32 * PQ;
    LAS bf16* Qm = Qt + 32 * PQ;
    LAS bf16* Km = Qm + 32 * PQ;
    LAS bf16* Qr = Km + 32 * PQ;
    LAS bf16* Kr = Qr + 16 * PQ;
    LAS bf16* KtT = Kr + 16 * PQ;
    LAS bf16* VT = KtT + 128 * PT;
    LAS bf16* IVr = VT + 128 * PT;
    LAS float* RSW = (LAS float*)(IVr + 32 * 128);
    const int fr = lane & 15, fq = lane >> 4;
    __syncthreads();
    if (tid < 128) { const int ch = h * 128 + tid; const float a0 = lb_raw[ch], a1 = lb_raw[1024 + ch], a2 = lb_raw[2048 + ch], a3 = lb_raw[3072 + ch];
        const float mx = fmaxf(fmaxf(a0, a1), fmaxf(a2, a3)); const float e0 = __expf(a0 - mx), e1 = __expf(a1 - mx), e2 = __expf(a2 - mx), e3 = __expf(a3 - mx); const float inv = 1.0f / (e0 + e1 + e2 + e3);
        float lb = 0.f; if (l >= 1) lb += e1; if (l >= 2) lb += e2; if (l >= 3) lb += e3; LBV[tid] = lb * inv; GV[tid] = onorm_g[ch]; }
    for (int i = tid; i < (128 * PT * 2) / 2; i += 512) ((LAS unsigned*)KtT)[i] = 0u;
    f32x4 sacc[8];
#pragma unroll
    for (int j = 0; j < 8; ++j) sacc[j] = (f32x4){0.f, 0.f, 0.f, 0.f};
    const int st = tid >> 4, sk8 = (tid & 15) * 8;
    const unsigned pst = (unsigned)((unsigned)(row0 + st) * (unsigned)NPAD + h * 128 + sk8) * 2u;
#define HG_LD16(off_) (*(const v4u*)((const char*)P + (unsigned)(off_)))
    v4u nq = HG_LD16(pst + 2u * OFF_AQ), nf = HG_LD16(pst + 2u * OFF_AF), ni = HG_LD16(pst + 2u * OFF_AI);
    f32x4 po0 = (f32x4){0.f, 0.f, 0.f, 0.f}, po1 = po0; bf16 pag[2][4];
#pragma unroll
    for (int hh = 0; hh < 2; ++hh)
#pragma unroll
        for (int r = 0; r < 4; ++r) pag[hh][r] = 0;
    const float gvv = onorm_g[h * 128 + 16 * wave + fr];
    __syncthreads();
#define HG_OUT(rb_) do { { const int t_ = lane & 31; const f32x4 p0 = *(const LAS f32x4*)(SS + t_ * 8), p1 = *(const LAS f32x4*)(SS + t_ * 8 + 4); \
            RSW[wave * 32 + t_] = rsqrtf_(((p0.x + p0.y) + (p0.z + p0.w) + (p1.x + p1.y) + (p1.z + p1.w)) * (1.0f / 128.0f) + NORM_EPS); } \
        LDS_WAIT(); asm volatile("" ::: "memory"); \
        _Pragma("unroll") for (int hh = 0; hh < 2; ++hh) { const f32x4 rs4 = *(const LAS f32x4*)(RSW + wave * 32 + 16 * hh + 4 * fq); \
            _Pragma("unroll") for (int r = 0; r < 4; ++r) { const int t = 16 * hh + 4 * fq + r; const float ov = hh ? po1[r] : po0[r]; \
            *(bf16*)((char*)YA + (unsigned)(((unsigned)(rb_) + t) * 1024u + h * 128 + 16 * wave + fr) * 2u) = (bf16)f2bf(ov * rs4[r] * gvv * siluf_(bf1(pag[hh][r]))); } } } while (0)
    for (int c = 0; c < 64; ++c) {
        const unsigned rbase = (unsigned)row0 + 32u * c;
        bf16 ag[2][4];
        { const f32x4 lb0 = *(const LAS f32x4*)(LBV + sk8), lb1 = *(const LAS f32x4*)(LBV + sk8 + 4); const float lb[8] = {lb0.x, lb0.y, lb0.z, lb0.w, lb1.x, lb1.y, lb1.z, lb1.w};
            const float aq[8] = {bflo(nq.x), bfhi(nq.x), bflo(nq.y), bfhi(nq.y), bflo(nq.z), bfhi(nq.z), bflo(nq.w), bfhi(nq.w)}, az[8] = {bflo(nf.x), bfhi(nf.x), bflo(nf.y), bfhi(nf.y), bflo(nf.z), bfhi(nf.z), bflo(nf.w), bfhi(nf.w)};
            float qv[8], kv[8], lf[8];
#pragma unroll
            for (int j = 0; j < 8; ++j) { qv[j] = siluf_(aq[j]); const float sg = sigmoidf_(az[j]); const float f = fmaxf(lb[j] + (1.0f - lb[j]) * sg, 1e-30f); kv[j] = (1.0f - lb[j]) * (1.0f - sg); lf[j] = __log2f(f); }
            *(LAS f32x4*)(LF + st * 128 + sk8) = (f32x4){lf[0], lf[1], lf[2], lf[3]}; *(LAS f32x4*)(LF + st * 128 + sk8 + 4) = (f32x4){lf[4], lf[5], lf[6], lf[7]};
            v4u qo, ko; qo.x = pk2(qv[0], qv[1]); qo.y = pk2(qv[2], qv[3]); qo.z = pk2(qv[4], qv[5]); qo.w = pk2(qv[6], qv[7]); ko.x = pk2(kv[0], kv[1]); ko.y = pk2(kv[2], kv[3]); ko.z = pk2(kv[4], kv[5]); ko.w = pk2(kv[6], kv[7]);
            *(LAS v4u*)(QB + st * PQ + sk8) = qo; *(LAS v4u*)(KB + st * PQ + sk8) = ko; *(LAS v4u*)(IVr + st * 128 + sk8) = ni;
#pragma unroll
            for (int hh = 0; hh < 2; ++hh)
#pragma unroll
                for (int r = 0; r < 4; ++r) ag[hh][r] = *(const bf16*)((const char*)P + (unsigned)((rbase + 16 * hh + 4 * fq + r) * (unsigned)NPAD + OFF_AG + h * 128 + 16 * wave + fr) * 2u);
            if (c + 1 < 64) { const unsigned pn = pst + (unsigned)(c + 1) * 32u * (unsigned)NPAD * 2u; nq = HG_LD16(pn + 2u * OFF_AQ); nf = HG_LD16(pn + 2u * OFF_AF); ni = HG_LD16(pn + 2u * OFF_AI); } }
        BAR_LDS();
        { const int k = tid & 127, tq = tid >> 7; float b[32]; float run = 0.f;
#pragma unroll
            for (int t = 0; t < 32; ++t) { run += LF[t * 128 + k]; b[t] = run; }
#pragma unroll
            for (int tq2 = 0; tq2 < 4; ++tq2) if (tq2 == tq) { const float mh = (tq2 < 2) ? b[7] : b[23]; float kt[8]; bf16 iv[8];
#pragma unroll
                for (int i = 0; i < 8; ++i) { const int t = 8 * tq2 + i; const float qv = bf1(QB[t * PQ + k]), kv = bf1(KB[t * PQ + k]); iv[i] = IVr[t * 128 + k];
                    Qt[t * PQ + k] = (bf16)f2bf(qv * __builtin_amdgcn_exp2f(b[t])); kt[i] = kv * __builtin_amdgcn_exp2f(b[31] - b[t]);
                    Qm[t * PQ + k] = (bf16)f2bf(qv * __builtin_amdgcn_exp2f(fminf(b[t] - mh, 115.f))); Km[t * PQ + k] = (bf16)f2bf(kv * __builtin_amdgcn_exp2f(fminf(mh - b[t], 115.f)));
                    if (tq2 < 2) Kr[t * PQ + k] = (bf16)f2bf(kv * __builtin_amdgcn_exp2f(b[15] - b[t])); else Qr[(t - 16) * PQ + k] = (bf16)f2bf(qv * __builtin_amdgcn_exp2f(b[t] - b[15])); }
                v4u ko; ko.x = pk2(kt[0], kt[1]); ko.y = pk2(kt[2], kt[3]); ko.z = pk2(kt[4], kt[5]); ko.w = pk2(kt[6], kt[7]); *(LAS v4u*)(KtT + k * PT + 8 * tq2) = ko;
                v4u vo; vo.x = (unsigned)iv[0] | ((unsigned)iv[1] << 16); vo.y = (unsigned)iv[2] | ((unsigned)iv[3] << 16); vo.z = (unsigned)iv[4] | ((unsigned)iv[5] << 16); vo.w = (unsigned)iv[6] | ((unsigned)iv[7] << 16); *(LAS v4u*)(VT + k * PT + 8 * tq2) = vo; }
            if (tq == 0) DEC[k] = __builtin_amdgcn_exp2f(b[31]); }
        if (c > 0) HG_OUT(rbase - 32);
        BAR_LDS();
        f32x4 at0 = (f32x4){0.f, 0.f, 0.f, 0.f}, at1 = at0, at2 = at0, o0 = at0, o1 = at0;
#pragma unroll
        for (int ks = 0; ks < 4; ++ks) { const int ko = 32 * ks + 8 * fq;
            at0 = MFMA16(LDFRAG(Km, fr, PQ, ko), LDFRAG(Qm, fr, PQ, ko), at0);
            at1 = MFMA16(LDFRAG(Km, 16 + fr, PQ, ko), LDFRAG(Qm, 16 + fr, PQ, ko), at1);
            at2 = MFMA16(LDFRAG(Kr, fr, PQ, ko), LDFRAG(Qr, fr, PQ, ko), at2);
            v4u sy; sy.x = pk2(sacc[2 * ks][0], sacc[2 * ks][1]); sy.y = pk2(sacc[2 * ks][2], sacc[2 * ks][3]); sy.z = pk2(sacc[2 * ks + 1][0], sacc[2 * ks + 1][1]); sy.w = pk2(sacc[2 * ks + 1][2], sacc[2 * ks + 1][3]);
            const v2u xa0 = *(const LAS v2u*)(Qt + fr * PQ + 32 * ks + 4 * fq), xb0 = *(const LAS v2u*)(Qt + fr * PQ + 32 * ks + 16 + 4 * fq);
            const v2u xa1 = *(const LAS v2u*)(Qt + (16 + fr) * PQ + 32 * ks + 4 * fq), xb1 = *(const LAS v2u*)(Qt + (16 + fr) * PQ + 32 * ks + 16 + 4 * fq);
            v4u x0; x0.x = xa0.x; x0.y = xa0.y; x0.z = xb0.x; x0.w = xb0.y; v4u x1; x1.x = xa1.x; x1.y = xa1.y; x1.z = xb1.x; x1.w = xb1.y;
            o0 = MFMA16(__builtin_bit_cast(bf16x8_t, x0), __builtin_bit_cast(bf16x8_t, sy), o0); o1 = MFMA16(__builtin_bit_cast(bf16x8_t, x1), __builtin_bit_cast(bf16x8_t, sy), o1); }
        {
            v4u a0, a1, a2; a0.z = 0u; a0.w = 0u; a1.z = 0u; a1.w = 0u; a2.z = 0u; a2.w = 0u;
            a0.x = pk2(4 * fq + 0 <= fr ? at0[0] : 0.f, 4 * fq + 1 <= fr ? at0[1] : 0.f); a0.y = pk2(4 * fq + 2 <= fr ? at0[2] : 0.f, 4 * fq + 3 <= fr ? at0[3] : 0.f);
            a1.x = pk2(4 * fq + 0 <= fr ? at1[0] : 0.f, 4 * fq + 1 <= fr ? at1[1] : 0.f); a1.y = pk2(4 * fq + 2 <= fr ? at1[2] : 0.f, 4 * fq + 3 <= fr ? at1[3] : 0.f);
            a2.x = pk2(at2[0], at2[1]); a2.y = pk2(at2[2], at2[3]);
            const v2u y0 = *(const LAS v2u*)(VT + (16 * wave + fr) * PT + 4 * fq), y1 = *(const LAS v2u*)(VT + (16 * wave + fr) * PT + 16 + 4 * fq);
            v4u v0; v0.x = y0.x; v0.y = y0.y; v0.z = 0u; v0.w = 0u; v4u v1; v1.x = y1.x; v1.y = y1.y; v1.z = 0u; v1.w = 0u;
            o0 = MFMA16(__builtin_bit_cast(bf16x8_t, a0), __builtin_bit_cast(bf16x8_t, v0), o0);
            o1 = MFMA16(__builtin_bit_cast(bf16x8_t, a1), __builtin_bit_cast(bf16x8_t, v1), o1);
            o1 = MFMA16(__builtin_bit_cast(bf16x8_t, a2), __builtin_bit_cast(bf16x8_t, v0), o1); }
#pragma unroll
        for (int r = 0; r < 4; ++r) { float q0 = o0[r] * o0[r], q1 = o1[r] * o1[r];
            q0 = row16_sum(q0); q1 = row16_sum(q1);
            if (fr == 0) { SS[(4 * fq + r) * 8 + wave] = q0; SS[(16 + 4 * fq + r) * 8 + wave] = q1; } }
        {
            const bf16x8_t vy = LDFRAG(VT, 16 * wave + fr, PT, 8 * fq);
#pragma unroll
            for (int kt = 0; kt < 8; ++kt) { const f32x4 d4 = *(const LAS f32x4*)(DEC + 16 * kt + 4 * fq); sacc[kt] = sacc[kt] * d4; sacc[kt] = MFMA16(LDFRAG(KtT, 16 * kt + fr, PT, 8 * fq), vy, sacc[kt]); } }
        po0 = o0; po1 = o1;
#pragma unroll
        for (int hh = 0; hh < 2; ++hh)
#pragma unroll
            for (int r = 0; r < 4; ++r) pag[hh][r] = ag[hh][r];
    }
    BAR_LDS();
    HG_OUT((unsigned)row0 + 2048u - 32u);
#undef HG_OUT
#undef HG_LD16
#pragma unroll
    for (int kt = 0; kt < 8; ++kt)
#pragma unroll
        for (int r = 0; r < 4; ++r) sout[(16 * kt + 4 * fq + r) * 128 + 16 * wave + fr] = sacc[kt][r];
    __syncthreads();
}

__device__ __forceinline__ void ssd_pre_phase(int lane, int gw, int NGW, const bf16* P, bf16* XC, float* DTb, float* ADT, float* ACUM,
                                              const float* conv_w, const float* conv_b, const float* dt_bias, const float* a_log, const float* state_conv, float* conv_out_p, float* conv_out_s) {
    unsigned ua = (unsigned)(((unsigned long long)(unsigned)gw * (3u * MT)) / (unsigned)NGW); const unsigned ub = (unsigned)(((unsigned long long)((unsigned)gw + 1u) * (3u * MT)) / (unsigned)NGW);
#define PRE_UNPK(dst, u) do { dst[0] = bflo(u.x); dst[1] = bfhi(u.x); dst[2] = bflo(u.y); dst[3] = bfhi(u.y); dst[4] = bflo(u.z); dst[5] = bfhi(u.z); dst[6] = bflo(u.w); dst[7] = bfhi(u.w); } while (0)
    while (ua < ub) {
        const int cg = (int)(ua / (unsigned)MT); const unsigned ue = ub < (unsigned)(cg + 1) * MT ? ub : (unsigned)(cg + 1) * MT;
        const int t0 = (int)(ua - (unsigned)cg * MT), t1 = (int)(ue - (unsigned)cg * MT), cc = cg * 512 + 8 * lane; ua = ue;
        float w[4][8], cb[8], a0[8], a1[8], a2[8];
#pragma unroll
        for (int j = 0; j < 4; ++j) { const f32x4 u0 = *(const f32x4*)(conv_w + j * 1536 + cc), u1 = *(const f32x4*)(conv_w + j * 1536 + cc + 4);
            w[j][0] = u0.x; w[j][1] = u0.y; w[j][2] = u0.z; w[j][3] = u0.w; w[j][4] = u1.x; w[j][5] = u1.y; w[j][6] = u1.z; w[j][7] = u1.w; }
        { const f32x4 u0 = *(const f32x4*)(conv_b + cc), u1 = *(const f32x4*)(conv_b + cc + 4); cb[0] = u0.x; cb[1] = u0.y; cb[2] = u0.z; cb[3] = u0.w; cb[4] = u1.x; cb[5] = u1.y; cb[6] = u1.z; cb[7] = u1.w; }
#pragma unroll
        for (int e = 0; e < 8; ++e) { a0[e] = 0.f; a1[e] = 0.f; a2[e] = 0.f; }
        const int ts = t0 >= 3 ? t0 - 3 : 0;
        const bf16* pc = P + OFF_XBC + cc; bf16* xo = XC + cc;
        v4u un[4];
#pragma unroll
        for (int k = 0; k < 4; ++k) { const int tt = ts + k < t1 ? ts + k : t1 - 1; un[k] = *(const v4u*)(pc + (size_t)tt * NPAD); }
        for (int tb = ts; tb < t1; tb += 4) { v4u uc[4];
#pragma unroll
            for (int k = 0; k < 4; ++k) uc[k] = un[k];
            if (tb + 4 < t1) {
#pragma unroll
                for (int k = 0; k < 4; ++k) { const int tt = tb + 4 + k < t1 ? tb + 4 + k : t1 - 1; un[k] = *(const v4u*)(pc + (size_t)tt * NPAD); } }
#pragma unroll
            for (int k = 0; k < 4; ++k) { const int t = tb + k; if (t < t1) {
                const bool smp = t >= NTOK_P; const bool st = smp ? (((t - NTOK_P) & 31) == 0) : ((t & 2047) == 0);
                if (st) {
                    if (smp) { const float* cbuf = state_conv + (size_t)((t - NTOK_P) >> 5) * 4608 + cc;
#pragma unroll
                        for (int e = 0; e < 8; ++e) { a0[e] = cbuf[e]; a1[e] = cbuf[1536 + e]; a2[e] = cbuf[3072 + e]; } }
                    else {
#pragma unroll
                        for (int e = 0; e < 8; ++e) { a0[e] = 0.f; a1[e] = 0.f; a2[e] = 0.f; } } }
                float cur[8]; PRE_UNPK(cur, uc[k]);
                if (t >= t0) { float o[8];
#pragma unroll
                    for (int e = 0; e < 8; ++e) o[e] = siluf_(cb[e] + w[0][e] * a0[e] + w[1][e] * a1[e] + w[2][e] * a2[e] + w[3][e] * cur[e]);
                    v4u ov; ov.x = pk2(o[0], o[1]); ov.y = pk2(o[2], o[3]); ov.z = pk2(o[4], o[5]); ov.w = pk2(o[6], o[7]);
                    *(v4u*)(xo + (size_t)t * 1536) = ov; }
#pragma unroll
                for (int e = 0; e < 8; ++e) { a0[e] = a1[e]; a1[e] = a2[e]; a2[e] = cur[e]; } } }
        }
    }
#undef PRE_UNPK
    const int dsp = NGW >= 528 * 2 ? NGW / (528 * 2) : 1;
    for (int it = (gw % dsp == 0) ? gw / dsp : 1056; it < 1056; it += NGW / dsp) {
        const int rb = it >> 1, h0 = (it & 1) * 8; const size_t row = (size_t)rb * 64 + lane;
        const v4u d0 = *(const v4u*)(P + row * NPAD + OFF_DT + h0);
        const float xr[8] = {bflo(d0.x), bfhi(d0.x), bflo(d0.y), bfhi(d0.y), bflo(d0.z), bfhi(d0.z), bflo(d0.w), bfhi(d0.w)};
        float dtv[8], av[8], csv[8];
#pragma unroll
        for (int h = 0; h < 8; ++h) { const float xv = xr[h] + dt_bias[h0 + h]; const float eu = __expf(-fabsf(xv)), ew = 1.0f + eu;
            const float l1p = (ew == 1.0f) ? eu : __logf(ew) * (eu * __builtin_amdgcn_rcpf(ew - 1.0f)); const float dt = fmaxf(xv, 0.f) + l1p; const float a = -dt * __expf(a_log[h0 + h]); dtv[h] = dt; av[h] = a; csv[h] = a; }
#pragma unroll
        for (int o = 1; o < 64; o <<= 1) {
#pragma unroll
            for (int h = 0; h < 8; ++h) { const float t = __shfl_up(csv[h], o); if (lane >= o) csv[h] += t; } }
#pragma unroll
        for (int q = 0; q < 2; ++q) { *(f32x4*)(DTb + row * 16 + h0 + 4 * q) = (f32x4){dtv[4 * q], dtv[4 * q + 1], dtv[4 * q + 2], dtv[4 * q + 3]};
            *(f32x4*)(ADT + row * 16 + h0 + 4 * q) = (f32x4){av[4 * q], av[4 * q + 1], av[4 * q + 2], av[4 * q + 3]};
            *(f32x4*)(ACUM + row * 16 + h0 + 4 * q) = (f32x4){csv[4 * q], csv[4 * q + 1], csv[4 * q + 2], csv[4 * q + 3]}; }
    }
    for (int e = gw * 64 + lane; e < 48 * 4608; e += NGW * 64) {
        const int sq = e / 4608, r = e - sq * 4608, j = r / 1536, cc = r - j * 1536;
        const size_t row = sq < 16 ? (size_t)sq * 2048 + 2045 + j : (size_t)NTOK_P + (sq - 16) * 32 + 29 + j;
        const float v = bf1(P[row * NPAD + OFF_XBC + cc]);
        if (sq < 16) conv_out_p[sq * 4608 + r] = v; else conv_out_s[(sq - 16) * 4608 + r] = v;
    }
}

__device__ __forceinline__ void ssd_item(LAS unsigned char* lds, int tid, int lane, int wave, const bf16* P, const bf16* XC, const float* DTb, const float* ADT, bf16* YB, int row0, int T, int h,
                                         const float* s0, float* sout, float Dh) {
    LAS float* X = (LAS float*)lds;
    LAS float* Bs = X + 2048;
    LAS float* Cs = Bs + 4096;
    LAS float* DT = Cs + 4096;
    LAS float* DA = DT + 32;
    LAS float* PY = DA + 32;
    const int g = h >> 3, ci = tid;
    int cc = 0; LAS float* dst = X; int dstride = 64;
    if (ci < 64) { cc = h * 64 + ci; dst = X + ci; dstride = 64; } else if (ci < 192) { cc = 1024 + g * 128 + (ci - 64); dst = Bs + (ci - 64); dstride = 128; } else if (ci < 320) { cc = 1280 + g * 128 + (ci - 192); dst = Cs + (ci - 192); dstride = 128; }
    float hst[16];
#pragma unroll
    for (int j = 0; j < 4; ++j) { f32x4 v = (f32x4){0.f, 0.f, 0.f, 0.f}; if (s0) v = *(const f32x4*)(s0 + lane * 128 + 16 * wave + 4 * j); hst[4 * j] = v.x; hst[4 * j + 1] = v.y; hst[4 * j + 2] = v.z; hst[4 * j + 3] = v.w; }
    __syncthreads();
    const int nch = T / 32;
    for (int c = 0; c < nch; ++c) {
        const size_t rbase = (size_t)(row0 + c * 32);
        if (ci < 320) { const bf16* pc = XC + rbase * 1536 + cc;
            bf16 sv[32];
#pragma unroll
            for (int t = 0; t < 32; ++t) sv[t] = pc[(size_t)t * 1536];
#pragma unroll
            for (int t = 0; t < 32; ++t) dst[t * dstride] = bf1(sv[t]); }
        else if (ci < 352) { const int t = ci - 320; DT[t] = DTb[(rbase + t) * 16 + h]; DA[t] = __expf(ADT[(rbase + t) * 16 + h]); }
        unsigned zg[2];
#pragma unroll
        for (int j = 0; j < 2; ++j) { const int e = tid + 512 * j; zg[j] = *(const unsigned*)(P + (rbase + (e >> 5)) * NPAD + OFF_BZ + h * 64 + (e & 31) * 2); }
        __syncthreads();
#pragma unroll 2
        for (int t = 0; t < 32; ++t) {
            const float dA = DA[t], xdt = X[t * 64 + lane] * DT[t]; float py = 0.f;
#pragma unroll
            for (int n4 = 0; n4 < 4; ++n4) { const f32x4 b4 = *(const LAS f32x4*)(Bs + t * 128 + 16 * wave + 4 * n4), c4 = *(const LAS f32x4*)(Cs + t * 128 + 16 * wave + 4 * n4);
#pragma unroll
                for (int j = 0; j < 4; ++j) { const int nn = 4 * n4 + j; hst[nn] = fmaf(xdt, b4[j], dA * hst[nn]); py = fmaf(hst[nn], c4[j], py); } }
            PY[(t * 8 + wave) * 64 + lane] = py;
        }
        __syncthreads();
#pragma unroll
        for (int j = 0; j < 2; ++j) { const int e = tid + 512 * j, t = e >> 5, p2 = (e & 31) * 2; float y0 = 0.f, y1 = 0.f;
#pragma unroll
            for (int w = 0; w < 8; ++w) { const f32x2 p = *(const LAS f32x2*)(PY + (t * 8 + w) * 64 + p2); y0 += p.x; y1 += p.y; }
            const f32x2 xv = *(const LAS f32x2*)(X + t * 64 + p2); y0 += Dh * xv.x; y1 += Dh * xv.y;
            const size_t row = rbase + t; const unsigned z = zg[j];
            *(unsigned*)(YB + row * 1024 + h * 64 + p2) = pk2(y0 * siluf_(bflo(z)), y1 * siluf_(bfhi(z))); }
        __syncthreads();
    }
#pragma unroll
    for (int j = 0; j < 4; ++j) *(f32x4*)(sout + lane * 128 + 16 * wave + 4 * j) = (f32x4){hst[4 * j], hst[4 * j + 1], hst[4 * j + 2], hst[4 * j + 3]};
    __syncthreads();
}

__device__ __forceinline__ bf16 v4u_el(const v4u& d, int e) { const unsigned w = d[e >> 1]; return (bf16)((e & 1) ? (w >> 16) : (w & 0xffffu)); }
__device__ __forceinline__ void ssd_mfma_pair(LAS unsigned char* lds, int tid, int lane, int wave, const bf16* P, const bf16* XC, const float* DTb, const float* ACUM, bf16* YB, int row0, int h0, float Dh0, float Dh1, float* sout0) {
    constexpr int PC = 136, PS = 72;
    LAS bf16* Cm0 = (LAS bf16*)lds;
    LAS bf16* Bm = Cm0 + 2 * 64 * PC;
    LAS bf16* BmT = Bm + 64 * PC;
    LAS bf16* XT0 = BmT + 128 * PS;
    LAS bf16* Mm0 = XT0 + 4 * 64 * PS;
    LAS float* AC0 = (LAS float*)(Mm0 + 2 * 64 * PS);
    static_assert((2 * 64 * PC + 64 * PC + 128 * PS + 4 * 64 * PS + 2 * 64 * PS) * 2 + 4 * 192 * 4 <= RING_BYTES, "ssd pair LDS");
    const int fr = lane & 15, fq = lane >> 4, g = h0 >> 3;
    const int hw = wave >> 2, pt = wave & 3;
    __syncthreads();
    f32x4 hacc[8];
#pragma unroll
    for (int j = 0; j < 8; ++j) hacc[j] = (f32x4){0.f, 0.f, 0.f, 0.f};
    int pf_s[6], pf_c[6]; v4u pf[6];
#pragma unroll
    for (int j = 0; j < 6; ++j) { const int q = tid + 512 * j; pf_s[j] = q / 48; const int c16 = q - 48 * pf_s[j];
        const int col = c16 < 16 ? (h0 + (c16 >> 3)) * 64 + 8 * (c16 & 7) : (c16 < 32 ? 1024 + g * 128 + 8 * (c16 - 16) : 1280 + g * 128 + 8 * (c16 - 32));
        pf_c[j] = (c16 << 16) | col; pf[j] = *(const v4u*)((const char*)XC + (unsigned)(((unsigned)row0 + pf_s[j]) * 1536u + col) * 2u); }
    float pf_ac = 0.f, pf_dt = 0.f, pf_acl = 0.f; const int sh = tid >> 6, ssx = tid & 63;
    if (tid < 128) { pf_ac = *(const float*)((const char*)ACUM + (unsigned)(((unsigned)row0 + ssx) * 16u + h0 + sh) * 4u); pf_dt = *(const float*)((const char*)DTb + (unsigned)(((unsigned)row0 + ssx) * 16u + h0 + sh) * 4u); pf_acl = *(const float*)((const char*)ACUM + (unsigned)(((unsigned)row0 + 63u) * 16u + h0 + sh) * 4u); }
    for (int c = 0; c < 32; ++c) {
        const unsigned rbase = (unsigned)row0 + 64u * c;
        bf16 zr[4][4];
#pragma unroll
        for (int li = 0; li < 4; ++li)
#pragma unroll
            for (int r = 0; r < 4; ++r) zr[li][r] = *(const bf16*)((const char*)P + (unsigned)((rbase + 16 * li + 4 * fq + r) * (unsigned)NPAD + OFF_BZ + (h0 + hw) * 64 + 16 * pt + fr) * 2u);
        const int cb = c & 1;
        LAS bf16* Cm = Cm0 + cb * 64 * PC; LAS bf16* XTb = XT0 + cb * 2 * 64 * PS; LAS float* ACb = AC0 + cb * 2 * 192;
        if (tid < 128) { LAS float* A = ACb + sh * 192; A[ssx] = pf_ac; A[128 + ssx] = pf_dt; A[64 + ssx] = __expf(pf_acl - pf_ac) * pf_dt; }
#pragma unroll
        for (int j = 0; j < 6; ++j) { const int s = pf_s[j], c16 = pf_c[j] >> 16; const v4u d = pf[j];
            if (c16 < 16) { LAS bf16* XT = XTb + (c16 >> 3) * 64 * PS; const int cc = c16 & 7;
#pragma unroll
                for (int e = 0; e < 8; ++e) XT[(8 * cc + e) * PS + (s ^ (cc << 3))] = v4u_el(d, e); }
            else if (c16 < 32) { const int n0 = 8 * (c16 - 16); *(LAS v4u*)(Bm + s * PC + n0) = d;
#pragma unroll
                for (int e = 0; e < 8; ++e) BmT[(n0 + e) * PS + (s ^ (((c16 - 16) & 7) << 3))] = v4u_el(d, e); }
            else { *(LAS v4u*)(Cm + s * PC + 8 * (c16 - 32)) = d; } }
        if (c + 1 < 32) {
#pragma unroll
            for (int j = 0; j < 6; ++j) pf[j] = *(const v4u*)((const char*)XC + (unsigned)((rbase + 64u + pf_s[j]) * 1536u + (pf_c[j] & 0xffff)) * 2u);
            if (tid < 128) { pf_ac = *(const float*)((const char*)ACUM + (unsigned)((rbase + 64u + ssx) * 16u + h0 + sh) * 4u); pf_dt = *(const float*)((const char*)DTb + (unsigned)((rbase + 64u + ssx) * 16u + h0 + sh) * 4u); pf_acl = *(const float*)((const char*)ACUM + (unsigned)((rbase + 127u) * 16u + h0 + sh) * 4u); } }
        BAR_LDS();
        const LAS float* AC = ACb + hw * 192; const LAS bf16* XT = XTb + hw * 64 * PS;
        f32x4 yo[4];
        { bf16x8_t hb[4];
#pragma unroll
          for (int m = 0; m < 4; ++m) { v4u o; o.x = pk2(hacc[2 * m][0], hacc[2 * m][1]); o.y = pk2(hacc[2 * m][2], hacc[2 * m][3]); o.z = pk2(hacc[2 * m + 1][0], hacc[2 * m + 1][1]); o.w = pk2(hacc[2 * m + 1][2], hacc[2 * m + 1][3]);
              hb[m] = __builtin_bit_cast(bf16x8_t, o); }
#pragma unroll
          for (int li = 0; li < 4; ++li) { yo[li] = (f32x4){0.f, 0.f, 0.f, 0.f};
#pragma unroll
              for (int m = 0; m < 4; ++m) { const LAS bf16* cp = Cm + (16 * li + fr) * PC + 32 * m + 4 * fq; const v2u c0 = *(const LAS v2u*)cp, c1 = *(const LAS v2u*)(cp + 16);
                  v4u xo; xo.x = c0.x; xo.y = c0.y; xo.z = c1.x; xo.w = c1.y; yo[li] = MFMA16(__builtin_bit_cast(bf16x8_t, xo), hb[m], yo[li]); } } }
        { const LAS float* WU = AC + 64; const float dec = __expf(AC[63]);
          bf16x8_t xs[2];
#pragma unroll
          for (int ss = 0; ss < 2; ++ss) { const v4u d = *(const LAS v4u*)(XT + (16 * pt + fr) * PS + ((32 * ss + 8 * fq) ^ (((2 * pt + (fr >> 3)) & 7) << 3)));
              const f32x4 wa = *(const LAS f32x4*)(WU + 32 * ss + 8 * fq), wb = *(const LAS f32x4*)(WU + 32 * ss + 8 * fq + 4);
              v4u o; o.x = pk2(bflo(d.x) * wa.x, bfhi(d.x) * wa.y); o.y = pk2(bflo(d.y) * wa.z, bfhi(d.y) * wa.w); o.z = pk2(bflo(d.z) * wb.x, bfhi(d.z) * wb.y); o.w = pk2(bflo(d.w) * wb.z, bfhi(d.w) * wb.w);
              xs[ss] = __builtin_bit_cast(bf16x8_t, o); }
#pragma unroll
          for (int j = 0; j < 8; ++j) { hacc[j] = hacc[j] * dec;
#pragma unroll
              for (int ss = 0; ss < 2; ++ss) hacc[j] = MFMA16(LDFRAG(BmT, 16 * j + fr, PS, (32 * ss + 8 * fq) ^ (((2 * j + (fr >> 3)) & 7) << 3)), xs[ss], hacc[j]); } }
        {
            const int li = wave >> 1, si0 = 2 * (wave & 1);
#pragma unroll
            for (int tt = 0; tt < 2; ++tt) { const int si = si0 + tt; f32x4 acc = (f32x4){0.f, 0.f, 0.f, 0.f};
                if (si <= li) {
#pragma unroll
                    for (int ks = 0; ks < 4; ++ks) acc = MFMA16(LDFRAG(Cm, 16 * li + fr, PC, 32 * ks + 8 * fq), LDFRAG(Bm, 16 * si + fr, PC, 32 * ks + 8 * fq), acc); }
                const int s = 16 * si + fr;
#pragma unroll
                for (int hh = 0; hh < 2; ++hh) { const LAS float* A2 = ACb + hh * 192; LAS bf16* Mm = Mm0 + hh * 64 * PS; const float acs = A2[s], dts = A2[128 + s];
#pragma unroll
                    for (int r = 0; r < 4; ++r) { const int l = 16 * li + 4 * fq + r; const float m = (s <= l) ? acc[r] * __expf(A2[l] - acs) * dts : 0.f; Mm[l * PS + s] = (bf16)f2bf(m); } } }
        }
        BAR_LDS();
        {
            const LAS bf16* Mm = Mm0 + hw * 64 * PS; const int h = h0 + hw; const float Dh = hw ? Dh1 : Dh0; const int p = 16 * pt + fr;
            bf16x8_t xf[2];
#pragma unroll
            for (int ss = 0; ss < 2; ++ss) xf[ss] = LDFRAG(XT, 16 * pt + fr, PS, (32 * ss + 8 * fq) ^ (((2 * pt + (fr >> 3)) & 7) << 3));
#pragma unroll
            for (int li = 0; li < 4; ++li) { f32x4 yd = (f32x4){0.f, 0.f, 0.f, 0.f};
#pragma unroll
                for (int ss = 0; ss < 2; ++ss) { if (ss == 1 && li < 2) continue;
                    yd = MFMA16(LDFRAG(Mm, 16 * li + fr, PS, 32 * ss + 8 * fq), xf[ss], yd); }
#pragma unroll
                for (int r = 0; r < 4; ++r) { const int l = 16 * li + 4 * fq + r; const float y = yd[r] + __expf(AC[l]) * yo[li][r] + Dh * bf1(XT[p * PS + (l ^ (((p >> 3) & 7) << 3))]);
                    const float z = bf1(zr[li][r]);
                    *(bf16*)((char*)YB + (unsigned)((rbase + l) * 1024u + h * 64 + p) * 2u) = (bf16)f2bf(y * siluf_(z)); } }
        }
    }
#pragma unroll
    for (int j = 0; j < 8; ++j) *(f32x4*)(sout0 + (size_t)hw * 8192 + (16 * pt + fr) * 128 + 16 * j + 4 * fq) = hacc[j];
    __syncthreads();
}

__device__ __forceinline__ unsigned cm_off_b(unsigned row, unsigned ch) { return 256u * row + 16u * (ch ^ (((row & 3u) << 2) | ((row >> 2) & 3u))); }
__device__ __forceinline__ unsigned cm_tr_addr(unsigned lane, unsigned c, unsigned ks, unsigned t) { const unsigned g = lane >> 4, q = (lane & 15) >> 2, p = lane & 3; return cm_off_b(32 * ks + 8 * g + 4 * t + q, 2 * c + (p >> 1)) + 8 * (p & 1); }
__device__ __forceinline__ void cmlp_mfma_item(LAS unsigned char* lds, int tid, int lane, int wave, bf16* P, bf16* YC, int row0, const float* ln_g, const float* ln_b, const float* wsl, const float* bsl) {
    constexpr int PW = 136;
    LAS bf16* Wb = (LAS bf16*)lds;
    LAS unsigned char* Vimg = lds + 34816;
    LAS bf16* OUTb = (LAS bf16*)(lds + 67584);
    LAS float* ST = (LAS float*)(lds + ST_OFF);
    const int fr = lane & 15, fq = lane >> 4;
    __syncthreads();
    v4u sa[4], sb[4];
    const unsigned cvo = (unsigned)(((unsigned)row0 + (unsigned)wave * 16u) * (unsigned)NPAD + OFF_CV + 16u * lane) * 2u;
#pragma unroll
    for (int j = 0; j < 4; ++j) { const v4u* p = (const v4u*)((const char*)P + cvo + (unsigned)j * (unsigned)(NPAD * 2)); sa[j] = p[0]; sb[j] = p[1]; }
#pragma unroll 1
    for (int ib = 0; ib < 4; ++ib) {
        v4u na[4], nb[4];
        if (ib < 3) {
#pragma unroll
            for (int j = 0; j < 4; ++j) { const v4u* p = (const v4u*)((const char*)P + cvo + (unsigned)(4 * ib + 4 + j) * (unsigned)(NPAD * 2)); na[j] = p[0]; nb[j] = p[1]; } }
#pragma unroll
        for (int j = 0; j < 4; ++j) { const int s = wave * 16 + 4 * ib + j; const v4u a = sa[j], b = sb[j];
            float v[16]; v[0] = bflo(a.x); v[1] = bfhi(a.x); v[2] = bflo(a.y); v[3] = bfhi(a.y); v[4] = bflo(a.z); v[5] = bfhi(a.z); v[6] = bflo(a.w); v[7] = bfhi(a.w);
            v[8] = bflo(b.x); v[9] = bfhi(b.x); v[10] = bflo(b.y); v[11] = bfhi(b.y); v[12] = bflo(b.z); v[13] = bfhi(b.z); v[14] = bflo(b.w); v[15] = bfhi(b.w);
            float sm = 0.f;
#pragma unroll
            for (int q = 0; q < 16; ++q) { v[q] = geluf_(v[q]); sm += v[q]; }
            v4u oa, ob; oa.x = pk2(v[0], v[1]); oa.y = pk2(v[2], v[3]); oa.z = pk2(v[4], v[5]); oa.w = pk2(v[6], v[7]); ob.x = pk2(v[8], v[9]); ob.y = pk2(v[10], v[11]); ob.z = pk2(v[12], v[13]); ob.w = pk2(v[14], v[15]);
            v4u* po = (v4u*)((char*)P + cvo + (unsigned)(4 * ib + j) * (unsigned)(NPAD * 2)); po[0] = oa; po[1] = ob;
            const float mean = wave_sum(sm) * (1.0f / 1024.0f); float sq = 0.f;
#pragma unroll
            for (int q = 0; q < 16; ++q) { const float d = v[q] - mean; sq += d * d; }
            const float rstd = rsqrtf_(wave_sum(sq) * (1.0f / 1024.0f) + NORM_EPS);
            if (lane == 0) { ST[2 * s] = mean; ST[2 * s + 1] = rstd; } }
        if (ib < 3) {
#pragma unroll
            for (int j = 0; j < 4; ++j) { sa[j] = na[j]; sb[j] = nb[j]; } }
    }
    __syncthreads();
    f32x4 wreg[8]; v2u vreg[8];
#pragma unroll
    for (int e = 0; e < 8; ++e) { const int q = tid + 512 * e; wreg[e] = *(const f32x4*)(wsl + (size_t)(q >> 5) * 128 + 4 * (q & 31)); vreg[e] = *(const v2u*)(P + (size_t)(row0 + (q >> 5)) * NPAD + OFF_CV + 4 * (q & 31)); }
    for (int gh = 0; gh < 8; ++gh) { const int g = gh >> 1, c0 = gh * 128;
        if ((gh & 1) == 0) {
#pragma unroll
            for (int e = 0; e < 8; ++e) { const int q = tid + 512 * e, t = q >> 5, s4 = 4 * (q & 31); const f32x4 w = wreg[e];
                v2u o; o.x = pk2(s4 + 0 <= t ? w.x : 0.f, s4 + 1 <= t ? w.y : 0.f); o.y = pk2(s4 + 2 <= t ? w.z : 0.f, s4 + 3 <= t ? w.w : 0.f); *(LAS v2u*)(Wb + t * PW + s4) = o; } }
#pragma unroll
        for (int e = 0; e < 8; ++e) { const int q = tid + 512 * e, sr = q >> 5, c4 = 4 * (q & 31); const v2u cv = vreg[e]; const float mean = ST[2 * sr], rstd = ST[2 * sr + 1];
            const f32x4 lg = *(const f32x4*)(ln_g + c0 + c4), lb = *(const f32x4*)(ln_b + c0 + c4);
            v2u o; o.x = pk2((bflo(cv.x) - mean) * rstd * lg.x + lb.x, (bfhi(cv.x) - mean) * rstd * lg.y + lb.y); o.y = pk2((bflo(cv.y) - mean) * rstd * lg.z + lb.z, (bfhi(cv.y) - mean) * rstd * lg.w + lb.w);
            *(LAS v2u*)(Vimg + cm_off_b((unsigned)sr, (unsigned)(c4 >> 3)) + 2 * (c4 & 7)) = o; }
        v4u ureg[4];
#pragma unroll
        for (int e = 0; e < 4; ++e) { const int q = tid + 512 * e; ureg[e] = *(const v4u*)(P + (size_t)(row0 + (q >> 4)) * NPAD + OFF_CU + c0 + 8 * (q & 15)); }
        if (gh + 1 < 8) {
#pragma unroll
            for (int e = 0; e < 8; ++e) { const int q = tid + 512 * e; vreg[e] = *(const v2u*)(P + (size_t)(row0 + (q >> 5)) * NPAD + OFF_CV + c0 + 128 + 4 * (q & 31)); }
            if (gh & 1) {
#pragma unroll
                for (int e = 0; e < 8; ++e) { const int q = tid + 512 * e; wreg[e] = *(const f32x4*)(wsl + ((size_t)(g + 1) * 128 + (q >> 5)) * 128 + 4 * (q & 31)); } } }
        BAR_LDS();
        { f32x4 acc[8];
#pragma unroll
            for (int ti = 0; ti < 8; ++ti) acc[ti] = (f32x4){0.f, 0.f, 0.f, 0.f};
            const unsigned vb = (unsigned)(size_t)Vimg;
#pragma unroll
            for (int ks = 0; ks < 4; ++ks) { v2u y0, y1;
                asm volatile("ds_read_b64_tr_b16 %0, %2\n\tds_read_b64_tr_b16 %1, %3\n\ts_waitcnt lgkmcnt(0)" : "=&v"(y0), "=&v"(y1) : "v"(vb + cm_tr_addr((unsigned)lane, (unsigned)wave, (unsigned)ks, 0u)), "v"(vb + cm_tr_addr((unsigned)lane, (unsigned)wave, (unsigned)ks, 1u)) : "memory");
                v4u yy; yy.x = y0.x; yy.y = y0.y; yy.z = y1.x; yy.w = y1.y; const bf16x8_t yf = __builtin_bit_cast(bf16x8_t, yy);
#pragma unroll
                for (int ti = 2 * ks; ti < 8; ++ti) acc[ti] = MFMA16(LDFRAG(Wb, 16 * ti + fr, PW, 32 * ks + 8 * fq), yf, acc[ti]); }
#pragma unroll
            for (int ti = 0; ti < 8; ++ti)
#pragma unroll
                for (int r = 0; r < 4; ++r) OUTb[(16 * ti + 4 * fq + r) * PW + 16 * wave + fr] = (bf16)f2bf(acc[ti][r]); }
        BAR_LDS();
#pragma unroll
        for (int e = 0; e < 4; ++e) { const int q = tid + 512 * e, t = q >> 4, c8 = 8 * (q & 15); const v4u o = *(const LAS v4u*)(OUTb + t * PW + c8); const v4u u = ureg[e]; const float bsv = bsl[g * 128 + t];
            v4u y; y.x = pk2(geluf_(bflo(u.x)) * (bflo(o.x) + bsv), geluf_(bfhi(u.x)) * (bfhi(o.x) + bsv)); y.y = pk2(geluf_(bflo(u.y)) * (bflo(o.y) + bsv), geluf_(bfhi(u.y)) * (bfhi(o.y) + bsv));
            y.z = pk2(geluf_(bflo(u.z)) * (bflo(o.z) + bsv), geluf_(bfhi(u.z)) * (bfhi(o.z) + bsv)); y.w = pk2(geluf_(bflo(u.w)) * (bflo(o.w) + bsv), geluf_(bfhi(u.w)) * (bfhi(o.w) + bsv));
            *(v4u*)(YC + (size_t)(row0 + t) * 1024 + c0 + c8) = y; }
    }
    __syncthreads();
}

__device__ __forceinline__ void cmlp_item(LAS unsigned char* lds, int tid, int lane, int wave, const bf16* P, bf16* YC, int row0, int Lc,
                                          const float* ln_g, const float* ln_b, const float* wsl, const float* bsl, float* vout) {
    LAS float* WT = (LAS float*)lds;
    LAS float* V = WT + 16384;
    LAS float* ST = (LAS float*)(lds + ST_OFF);
    __syncthreads();
    for (int i = 0; i < 16; ++i) { const int s = wave * 16 + i; if (s < Lc) {
            const v4u* p = (const v4u*)(P + (size_t)(row0 + s) * NPAD + OFF_CV + 16 * lane); const v4u a = p[0], b = p[1];
            float v[16]; v[0] = bflo(a.x); v[1] = bfhi(a.x); v[2] = bflo(a.y); v[3] = bfhi(a.y); v[4] = bflo(a.z); v[5] = bfhi(a.z); v[6] = bflo(a.w); v[7] = bfhi(a.w);
            v[8] = bflo(b.x); v[9] = bfhi(b.x); v[10] = bflo(b.y); v[11] = bfhi(b.y); v[12] = bflo(b.z); v[13] = bfhi(b.z); v[14] = bflo(b.w); v[15] = bfhi(b.w);
            float sm = 0.f;
#pragma unroll
            for (int j = 0; j < 16; ++j) { v[j] = geluf_(v[j]); sm += v[j]; }
            const float mean = wave_sum(sm) * (1.0f / 1024.0f); float sq = 0.f;
#pragma unroll
            for (int j = 0; j < 16; ++j) { const float d = v[j] - mean; sq += d * d; }
            const float rstd = 1.0f / sqrtf(wave_sum(sq) * (1.0f / 1024.0f) + NORM_EPS);
            if (lane == 0) { ST[2 * s] = mean; ST[2 * s + 1] = rstd; } } }
    const int tg = tid >> 4, cg = tid & 15;
    for (int g = 0; g < 4; ++g) {
        __syncthreads();
#pragma unroll 1
        for (int j = 0; j < 8; ++j) { const int e = tid + 512 * j, s4 = (e >> 7) * 4, t = e & 127;
            f32x4 w = (f32x4){0.f, 0.f, 0.f, 0.f}; if (t < Lc && s4 < Lc) w = *(const f32x4*)(wsl + ((size_t)g * 128 + t) * 128 + s4);
#pragma unroll
            for (int jj = 0; jj < 4; ++jj) WT[(s4 + jj) * 128 + t] = (s4 + jj <= t) ? w[jj] : 0.f; }
        for (int half = 0; half < 2; ++half) { const int c0 = g * 256 + half * 128;
            if (half) __syncthreads();
#pragma unroll 2
            for (int j = 0; j < 8; ++j) { const int e = tid + 512 * j, s = e >> 5, c4 = (e & 31) * 4;
                if (s < Lc) { const v2u cv = *(const v2u*)(P + (size_t)(row0 + s) * NPAD + OFF_CV + c0 + c4); const float mean = ST[2 * s], rstd = ST[2 * s + 1];
                    const f32x4 lg = *(const f32x4*)(ln_g + c0 + c4), lb = *(const f32x4*)(ln_b + c0 + c4);
                    f32x4 v; v.x = (geluf_(bflo(cv.x)) - mean) * rstd * lg.x + lb.x; v.y = (geluf_(bfhi(cv.x)) - mean) * rstd * lg.y + lb.y; v.z = (geluf_(bflo(cv.y)) - mean) * rstd * lg.z + lb.z; v.w = (geluf_(bfhi(cv.y)) - mean) * rstd * lg.w + lb.w;
                    *(LAS f32x4*)(V + s * 128 + c4) = v; if (vout) *(f32x4*)(vout + (size_t)s * 1024 + c0 + c4) = v; } }
            __syncthreads();
            float acc[4][8];
#pragma unroll
            for (int i = 0; i < 4; ++i)
#pragma unroll
                for (int j = 0; j < 8; ++j) acc[i][j] = 0.f;
            for (int s = 0; s < Lc; ++s) { const f32x4 w4 = *(const LAS f32x4*)(WT + s * 128 + 4 * tg), va = *(const LAS f32x4*)(V + s * 128 + 4 * cg), vb = *(const LAS f32x4*)(V + s * 128 + 64 + 4 * cg);
#pragma unroll
                for (int i = 0; i < 4; ++i) {
#pragma unroll
                    for (int j = 0; j < 4; ++j) { acc[i][j] = fmaf(w4[i], va[j], acc[i][j]); acc[i][4 + j] = fmaf(w4[i], vb[j], acc[i][4 + j]); } } }
#pragma unroll
            for (int i = 0; i < 4; ++i) { const int t = 4 * tg + i; if (t < Lc) { const size_t row = (size_t)(row0 + t); const float bsv = bsl[g * 128 + t];
                    const v2u ua = *(const v2u*)(P + row * NPAD + OFF_CU + c0 + 4 * cg), ub = *(const v2u*)(P + row * NPAD + OFF_CU + c0 + 64 + 4 * cg);
                    v2u oa, ob; oa.x = pk2(geluf_(bflo(ua.x)) * (acc[i][0] + bsv), geluf_(bfhi(ua.x)) * (acc[i][1] + bsv)); oa.y = pk2(geluf_(bflo(ua.y)) * (acc[i][2] + bsv), geluf_(bfhi(ua.y)) * (acc[i][3] + bsv));
                    ob.x = pk2(geluf_(bflo(ub.x)) * (acc[i][4] + bsv), geluf_(bfhi(ub.x)) * (acc[i][5] + bsv)); ob.y = pk2(geluf_(bflo(ub.y)) * (acc[i][6] + bsv), geluf_(bfhi(ub.y)) * (acc[i][7] + bsv));
                    *(v2u*)(YC + row * 1024 + c0 + 4 * cg) = oa; *(v2u*)(YC + row * 1024 + c0 + 64 + 4 * cg) = ob; } }
        }
    }
    __syncthreads();
}

#ifndef DOWN_REV
#define DOWN_REV 1
#endif
#ifndef EPI_ALIGN_HEAVY
#define EPI_ALIGN_HEAVY true
#endif
#ifndef TAIL_SPLIT
#define TAIL_SPLIT 1
#endif
#ifndef MK_N_LAUNCHES
#define MK_N_LAUNCHES 1
#endif
constexpr int PH_PER_LAYER = 10, N_PHASES = 2 + DEPTH * PH_PER_LAYER;
constexpr int Q_NITEMS = 128 + 128 + 256 + 256 + 512 + 32;
struct Args { const float* in[29]; float* out; unsigned char* ws; int ph_lo, ph_hi; };
static_assert(sizeof(Args) == 29 * 8 + 8 + 8 + 8, "no padding in Args");

typedef const __attribute__((address_space(4))) unsigned long long* karg_t;
__device__ __forceinline__ unsigned long long ldarg(int i) { karg_t p = (karg_t)__builtin_amdgcn_kernarg_segment_ptr(); asm volatile("" : "+s"(p)); return p[i]; }
#define INP(i) ((const float*)(const GAS float*)ldarg(i))
#define OUTP() ((float*)(GAS float*)ldarg(29))
#define WSP() ((unsigned char*)(GAS unsigned char*)ldarg(30))

__device__ __forceinline__ int tid_now(int wave_s) { int t = (int)__builtin_amdgcn_mbcnt_hi(~0u, __builtin_amdgcn_mbcnt_lo(~0u, 0u)); asm volatile("" : "+v"(t)); return t + 64 * wave_s; }
__global__ void __launch_bounds__(NWAVES * 64, 2) fwd(Args args) {
    extern __shared__ __attribute__((aligned(16))) unsigned char lds_raw[];
    LAS unsigned char* lds = (LAS unsigned char*)lds_raw;
    volatile LAS unsigned* MISC = (volatile LAS unsigned*)(lds + MISC_OFF);
    const int wave_s = __builtin_amdgcn_readfirstlane((int)threadIdx.x >> 6);
    for (int u = threadIdx.x; u < 64; u += NWAVES * 64) MISC[u] = 0u;
    __syncthreads();
    XcdBarrier bar = xcd_barrier_post((unsigned*)WSP() + CW_BAR, MISC + 8, (int)threadIdx.x);
    const int lo = args.ph_lo, hi = args.ph_hi;
#define IN(k) (lo <= (k) && (k) < hi)
#define SEAM(k) do { if (IN((k) + 1)) { XcdBarrier b2_ = bar; b2_.bar = (unsigned*)WSP() + CW_BAR; asm volatile("" : "+s"(b2_.x)); xcd_barrier(b2_, tid_now(wave_s)); } } while (0)
#define GEOM() int tid = tid_now(wave_s); asm volatile("" : "+v"(tid)); int G = gridDim.x, bx = blockIdx.x; asm volatile("" : "+s"(G), "+s"(bx)); \
    const int lane = tid & 63, wave = __builtin_amdgcn_readfirstlane(tid >> 6); \
    const int vcu = (G % 8 == 0) ? (bx % 8) * (G / 8) + bx / 8 : bx; const int gw = vcu * NWAVES + wave, NGW = G * NWAVES; (void)lane; (void)gw; (void)NGW; (void)wave; (void)tid

    if (IN(0)) { GEOM();
        for (int it = bx; it < DEPTH * 96; it += G) mod_item(lds, tid, it, INP(5), INP(6), INP(9), INP(10), (float*)(WSP() + WS_MOD));
        { unsigned char* ws = WSP(); cvt_phase<true>(lds, wave, lane, 0, 0, 0, INP(11), INP(24), INP(25), INP(26), INP(27), ws + wofs(0), (unsigned*)ws + CW_QC); }
        SEAM(0);
    }
    for (int lc = 0; lc < DEPTH; ++lc) {
        const int pb = 1 + PH_PER_LAYER * lc;
        if (IN(pb + 0)) { GEOM(); int l = lc; asm volatile("" : "+s"(l)); unsigned char* ws = WSP(); bf16* X = (bf16*)(ws + WS_X);
            const bool comb = TAIL_SPLIT && l > 0; if (comb) build_tail_map((LAS int*)lds, tid, G, DOWN_REV);
            const float* modl = (const float*)(ws + WS_MOD) + (size_t)l * NSEQ * 12288;
            if (l == 0) norm_mod_phase<true>(lane, gw, NGW, INP(0), INP(1), X, INP(7), modl, 0, 1, (bf16*)(ws + WS_H), false, (const LAS int*)lds, (const float*)(ws + WS_SLAB), false);
            else norm_mod_phase<false>(lane, gw, NGW, nullptr, nullptr, X, INP(7) + l * DM, modl, 0, 1, (bf16*)(ws + WS_H), comb, (const LAS int*)lds, (const float*)(ws + WS_SLAB), false);
            SEAM(pb + 0);
        }
        if (IN(pb + 1)) { unsigned char* ws = WSP(); const int G = gridDim.x, bx = blockIdx.x;
            pg8::Gemm g{(const bf16*)(ws + WS_H), (const bf16*)(ws + wofs(lc) + WS_WIN), MT, NPAD, DM, DM}; pg8::StaticOrder S; S.init(MT, NPAD, G, bx);
            pg8::EpiStore<0> E{(bf16*)(ws + WS_P), NPAD};
#ifndef REP_P1
#define REP_P1 1
#endif
#pragma unroll 1
            for (int rp = 0; rp < REP_P1; ++rp)
#ifndef WIN_B_AUX
#define WIN_B_AUX 0
#endif
#ifdef SPLIT_WIN
            { S.nlim = (S.nwg / (2 * G)) * G; pg8::gemm_phase<pg8::EpiStore<0>, pg8::StaticOrder, true, true, 0, WIN_B_AUX>(lds, g, S, E, tid_now(wave_s));
              { XcdBarrier b2_ = bar; b2_.bar = (unsigned*)WSP() + CW_BAR; asm volatile("" : "+s"(b2_.x)); xcd_barrier(b2_, tid_now(wave_s)); }
              S.off = S.nlim; S.nlim = S.nwg; }
#endif
            pg8::gemm_phase<pg8::EpiStore<0>, pg8::StaticOrder, true, true, 0, WIN_B_AUX>(lds, g, S, E, tid_now(wave_s));
            SEAM(pb + 1);
        }
        if (IN(pb + 2)) { GEOM(); int l = lc; asm volatile("" : "+s"(l)); unsigned char* ws = WSP(); float* out = OUTP();
#ifndef REP_P2
#define REP_P2 1
#endif
#pragma unroll 1
            for (int rp = 0; rp < REP_P2; ++rp)
            ssd_pre_phase(lane, gw, NGW, (const bf16*)(ws + WS_P), (bf16*)(ws + WS_XC), (float*)(ws + WS_DT), (float*)(ws + WS_DT + DT_ARR), (float*)(ws + WS_DT + 2 * DT_ARR),
                          INP(14) + (size_t)l * 4 * 1536, INP(15) + l * 1536, INP(16) + l * 16, INP(17) + l * 16, INP(4) + (size_t)l * 32 * 4608, out + OUT_CONV_P + (size_t)l * 16 * 4608, out + OUT_CONV_S + (size_t)l * 32 * 4608);
            SEAM(pb + 2);
        }
        if (IN(pb + 3)) { GEOM(); int l = lc; asm volatile("" : "+s"(l));
#ifndef MIX_REPS
#define MIX_REPS 1
#endif
#pragma unroll 1
            for (int rep = 0; rep < MIX_REPS; ++rep)
            for (;;) {
                unsigned char* ws = WSP(); float* out = OUTP(); bf16* Pb = (bf16*)(ws + WS_P); bf16* Y3 = (bf16*)(ws + WS_Y3);
                __syncthreads();
                if (tid_now(wave_s) == 0) MISC[0] = __hip_atomic_fetch_add((unsigned*)ws + CW_Q + 64 * (l + 4 * rep), 1u, __ATOMIC_RELAXED, __HIP_MEMORY_SCOPE_AGENT);
                __syncthreads();
                int it = (int)MISC[0];
#ifdef EXTRA_BASE
                if (it >= Q_NITEMS && it < Q_NITEMS + EXTRA_N) it = EXTRA_BASE + (it - Q_NITEMS);
#endif
                if (it >= Q_NITEMS) break;
                it = it < 256 ? it : (it < 288 ? it + 1024 : it - 32);
#define ITEM_GEOM() int tid_i = tid_now(wave_s); asm volatile("" : "+v"(tid_i)); const int lane_i = tid_i & 63, wave_i = __builtin_amdgcn_readfirstlane(tid_i >> 6)
                if (it < 128) {
                    const int b = 15 - (it >> 3), h = it & 7;
                    ITEM_GEOM(); hgrn_mfma_item(lds, tid_i, lane_i, wave_i, Pb, Y3, b * 2048, h, l, out + OUT_HGRN_P + (((size_t)l * 16 + b) * 8 + h) * 16384, INP(12), INP(13) + l * 1024);
                } else if (it < 256) {
                    const int j = it - 128, b = 15 - (j >> 3), h0 = 2 * (j & 7);
                    ITEM_GEOM(); ssd_mfma_pair(lds, tid_i, lane_i, wave_i, Pb, (const bf16*)(ws + WS_XC), (const float*)(ws + WS_DT), (const float*)(ws + WS_DT + 2 * DT_ARR), Y3 + (size_t)MT * 1024, b * 2048, h0, INP(18)[l * 16 + h0], INP(18)[l * 16 + h0 + 1],
                                  out + OUT_SSM_P + (((size_t)l * 16 + b) * 16 + h0) * 8192);
                } else if (it < 512) {
                    ITEM_GEOM(); cmlp_mfma_item(lds, tid_i, lane_i, wave_i, Pb, Y3 + (size_t)2 * MT * 1024, (255 - (it - 256)) * 128, INP(20) + l * 1024, INP(21) + l * 1024, INP(22) + (size_t)l * 4 * 16384, INP(23) + l * 512);
                } else if (it < 768) {
                    const int j = it - 512, b = j >> 3, h = j & 7;
                    ITEM_GEOM(); hgrn_item(lds, tid_i, lane_i, wave_i, Pb, Y3, NTOK_P + b * 32, 32, h, l, INP(2) + (((size_t)l * 32 + b) * 8 + h) * 16384, out + OUT_HGRN_S + (((size_t)l * 32 + b) * 8 + h) * 16384, INP(12), INP(13) + l * 1024);
                } else if (it < 1280) {
                    const int j = it - 768, b = j >> 4, h = j & 15;
                    ITEM_GEOM(); ssd_item(lds, tid_i, lane_i, wave_i, Pb, (const bf16*)(ws + WS_XC), (const float*)(ws + WS_DT), (const float*)(ws + WS_DT + DT_ARR), Y3 + (size_t)MT * 1024, NTOK_P + b * 32, 32, h,
                             INP(3) + (((size_t)l * 32 + b) * 16 + h) * 8192, out + OUT_SSM_S + (((size_t)l * 32 + b) * 16 + h) * 8192, INP(18)[l * 16 + h]);
                } else {
                    const int j = it - 1280;
                    ITEM_GEOM(); cmlp_item(lds, tid_i, lane_i, wave_i, Pb, Y3 + (size_t)2 * MT * 1024, NTOK_P + j * 32, 32, INP(20) + l * 1024, INP(21) + l * 1024, INP(22) + (size_t)l * 4 * 16384, INP(23) + l * 512, out + OUT_V_S + ((size_t)l * 32 + j) * 32 * 1024);
                }
            }
            SEAM(pb + 3);
        }
        if (IN(pb + 4)) { GEOM(); int l = lc; asm volatile("" : "+s"(l)); ssd_norm_phase(lane, gw, NGW, (bf16*)(WSP() + WS_Y3) + (size_t)MT * 1024, INP(19) + l * 1024); SEAM(pb + 4); }
        if (IN(pb + 5)) { unsigned char* ws = WSP(); const int G = gridDim.x, bx = blockIdx.x;
            pg8::Gemm g{(const bf16*)(ws + WS_Y3), (const bf16*)(ws + wofs(lc) + WS_WBR), 3 * MT, 3 * DM, 1024, 1024}; pg8::BranchOrder S; S.init(MT / 256, DM / 256, G, bx);
            pg8::EpiBranch E{(const bf16*)(ws + WS_P), NPAD, OFF_GATE, (bf16*)(ws + WS_H), DM, MT / 256, DM / 256};
#ifndef STAGGER_BR
#define STAGGER_BR 0
#endif
            if (STAGGER_BR && ((bx >> 3) & 1)) { for (int i = 0; i < STAGGER_BR; ++i) __builtin_amdgcn_s_sleep(127); }
#ifndef REP_P5
#define REP_P5 1
#endif
#pragma unroll 1
            for (int rp = 0; rp < REP_P5; ++rp)
            pg8::gemm_phase<pg8::EpiBranch, pg8::BranchOrder, EPI_ALIGN_HEAVY, true>(lds, g, S, E, tid_now(wave_s));
            if (lc + 1 < DEPTH) {
                GEOM(); int l1 = lc + 1; asm volatile("" : "+s"(l1)); unsigned char* ws2 = WSP();
                cvt_phase<true>(lds, wave, lane, 0, 0, l1, INP(11), INP(24), INP(25), INP(26), INP(27), ws2 + wofs(l1), (unsigned*)ws2 + CW_QC + 64 * l1);
#ifdef REP_CVT
                cvt_phase<true>(lds, wave, lane, 0, 0, l1, INP(11), INP(24), INP(25), INP(26), INP(27), ws2 + wofs(l1), (unsigned*)ws2 + CW_QC + 64 * (l1 + 4));
#endif
            }
            SEAM(pb + 5);
        }
        if (IN(pb + 6)) { int l = lc; asm volatile("" : "+s"(l)); unsigned char* ws = WSP(); bf16* X = (bf16*)(ws + WS_X); const int G = gridDim.x, bx = blockIdx.x;
            pg8::StaticOrder S; S.init(MT, DM, G, bx); S.wgm = WGM_N8; const int nfull = TAIL_SPLIT ? tail_nfull(S.nwg, G) : S.nwg; S.nlim = nfull;
            const float* gm = (const float*)(ws + WS_MOD) + (size_t)l * NSEQ * 12288 + 2 * DM;
            { pg8::Gemm g{(const bf16*)(ws + WS_H), (const bf16*)(ws + wofs(lc) + WS_WOUT), MT, DM, DM, DM};
#ifdef REP_P6
              { pg8::EpiRes E0{X, (const float*)(ws + 524288), 0}; pg8::gemm_phase<pg8::EpiRes, pg8::StaticOrder, EPI_ALIGN_HEAVY, true>(lds, g, S, E0, tid_now(wave_s)); }
#endif
              pg8::EpiRes E{X, gm, 12288};
              pg8::gemm_phase<pg8::EpiRes, pg8::StaticOrder, EPI_ALIGN_HEAVY, true>(lds, g, S, E, tid_now(wave_s)); }
            if (TAIL_SPLIT) { pg8::Gemm g{(const bf16*)(ws + WS_H), (const bf16*)(ws + wofs(lc) + WS_WOUT), MT, DM, DM / 8, DM}; pg8::TailOrder T; T.init(S, nfull, 8, DM / 8);
              pg8::EpiSlab E{(float*)(ws + WS_SLAB), gm};
              pg8::gemm_phase<pg8::EpiSlab, pg8::TailOrder, true, true>(lds, g, T, E, tid_now(wave_s)); }
            SEAM(pb + 6);
        }
        if (IN(pb + 7)) { GEOM(); int l = lc; asm volatile("" : "+s"(l)); unsigned char* ws = WSP(); bf16* X = (bf16*)(ws + WS_X);
            if (TAIL_SPLIT) build_tail_map((LAS int*)lds, tid, G, 0);
#ifdef REP_N7
            norm_mod_phase<false>(lane, gw, NGW, nullptr, nullptr, X, INP(8) + l * DM, (const float*)(ws + WS_MOD) + (size_t)l * NSEQ * 12288, 3, 4, (bf16*)(ws + WS_H), false, (const LAS int*)lds, (const float*)(ws + WS_SLAB), true);
#endif
            norm_mod_phase<false>(lane, gw, NGW, nullptr, nullptr, X, INP(8) + l * DM, (const float*)(ws + WS_MOD) + (size_t)l * NSEQ * 12288, 3, 4, (bf16*)(ws + WS_H), TAIL_SPLIT != 0, (const LAS int*)lds, (const float*)(ws + WS_SLAB), true); SEAM(pb + 7); }
        if (IN(pb + 8)) { unsigned char* ws = WSP(); const int G = gridDim.x, bx = blockIdx.x;
            pg8::Gemm g{(const bf16*)(ws + WS_H), (const bf16*)(ws + wofs(lc) + WS_WUP), MT, DFF, DM, DM}; pg8::StaticOrder S; S.init(MT, DFF, G, bx);
            pg8::EpiStore<1> E{(bf16*)(ws + WS_P), DFF};
#ifndef REP_P8
#define REP_P8 1
#endif
#pragma unroll 1
            for (int rp = 0; rp < REP_P8; ++rp)
            pg8::gemm_phase<pg8::EpiStore<1>, pg8::StaticOrder, true, true, 0, WIN_B_AUX>(lds, g, S, E, tid_now(wave_s));
            SEAM(pb + 8);
        }
        if (IN(pb + 9)) { int l = lc; asm volatile("" : "+s"(l)); unsigned char* ws = WSP(); bf16* X = (bf16*)(ws + WS_X); const int G = gridDim.x, bx = blockIdx.x;
            pg8::StaticOrder S; S.init(MT, DM, G, bx); S.wgm = WGM_N8; S.rev = DOWN_REV; const int nfull = TAIL_SPLIT ? tail_nfull(S.nwg, G) : S.nwg; S.nlim = nfull;
            const float* gm = (const float*)(ws + WS_MOD) + (size_t)l * NSEQ * 12288 + 5 * DM;
            { pg8::Gemm g{(const bf16*)(ws + WS_P), (const bf16*)(ws + wofs(lc) + WS_WDN), MT, DM, DFF, DFF};
#ifdef REP_P9
              { pg8::EpiRes E0{X, (const float*)(ws + 524288), 0}; pg8::gemm_phase<pg8::EpiRes, pg8::StaticOrder, EPI_ALIGN_HEAVY, true>(lds, g, S, E0, tid_now(wave_s)); }
#endif
              pg8::EpiRes E{X, gm, 12288};
#ifndef DOWN_A_AUX
#define DOWN_A_AUX 0
#endif
              pg8::gemm_phase<pg8::EpiRes, pg8::StaticOrder, EPI_ALIGN_HEAVY, true, DOWN_A_AUX>(lds, g, S, E, tid_now(wave_s)); }
            if (TAIL_SPLIT) { pg8::Gemm g{(const bf16*)(ws + WS_P), (const bf16*)(ws + wofs(lc) + WS_WDN), MT, DM, DFF / 8, DFF}; pg8::TailOrder T; T.init(S, nfull, 8, DFF / 8);
              pg8::EpiSlab E{(float*)(ws + WS_SLAB), gm};
              pg8::gemm_phase<pg8::EpiSlab, pg8::TailOrder, true, true>(lds, g, T, E, tid_now(wave_s)); }
            SEAM(pb + 9);
        }
    }
    if (IN(N_PHASES - 1)) { GEOM(); unsigned char* ws = WSP(); if (TAIL_SPLIT) build_tail_map((LAS int*)lds, tid, G, DOWN_REV);
        final_norm_phase(lane, gw, NGW, (const bf16*)(ws + WS_X), OUTP(), INP(28), TAIL_SPLIT != 0, (const LAS int*)lds, (const float*)(ws + WS_SLAB)); }
#undef IN
#undef SEAM
#undef GEOM
}

extern "C" void kernel_launch(void* const* d_in, const int* in_sizes, int n_in, void* d_out, int out_size, void* d_ws, size_t ws_size, hipStream_t stream) {
    static int grid = 0;
    if (grid == 0) {
        if (n_in != 29 || (size_t)out_size != OUT_TOTAL || ws_size < WS_END) { fprintf(stderr, "kernel_launch: unexpected shapes: n_in %d out %d ws %zu (need %zu)\n", n_in, out_size, ws_size, (size_t)WS_END); grid = -1; return; }
        int dev = 0, cus = 0, per_cu = 0;
        if (hipGetDevice(&dev) != hipSuccess || hipDeviceGetAttribute(&cus, hipDeviceAttributeMultiprocessorCount, dev) != hipSuccess) { grid = -1; return; }
        if (hipFuncSetAttribute((const void*)fwd, hipFuncAttributeMaxDynamicSharedMemorySize, LDS_BYTES) != hipSuccess) { fprintf(stderr, "kernel_launch: hipFuncSetAttribute failed\n"); grid = -1; return; }
        if (hipOccupancyMaxActiveBlocksPerMultiprocessor(&per_cu, (const void*)fwd, NWAVES * 64, LDS_BYTES) != hipSuccess || per_cu < 1) fprintf(stderr, "kernel_launch: occupancy query says %d\n", per_cu);
        (void)hipGetLastError();
        grid = cus;
    }
    if (grid < 0) return;
    if (hipMemsetAsync((char*)d_ws + WS_CTL, 0, CTL_ZERO_BYTES, stream) != hipSuccess) return;
    Args a{};
    for (int i = 0; i < 29; ++i) a.in[i] = (const float*)d_in[i];
    a.out = (float*)d_out; a.ws = (unsigned char*)d_ws;
#if MK_N_LAUNCHES == 1
    a.ph_lo = 0; a.ph_hi = N_PHASES;
    hipLaunchKernelGGL(fwd, dim3(grid), dim3(NWAVES * 64), LDS_BYTES, stream, a);
#else
    for (int p = 0; p < N_PHASES; ++p) { a.ph_lo = p; a.ph_hi = p + 1; hipLaunchKernelGGL(fwd, dim3(grid), dim3(NWAVES * 64), LDS_BYTES, stream, a); }
#endif
}
```
